# Optimizing an MI355X kernel written in HIP

```python
import math
import jax, jax.numpy as jnp
from jax import lax
import numpy as np

D_MODEL = 1024
BATCH = 8
SEQ = 4096
DEPTH = 1

GRID_W = 64
CTX_LEN = 256
N_MOD = 9
D_FF = 2816
EPS = 1e-6
SSD_HEADS = 8
SSD_HEAD_DIM = 64
SSD_WIDTH = SSD_HEADS * SSD_HEAD_DIM
SSD_GROUPS = 2
SSD_STATE = 128
SSD_CONV = 5
SSD_CHUNK = 128
N_DIR = 2
CONV_CH = SSD_WIDTH + 2 * SSD_GROUPS * SSD_STATE
MLA_HEADS = 8
QK_NOPE = 64
QK_ROPE = 32
V_DIM = 64
Q_LORA = 768
KV_LORA = 256
MLA_WIDTH = MLA_HEADS * V_DIM
MLA_SCALE = (QK_NOPE + QK_ROPE) ** -0.5
ROPE_BASE = 10000.0
Q_BLOCK = 128
MIX_WIDTH = SSD_WIDTH + MLA_WIDTH
SPLIT_Z = SSD_WIDTH
SPLIT_XBC = SPLIT_Z + CONV_CH
SPLIT_DT = SPLIT_XBC + N_DIR * SSD_HEADS
SPLIT_CQ = SPLIT_DT + Q_LORA
SPLIT_CKV = SPLIT_CQ + KV_LORA
IN_DIM = SPLIT_CKV + QK_ROPE
IN_SPLITS = (SPLIT_Z, SPLIT_XBC, SPLIT_DT, SPLIT_CQ, SPLIT_CKV)

kernel_name = 'hymba_ssd_mla_macaron_dit'

F32 = jnp.float32


def rmsnorm(x, g):
    xf = x.astype(F32)
    y = xf * lax.rsqrt(jnp.mean(xf * xf, axis=-1, keepdims=True) + EPS)
    return y.astype(x.dtype) * g


def modulate(h, shift, scale):
    return h * (1 + scale) + shift


def swiglu(h, w_in, w_out):
    gate, up = jnp.split(h @ w_in, 2, axis=-1)
    return (jax.nn.silu(gate) * up) @ w_out


def ffn_half_step(h, m, k, norm_g, w_in, w_out):
    hn = modulate(rmsnorm(h, norm_g), m[:, :, k], m[:, :, k + 1])
    return h + 0.5 * m[:, :, k + 2] * swiglu(hn, w_in, w_out)


def _flip(t):
    return jnp.flip(t, axis=1)


def dwconv_centred(u, w, b):
    y = lax.conv_general_dilated(u, w[:, None, :], window_strides=(1,),
                                 padding=((SSD_CONV // 2, SSD_CONV // 2),),
                                 dimension_numbers=('NWC', 'WIO', 'NWC'),
                                 feature_group_count=u.shape[-1])
    return y + b


def ssd_inputs(xbc, dt_raw, conv_w, conv_b, dt_bias):
    b, L, _ = xbc.shape
    xbc = jax.nn.silu(dwconv_centred(xbc, conv_w, conv_b))
    xs, bm, cm = jnp.split(xbc, [SSD_WIDTH, SSD_WIDTH + SSD_GROUPS * SSD_STATE], axis=-1)
    xh = xs.reshape(b, L, SSD_HEADS, SSD_HEAD_DIM)
    bm = bm.reshape(b, L, SSD_GROUPS, SSD_STATE)
    cm = cm.reshape(b, L, SSD_GROUPS, SSD_STATE)
    dt = jax.nn.softplus(dt_raw.astype(F32).reshape(b, L, N_DIR, SSD_HEADS) + dt_bias.astype(F32))
    return xh, bm, cm, dt


def ssd_scan(xh, dt, a_neg, bm, cm, h0):
    b, L, H, P = xh.shape
    G, N = bm.shape[-2:]
    HG = H // G
    Q = SSD_CHUNK
    nc = L // Q
    xdt = (xh.astype(F32) * dt[..., None]).reshape(b, nc, Q, G, HG, P)
    a = (dt * a_neg).reshape(b, nc, Q, G, HG)
    a_cum = jnp.cumsum(jnp.moveaxis(a, 2, -1), axis=-1)
    bc = bm.astype(F32).reshape(b, nc, Q, G, N)
    cc = cm.astype(F32).reshape(b, nc, Q, G, N)
    seg = a_cum[..., :, None] - a_cum[..., None, :]
    lower = jnp.tril(jnp.ones((Q, Q), dtype=bool))
    decay_in = jnp.exp(jnp.where(lower, seg, -jnp.inf))
    cb = jnp.einsum('bcign,bcjgn->bcgij', cc, bc)
    y_diag = jnp.einsum('bcghij,bcjghp->bcighp', cb[:, :, :, None] * decay_in, xdt)
    decay_end = jnp.moveaxis(jnp.exp(a_cum[..., -1:] - a_cum), -1, 2)
    states = jnp.einsum('bcjgn,bcjghp->bcghpn', bc, xdt * decay_end[..., None])
    chunk_decay = jnp.exp(a_cum[..., -1])

    def step(h, inp):
        dec, st = inp
        return dec[..., None, None] * h + st, h

    h_last, h_enter = lax.scan(step, h0.reshape(b, G, HG, P, N),
                               (jnp.moveaxis(chunk_decay, 1, 0), jnp.moveaxis(states, 1, 0)))
    h_enter = jnp.moveaxis(h_enter, 0, 1)
    decay_from_start = jnp.moveaxis(jnp.exp(a_cum), -1, 2)
    y_off = jnp.einsum('bcign,bcghpn->bcighp', cc, h_enter) * decay_from_start[..., None]
    y = (y_diag + y_off).reshape(b, L, H, P)
    return y, h_last.reshape(b, H, P, N)


def ssd_merge(y_fwd, y_bwd, xh, z, d_skip, ssd_norm):
    b, L = xh.shape[:2]
    y = y_fwd + y_bwd + d_skip[:, None] * xh
    return rmsnorm(y.reshape(b, L, SSD_WIDTH) * jax.nn.silu(z), ssd_norm)


def axial_rope(t, row, col):
    half = QK_ROPE // 2
    inv = ROPE_BASE ** (-jnp.arange(0, half, 2, dtype=F32) / half)

    def rot(u, pos):
        ang = pos.astype(F32)[:, None] * inv
        cos = jnp.cos(ang)[:, None, :].astype(u.dtype)
        sin = jnp.sin(ang)[:, None, :].astype(u.dtype)
        u1, u2 = jnp.split(u, 2, axis=-1)
        return jnp.concatenate([u1 * cos - u2 * sin, u1 * sin + u2 * cos], axis=-1)

    t_row, t_col = jnp.split(t, 2, axis=-1)
    return jnp.concatenate([rot(t_row, row), rot(t_col, col)], axis=-1)


def mla_project(c_q, c_kv, k_pe, q_norm, w_uq, kv_norm, w_ukv, row, col):
    b, L, _ = c_q.shape
    q = (rmsnorm(c_q, q_norm) @ w_uq).reshape(b, L, MLA_HEADS, QK_NOPE + QK_ROPE)
    kv = (rmsnorm(c_kv, kv_norm) @ w_ukv).reshape(b, L, MLA_HEADS, QK_NOPE + V_DIM)
    q_nope, q_pe = jnp.split(q, [QK_NOPE], axis=-1)
    k_nope, v = jnp.split(kv, [QK_NOPE], axis=-1)
    k_pe = k_pe[:, :, None, :]
    if row is not None:
        q_pe = axial_rope(q_pe, row, col)
        k_pe = axial_rope(k_pe, row, col)
    q = jnp.concatenate([q_nope, q_pe], axis=-1)
    k = jnp.concatenate([k_nope, jnp.broadcast_to(k_pe, (b, L, MLA_HEADS, QK_ROPE))], axis=-1)
    return q, k, v


def softmax_attend(q, k, v):
    s = jnp.einsum('bqhd,bkhd->bhqk', q, k).astype(F32) * MLA_SCALE
    p = jax.nn.softmax(s, axis=-1).astype(v.dtype)
    return jnp.einsum('bhqk,bkhd->bqhd', p, v)


def hybrid_mixer(hx, hc, w_in, conv_w, conv_b, dt_bias, a_log, d_skip, ssd_norm,
                 q_norm, w_uq, kv_norm, w_ukv, w_out, need_ctx):
    b, L, _ = hx.shape
    cl = hc.shape[1]
    rows = L // GRID_W
    row = jnp.repeat(jnp.arange(rows, dtype=jnp.int32), GRID_W)
    col = jnp.arange(rows * GRID_W, dtype=jnp.int32) % GRID_W

    z_x, xbc_x, dt_x, cq_x, ckv_x, kpe_x = jnp.split(hx @ w_in, IN_SPLITS, axis=-1)
    z_c, xbc_c, dt_c, cq_c, ckv_c, kpe_c = jnp.split(hc @ w_in, IN_SPLITS, axis=-1)

    xh_x, bm_x, cm_x, dtv_x = ssd_inputs(xbc_x, dt_x, conv_w, conv_b, dt_bias)
    xh_c, bm_c, cm_c, dtv_c = ssd_inputs(xbc_c, dt_c, conv_w, conv_b, dt_bias)
    a_neg = -jnp.exp(a_log.astype(F32))
    h0 = jnp.zeros((b, SSD_HEADS, SSD_HEAD_DIM, SSD_STATE), F32)
    yf_c, hf = ssd_scan(xh_c, dtv_c[:, :, 0], a_neg[0], bm_c, cm_c, h0)
    yf_x, _ = ssd_scan(xh_x, dtv_x[:, :, 0], a_neg[0], bm_x, cm_x, hf)
    yb_c, hb = ssd_scan(_flip(xh_c), _flip(dtv_c[:, :, 1]), a_neg[1], _flip(bm_c), _flip(cm_c), h0)
    yb_x, _ = ssd_scan(_flip(xh_x), _flip(dtv_x[:, :, 1]), a_neg[1], _flip(bm_x), _flip(cm_x), hb)
    ssd_x = ssd_merge(yf_x, _flip(yb_x), xh_x, z_x, d_skip, ssd_norm)

    q_x, k_x, v_x = mla_project(cq_x, ckv_x, kpe_x, q_norm, w_uq, kv_norm, w_ukv, row, col)
    q_c, k_c, v_c = mla_project(cq_c, ckv_c, kpe_c, q_norm, w_uq, kv_norm, w_ukv, None, None)
    k_all = jnp.concatenate([k_c, k_x], axis=1)
    v_all = jnp.concatenate([v_c, v_x], axis=1)
    nb = L // Q_BLOCK
    q_blocks = jnp.swapaxes(q_x.reshape(b, nb, Q_BLOCK, MLA_HEADS, QK_NOPE + QK_ROPE), 0, 1)
    o_blocks = lax.map(lambda qb: softmax_attend(qb, k_all, v_all), q_blocks)
    mla_x = jnp.swapaxes(o_blocks, 0, 1).reshape(b, L, MLA_WIDTH)

    y_x = jnp.concatenate([ssd_x, mla_x], axis=-1) @ w_out
    if need_ctx:
        ssd_c = ssd_merge(yf_c, _flip(yb_c), xh_c, z_c, d_skip, ssd_norm)
        mla_c = softmax_attend(q_c, k_c, v_c).reshape(b, cl, MLA_WIDTH)
        y_c = jnp.concatenate([ssd_c, mla_c], axis=-1) @ w_out
        return y_x, y_c
    return y_x, None


def setup_inputs(seed: int = 0) -> dict:
    key = jax.random.key(seed)
    ks = jax.random.split(key, 28)

    def nrm(k, shape, scale):
        return jax.random.normal(k, shape, F32) * scale

    def gain(k, shape):
        return 1.0 + 0.02 * jax.random.normal(k, shape, F32)

    dt0 = jnp.exp(jax.random.uniform(ks[11], (DEPTH, N_DIR, SSD_HEADS), F32,
                                     math.log(1e-3), math.log(1e-1)))
    in_col_scale = jnp.ones((IN_DIM,), F32).at[SPLIT_XBC:SPLIT_DT].set(0.1)
    return {
        'x': nrm(ks[0], (BATCH, SEQ, D_MODEL), 1.0),
        'c': nrm(ks[1], (BATCH, D_MODEL), 1.0),
        'ctx': nrm(ks[2], (BATCH, CTX_LEN, D_MODEL), 1.0),
        'c_ctx': nrm(ks[3], (D_MODEL,), 1.0),
        'w_ada': nrm(ks[4], (DEPTH, D_MODEL, N_MOD * D_MODEL), 0.5 * D_MODEL ** -0.5),
        'b_ada': nrm(ks[5], (DEPTH, N_MOD * D_MODEL), 0.02),
        'norm_ffn1': gain(ks[6], (DEPTH, D_MODEL)),
        'w_ffn1_in': nrm(ks[7], (DEPTH, D_MODEL, 2 * D_FF), D_MODEL ** -0.5),
        'w_ffn1_out': nrm(ks[8], (DEPTH, D_FF, D_MODEL), D_FF ** -0.5),
        'norm_mix': gain(ks[9], (DEPTH, D_MODEL)),
        'w_in': nrm(ks[10], (DEPTH, D_MODEL, IN_DIM), D_MODEL ** -0.5) * in_col_scale,
        'conv_w': nrm(ks[12], (DEPTH, SSD_CONV, CONV_CH), SSD_CONV ** -0.5),
        'conv_b': nrm(ks[13], (DEPTH, CONV_CH), 0.02),
        'dt_bias': dt0 + jnp.log(-jnp.expm1(-dt0)),
        'a_log': jnp.log(jax.random.uniform(ks[14], (DEPTH, N_DIR, SSD_HEADS), F32, 1.0, 16.0)),
        'd_skip': gain(ks[15], (DEPTH, SSD_HEADS)),
        'ssd_norm': gain(ks[16], (DEPTH, SSD_WIDTH)),
        'q_norm': gain(ks[17], (DEPTH, Q_LORA)),
        'w_uq': nrm(ks[18], (DEPTH, Q_LORA, MLA_HEADS * (QK_NOPE + QK_ROPE)), Q_LORA ** -0.5),
        'kv_norm': gain(ks[19], (DEPTH, KV_LORA)),
        'w_ukv': nrm(ks[20], (DEPTH, KV_LORA, MLA_HEADS * (QK_NOPE + V_DIM)), KV_LORA ** -0.5),
        'w_out': nrm(ks[21], (DEPTH, MIX_WIDTH, D_MODEL), MIX_WIDTH ** -0.5),
        'norm_ffn2': gain(ks[22], (DEPTH, D_MODEL)),
        'w_ffn2_in': nrm(ks[23], (DEPTH, D_MODEL, 2 * D_FF), D_MODEL ** -0.5),
        'w_ffn2_out': nrm(ks[24], (DEPTH, D_FF, D_MODEL), D_FF ** -0.5),
        'final_norm': gain(ks[25], (D_MODEL,)),
    }


def reference(x, c, ctx, c_ctx, w_ada, b_ada, norm_ffn1, w_ffn1_in, w_ffn1_out, norm_mix,
              w_in, conv_w, conv_b, dt_bias, a_log, d_skip, ssd_norm, q_norm, w_uq,
              kv_norm, w_ukv, w_out, norm_ffn2, w_ffn2_in, w_ffn2_out, final_norm):
    b = x.shape[0]
    for i in range(DEPTH):
        last = i == DEPTH - 1
        m_x = (jax.nn.silu(c) @ w_ada[i] + b_ada[i]).reshape(b, 1, N_MOD, D_MODEL)
        m_c = (jax.nn.silu(c_ctx) @ w_ada[i] + b_ada[i]).reshape(1, 1, N_MOD, D_MODEL)
        x = ffn_half_step(x, m_x, 0, norm_ffn1[i], w_ffn1_in[i], w_ffn1_out[i])
        ctx = ffn_half_step(ctx, m_c, 0, norm_ffn1[i], w_ffn1_in[i], w_ffn1_out[i])
        hx = modulate(rmsnorm(x, norm_mix[i]), m_x[:, :, 3], m_x[:, :, 4])
        hc = modulate(rmsnorm(ctx, norm_mix[i]), m_c[:, :, 3], m_c[:, :, 4])
        y_x, y_c = hybrid_mixer(hx, hc, w_in[i], conv_w[i], conv_b[i], dt_bias[i], a_log[i],
                                d_skip[i], ssd_norm[i], q_norm[i], w_uq[i], kv_norm[i],
                                w_ukv[i], w_out[i], not last)
        x = x + m_x[:, :, 5] * y_x
        x = ffn_half_step(x, m_x, 6, norm_ffn2[i], w_ffn2_in[i], w_ffn2_out[i])
        if not last:
            ctx = ctx + m_c[:, :, 5] * y_c
            ctx = ffn_half_step(ctx, m_c, 6, norm_ffn2[i], w_ffn2_in[i], w_ffn2_out[i])
    return rmsnorm(x, final_norm)
```

```cpp
#include <hip/hip_runtime.h>
#include <hip/hip_cooperative_groups.h>
#include <cstdio>
#include <cstdint>
namespace cg = cooperative_groups;
namespace pg8 {
#define PG8_LAS __attribute__((address_space(3)))
typedef unsigned short bf16_t;
typedef short bf16x8 __attribute__((ext_vector_type(8)));
typedef float f32x4 __attribute__((ext_vector_type(4)));
typedef unsigned u32x4 __attribute__((ext_vector_type(4)));
constexpr int BM = 256, BK = 64, HALF = 128, HTB = HALF * BK * 2  , STAGE_BYTES = 8 * HTB, NXCD = 8, WGM = 8;

__host__ __device__ __forceinline__ int lds_byte(int r, int c) { const int st = (r >> 4) * 2 + (c >> 5), rr = r & 15, cc = c & 31, ob = rr * 64 + cc * 2; return st * 1024 + (ob ^ (((ob >> 9) & 1) << 5)); }
__host__ __device__ __forceinline__ void stage_rc(int b, int& R, int& C) { const int st = b / 1024, sb = b % 1024, swz = sb ^ (((sb >> 9) & 1) << 5); R = (st >> 1) * 16 + swz / 64; C = (st & 1) * 32 + (swz % 64) / 2; }
__host__ __device__ __forceinline__ int perm32(int rho) { const int n = rho >> 4, i = rho & 15; return 8 * (i >> 2) + 4 * n + (i & 3); }

struct Unit { int pm, pn; };
struct Gemm { const bf16_t* A; const bf16_t* Bt; int M, N, K; };

struct StaticOrder {
    int nM, nN, nwg, G, c;
    __host__ __device__ void init(int M, int N, int G_, int c_) { nM = M / BM; nN = N / BM; nwg = nM * nN; G = G_; c = c_; }
    __host__ __device__ bool next(int i, Unit& u) const {
        const long L = (long)i * G + c; if (L >= nwg) return false;
        int wgid = (int)L; { const int q = nwg / NXCD, r = nwg % NXCD, xcd = wgid % NXCD, off = wgid / NXCD; wgid = (xcd < r ? xcd * (q + 1) : r * (q + 1) + (xcd - r) * q) + off; }
        const int nig = WGM * nN, gid = wgid / nig, fm = gid * WGM, gsz = (nM - fm) < WGM ? (nM - fm) : WGM;
        u.pm = fm + ((wgid % nig) % gsz); u.pn = (wgid % nig) / gsz; return true;
    }
    __device__ __forceinline__ void a_ready(const Unit&) const {}
    __device__ __forceinline__ void done(const Unit&) const {}
};

__device__ __forceinline__ unsigned cvt_pk_bf16(float lo, float hi) { unsigned r; asm volatile("v_cvt_pk_bf16_f32 %0, %1, %2" : "=v"(r) : "v"(lo), "v"(hi)); return r; }
typedef float f32x2 __attribute__((ext_vector_type(2)));
__device__ __forceinline__ f32x2 gelu_pk(f32x2 v) {
    const f32x2 av = __builtin_elementwise_abs(v), d = av * 0.2316418882f + 1.0f;
    f32x2 t; t.x = __builtin_amdgcn_rcpf(d.x); t.y = __builtin_amdgcn_rcpf(d.y);
    f32x2 q = t * 0.5307027145f + (-0.7265760135f); q = q * t + 0.7107068705f; q = q * t + (-0.142248368f); q = q * t + 0.127414796f; q = q * t;
    const f32x2 s = (v * v) * (-0.72134752044f);
    f32x2 e; e.x = __builtin_amdgcn_exp2f(s.x); e.y = __builtin_amdgcn_exp2f(s.y);
    const f32x2 m = v * (q * e), r = v - m;
    f32x2 o; o.x = v.x < 0.f ? m.x : r.x; o.y = v.y < 0.f ? m.y : r.y; return o;
}

template <int ACT  > struct EpiBf16 {
    static constexpr bool PERM = true, AFTER_DRAIN = false; static_assert(ACT == 0 || ACT == 1, "EpiBf16: ACT is 0 (none) or 1 (gelu_pk)");
    bf16_t* O; int ldc; const float* bias; int split_cols; size_t split_stride; float scale0;
    __device__ __forceinline__ void operator()(const f32x4 (&acc)[2][2][4][2], const Unit& u, int wr, int wc, int fr, int fq) const {
        const int row0 = u.pm * BM + wr * 64 + fr; int colt = u.pn * BM; bf16_t* base = O;
        float sc = 1.f; if (split_cols) { const int t = colt / split_cols; base += (size_t)t * split_stride; colt -= t * split_cols; if (t == 0) sc = scale0; }
        const int col0 = colt + wc * 32 + 8 * fq, bcol0 = u.pn * BM + wc * 32 + 8 * fq;
        f32x4 bv[2][2];
#pragma unroll
        for (int bj = 0; bj < 2; ++bj)
#pragma unroll
            for (int n = 0; n < 2; ++n) bv[bj][n] = bias ? *(const f32x4*)(bias + bcol0 + bj * HALF + 4 * n) : (f32x4){0.f, 0.f, 0.f, 0.f};
#pragma unroll
        for (int ai = 0; ai < 2; ++ai)
#pragma unroll
            for (int m = 0; m < 4; ++m) { bf16_t* rowp = base + (size_t)(row0 + ai * HALF + m * 16) * ldc + col0;
#pragma unroll
                for (int bj = 0; bj < 2; ++bj) { f32x4 v0 = acc[ai][bj][m][0] + bv[bj][0], v1 = acc[ai][bj][m][1] + bv[bj][1];
                    if (ACT == 1) { f32x2 a = gelu_pk((f32x2){v0[0], v0[1]}), b = gelu_pk((f32x2){v0[2], v0[3]}), c = gelu_pk((f32x2){v1[0], v1[1]}), d = gelu_pk((f32x2){v1[2], v1[3]});
                        v0 = (f32x4){a.x, a.y, b.x, b.y}; v1 = (f32x4){c.x, c.y, d.x, d.y}; }
                    v0 = v0 * sc; v1 = v1 * sc; u32x4 w; w.x = cvt_pk_bf16(v0[0], v0[1]); w.y = cvt_pk_bf16(v0[2], v0[3]); w.z = cvt_pk_bf16(v1[0], v1[1]); w.w = cvt_pk_bf16(v1[2], v1[3]);
                    *(u32x4*)(rowp + bj * HALF) = w; } }
    }
};
template <class Epi, class Sched, bool ALIGN_EPI = false, bool SP2 = false>
__device__ __forceinline__ void gemm_phase(PG8_LAS unsigned char* lds, const Gemm g, const Sched& S, const Epi& E) {
    const int tid = threadIdx.x, wid = __builtin_amdgcn_readfirstlane(tid >> 6), lane = tid & 63, wr = wid >> 2, wc = wid & 3, fr = lane & 15, fq = lane >> 4;
    const int K = g.K, nt = K / BK;
    unsigned voffA[2], voffB[2];
#pragma unroll
    for (int i = 0; i < 2; ++i) { int R, C; stage_rc(tid * 16 + i * 8192, R, C); const int Rb = Epi::PERM ? ((R & ~31) + perm32(R & 31)) : R;
        voffA[i] = (unsigned)(R * K + C) * 2u; voffB[i] = (unsigned)(Rb * K + C) * 2u; }
    const size_t kstep = (size_t)(BK * 2);
    const size_t hstep = (size_t)HALF * K * 2;
    const size_t tstep = 2 * hstep;
    const unsigned ldsw = (unsigned)wid * 1024u;
    const int aoff = lds_byte(wr * 64 + fr, fq * 8), boff = lds_byte(wc * 32 + fr, fq * 8);
#define PG8_SA(b, h) (((b) * 2 + (h)) * HTB)
#define PG8_SB(b, h) ((4 + (b) * 2 + (h)) * HTB)
#define PG8_STAGE(bufoff, gbase, voff) do { _Pragma("unroll") for (int _i = 0; _i < 2; ++_i) \
        __builtin_amdgcn_global_load_lds((const unsigned*)((const char*)(gbase) + (voff)[_i]), (PG8_LAS unsigned*)(lds + (bufoff) + ldsw + _i * 8192), 16, 0, 0); } while (0)
#define PG8_LDA(dst, b, h) do { _Pragma("unroll") for (int m = 0; m < 4; ++m) _Pragma("unroll") for (int k = 0; k < 2; ++k) dst[m][k] = *(const PG8_LAS bf16x8*)(lds + PG8_SA(b, h) + aoff + m * 2048 + k * 1024); } while (0)
#define PG8_LDB(dst, b, h) do { _Pragma("unroll") for (int n = 0; n < 2; ++n) _Pragma("unroll") for (int k = 0; k < 2; ++k) dst[n][k] = *(const PG8_LAS bf16x8*)(lds + PG8_SB(b, h) + boff + n * 2048 + k * 1024); } while (0)
#define PG8_MMA(ai, bj, At, Bt) do { __builtin_amdgcn_s_setprio(1); _Pragma("unroll") for (int m = 0; m < 4; ++m) _Pragma("unroll") for (int n = 0; n < 2; ++n) _Pragma("unroll") for (int k = 0; k < 2; ++k) \
        acc[ai][bj][m][n] = __builtin_amdgcn_mfma_f32_16x16x32_bf16(Bt[n][k], At[m][k], acc[ai][bj][m][n], 0, 0, 0); __builtin_amdgcn_s_setprio(0); } while (0)
#define PG8_WAIT_V(n) asm volatile("s_waitcnt vmcnt(" #n ")" ::: "memory")
#define PG8_WAIT_L(n) asm volatile("s_waitcnt lgkmcnt(" #n ")" ::: "memory")
#define PG8_BAR __builtin_amdgcn_s_barrier()
#define PG8_SCHED __builtin_amdgcn_sched_barrier(0)
    Unit cur, nxt; int ui = 0;
    if (!S.next(0, cur)) return;
    f32x4 acc[2][2][4][2];
#pragma unroll
    for (int a = 0; a < 2; ++a)
#pragma unroll
        for (int b = 0; b < 2; ++b)
#pragma unroll
            for (int m = 0; m < 4; ++m)
#pragma unroll
                for (int n = 0; n < 2; ++n) acc[a][b][m][n] = (f32x4){0.f, 0.f, 0.f, 0.f};
    bf16x8 At[4][2], B0[2][2], B1[2][2];
    const char* cA = (const char*)g.A + (size_t)cur.pm * tstep; const char* cB = (const char*)g.Bt + (size_t)cur.pn * tstep;
    S.a_ready(cur);
    if constexpr (SP2) {
        PG8_STAGE(PG8_SB(0, 0), cB, voffB); PG8_STAGE(PG8_SB(0, 1), cB + hstep, voffB); PG8_STAGE(PG8_SA(0, 0), cA, voffA); PG8_STAGE(PG8_SA(0, 1), cA + hstep, voffA);
        if (wr == 1) PG8_BAR;
        PG8_WAIT_V(2); PG8_BAR;
        PG8_STAGE(PG8_SB(1, 0), cB + kstep, voffB); PG8_STAGE(PG8_SA(1, 0), cA + kstep, voffA); PG8_STAGE(PG8_SB(1, 1), cB + hstep + kstep, voffB);
        PG8_WAIT_V(6); PG8_BAR;
    } else {
        PG8_STAGE(PG8_SB(0, 0), cB, voffB); PG8_STAGE(PG8_SA(0, 0), cA, voffA); PG8_STAGE(PG8_SB(0, 1), cB + hstep, voffB); PG8_STAGE(PG8_SA(0, 1), cA + hstep, voffA);
        if (wr == 1) PG8_BAR;
        PG8_WAIT_V(4); PG8_BAR;
        PG8_STAGE(PG8_SB(1, 0), cB + kstep, voffB); PG8_STAGE(PG8_SA(1, 0), cA + kstep, voffA); PG8_STAGE(PG8_SB(1, 1), cB + hstep + kstep, voffB);
        PG8_WAIT_V(6); PG8_BAR;
    }
    for (;;) {
        const bool has_next = S.next(ui + 1, nxt);
        const char* nA = has_next ? (const char*)g.A + (size_t)nxt.pm * tstep : cA; const char* nB = has_next ? (const char*)g.Bt + (size_t)nxt.pn * tstep : cB;
        for (int t = 0; t < nt; t += 2) {
            const bool last = (t == nt - 2);
            const char* a1 = cA + (size_t)(t + 1) * kstep;
            const char* a2 = last ? nA : cA + (size_t)(t + 2) * kstep; const char* b2 = last ? nB : cB + (size_t)(t + 2) * kstep;
            const char* a3 = a2 + kstep; const char* b3 = b2 + kstep;
            if (last && has_next) S.a_ready(nxt);
            if constexpr (SP2) {
            PG8_LDB(B0, 0, 0); PG8_LDB(B1, 0, 1); PG8_SCHED; PG8_LDA(At, 0, 0); PG8_STAGE(PG8_SA(1, 1), a1 + hstep, voffA);
            PG8_WAIT_V(8); PG8_WAIT_L(0); PG8_BAR; PG8_MMA(0, 0, At, B0); PG8_MMA(0, 1, At, B1); PG8_BAR; PG8_SCHED;
            PG8_LDA(At, 0, 1); PG8_STAGE(PG8_SB(0, 0), b2, voffB); PG8_STAGE(PG8_SB(0, 1), b2 + hstep, voffB); PG8_STAGE(PG8_SA(0, 0), a2, voffA);
            PG8_WAIT_V(8); PG8_WAIT_L(0); PG8_BAR; PG8_MMA(1, 0, At, B0); PG8_MMA(1, 1, At, B1); PG8_BAR; PG8_SCHED;
            PG8_LDB(B0, 1, 0); PG8_LDB(B1, 1, 1); PG8_SCHED; PG8_LDA(At, 1, 0); PG8_STAGE(PG8_SA(0, 1), a2 + hstep, voffA);
            PG8_WAIT_V(8); PG8_WAIT_L(0); PG8_BAR; PG8_MMA(0, 0, At, B0); PG8_MMA(0, 1, At, B1); PG8_BAR; PG8_SCHED;
            PG8_LDA(At, 1, 1); PG8_STAGE(PG8_SB(1, 0), b3, voffB); PG8_STAGE(PG8_SB(1, 1), b3 + hstep, voffB); PG8_STAGE(PG8_SA(1, 0), a3, voffA);
            PG8_WAIT_V(8); PG8_WAIT_L(0); PG8_BAR; PG8_MMA(1, 0, At, B0); PG8_MMA(1, 1, At, B1); PG8_BAR; PG8_SCHED;
            } else {
            PG8_LDB(B0, 0, 0); PG8_SCHED; PG8_LDA(At, 0, 0); PG8_STAGE(PG8_SA(1, 1), a1 + hstep, voffA);
            PG8_WAIT_L(8); PG8_BAR; PG8_WAIT_L(0); PG8_MMA(0, 0, At, B0); PG8_BAR; PG8_SCHED;
            PG8_LDB(B1, 0, 1); PG8_STAGE(PG8_SB(0, 0), b2, voffB);
            PG8_BAR; PG8_WAIT_L(0); PG8_MMA(0, 1, At, B1); PG8_BAR;
            PG8_LDA(At, 0, 1); PG8_STAGE(PG8_SA(0, 0), a2, voffA);
            PG8_BAR; PG8_WAIT_L(0); PG8_MMA(1, 0, At, B0); PG8_BAR; PG8_SCHED;
            PG8_STAGE(PG8_SB(0, 1), b2 + hstep, voffB);
            PG8_WAIT_V(6); PG8_BAR; PG8_MMA(1, 1, At, B1); PG8_BAR;
            PG8_LDB(B0, 1, 0); PG8_SCHED; PG8_LDA(At, 1, 0); PG8_STAGE(PG8_SA(0, 1), a2 + hstep, voffA);
            PG8_WAIT_L(8); PG8_BAR; PG8_WAIT_L(0); PG8_MMA(0, 0, At, B0); PG8_BAR; PG8_SCHED;
            PG8_LDB(B1, 1, 1); PG8_STAGE(PG8_SB(1, 0), b3, voffB);
            PG8_BAR; PG8_WAIT_L(0); PG8_MMA(0, 1, At, B1); PG8_BAR;
            PG8_LDA(At, 1, 1); PG8_STAGE(PG8_SA(1, 0), a3, voffA);
            PG8_BAR; PG8_WAIT_L(0); PG8_MMA(1, 0, At, B0); PG8_BAR; PG8_SCHED;
            PG8_STAGE(PG8_SB(1, 1), b3 + hstep, voffB);
            PG8_WAIT_V(6); PG8_BAR; PG8_MMA(1, 1, At, B1); PG8_BAR;
            }
        }
        if constexpr (ALIGN_EPI) { if (wr == 0) PG8_BAR; }
        if constexpr (!Epi::AFTER_DRAIN) { E(acc, cur, wr, wc, fr, fq); S.done(cur); }
        if (!has_next) break;
#pragma unroll
        for (int a = 0; a < 2; ++a)
#pragma unroll
            for (int b = 0; b < 2; ++b)
#pragma unroll
                for (int m = 0; m < 4; ++m)
#pragma unroll
                    for (int n = 0; n < 2; ++n) acc[a][b][m][n] = (f32x4){0.f, 0.f, 0.f, 0.f};
        cur = nxt; cA = nA; cB = nB; ++ui;
        if constexpr (ALIGN_EPI) { if (wr == 1) PG8_BAR; }
    }
    PG8_WAIT_V(0);
    if constexpr (!ALIGN_EPI) { if (wr == 0) PG8_BAR; }
    PG8_BAR;
    if constexpr (Epi::AFTER_DRAIN) { E.fused(acc, cur, wr, wc, fr, fq, lds, wid, lane); S.done(cur); }
#undef PG8_SA
#undef PG8_SB
#undef PG8_STAGE
#undef PG8_LDA
#undef PG8_LDB
#undef PG8_MMA
#undef PG8_WAIT_V
#undef PG8_WAIT_L
#undef PG8_BAR
#undef PG8_SCHED
}
}

#define LAS __attribute__((address_space(3)))
typedef unsigned short bf16;
typedef short bf16x8 __attribute__((ext_vector_type(8)));
typedef float f32x2 __attribute__((ext_vector_type(2)));
typedef float f32x4 __attribute__((ext_vector_type(4)));
typedef float f32x16 __attribute__((ext_vector_type(16)));
typedef unsigned u32x2 __attribute__((ext_vector_type(2)));
typedef unsigned u32x4 __attribute__((ext_vector_type(4)));
typedef __bf16 bf16x2_t __attribute__((ext_vector_type(2)));

constexpr int D = 1024, NB = 8, SEQ = 4096, CTXL = 256, NLAT = NB * SEQ, NCTX = NB * CTXL, MTOT = NLAT + NCTX;
constexpr int DFF = 2816, UL = SEQ + CTXL, NCH = UL / 128;
constexpr float EPS = 1e-6f;
constexpr float QSCALE = 0.10206207261596575f * 1.4426950408889634f;
constexpr int NPHASE = 16;

constexpr size_t MiB = (size_t)1 << 20, KiB = 1024;
constexpr size_t WS_MOD = 0, WS_ROPE = 384 * KiB, WS_CD = 448 * KiB, WS_RSTDQ = 512 * KiB, WS_RSTDKV = 768 * KiB;
constexpr size_t WS_W1A = 2 * MiB, WS_W1B = 13 * MiB, WS_WIN = 18 * MiB + 512 * KiB, WS_WUQ = 24 * MiB, WS_WK = 25 * MiB + 512 * KiB, WS_WV = 25 * MiB + 768 * KiB,
                 WS_WOUT = 26 * MiB, WS_W2A = 28 * MiB, WS_W2B = 39 * MiB;
constexpr size_t WS_A = 45 * MiB;
constexpr size_t WS_B = 113 * MiB;
constexpr size_t WS_Z = WS_B, WS_XBCR = WS_B + 34 * MiB, WS_CQ = WS_B + 102 * MiB, WS_CKV = WS_B + 153 * MiB, WS_MISC = WS_B + 170 * MiB;
constexpr size_t WS_ST = WS_XBCR, WS_MIX = WS_XBCR, WS_HE = WS_CQ;
constexpr size_t WS_C = 300 * MiB;
constexpr size_t WS_XT = 436 * MiB, WS_BT = 470 * MiB, WS_CROW = 487 * MiB, WS_DT = 504 * MiB, WS_KPE = 506 * MiB + 256 * KiB, WS_END = 512 * MiB;
constexpr size_t WS_BROW = WS_A;
constexpr size_t OUT_Q = 0, OUT_KN = 48 * MiB, OUT_VT = 82 * MiB;
constexpr int LDS_BYTES = 147456;

__device__ __forceinline__ unsigned pk2(float lo, float hi) { f32x2 v = {lo, hi}; bf16x2_t b = __builtin_convertvector(v, bf16x2_t); return __builtin_bit_cast(unsigned, b); }
__device__ __forceinline__ float bflo(unsigned w) { return __uint_as_float(w << 16); }
__device__ __forceinline__ float bfhi(unsigned w) { return __uint_as_float(w & 0xffff0000u); }
__device__ __forceinline__ float bf2f(bf16 u) { return __uint_as_float((unsigned)u << 16); }
__device__ __forceinline__ float silu_f(float x) { return x / (1.f + __expf(-x)); }
__device__ __forceinline__ float wave_sum(float v) {
#pragma unroll
    for (int o = 1; o < 64; o <<= 1) v += __shfl_xor(v, o);
    return v;
}
__device__ __forceinline__ float incl_scan(float v, int lane) {
#pragma unroll
    for (int o = 1; o < 64; o <<= 1) { float t = __shfl_up(v, o); if (lane >= o) v += t; }
    return v;
}
#define LDS_FENCE() asm volatile("s_waitcnt lgkmcnt(0)" ::: "memory")
__device__ __forceinline__ int crow(int r, int hi) { return (r & 3) + 8 * (r >> 2) + 4 * hi; }
__device__ __forceinline__ bf16x8 pack8(float a0, float a1, float a2, float a3, float a4, float a5, float a6, float a7) {
    u32x4 w; w.x = pk2(a0, a1); w.y = pk2(a2, a3); w.z = pk2(a4, a5); w.w = pk2(a6, a7); return __builtin_bit_cast(bf16x8, w);
}

struct Args { const float* in[26]; float* out; unsigned char* ws; int ph_lo, ph_hi; };

namespace pg8 {
struct EpiSwiglu {
    static constexpr bool PERM = true, AFTER_DRAIN = false;
    bf16_t* O; int ldc;
    __device__ __forceinline__ void operator()(const f32x4 (&acc)[2][2][4][2], const Unit& u, int wr, int wc, int fr, int fq) const {
        const int row0 = u.pm * BM + wr * 64 + fr, col0 = u.pn * HALF + wc * 32 + 8 * fq;
#pragma unroll
        for (int ai = 0; ai < 2; ++ai)
#pragma unroll
            for (int m = 0; m < 4; ++m) {
                bf16_t* rowp = O + (size_t)(row0 + ai * HALF + m * 16) * ldc + col0;
                const f32x4 g0 = acc[ai][0][m][0], g1 = acc[ai][0][m][1], u0 = acc[ai][1][m][0], u1 = acc[ai][1][m][1];
                u32x4 w;
                w.x = cvt_pk_bf16(silu_f(g0[0]) * u0[0], silu_f(g0[1]) * u0[1]); w.y = cvt_pk_bf16(silu_f(g0[2]) * u0[2], silu_f(g0[3]) * u0[3]);
                w.z = cvt_pk_bf16(silu_f(g1[0]) * u1[0], silu_f(g1[1]) * u1[1]); w.w = cvt_pk_bf16(silu_f(g1[2]) * u1[2], silu_f(g1[3]) * u1[3]);
                *(u32x4*)rowp = w;
            }
    }
};
struct EpiRes {
    static constexpr bool PERM = false, AFTER_DRAIN = false;
    const float* base_lat; const float* base_ctx; float* out; const float* mod; int kg; float mul;
    __device__ __forceinline__ void operator()(const f32x4 (&acc)[2][2][4][2], const Unit& u, int wr, int wc, int fr, int fq) const {
        const int row0 = u.pm * BM + wr * 64 + fr, col0 = u.pn * BM + wc * 32 + 4 * fq;
        const int bb = u.pm < (NLAT / BM) ? u.pm / (SEQ / BM) : 8;
        const float* gp = mod + bb * 9216 + kg * 1024 + col0;
        f32x4 gv[2][2];
#pragma unroll
        for (int bj = 0; bj < 2; ++bj)
#pragma unroll
            for (int n = 0; n < 2; ++n) gv[bj][n] = *(const f32x4*)(gp + bj * HALF + n * 16) * mul;
#pragma unroll
        for (int ai = 0; ai < 2; ++ai)
#pragma unroll
            for (int m = 0; m < 4; ++m) {
                const int r = row0 + ai * HALF + m * 16;
                const float* bp = (r < NLAT ? base_lat + (size_t)r * D : base_ctx + (size_t)(r - NLAT) * D) + col0;
                float* op = out + (size_t)r * D + col0;
#pragma unroll
                for (int bj = 0; bj < 2; ++bj)
#pragma unroll
                    for (int n = 0; n < 2; ++n) { const f32x4 bs = *(const f32x4*)(bp + bj * HALF + n * 16); *(f32x4*)(op + bj * HALF + n * 16) = bs + gv[bj][n] * acc[ai][bj][m][n]; }
            }
    }
};
struct EpiSplit {
    static constexpr bool PERM = true, AFTER_DRAIN = false;
    bf16_t *zb, *xbcr, *cq, *ckv, *misc;
    __device__ __forceinline__ void operator()(const f32x4 (&acc)[2][2][4][2], const Unit& u, int wr, int wc, int fr, int fq) const {
        const int pn = u.pn; bf16_t* base; int ld;
        if (pn < 2) { base = zb + pn * 256; ld = 512; } else if (pn < 6) { base = xbcr + (pn - 2) * 256; ld = 1024; } else if (pn < 9) { base = cq + (pn - 6) * 256; ld = 768; }
        else if (pn == 9) { base = ckv; ld = 256; } else { base = misc; ld = 256; }
        const int row0 = u.pm * BM + wr * 64 + fr, col0 = wc * 32 + 8 * fq;
#pragma unroll
        for (int ai = 0; ai < 2; ++ai)
#pragma unroll
            for (int m = 0; m < 4; ++m) {
                bf16_t* rowp = base + (size_t)(row0 + ai * HALF + m * 16) * ld + col0;
#pragma unroll
                for (int bj = 0; bj < 2; ++bj) { const f32x4 v0 = acc[ai][bj][m][0], v1 = acc[ai][bj][m][1];
                    u32x4 w; w.x = cvt_pk_bf16(v0[0], v0[1]); w.y = cvt_pk_bf16(v0[2], v0[3]); w.z = cvt_pk_bf16(v1[0], v1[1]); w.w = cvt_pk_bf16(v1[2], v1[3]);
                    *(u32x4*)(rowp + bj * HALF) = w; }
            }
    }
};
struct EpiScale {
    static constexpr bool PERM = true, AFTER_DRAIN = false;
    bf16_t* O; int ldc; const float* rs; const float* cs;
    __device__ __forceinline__ void operator()(const f32x4 (&acc)[2][2][4][2], const Unit& u, int wr, int wc, int fr, int fq) const {
        const int row0 = u.pm * BM + wr * 64 + fr, col0 = u.pn * BM + wc * 32 + 8 * fq;
        f32x4 cv[2][2];
#pragma unroll
        for (int bj = 0; bj < 2; ++bj)
#pragma unroll
            for (int n = 0; n < 2; ++n) cv[bj][n] = cs ? *(const f32x4*)(cs + col0 + bj * HALF + 4 * n) : (f32x4){1.f, 1.f, 1.f, 1.f};
#pragma unroll
        for (int ai = 0; ai < 2; ++ai)
#pragma unroll
            for (int m = 0; m < 4; ++m) {
                const int r = row0 + ai * HALF + m * 16; const float rv = rs ? rs[r] : 1.f;
                bf16_t* rowp = O + (size_t)r * ldc + col0;
#pragma unroll
                for (int bj = 0; bj < 2; ++bj) { const f32x4 v0 = acc[ai][bj][m][0] * cv[bj][0] * rv, v1 = acc[ai][bj][m][1] * cv[bj][1] * rv;
                    u32x4 w; w.x = cvt_pk_bf16(v0[0], v0[1]); w.y = cvt_pk_bf16(v0[2], v0[3]); w.z = cvt_pk_bf16(v1[0], v1[1]); w.w = cvt_pk_bf16(v1[2], v1[3]);
                    *(u32x4*)(rowp + bj * HALF) = w; }
            }
    }
};
struct EpiQ {
    static constexpr bool PERM = true, AFTER_DRAIN = false;
    bf16_t* O; const float* rs; const f32x2* rope;
    __device__ __forceinline__ void operator()(const f32x4 (&acc)[2][2][4][2], const Unit& u, int wr, int wc, int fr, int fq) const {
        const int row0 = u.pm * BM + wr * 64 + fr, col0 = u.pn * BM + wc * 32 + 8 * fq;
#pragma unroll
        for (int ai = 0; ai < 2; ++ai)
#pragma unroll
            for (int m = 0; m < 4; ++m) {
                const int r = row0 + ai * HALF + m * 16; const float rv = rs[r] * QSCALE; const int t = r & (SEQ - 1);
                bf16_t* rowp = O + (size_t)r * 768 + col0;
#pragma unroll
                for (int bj = 0; bj < 2; ++bj) {
                    f32x4 v0 = acc[ai][bj][m][0] * rv, v1 = acc[ai][bj][m][1] * rv;
                    const int cc = (col0 + bj * HALF) % 96;
                    if (cc >= 64) {
                        const int q = cc - 64, half = q >> 4, jj = (q & 15) >> 1, pos = half ? (t & 63) : (t >> 6);
                        const f32x2* rp = rope + pos * 8 + jj;
                        const f32x2 c0 = rp[0], c1 = rp[1], c2 = rp[2], c3 = rp[3];
                        f32x4 o0, o1;
                        o0[0] = v0[0] * c0.x - v0[1] * c0.y; o0[1] = v0[0] * c0.y + v0[1] * c0.x; o0[2] = v0[2] * c1.x - v0[3] * c1.y; o0[3] = v0[2] * c1.y + v0[3] * c1.x;
                        o1[0] = v1[0] * c2.x - v1[1] * c2.y; o1[1] = v1[0] * c2.y + v1[1] * c2.x; o1[2] = v1[2] * c3.x - v1[3] * c3.y; o1[3] = v1[2] * c3.y + v1[3] * c3.x;
                        v0 = o0; v1 = o1;
                    }
                    u32x4 w; w.x = cvt_pk_bf16(v0[0], v0[1]); w.y = cvt_pk_bf16(v0[2], v0[3]); w.z = cvt_pk_bf16(v1[0], v1[1]); w.w = cvt_pk_bf16(v1[2], v1[3]);
                    *(u32x4*)(rowp + bj * HALF) = w;
                }
            }
    }
};
}

__device__ __forceinline__ int cmap(int id, int n) {
    switch (id) {
    case 0: return ((n >> 7) & 1) * DFF + (n >> 8) * 128 + (n & 127);
    case 1: return n;
    case 2: {
        if (n < 1536) return n;
        if (n < 2304) return 1552 + (n - 1536);
        if (n < 2560) return 2320 + (n - 2304);
        if (n < 2592) { const int q = n - 2560, half = q >> 4, jj = (q & 15) >> 1, which = q & 1; return 2576 + half * 16 + which * 8 + jj; }
        if (n < 2608) return 1536 + (n - 2592);
        return -1; }
    case 3: { const int hh = n / 96, cc = n % 96; if (cc < 64) return hh * 96 + cc;
        const int q = cc - 64, half = q >> 4, jj = (q & 15) >> 1, which = q & 1; return hh * 96 + 64 + half * 16 + which * 8 + jj; }
    case 4: return (n >> 6) * 128 + (n & 63);
    default: return (n >> 6) * 128 + 64 + (n & 63);
    }
}
__device__ __forceinline__ void titem(const float* W, int K, int N, bf16* WT, const float* gk, LAS float* scr, int item, int nblk, int lane, int id, float mulc = 1.f) {
    const int kb = item / nblk, nb = item % nblk, k0 = 64 * kb, n0 = 32 * nb;
    const int src = cmap(id, n0 + (lane & 31));
#pragma unroll 8
    for (int i = 0; i < 32; ++i) { const int kk = 2 * i + (lane >> 5); float v = src >= 0 ? W[(size_t)(k0 + kk) * N + src] : 0.f; if (gk) v *= gk[k0 + kk] * mulc; scr[kk * 33 + (lane & 31)] = v; }
    LDS_FENCE();
    const int c = lane & 7;
#pragma unroll
    for (int j = 0; j < 4; ++j) { const int n = (lane >> 3) + 8 * j; const LAS float* s = scr + (8 * c) * 33 + n;
        u32x4 o; o.x = pk2(s[0 * 33], s[1 * 33]); o.y = pk2(s[2 * 33], s[3 * 33]); o.z = pk2(s[4 * 33], s[5 * 33]); o.w = pk2(s[6 * 33], s[7 * 33]);
        *(u32x4*)(WT + (size_t)(n0 + n) * K + k0 + 8 * c) = o; }
    LDS_FENCE();
}
__device__ __forceinline__ void phase0(const Args& a, LAS unsigned char* lds, int gw, int NGW, int tid, int lane, int wave) {
    unsigned char* ws = a.ws;
    LAS float* scr = (LAS float*)(lds + wave * 16384);
    constexpr int I_W1A = 16 * 176, I_W1B = 44 * 32, I_WIN = 16 * 88, I_WUQ = 12 * 24, I_WK = 4 * 16, I_WOUT = 16 * 32;
    constexpr int NITEMS = 2 * I_W1A + 2 * I_W1B + I_WIN + I_WUQ + 2 * I_WK + I_WOUT;
    for (int it = gw; it < NITEMS; it += NGW) {
        int r = it;
        if (r < I_W1A) { titem(a.in[7], 1024, 5632, (bf16*)(ws + WS_W1A), nullptr, scr, r, 176, lane, 0); continue; } r -= I_W1A;
        if (r < I_W1A) { titem(a.in[23], 1024, 5632, (bf16*)(ws + WS_W2A), nullptr, scr, r, 176, lane, 0); continue; } r -= I_W1A;
        if (r < I_W1B) { titem(a.in[8], 2816, 1024, (bf16*)(ws + WS_W1B), nullptr, scr, r, 32, lane, 1); continue; } r -= I_W1B;
        if (r < I_W1B) { titem(a.in[24], 2816, 1024, (bf16*)(ws + WS_W2B), nullptr, scr, r, 32, lane, 1); continue; } r -= I_W1B;
        if (r < I_WIN) { titem(a.in[10], 1024, 2608, (bf16*)(ws + WS_WIN), nullptr, scr, r, 88, lane, 2); continue; } r -= I_WIN;
        if (r < I_WUQ) { titem(a.in[18], 768, 768, (bf16*)(ws + WS_WUQ), a.in[17], scr, r, 24, lane, 3, QSCALE); continue; } r -= I_WUQ;
        if (r < I_WK) { titem(a.in[20], 256, 1024, (bf16*)(ws + WS_WK), a.in[19], scr, r, 16, lane, 4); continue; } r -= I_WK;
        if (r < I_WK) { titem(a.in[20], 256, 1024, (bf16*)(ws + WS_WV), a.in[19], scr, r, 16, lane, 5); continue; } r -= I_WK;
        titem(a.in[21], 1024, 1024, (bf16*)(ws + WS_WOUT), nullptr, scr, r, 32, lane, 1);
    }
    float* MOD = (float*)(ws + WS_MOD);
    const float* cin = a.in[1]; const float* cctx = a.in[3]; const float* wada = a.in[4]; const float* bada = a.in[5];
    for (int it = gw; it < 576; it += NGW) {
        const int kc = it / 36, nc = it % 36, k0 = kc * 64, n0 = nc * 256 + 4 * lane;
        float sv[9];
#pragma unroll
        for (int bb = 0; bb < 8; ++bb) sv[bb] = silu_f(cin[bb * 1024 + k0 + lane]);
        sv[8] = silu_f(cctx[k0 + lane]);
        f32x4 acc[9];
#pragma unroll
        for (int bb = 0; bb < 9; ++bb) acc[bb] = (f32x4){0.f, 0.f, 0.f, 0.f};
#pragma unroll 4
        for (int k = 0; k < 64; ++k) {
            const f32x4 w = *(const f32x4*)(wada + (size_t)(k0 + k) * 9216 + n0);
#pragma unroll
            for (int bb = 0; bb < 9; ++bb) { const float s = __shfl(sv[bb], k); acc[bb] += w * s; }
        }
        if (kc == 0) { const f32x4 bv = *(const f32x4*)(bada + n0);
#pragma unroll
            for (int bb = 0; bb < 9; ++bb) acc[bb] += bv; }
#pragma unroll
        for (int bb = 0; bb < 9; ++bb) { float* p = MOD + bb * 9216 + n0; atomicAdd(p, acc[bb][0]); atomicAdd(p + 1, acc[bb][1]); atomicAdd(p + 2, acc[bb][2]); atomicAdd(p + 3, acc[bb][3]); }
    }
    if (blockIdx.x == 0) {
        const int pos = tid >> 3, jj = tid & 7; const float inv = __builtin_amdgcn_exp2f(-(float)jj * 1.6609640474436813f);
        const float ang = (float)pos * inv;
        ((f32x2*)(ws + WS_ROPE))[tid] = (f32x2){__cosf(ang), __sinf(ang)};
    }
}

__device__ __forceinline__ void norm_rows(const float* src_lat, const float* src_ctx, int nrows, const float* gvec, const float* mod, int kshift, bf16* out, int gw, int NGW, int lane) {
    for (int row = gw; row < nrows; row += NGW) {
        const float* xr = (row < NLAT ? src_lat + (size_t)row * D : src_ctx + (size_t)(row - NLAT) * D) + 4 * lane;
        const int bb = row < NLAT ? row / SEQ : 8;
        const float* sh = mod + bb * 9216 + kshift * 1024 + 4 * lane; const float* sc = sh + 1024;
        f32x4 v[4]; float s = 0.f;
#pragma unroll
        for (int j = 0; j < 4; ++j) { v[j] = *(const f32x4*)(xr + 256 * j); s += (v[j][0] * v[j][0] + v[j][1] * v[j][1]) + (v[j][2] * v[j][2] + v[j][3] * v[j][3]); }
        const float rstd = 1.0f / sqrtf(wave_sum(s) * (1.f / D) + EPS);
        bf16* orow = out + (size_t)row * D + 4 * lane;
#pragma unroll
        for (int j = 0; j < 4; ++j) {
            const f32x4 g = *(const f32x4*)(gvec + 4 * lane + 256 * j), scv = *(const f32x4*)(sc + 256 * j), shv = *(const f32x4*)(sh + 256 * j);
            const f32x4 y = (v[j] * rstd) * g * (scv + 1.f) + shv;
            u32x2 w; w.x = pk2(y[0], y[1]); w.y = pk2(y[2], y[3]); *(u32x2*)(orow + 256 * j) = w;
        }
    }
}
__device__ __forceinline__ void final_norm_rows(float* io, const float* gvec, int gw, int NGW, int lane) {
    for (int row = gw; row < NLAT; row += NGW) {
        float* xr = io + (size_t)row * D + 4 * lane;
        f32x4 v[4]; float s = 0.f;
#pragma unroll
        for (int j = 0; j < 4; ++j) { v[j] = *(const f32x4*)(xr + 256 * j); s += (v[j][0] * v[j][0] + v[j][1] * v[j][1]) + (v[j][2] * v[j][2] + v[j][3] * v[j][3]); }
        const float rstd = 1.0f / sqrtf(wave_sum(s) * (1.f / D) + EPS);
#pragma unroll
        for (int j = 0; j < 4; ++j) { const f32x4 g = *(const f32x4*)(gvec + 4 * lane + 256 * j); *(f32x4*)(xr + 256 * j) = (v[j] * rstd) * g; }
    }
}

__device__ __forceinline__ float softplus_f(float x) { return fmaxf(x, 0.f) + log1pf(__expf(-fabsf(x))); }
__device__ __forceinline__ void phase6(const Args& a, LAS unsigned char* lds, int G, int bx, int tid, int lane, int wave) {
    unsigned char* ws = a.ws;
    const bf16* XBCR = (const bf16*)(ws + WS_XBCR); const bf16* MISC = (const bf16*)(ws + WS_MISC); const bf16* CQ = (const bf16*)(ws + WS_CQ); const bf16* CKV = (const bf16*)(ws + WS_CKV);
    bf16* XT = (bf16*)(ws + WS_XT); bf16* BT = (bf16*)(ws + WS_BT); bf16* BROW = (bf16*)(ws + WS_BROW); bf16* CROW = (bf16*)(ws + WS_CROW); bf16* KPE = (bf16*)(ws + WS_KPE);
    float* DT = (float*)(ws + WS_DT); float* RSTDQ = (float*)(ws + WS_RSTDQ); float* RSTDKV = (float*)(ws + WS_RSTDKV); const f32x2* ROPE = (const f32x2*)(ws + WS_ROPE);
    const float* conv_w = a.in[11]; const float* conv_b = a.in[12]; const float* dt_bias = a.in[13];
    LAS bf16* T = (LAS bf16*)lds;
    const int ch = 2 * tid;
    float w0[5], w1[5];
#pragma unroll
    for (int k = 0; k < 5; ++k) { w0[k] = conv_w[k * 1024 + ch]; w1[k] = conv_w[k * 1024 + ch + 1]; }
    const float b0 = conv_b[ch], b1 = conv_b[ch + 1];
    for (int unit = bx; unit < NB * 68; unit += G) {
        const int b = unit / 68, ut = unit % 68, u0 = ut * 64;
        const int seg_lo = u0 < CTXL ? 0 : CTXL, seg_hi = u0 < CTXL ? CTXL : UL;
        const int rb = u0 < CTXL ? NLAT + b * CTXL : b * SEQ - CTXL;
#define P6_LD(u) (((u) >= seg_lo && (u) < seg_hi) ? *(const unsigned*)(XBCR + (size_t)(rb + (u)) * 1024 + ch) : 0u)
        unsigned xm2 = P6_LD(u0 - 2), xm1 = P6_LD(u0 - 1), x0 = P6_LD(u0), xp1 = P6_LD(u0 + 1);
#pragma unroll 8
        for (int t = 0; t < 64; ++t) {
            const unsigned xp2 = P6_LD(u0 + t + 2);
            float y0 = b0 + w0[0] * bflo(xm2) + w0[1] * bflo(xm1) + w0[2] * bflo(x0) + w0[3] * bflo(xp1) + w0[4] * bflo(xp2);
            float y1 = b1 + w1[0] * bfhi(xm2) + w1[1] * bfhi(xm1) + w1[2] * bfhi(x0) + w1[3] * bfhi(xp1) + w1[4] * bfhi(xp2);
            const unsigned pk = pk2(silu_f(y0), silu_f(y1));
            if (tid < 384) { T[ch * 72 + t] = (bf16)(pk & 0xffffu); T[(ch + 1) * 72 + t] = (bf16)(pk >> 16); }
            if (tid >= 256) { bf16* dst = tid < 384 ? BROW + (ch - 512) : CROW + (ch - 768); *(unsigned*)(dst + (size_t)(b * UL + u0 + t) * 256) = pk; }
            xm2 = xm1; xm1 = x0; x0 = xp1; xp1 = xp2;
        }
#undef P6_LD
        __syncthreads();
#pragma unroll
        for (int i = 0; i < 12; ++i) { const int q = tid + 512 * i, c = q >> 3, part = q & 7;
            const u32x4 v = *(const LAS u32x4*)(T + c * 72 + part * 8);
            bf16* dst = c < 512 ? XT + (size_t)(b * 512 + c) * UL : BT + (size_t)(b * 256 + c - 512) * UL;
            *(u32x4*)(dst + u0 + part * 8) = v; }
        {
            const int uu = tid >> 3, k = (tid & 7) * 2; const size_t row = (size_t)(rb + u0 + uu);
            const unsigned raw = *(const unsigned*)(MISC + row * 256 + 32 + k);
            f32x2 o; o.x = softplus_f(bflo(raw) + dt_bias[k]); o.y = softplus_f(bfhi(raw) + dt_bias[k + 1]);
            *(f32x2*)(DT + (size_t)(b * UL + u0 + uu) * 16 + k) = o;
        }
        {
            const int uu = tid >> 3, pp = (tid & 7) * 2; const size_t row = (size_t)(rb + u0 + uu);
            u32x2 raw = *(const u32x2*)(MISC + row * 256 + 2 * pp);
            if (u0 >= CTXL) {
                const int t = u0 + uu - CTXL, half = pp >> 3, jj = pp & 7, pos = half ? (t & 63) : (t >> 6);
                const f32x2 c0 = ROPE[pos * 8 + jj], c1 = ROPE[pos * 8 + jj + 1];
                const float a0 = bflo(raw.x), a1 = bfhi(raw.x), a2 = bflo(raw.y), a3 = bfhi(raw.y);
                raw.x = pk2(a0 * c0.x - a1 * c0.y, a0 * c0.y + a1 * c0.x); raw.y = pk2(a2 * c1.x - a3 * c1.y, a2 * c1.y + a3 * c1.x);
            }
            *(u32x2*)(KPE + row * 32 + 2 * pp) = raw;
        }
#pragma unroll 2
        for (int rr = 0; rr < 8; ++rr) {
            const size_t row = (size_t)(rb + u0 + wave * 8 + rr);
            { const u32x2 w = *(const u32x2*)(CKV + row * 256 + 4 * lane); const float c0 = bflo(w.x), c1 = bfhi(w.x), c2 = bflo(w.y), c3 = bfhi(w.y);
              const float s = wave_sum((c0 * c0 + c1 * c1) + (c2 * c2 + c3 * c3)); if (lane == 0) RSTDKV[row] = 1.0f / sqrtf(s * (1.f / 256.f) + EPS); }
            if (u0 >= CTXL) { float s = 0.f;
#pragma unroll
                for (int i = 0; i < 3; ++i) { const u32x2 w = *(const u32x2*)(CQ + row * 768 + 4 * lane + 256 * i); const float c0 = bflo(w.x), c1 = bfhi(w.x), c2 = bflo(w.y), c3 = bfhi(w.y);
                    s += (c0 * c0 + c1 * c1) + (c2 * c2 + c3 * c3); }
                s = wave_sum(s); if (lane == 0) RSTDQ[row] = 1.0f / sqrtf(s * (1.f / 768.f) + EPS); }
        }
        __syncthreads();
    }
}

__device__ __forceinline__ void acum_wave(const float* DT, size_t dtrow0, int h, float anf, float anb, LAS float* sc, int lane) {
    const float df0 = DT[(dtrow0 + lane) * 16 + h], df1 = DT[(dtrow0 + 64 + lane) * 16 + h];
    const float db0 = DT[(dtrow0 + lane) * 16 + 8 + h], db1 = DT[(dtrow0 + 64 + lane) * 16 + 8 + h];
    const float f0 = incl_scan(df0 * anf, lane); float f1 = incl_scan(df1 * anf, lane); f1 += __shfl(f0, 63);
    const float a0 = db0 * anb, a1 = db1 * anb; const float g0 = incl_scan(a0, lane), g1 = incl_scan(a1, lane);
    const float t0 = __shfl(g0, 63), t1 = __shfl(g1, 63), tot = t0 + t1;
    sc[lane] = f0; sc[64 + lane] = f1; sc[128 + lane] = tot - g0 + a0; sc[192 + lane] = t1 - g1 + a1;
    sc[256 + lane] = df0; sc[320 + lane] = df1; sc[384 + lane] = db0; sc[448 + lane] = db1;
    LDS_FENCE();
}
#define MFMA32(a, b, c) __builtin_amdgcn_mfma_f32_32x32x16_bf16((a), (b), (c), 0, 0, 0)
__device__ __forceinline__ f32x16 zero16() { f32x16 z;
#pragma unroll
    for (int r = 0; r < 16; ++r) z[r] = 0.f; return z; }

__device__ __forceinline__ void phase8(const Args& a, LAS unsigned char* lds, int G, int bx, int lane, int wave) {
    unsigned char* ws = a.ws;
    const bf16* XT = (const bf16*)(ws + WS_XT); const bf16* BT = (const bf16*)(ws + WS_BT); const float* DT = (const float*)(ws + WS_DT);
    bf16* ST = (bf16*)(ws + WS_ST); float* CD = (float*)(ws + WS_CD);
    LAS float* sc = (LAS float*)lds + wave * 512;
    const int h = wave, g = h >> 2, r32 = lane & 31, hi = lane >> 5;
    const float anf = -__expf(a.in[14][h]), anb = -__expf(a.in[14][8 + h]);
    for (int unit = bx; unit < NB * NCH; unit += G) {
        const int b = unit / NCH, c = unit % NCH;
        acum_wave(DT, (size_t)b * UL + c * 128, h, anf, anb, sc, lane);
        const float af_last = sc[127], ab_first = sc[128];
#pragma unroll
        for (int hf = 0; hf < 2; ++hf) { const int j = lane + 64 * hf;
            const float wf = __expf(af_last - sc[j]) * sc[256 + j], wb = __expf(ab_first - sc[128 + j]) * sc[384 + j];
            sc[256 + j] = wf; sc[384 + j] = wb; }
        if (lane == 0) { CD[((b * 2 + 0) * 8 + h) * NCH + c] = __expf(af_last); CD[((b * 2 + 1) * 8 + h) * NCH + c] = __expf(ab_first); }
        LDS_FENCE();
        const bf16* xbase = XT + (size_t)(b * 512 + h * 64 + r32) * UL + c * 128 + 8 * hi;
        const bf16* bbase = BT + (size_t)(b * 256 + g * 128 + r32) * UL + c * 128 + 8 * hi;
#pragma unroll 1
        for (int dir = 0; dir < 2; ++dir) {
            const LAS float* w = sc + 256 + 128 * dir + 8 * hi;
            f32x16 acc[4][2];
#pragma unroll
            for (int nb = 0; nb < 4; ++nb) { acc[nb][0] = zero16(); acc[nb][1] = zero16(); }
#pragma unroll 2
            for (int s = 0; s < 8; ++s) {
                const f32x4 wa = *(const LAS f32x4*)(w + 16 * s), wb = *(const LAS f32x4*)(w + 16 * s + 4);
                bf16x8 xw[2];
#pragma unroll
                for (int pb = 0; pb < 2; ++pb) { const u32x4 raw = *(const u32x4*)(xbase + (size_t)pb * 32 * UL + 16 * s);
                    xw[pb] = pack8(bflo(raw.x) * wa[0], bfhi(raw.x) * wa[1], bflo(raw.y) * wa[2], bfhi(raw.y) * wa[3], bflo(raw.z) * wb[0], bfhi(raw.z) * wb[1], bflo(raw.w) * wb[2], bfhi(raw.w) * wb[3]); }
#pragma unroll
                for (int nb = 0; nb < 4; ++nb) { const bf16x8 bt = *(const bf16x8*)(bbase + (size_t)nb * 32 * UL + 16 * s);
                    acc[nb][0] = MFMA32(bt, xw[0], acc[nb][0]); acc[nb][1] = MFMA32(bt, xw[1], acc[nb][1]); }
            }
            bf16* so = ST + ((size_t)(((b * 2 + dir) * 8 + h) * NCH + c) * 64) * 128;
#pragma unroll
            for (int nb = 0; nb < 4; ++nb)
#pragma unroll
                for (int pb = 0; pb < 2; ++pb)
#pragma unroll
                    for (int g4 = 0; g4 < 4; ++g4) { u32x2 o; o.x = pk2(acc[nb][pb][4 * g4], acc[nb][pb][4 * g4 + 1]); o.y = pk2(acc[nb][pb][4 * g4 + 2], acc[nb][pb][4 * g4 + 3]);
                        *(u32x2*)(so + (size_t)(32 * pb + r32) * 128 + 32 * nb + 8 * g4 + 4 * hi) = o; }
        }
        LDS_FENCE();
    }
}
__device__ __forceinline__ void phase9(const Args& a, int G, int bx, int tid) {
    unsigned char* ws = a.ws;
    const bf16* ST = (const bf16*)(ws + WS_ST); bf16* HE = (bf16*)(ws + WS_HE); const float* CD = (const float*)(ws + WS_CD);
    for (int idx = bx * 512 + tid; idx < NB * 2 * 8 * 8192; idx += G * 512) {
        const int e = idx & 8191, bdh = idx >> 13, dir = (bdh >> 3) & 1;
        const bf16* st = ST + (size_t)bdh * NCH * 8192 + e; bf16* he = HE + (size_t)bdh * 32 * 8192 + e; const float* cd = CD + bdh * NCH;
        float hs;
        if (dir == 0) {
            hs = bf2f(st[0]); hs = cd[1] * hs + bf2f(st[8192]);
#pragma unroll 8
            for (int c = 2; c < NCH; ++c) { he[(size_t)(c - 2) * 8192] = (bf16)(pk2(hs, 0.f) & 0xffffu); hs = cd[c] * hs + bf2f(st[(size_t)c * 8192]); }
        } else {
            hs = bf2f(st[8192]); hs = cd[0] * hs + bf2f(st[0]);
#pragma unroll 8
            for (int c = NCH - 1; c >= 2; --c) { he[(size_t)(c - 2) * 8192] = (bf16)(pk2(hs, 0.f) & 0xffffu); hs = cd[c] * hs + bf2f(st[(size_t)c * 8192]); }
        }
    }
}
__device__ __forceinline__ void phase10_ssd(const Args& a, LAS unsigned char* lds, int G, int bx, int lane, int wave) {
    unsigned char* ws = a.ws;
    const bf16* XT = (const bf16*)(ws + WS_XT); const bf16* BROW = (const bf16*)(ws + WS_BROW); const bf16* CROW = (const bf16*)(ws + WS_CROW); const float* DT = (const float*)(ws + WS_DT);
    const bf16* HE = (const bf16*)(ws + WS_HE); const bf16* Z = (const bf16*)(ws + WS_Z); bf16* MIX = (bf16*)(ws + WS_MIX);
    LAS float* sc = (LAS float*)lds + wave * 512;
    LAS float* SS = (LAS float*)(lds + 16384);
    const int h = wave, g = h >> 2, r32 = lane & 31, hi = lane >> 5;
    const float anf = -__expf(a.in[14][h]), anb = -__expf(a.in[14][8 + h]);
    const float dskip = a.in[15][h]; const float* snorm = a.in[16] + h * 64;
    for (int unit = bx; unit < NB * 32; unit += G) {
        const int b = unit >> 5, lc = unit & 31, c = lc + 2; const size_t u0 = (size_t)b * UL + c * 128;
        acum_wave(DT, u0, h, anf, anb, sc, lane);
#pragma unroll 1
        for (int ib = 0; ib < 4; ++ib) {
            const int i = 32 * ib + r32;
            const float afi = sc[i], abi = sc[128 + i];
            bf16x8 cfr[8];
            { const bf16* cp = CROW + (u0 + i) * 256 + g * 128 + 8 * hi;
#pragma unroll
              for (int s = 0; s < 8; ++s) cfr[s] = *(const bf16x8*)(cp + 16 * s); }
            f32x16 acc[2]; acc[0] = zero16(); acc[1] = zero16();
#pragma unroll 1
            for (int jb = 0; jb < 4; ++jb) {
                f32x16 ga = zero16();
                { const bf16* bp = BROW + (u0 + 32 * jb + r32) * 256 + g * 128 + 8 * hi;
#pragma unroll
                  for (int s = 0; s < 8; ++s) { const bf16x8 bfr = *(const bf16x8*)(bp + 16 * s); ga = MFMA32(bfr, cfr[s], ga); } }
                float mm[16];
#pragma unroll
                for (int r = 0; r < 16; ++r) {
                    const int jl = crow(r, hi), j = 32 * jb + jl;
                    float mf = 0.f, mb = 0.f;
                    if (jb <= ib) { const float e = __expf(afi - sc[j]) * sc[256 + j]; mf = (jb < ib || jl <= r32) ? e : 0.f; }
                    if (jb >= ib) { const float e = __expf(abi - sc[128 + j]) * sc[384 + j]; mb = (jb > ib || jl >= r32) ? e : 0.f; }
                    float mt = ga[r] * (mf + mb);
                    if (jb == ib && jl == r32) mt += dskip;
                    mm[r] = mt;
                }
                const bf16x8 pf0 = pack8(mm[0], mm[1], mm[2], mm[3], mm[4], mm[5], mm[6], mm[7]), pf1 = pack8(mm[8], mm[9], mm[10], mm[11], mm[12], mm[13], mm[14], mm[15]);
#pragma unroll
                for (int pb = 0; pb < 2; ++pb) {
                    const bf16* xp = XT + (size_t)(b * 512 + h * 64 + 32 * pb + r32) * UL + c * 128 + 32 * jb + 4 * hi;
                    const u32x2 a0 = *(const u32x2*)(xp), a1 = *(const u32x2*)(xp + 8), a2 = *(const u32x2*)(xp + 16), a3 = *(const u32x2*)(xp + 24);
                    const bf16x8 xa0 = __builtin_bit_cast(bf16x8, (u32x4){a0.x, a0.y, a1.x, a1.y}), xa1 = __builtin_bit_cast(bf16x8, (u32x4){a2.x, a2.y, a3.x, a3.y});
                    acc[pb] = MFMA32(xa0, pf0, acc[pb]); acc[pb] = MFMA32(xa1, pf1, acc[pb]);
                }
            }
#pragma unroll
            for (int dir = 0; dir < 2; ++dir) {
                const float e = __expf(dir ? abi : afi);
#pragma unroll
                for (int pb = 0; pb < 2; ++pb) {
                    const bf16* hp = HE + ((size_t)(((b * 2 + dir) * 8 + h) * 32 + lc) * 64 + 32 * pb + r32) * 128 + 8 * hi;
                    f32x16 ta = zero16();
#pragma unroll
                    for (int s = 0; s < 8; ++s) { const bf16x8 hf = *(const bf16x8*)(hp + 16 * s); ta = MFMA32(hf, cfr[s], ta); }
#pragma unroll
                    for (int r = 0; r < 16; ++r) acc[pb][r] += e * ta[r];
                }
            }
            const size_t row = (size_t)b * SEQ + lc * 128 + i;
            float ss = 0.f;
#pragma unroll
            for (int pb = 0; pb < 2; ++pb)
#pragma unroll
                for (int g4 = 0; g4 < 4; ++g4) { const u32x2 zw = *(const u32x2*)(Z + row * 512 + h * 64 + 32 * pb + 8 * g4 + 4 * hi);
                    const float z0 = bflo(zw.x), z1 = bfhi(zw.x), z2 = bflo(zw.y), z3 = bfhi(zw.y);
                    float v0 = acc[pb][4 * g4] * silu_f(z0), v1 = acc[pb][4 * g4 + 1] * silu_f(z1), v2 = acc[pb][4 * g4 + 2] * silu_f(z2), v3 = acc[pb][4 * g4 + 3] * silu_f(z3);
                    ss += (v0 * v0 + v1 * v1) + (v2 * v2 + v3 * v3);
                    acc[pb][4 * g4] = v0; acc[pb][4 * g4 + 1] = v1; acc[pb][4 * g4 + 2] = v2; acc[pb][4 * g4 + 3] = v3; }
            ss += __shfl_xor(ss, 32);
            LAS float* ssb = SS + (ib & 1) * 256;
            if (hi == 0) ssb[wave * 32 + r32] = ss;
            __syncthreads();
            float tot = 0.f;
#pragma unroll
            for (int w = 0; w < 8; ++w) tot += ssb[w * 32 + r32];
            const float rstd = 1.0f / sqrtf(tot * (1.f / 512.f) + EPS);
#pragma unroll
            for (int pb = 0; pb < 2; ++pb)
#pragma unroll
                for (int g4 = 0; g4 < 4; ++g4) { const int p0 = 32 * pb + 8 * g4 + 4 * hi; const f32x4 gn = *(const f32x4*)(snorm + p0);
                    u32x2 o; o.x = pk2(acc[pb][4 * g4] * rstd * gn[0], acc[pb][4 * g4 + 1] * rstd * gn[1]); o.y = pk2(acc[pb][4 * g4 + 2] * rstd * gn[2], acc[pb][4 * g4 + 3] * rstd * gn[3]);
                    *(u32x2*)(MIX + row * 1024 + h * 64 + p0) = o; }
        }
        __syncthreads();
    }
}

constexpr int AT_KS = 104, AT_VS = 68, AT_KB = 64 * AT_KS * 2, AT_BUF = AT_KB + 64 * AT_VS * 2;
__device__ __forceinline__ void phase10_attn(const Args& a, LAS unsigned char* lds, int G, int vcu, int tid, int lane, int wave) {
    unsigned char* ws = a.ws; unsigned char* ob = (unsigned char*)a.out;
    const bf16* Q = (const bf16*)(ob + OUT_Q); const bf16* KN = (const bf16*)(ob + OUT_KN); const bf16* VT = (const bf16*)(ob + OUT_VT); const bf16* KPE = (const bf16*)(ws + WS_KPE);
    bf16* MIX = (bf16*)(ws + WS_MIX); const f32x2* ROPE = (const f32x2*)(ws + WS_ROPE);
    const int r32 = lane & 31, hi = lane >> 5;
    for (int unit = vcu; unit < NB * 8 * 16; unit += G) {
        const int bh = unit >> 4, qb = unit & 15, b = bh >> 3, h = bh & 7;
        const size_t qrow = (size_t)b * SEQ + qb * 256 + wave * 32 + r32;
        bf16x8 qr[6];
        { const bf16* qp = Q + qrow * 768 + h * 96 + 8 * hi;
#pragma unroll
          for (int s = 0; s < 6; ++s) qr[s] = *(const bf16x8*)(qp + 16 * s);
          const int tq = qb * 256 + wave * 32 + r32;
#pragma unroll
          for (int s = 4; s < 6; ++s) { const int pos = (s == 4) ? (tq >> 6) : (tq & 63); const f32x2* rp = ROPE + pos * 8 + 4 * hi;
              const u32x4 w = __builtin_bit_cast(u32x4, qr[s]); const f32x2 c0 = rp[0], c1 = rp[1], c2 = rp[2], c3 = rp[3]; u32x4 o;
              o.x = pk2(bflo(w.x) * c0.x - bfhi(w.x) * c0.y, bflo(w.x) * c0.y + bfhi(w.x) * c0.x); o.y = pk2(bflo(w.y) * c1.x - bfhi(w.y) * c1.y, bflo(w.y) * c1.y + bfhi(w.y) * c1.x);
              o.z = pk2(bflo(w.z) * c2.x - bfhi(w.z) * c2.y, bflo(w.z) * c2.y + bfhi(w.z) * c2.x); o.w = pk2(bflo(w.w) * c3.x - bfhi(w.w) * c3.y, bflo(w.w) * c3.y + bfhi(w.w) * c3.x);
              qr[s] = __builtin_bit_cast(bf16x8, o); } }
        const int kr = tid >> 3, kpart = tid & 7;
        const int pr = tid >> 2, ppart = tid & 3;
#define AT_ROW0(t) ((t) < 4 ? (size_t)NLAT + b * CTXL + (t) * 64 : (size_t)b * SEQ + ((t) - 4) * 64)
#define AT_LOAD(t) do { const size_t r0_ = AT_ROW0(t); \
        gk = *(const u32x4*)(KN + (r0_ + kr) * 512 + h * 64 + kpart * 8); \
        gv = *(const u32x4*)(VT + (size_t)(h * 64 + kr) * MTOT + r0_ + kpart * 8); \
        if (tid < 256) gp = *(const u32x4*)(KPE + (r0_ + pr) * 32 + ppart * 8); } while (0)
#define AT_STORE(bufi) do { LAS unsigned char* B_ = lds + (bufi) * AT_BUF; \
        *(LAS u32x4*)(B_ + (kr * AT_KS + kpart * 8) * 2) = gk; \
        *(LAS u32x2*)(B_ + AT_KB + (kr * AT_VS + kpart * 8) * 2) = (u32x2){gv.x, gv.y}; *(LAS u32x2*)(B_ + AT_KB + (kr * AT_VS + kpart * 8 + 4) * 2) = (u32x2){gv.z, gv.w}; \
        if (tid < 256) *(LAS u32x4*)(B_ + (pr * AT_KS + 64 + ppart * 8) * 2) = gp; } while (0)
        u32x4 gk, gv, gp = (u32x4){0u, 0u, 0u, 0u};
        AT_LOAD(0); AT_STORE(0);
        __syncthreads();
        float mrun = -INFINITY, lrun = 0.f;
        f32x16 o[2]; o[0] = zero16(); o[1] = zero16();
#pragma unroll 1
        for (int t = 0; t < 68; ++t) {
            if (t + 1 < 68) AT_LOAD(t + 1);
            const LAS unsigned char* Bc = lds + (t & 1) * AT_BUF;
            f32x16 p0 = zero16(), p1 = zero16();
#pragma unroll
            for (int s = 0; s < 6; ++s) {
                const bf16x8 k0 = *(const LAS bf16x8*)(Bc + (r32 * AT_KS + 16 * s + 8 * hi) * 2), k1 = *(const LAS bf16x8*)(Bc + ((32 + r32) * AT_KS + 16 * s + 8 * hi) * 2);
                p0 = MFMA32(k0, qr[s], p0); p1 = MFMA32(k1, qr[s], p1);
            }
            float mx = fmaxf(p0[0], p1[0]);
#pragma unroll
            for (int r = 1; r < 16; ++r) mx = fmaxf(mx, fmaxf(p0[r], p1[r]));
            mx = fmaxf(mx, __shfl_xor(mx, 32));
            const float mnew = fmaxf(mrun, mx), alpha = __builtin_amdgcn_exp2f(mrun - mnew);
            mrun = mnew;
            float rs = 0.f;
#pragma unroll
            for (int r = 0; r < 16; ++r) { p0[r] = __builtin_amdgcn_exp2f(p0[r] - mnew); p1[r] = __builtin_amdgcn_exp2f(p1[r] - mnew); rs += p0[r] + p1[r]; }
            lrun = lrun * alpha + rs;
#pragma unroll
            for (int r = 0; r < 16; ++r) { o[0][r] *= alpha; o[1][r] *= alpha; }
            bf16x8 pf[4];
            pf[0] = pack8(p0[0], p0[1], p0[2], p0[3], p0[4], p0[5], p0[6], p0[7]); pf[1] = pack8(p0[8], p0[9], p0[10], p0[11], p0[12], p0[13], p0[14], p0[15]);
            pf[2] = pack8(p1[0], p1[1], p1[2], p1[3], p1[4], p1[5], p1[6], p1[7]); pf[3] = pack8(p1[8], p1[9], p1[10], p1[11], p1[12], p1[13], p1[14], p1[15]);
#pragma unroll
            for (int db = 0; db < 2; ++db)
#pragma unroll
                for (int s = 0; s < 4; ++s) {
                    const LAS unsigned char* vp = Bc + AT_KB + ((32 * db + r32) * AT_VS + 16 * s + 4 * hi) * 2;
                    const u32x2 v0 = *(const LAS u32x2*)vp, v1 = *(const LAS u32x2*)(vp + 16);
                    o[db] = MFMA32(__builtin_bit_cast(bf16x8, (u32x4){v0.x, v0.y, v1.x, v1.y}), pf[s], o[db]);
                }
            if (t + 1 < 68) AT_STORE((t + 1) & 1);
            __syncthreads();
        }
#undef AT_ROW0
#undef AT_LOAD
#undef AT_STORE
        const float ltot = lrun + __shfl_xor(lrun, 32), rl = 1.0f / ltot;
        bf16* op = MIX + qrow * 1024 + 512 + h * 64 + 4 * hi;
#pragma unroll
        for (int db = 0; db < 2; ++db)
#pragma unroll
            for (int g4 = 0; g4 < 4; ++g4) { u32x2 w; w.x = pk2(o[db][4 * g4] * rl, o[db][4 * g4 + 1] * rl); w.y = pk2(o[db][4 * g4 + 2] * rl, o[db][4 * g4 + 3] * rl);
                *(u32x2*)(op + 32 * db + 8 * g4) = w; }
    }
}

__global__ void __launch_bounds__(512, 2) hymba_fwd(Args args) {
    extern __shared__ __attribute__((aligned(16))) unsigned char lds_raw[];
    LAS unsigned char* lds = (LAS unsigned char*)lds_raw;
    cg::grid_group grid = cg::this_grid();
    const int tid = threadIdx.x, lane = tid & 63, wave = __builtin_amdgcn_readfirstlane(tid >> 6);
    const int G = gridDim.x, bx = blockIdx.x, vcu = (G % 8 == 0) ? (bx % 8) * (G / 8) + bx / 8 : bx;
    const int gw = bx * 8 + wave, NGW = G * 8;
    unsigned char* ws = args.ws;
    const int lo = args.ph_lo, hi = args.ph_hi;
    const float* MOD = (const float*)(ws + WS_MOD);
    bf16* XN = (bf16*)(ws + WS_A); bf16* HB = (bf16*)(ws + WS_B); float* X1 = (float*)(ws + WS_C);
#ifndef PHMASK
#define PHMASK 0xFFFF
#endif
#define IN(k) (((PHMASK >> (k)) & 1) && lo <= (k) && (k) < hi)
#define SEAM(k) do { if (IN(k) && IN((k) + 1)) grid.sync(); } while (0)
    if (IN(0)) { phase0(args, lds, gw, NGW, tid, lane, wave); } SEAM(0);
    if (IN(1)) { norm_rows(args.in[0], args.in[2], MTOT, args.in[6], MOD, 0, XN, gw, NGW, lane); } SEAM(1);
    if (IN(2)) { pg8::Gemm g{XN, (const bf16*)(ws + WS_W1A), MTOT, 2 * DFF, D}; pg8::StaticOrder S; S.init(MTOT, 2 * DFF, G, bx);
        pg8::EpiSwiglu E{HB, DFF}; pg8::gemm_phase<pg8::EpiSwiglu, pg8::StaticOrder, true, true>(lds, g, S, E); } SEAM(2);
    if (IN(3)) { pg8::Gemm g{HB, (const bf16*)(ws + WS_W1B), MTOT, D, DFF}; pg8::StaticOrder S; S.init(MTOT, D, G, bx);
        pg8::EpiRes E{args.in[0], args.in[2], X1, MOD, 2, 0.5f}; pg8::gemm_phase<pg8::EpiRes, pg8::StaticOrder, true, true>(lds, g, S, E); } SEAM(3);
    if (IN(4)) { norm_rows(X1, X1 + (size_t)NLAT * D, MTOT, args.in[9], MOD, 3, XN, gw, NGW, lane); } SEAM(4);
    if (IN(5)) { pg8::Gemm g{XN, (const bf16*)(ws + WS_WIN), MTOT, 2816, D}; pg8::StaticOrder S; S.init(MTOT, 2816, G, bx);
        pg8::EpiSplit E{(bf16*)(ws + WS_Z), (bf16*)(ws + WS_XBCR), (bf16*)(ws + WS_CQ), (bf16*)(ws + WS_CKV), (bf16*)(ws + WS_MISC)};
        pg8::gemm_phase<pg8::EpiSplit, pg8::StaticOrder, true, true>(lds, g, S, E); } SEAM(5);
    if (IN(6)) { phase6(args, lds, G, bx, tid, lane, wave); } SEAM(6);
    if (IN(7)) {
        unsigned char* ob = (unsigned char*)args.out;
        { pg8::Gemm g{(const bf16*)(ws + WS_CQ), (const bf16*)(ws + WS_WUQ), NLAT, 768, 768}; pg8::StaticOrder S; S.init(NLAT, 768, G, bx);
          pg8::EpiScale E{(bf16*)(ob + OUT_Q), 768, (const float*)(ws + WS_RSTDQ), nullptr}; pg8::gemm_phase<pg8::EpiScale, pg8::StaticOrder, true, true>(lds, g, S, E); }
        { pg8::Gemm g{(const bf16*)(ws + WS_CKV), (const bf16*)(ws + WS_WK), MTOT, 512, 256}; pg8::StaticOrder S; S.init(MTOT, 512, G, bx);
          pg8::EpiScale E{(bf16*)(ob + OUT_KN), 512, (const float*)(ws + WS_RSTDKV), nullptr}; pg8::gemm_phase<pg8::EpiScale, pg8::StaticOrder, true, true>(lds, g, S, E); }
        { pg8::Gemm g{(const bf16*)(ws + WS_WV), (const bf16*)(ws + WS_CKV), 512, MTOT, 256}; pg8::StaticOrder S; S.init(512, MTOT, G, bx);
          pg8::EpiScale E{(bf16*)(ob + OUT_VT), MTOT, nullptr, (const float*)(ws + WS_RSTDKV)}; pg8::gemm_phase<pg8::EpiScale, pg8::StaticOrder, true, true>(lds, g, S, E); }
    } SEAM(7);
    if (IN(8)) { phase8(args, lds, G, bx, lane, wave); } SEAM(8);
    if (IN(9)) { phase9(args, G, bx, tid); } SEAM(9);
    if (IN(10)) { phase10_ssd(args, lds, G, bx, lane, wave); phase10_attn(args, lds, G, vcu, tid, lane, wave); } SEAM(10);
    if (IN(11)) { pg8::Gemm g{(const bf16*)(ws + WS_MIX), (const bf16*)(ws + WS_WOUT), NLAT, D, D}; pg8::StaticOrder S; S.init(NLAT, D, G, bx);
        pg8::EpiRes E{X1, X1, X1, MOD, 5, 1.0f}; pg8::gemm_phase<pg8::EpiRes, pg8::StaticOrder, true, true>(lds, g, S, E); } SEAM(11);
    if (IN(12)) { norm_rows(X1, X1, NLAT, args.in[22], MOD, 6, XN, gw, NGW, lane); } SEAM(12);
    if (IN(13)) { pg8::Gemm g{XN, (const bf16*)(ws + WS_W2A), NLAT, 2 * DFF, D}; pg8::StaticOrder S; S.init(NLAT, 2 * DFF, G, bx);
        pg8::EpiSwiglu E{HB, DFF}; pg8::gemm_phase<pg8::EpiSwiglu, pg8::StaticOrder, true, true>(lds, g, S, E); } SEAM(13);
    if (IN(14)) { pg8::Gemm g{HB, (const bf16*)(ws + WS_W2B), NLAT, D, DFF}; pg8::StaticOrder S; S.init(NLAT, D, G, bx);
        pg8::EpiRes E{X1, X1, args.out, MOD, 8, 0.5f}; pg8::gemm_phase<pg8::EpiRes, pg8::StaticOrder, true, true>(lds, g, S, E); } SEAM(14);
    if (IN(15)) { final_norm_rows(args.out, args.in[25], gw, NGW, lane); }
#undef IN
#undef SEAM
}

#ifndef N_LAUNCHES
#define N_LAUNCHES 1
#endif
extern "C" void kernel_launch(void* const* d_in, const int* in_sizes, int n_in, void* d_out, int out_size, void* d_ws, size_t ws_size, hipStream_t stream) {
    static int grid = 0;
    if (grid == 0) {
        if (n_in != 26 || out_size != NLAT * D || ws_size < WS_END) { fprintf(stderr, "kernel_launch: unexpected shapes (n_in %d out %d ws %zu)\n", n_in, out_size, ws_size); grid = -1; return; }
        int dev = 0, cus = 0, per_cu = 0;
        hipGetDevice(&dev); hipDeviceGetAttribute(&cus, hipDeviceAttributeMultiprocessorCount, dev);
        if (hipFuncSetAttribute((const void*)hymba_fwd, hipFuncAttributeMaxDynamicSharedMemorySize, LDS_BYTES) != hipSuccess) { fprintf(stderr, "kernel_launch: hipFuncSetAttribute failed\n"); grid = -1; return; }
        if (hipOccupancyMaxActiveBlocksPerMultiprocessor(&per_cu, (const void*)hymba_fwd, 512, LDS_BYTES) != hipSuccess || per_cu < 1) { fprintf(stderr, "kernel_launch: occupancy query failed (%d)\n", per_cu); grid = -1; (void)hipGetLastError(); return; }
        grid = cus;
    }
    if (grid < 0) return;
    hipMemsetAsync((char*)d_ws + WS_MOD, 0, 9 * 9216 * 4, stream);
    Args a{};
    for (int i = 0; i < 26; ++i) a.in[i] = (const float*)d_in[i];
    a.out = (float*)d_out; a.ws = (unsigned char*)d_ws;
    for (int li = 0; li < N_LAUNCHES; ++li) {
        a.ph_lo = (N_LAUNCHES == 1) ? 0 : li; a.ph_hi = (N_LAUNCHES == 1) ? NPHASE : li + 1;
        void* kargs[] = {&a};
        hipError_t e = hipLaunchCooperativeKernel((const void*)hymba_fwd, dim3(grid), dim3(512), kargs, LDS_BYTES, stream);
        if (e != hipSuccess) { fprintf(stderr, "kernel_launch: cooperative launch %d failed: %s (grid %d)\n", li, hipGetErrorString(e), grid); break; }
    }
}
```

```cpp
#include <hip/hip_runtime.h>
#include <hip/hip_cooperative_groups.h>
#include <cstdio>
#include <cstdint>
namespace cg = cooperative_groups;
namespace pg8 {
#define PG8_LAS __attribute__((address_space(3)))
typedef unsigned short bf16_t;
typedef short bf16x8 __attribute__((ext_vector_type(8)));
typedef float f32x4 __attribute__((ext_vector_type(4)));
typedef unsigned u32x4 __attribute__((ext_vector_type(4)));
constexpr int BM = 256, BK = 64, HALF = 128, HTB = HALF * BK * 2  , STAGE_BYTES = 8 * HTB, NXCD = 8, WGM = 8;

__host__ __device__ __forceinline__ int lds_byte(int r, int c) { const int st = (r >> 4) * 2 + (c >> 5), rr = r & 15, cc = c & 31, ob = rr * 64 + cc * 2; return st * 1024 + (ob ^ (((ob >> 9) & 1) << 5)); }
__host__ __device__ __forceinline__ void stage_rc(int b, int& R, int& C) { const int st = b / 1024, sb = b % 1024, swz = sb ^ (((sb >> 9) & 1) << 5); R = (st >> 1) * 16 + swz / 64; C = (st & 1) * 32 + (swz % 64) / 2; }
__host__ __device__ __forceinline__ int perm32(int rho) { const int n = rho >> 4, i = rho & 15; return 8 * (i >> 2) + 4 * n + (i & 3); }

struct Unit { int pm, pn; };
struct Gemm { const bf16_t* A; const bf16_t* Bt; int M, N, K; };

struct StaticOrder {
    int nM, nN, nwg, G, c;
    __host__ __device__ void init(int M, int N, int G_, int c_) { nM = M / BM; nN = N / BM; nwg = nM * nN; G = G_; c = c_; }
    __host__ __device__ bool next(int i, Unit& u) const {
        const long L = (long)i * G + c; if (L >= nwg) return false;
        int wgid = (int)L; { const int q = nwg / NXCD, r = nwg % NXCD, xcd = wgid % NXCD, off = wgid / NXCD; wgid = (xcd < r ? xcd * (q + 1) : r * (q + 1) + (xcd - r) * q) + off; }
        const int nig = WGM * nN, gid = wgid / nig, fm = gid * WGM, gsz = (nM - fm) < WGM ? (nM - fm) : WGM;
        u.pm = fm + ((wgid % nig) % gsz); u.pn = (wgid % nig) / gsz; return true;
    }
    __device__ __forceinline__ void a_ready(const Unit&) const {}
    __device__ __forceinline__ void done(const Unit&) const {}
};

__device__ __forceinline__ unsigned cvt_pk_bf16(float lo, float hi) { unsigned r; asm volatile("v_cvt_pk_bf16_f32 %0, %1, %2" : "=v"(r) : "v"(lo), "v"(hi)); return r; }
typedef float f32x2 __attribute__((ext_vector_type(2)));
__device__ __forceinline__ f32x2 gelu_pk(f32x2 v) {
    const f32x2 av = __builtin_elementwise_abs(v), d = av * 0.2316418882f + 1.0f;
    f32x2 t; t.x = __builtin_amdgcn_rcpf(d.x); t.y = __builtin_amdgcn_rcpf(d.y);
    f32x2 q = t * 0.5307027145f + (-0.7265760135f); q = q * t + 0.7107068705f; q = q * t + (-0.142248368f); q = q * t + 0.127414796f; q = q * t;
    const f32x2 s = (v * v) * (-0.72134752044f);
    f32x2 e; e.x = __builtin_amdgcn_exp2f(s.x); e.y = __builtin_amdgcn_exp2f(s.y);
    const f32x2 m = v * (q * e), r = v - m;
    f32x2 o; o.x = v.x < 0.f ? m.x : r.x; o.y = v.y < 0.f ? m.y : r.y; return o;
}

template <int ACT  > struct EpiBf16 {
    static constexpr bool PERM = true, AFTER_DRAIN = false; static_assert(ACT == 0 || ACT == 1, "EpiBf16: ACT is 0 (none) or 1 (gelu_pk)");
    bf16_t* O; int ldc; const float* bias; int split_cols; size_t split_stride; float scale0;
    __device__ __forceinline__ void operator()(const f32x4 (&acc)[2][2][4][2], const Unit& u, int wr, int wc, int fr, int fq) const {
        const int row0 = u.pm * BM + wr * 64 + fr; int colt = u.pn * BM; bf16_t* base = O;
        float sc = 1.f; if (split_cols) { const int t = colt / split_cols; base += (size_t)t * split_stride; colt -= t * split_cols; if (t == 0) sc = scale0; }
        const int col0 = colt + wc * 32 + 8 * fq, bcol0 = u.pn * BM + wc * 32 + 8 * fq;
        f32x4 bv[2][2];
#pragma unroll
        for (int bj = 0; bj < 2; ++bj)
#pragma unroll
            for (int n = 0; n < 2; ++n) bv[bj][n] = bias ? *(const f32x4*)(bias + bcol0 + bj * HALF + 4 * n) : (f32x4){0.f, 0.f, 0.f, 0.f};
#pragma unroll
        for (int ai = 0; ai < 2; ++ai)
#pragma unroll
            for (int m = 0; m < 4; ++m) { bf16_t* rowp = base + (size_t)(row0 + ai * HALF + m * 16) * ldc + col0;
#pragma unroll
                for (int bj = 0; bj < 2; ++bj) { f32x4 v0 = acc[ai][bj][m][0] + bv[bj][0], v1 = acc[ai][bj][m][1] + bv[bj][1];
                    if (ACT == 1) { f32x2 a = gelu_pk((f32x2){v0[0], v0[1]}), b = gelu_pk((f32x2){v0[2], v0[3]}), c = gelu_pk((f32x2){v1[0], v1[1]}), d = gelu_pk((f32x2){v1[2], v1[3]});
                        v0 = (f32x4){a.x, a.y, b.x, b.y}; v1 = (f32x4){c.x, c.y, d.x, d.y}; }
                    v0 = v0 * sc; v1 = v1 * sc; u32x4 w; w.x = cvt_pk_bf16(v0[0], v0[1]); w.y = cvt_pk_bf16(v0[2], v0[3]); w.z = cvt_pk_bf16(v1[0], v1[1]); w.w = cvt_pk_bf16(v1[2], v1[3]);
                    *(u32x4*)(rowp + bj * HALF) = w; } }
    }
};
template <class Epi, class Sched, bool ALIGN_EPI = false, bool SP2 = false>
__device__ __forceinline__ void gemm_phase(PG8_LAS unsigned char* lds, const Gemm g, const Sched& S, const Epi& E) {
    const int tid = threadIdx.x, wid = __builtin_amdgcn_readfirstlane(tid >> 6), lane = tid & 63, wr = wid >> 2, wc = wid & 3, fr = lane & 15, fq = lane >> 4;
    const int K = g.K, nt = K / BK;
    unsigned voffA[2], voffB[2];
#pragma unroll
    for (int i = 0; i < 2; ++i) { int R, C; stage_rc(tid * 16 + i * 8192, R, C); const int Rb = Epi::PERM ? ((R & ~31) + perm32(R & 31)) : R;
        voffA[i] = (unsigned)(R * K + C) * 2u; voffB[i] = (unsigned)(Rb * K + C) * 2u; }
    const size_t kstep = (size_t)(BK * 2);
    const size_t hstep = (size_t)HALF * K * 2;
    const size_t tstep = 2 * hstep;
    const unsigned ldsw = (unsigned)wid * 1024u;
    const int aoff = lds_byte(wr * 64 + fr, fq * 8), boff = lds_byte(wc * 32 + fr, fq * 8);
#define PG8_SA(b, h) (((b) * 2 + (h)) * HTB)
#define PG8_SB(b, h) ((4 + (b) * 2 + (h)) * HTB)
#define PG8_STAGE(bufoff, gbase, voff) do { _Pragma("unroll") for (int _i = 0; _i < 2; ++_i) \
        __builtin_amdgcn_global_load_lds((const unsigned*)((const char*)(gbase) + (voff)[_i]), (PG8_LAS unsigned*)(lds + (bufoff) + ldsw + _i * 8192), 16, 0, 0); } while (0)
#define PG8_LDA(dst, b, h) do { _Pragma("unroll") for (int m = 0; m < 4; ++m) _Pragma("unroll") for (int k = 0; k < 2; ++k) dst[m][k] = *(const PG8_LAS bf16x8*)(lds + PG8_SA(b, h) + aoff + m * 2048 + k * 1024); } while (0)
#define PG8_LDB(dst, b, h) do { _Pragma("unroll") for (int n = 0; n < 2; ++n) _Pragma("unroll") for (int k = 0; k < 2; ++k) dst[n][k] = *(const PG8_LAS bf16x8*)(lds + PG8_SB(b, h) + boff + n * 2048 + k * 1024); } while (0)
#define PG8_MMA(ai, bj, At, Bt) do { __builtin_amdgcn_s_setprio(1); _Pragma("unroll") for (int m = 0; m < 4; ++m) _Pragma("unroll") for (int n = 0; n < 2; ++n) _Pragma("unroll") for (int k = 0; k < 2; ++k) \
        acc[ai][bj][m][n] = __builtin_amdgcn_mfma_f32_16x16x32_bf16(Bt[n][k], At[m][k], acc[ai][bj][m][n], 0, 0, 0); __builtin_amdgcn_s_setprio(0); } while (0)
#define PG8_WAIT_V(n) asm volatile("s_waitcnt vmcnt(" #n ")" ::: "memory")
#define PG8_WAIT_L(n) asm volatile("s_waitcnt lgkmcnt(" #n ")" ::: "memory")
#define PG8_BAR __builtin_amdgcn_s_barrier()
#define PG8_SCHED __builtin_amdgcn_sched_barrier(0)
    Unit cur, nxt; int ui = 0;
    if (!S.next(0, cur)) return;
    f32x4 acc[2][2][4][2];
#pragma unroll
    for (int a = 0; a < 2; ++a)
#pragma unroll
        for (int b = 0; b < 2; ++b)
#pragma unroll
            for (int m = 0; m < 4; ++m)
#pragma unroll
                for (int n = 0; n < 2; ++n) acc[a][b][m][n] = (f32x4){0.f, 0.f, 0.f, 0.f};
    bf16x8 At[4][2], B0[2][2], B1[2][2];
    const char* cA = (const char*)g.A + (size_t)cur.pm * tstep; const char* cB = (const char*)g.Bt + (size_t)cur.pn * tstep;
    S.a_ready(cur);
    if constexpr (SP2) {
        PG8_STAGE(PG8_SB(0, 0), cB, voffB); PG8_STAGE(PG8_SB(0, 1), cB + hstep, voffB); PG8_STAGE(PG8_SA(0, 0), cA, voffA); PG8_STAGE(PG8_SA(0, 1), cA + hstep, voffA);
        if (wr == 1) PG8_BAR;
        PG8_WAIT_V(2); PG8_BAR;
        PG8_STAGE(PG8_SB(1, 0), cB + kstep, voffB); PG8_STAGE(PG8_SA(1, 0), cA + kstep, voffA); PG8_STAGE(PG8_SB(1, 1), cB + hstep + kstep, voffB);
        PG8_WAIT_V(6); PG8_BAR;
    } else {
        PG8_STAGE(PG8_SB(0, 0), cB, voffB); PG8_STAGE(PG8_SA(0, 0), cA, voffA); PG8_STAGE(PG8_SB(0, 1), cB + hstep, voffB); PG8_STAGE(PG8_SA(0, 1), cA + hstep, voffA);
        if (wr == 1) PG8_BAR;
        PG8_WAIT_V(4); PG8_BAR;
        PG8_STAGE(PG8_SB(1, 0), cB + kstep, voffB); PG8_STAGE(PG8_SA(1, 0), cA + kstep, voffA); PG8_STAGE(PG8_SB(1, 1), cB + hstep + kstep, voffB);
        PG8_WAIT_V(6); PG8_BAR;
    }
    for (;;) {
        const bool has_next = S.next(ui + 1, nxt);
        const char* nA = has_next ? (const char*)g.A + (size_t)nxt.pm * tstep : cA; const char* nB = has_next ? (const char*)g.Bt + (size_t)nxt.pn * tstep : cB;
        for (int t = 0; t < nt; t += 2) {
            const bool last = (t == nt - 2);
            const char* a1 = cA + (size_t)(t + 1) * kstep;
            const char* a2 = last ? nA : cA + (size_t)(t + 2) * kstep; const char* b2 = last ? nB : cB + (size_t)(t + 2) * kstep;
            const char* a3 = a2 + kstep; const char* b3 = b2 + kstep;
            if (last && has_next) S.a_ready(nxt);
            if constexpr (SP2) {
            PG8_LDB(B0, 0, 0); PG8_LDB(B1, 0, 1); PG8_SCHED; PG8_LDA(At, 0, 0); PG8_STAGE(PG8_SA(1, 1), a1 + hstep, voffA);
            PG8_WAIT_V(8); PG8_WAIT_L(0); PG8_BAR; PG8_MMA(0, 0, At, B0); PG8_MMA(0, 1, At, B1); PG8_BAR; PG8_SCHED;
            PG8_LDA(At, 0, 1); PG8_STAGE(PG8_SB(0, 0), b2, voffB); PG8_STAGE(PG8_SB(0, 1), b2 + hstep, voffB); PG8_STAGE(PG8_SA(0, 0), a2, voffA);
            PG8_WAIT_V(8); PG8_WAIT_L(0); PG8_BAR; PG8_MMA(1, 0, At, B0); PG8_MMA(1, 1, At, B1); PG8_BAR; PG8_SCHED;
            PG8_LDB(B0, 1, 0); PG8_LDB(B1, 1, 1); PG8_SCHED; PG8_LDA(At, 1, 0); PG8_STAGE(PG8_SA(0, 1), a2 + hstep, voffA);
            PG8_WAIT_V(8); PG8_WAIT_L(0); PG8_BAR; PG8_MMA(0, 0, At, B0); PG8_MMA(0, 1, At, B1); PG8_BAR; PG8_SCHED;
            PG8_LDA(At, 1, 1); PG8_STAGE(PG8_SB(1, 0), b3, voffB); PG8_STAGE(PG8_SB(1, 1), b3 + hstep, voffB); PG8_STAGE(PG8_SA(1, 0), a3, voffA);
            PG8_WAIT_V(8); PG8_WAIT_L(0); PG8_BAR; PG8_MMA(1, 0, At, B0); PG8_MMA(1, 1, At, B1); PG8_BAR; PG8_SCHED;
            } else {
            PG8_LDB(B0, 0, 0); PG8_SCHED; PG8_LDA(At, 0, 0); PG8_STAGE(PG8_SA(1, 1), a1 + hstep, voffA);
            PG8_WAIT_L(8); PG8_BAR; PG8_WAIT_L(0); PG8_MMA(0, 0, At, B0); PG8_BAR; PG8_SCHED;
            PG8_LDB(B1, 0, 1); PG8_STAGE(PG8_SB(0, 0), b2, voffB);
            PG8_BAR; PG8_WAIT_L(0); PG8_MMA(0, 1, At, B1); PG8_BAR;
            PG8_LDA(At, 0, 1); PG8_STAGE(PG8_SA(0, 0), a2, voffA);
            PG8_BAR; PG8_WAIT_L(0); PG8_MMA(1, 0, At, B0); PG8_BAR; PG8_SCHED;
            PG8_STAGE(PG8_SB(0, 1), b2 + hstep, voffB);
            PG8_WAIT_V(6); PG8_BAR; PG8_MMA(1, 1, At, B1); PG8_BAR;
            PG8_LDB(B0, 1, 0); PG8_SCHED; PG8_LDA(At, 1, 0); PG8_STAGE(PG8_SA(0, 1), a2 + hstep, voffA);
            PG8_WAIT_L(8); PG8_BAR; PG8_WAIT_L(0); PG8_MMA(0, 0, At, B0); PG8_BAR; PG8_SCHED;
            PG8_LDB(B1, 1, 1); PG8_STAGE(PG8_SB(1, 0), b3, voffB);
            PG8_BAR; PG8_WAIT_L(0); PG8_MMA(0, 1, At, B1); PG8_BAR;
            PG8_LDA(At, 1, 1); PG8_STAGE(PG8_SA(1, 0), a3, voffA);
            PG8_BAR; PG8_WAIT_L(0); PG8_MMA(1, 0, At, B0); PG8_BAR; PG8_SCHED;
            PG8_STAGE(PG8_SB(1, 1), b3 + hstep, voffB);
            PG8_WAIT_V(6); PG8_BAR; PG8_MMA(1, 1, At, B1); PG8_BAR;
            }
        }
        if constexpr (ALIGN_EPI) { if (wr == 0) PG8_BAR; }
        if constexpr (!Epi::AFTER_DRAIN) { E(acc, cur, wr, wc, fr, fq); S.done(cur); }
        if (!has_next) break;
#pragma unroll
        for (int a = 0; a < 2; ++a)
#pragma unroll
            for (int b = 0; b < 2; ++b)
#pragma unroll
                for (int m = 0; m < 4; ++m)
#pragma unroll
                    for (int n = 0; n < 2; ++n) acc[a][b][m][n] = (f32x4){0.f, 0.f, 0.f, 0.f};
        cur = nxt; cA = nA; cB = nB; ++ui;
        if constexpr (ALIGN_EPI) { if (wr == 1) PG8_BAR; }
    }
    PG8_WAIT_V(0);
    if constexpr (!ALIGN_EPI) { if (wr == 0) PG8_BAR; }
    PG8_BAR;
    if constexpr (Epi::AFTER_DRAIN) { E.fused(acc, cur, wr, wc, fr, fq, lds, wid, lane); S.done(cur); }
#undef PG8_SA
#undef PG8_SB
#undef PG8_STAGE
#undef PG8_LDA
#undef PG8_LDB
#undef PG8_MMA
#undef PG8_WAIT_V
#undef PG8_WAIT_L
#undef PG8_BAR
#undef PG8_SCHED
}
}
#ifndef PROBE_PHASE
#define PROBE_PHASE -1
#endif

#define LAS __attribute__((address_space(3)))
typedef unsigned short bf16;
typedef short bf16x8 __attribute__((ext_vector_type(8)));
typedef float f32x2 __attribute__((ext_vector_type(2)));
typedef float f32x4 __attribute__((ext_vector_type(4)));
typedef float f32x16 __attribute__((ext_vector_type(16)));
typedef unsigned u32x2 __attribute__((ext_vector_type(2)));
typedef unsigned u32x4 __attribute__((ext_vector_type(4)));
typedef __bf16 bf16x2_t __attribute__((ext_vector_type(2)));

constexpr int D = 1024, NB = 8, SEQ = 4096, CTXL = 256, NLAT = NB * SEQ, NCTX = NB * CTXL, MTOT = NLAT + NCTX;
constexpr int DFF = 2816, UL = SEQ + CTXL, NCH = UL / 128;
constexpr float EPS = 1e-6f;
constexpr float QSCALE = 0.10206207261596575f * 1.4426950408889634f;
constexpr int NPHASE = 16;

constexpr size_t MiB = (size_t)1 << 20, KiB = 1024;
constexpr size_t WS_BAR = 1 * MiB, WS_ZERO_BYTES = 1 * MiB + 16 * KiB;
constexpr size_t WS_MOD = 0, WS_ROPE = 384 * KiB, WS_CD = 448 * KiB, WS_RSTDQ = 512 * KiB, WS_RSTDKV = 768 * KiB;
constexpr size_t WS_W1A = 2 * MiB, WS_W1B = 13 * MiB, WS_WIN = 18 * MiB + 512 * KiB, WS_WUQ = 24 * MiB, WS_WK = 25 * MiB + 512 * KiB, WS_WV = 25 * MiB + 768 * KiB,
                 WS_WOUT = 26 * MiB, WS_W2A = 28 * MiB, WS_W2B = 39 * MiB;
constexpr size_t WS_A = 45 * MiB;
constexpr size_t WS_B = 113 * MiB;
constexpr size_t WS_Z = WS_B, WS_XBCR = WS_B + 34 * MiB, WS_CQ = WS_B + 102 * MiB, WS_CKV = WS_B + 153 * MiB, WS_MISC = WS_B + 170 * MiB;
constexpr size_t WS_ST = WS_XBCR, WS_MIX = WS_XBCR, WS_HE = WS_CQ;
constexpr size_t WS_C = 300 * MiB;
constexpr size_t WS_XT = 436 * MiB, WS_BT = 470 * MiB, WS_CROW = 487 * MiB, WS_DT = 504 * MiB, WS_KPE = 506 * MiB + 256 * KiB, WS_END = 512 * MiB;
constexpr size_t WS_BROW = WS_A;
constexpr size_t OUT_Q = 0, OUT_KN = 48 * MiB, OUT_VT = 82 * MiB;
constexpr int LDS_BYTES = 147456;

__device__ __forceinline__ unsigned pk2(float lo, float hi) { f32x2 v = {lo, hi}; bf16x2_t b = __builtin_convertvector(v, bf16x2_t); return __builtin_bit_cast(unsigned, b); }
__device__ __forceinline__ float bflo(unsigned w) { return __uint_as_float(w << 16); }
__device__ __forceinline__ float bfhi(unsigned w) { return __uint_as_float(w & 0xffff0000u); }
__device__ __forceinline__ float bf2f(bf16 u) { return __uint_as_float((unsigned)u << 16); }
__device__ __forceinline__ float silu_f(float x) { return x / (1.f + __expf(-x)); }
__device__ __forceinline__ float wave_sum(float v) {
#pragma unroll
    for (int o = 1; o < 64; o <<= 1) v += __shfl_xor(v, o);
    return v;
}
__device__ __forceinline__ float incl_scan(float v, int lane) {
#pragma unroll
    for (int o = 1; o < 64; o <<= 1) { float t = __shfl_up(v, o); if (lane >= o) v += t; }
    return v;
}
#define LDS_FENCE() asm volatile("s_waitcnt lgkmcnt(0)" ::: "memory")
__device__ __forceinline__ int crow(int r, int hi) { return (r & 3) + 8 * (r >> 2) + 4 * hi; }
__device__ __forceinline__ bf16x8 pack8(float a0, float a1, float a2, float a3, float a4, float a5, float a6, float a7) {
    u32x4 w; w.x = pk2(a0, a1); w.y = pk2(a2, a3); w.z = pk2(a4, a5); w.w = pk2(a6, a7); return __builtin_bit_cast(bf16x8, w);
}

struct Args { const float* in[26]; float* out; unsigned char* ws; int ph_lo, ph_hi; };

namespace pg8 {
struct EpiSwiglu {
    static constexpr bool PERM = true, AFTER_DRAIN = false;
    bf16_t* O; int ldc;
    __device__ __forceinline__ void operator()(const f32x4 (&acc)[2][2][4][2], const Unit& u, int wr, int wc, int fr, int fq) const {
        const int row0 = u.pm * BM + wr * 64 + fr, col0 = u.pn * HALF + wc * 32 + 8 * fq;
#pragma unroll
        for (int ai = 0; ai < 2; ++ai)
#pragma unroll
            for (int m = 0; m < 4; ++m) {
                bf16_t* rowp = O + (size_t)(row0 + ai * HALF + m * 16) * ldc + col0;
                const f32x4 g0 = acc[ai][0][m][0], g1 = acc[ai][0][m][1], u0 = acc[ai][1][m][0], u1 = acc[ai][1][m][1];
                u32x4 w;
                w.x = cvt_pk_bf16(silu_f(g0[0]) * u0[0], silu_f(g0[1]) * u0[1]); w.y = cvt_pk_bf16(silu_f(g0[2]) * u0[2], silu_f(g0[3]) * u0[3]);
                w.z = cvt_pk_bf16(silu_f(g1[0]) * u1[0], silu_f(g1[1]) * u1[1]); w.w = cvt_pk_bf16(silu_f(g1[2]) * u1[2], silu_f(g1[3]) * u1[3]);
                *(u32x4*)rowp = w;
            }
    }
};
struct EpiRes {
    static constexpr bool PERM = false, AFTER_DRAIN = false;
    const float* base_lat; const float* base_ctx; float* out; const float* mod; int kg; float mul;
    __device__ __forceinline__ void operator()(const f32x4 (&acc)[2][2][4][2], const Unit& u, int wr, int wc, int fr, int fq) const {
        const int row0 = u.pm * BM + wr * 64 + fr, col0 = u.pn * BM + wc * 32 + 4 * fq;
        const int bb = u.pm < (NLAT / BM) ? u.pm / (SEQ / BM) : 8;
        const float* gp = mod + bb * 9216 + kg * 1024 + col0;
        f32x4 gv[2][2];
#pragma unroll
        for (int bj = 0; bj < 2; ++bj)
#pragma unroll
            for (int n = 0; n < 2; ++n) gv[bj][n] = *(const f32x4*)(gp + bj * HALF + n * 16) * mul;
#pragma unroll
        for (int ai = 0; ai < 2; ++ai)
#pragma unroll
            for (int m = 0; m < 4; ++m) {
                const int r = row0 + ai * HALF + m * 16;
                const float* bp = (r < NLAT ? base_lat + (size_t)r * D : base_ctx + (size_t)(r - NLAT) * D) + col0;
                float* op = out + (size_t)r * D + col0;
#pragma unroll
                for (int bj = 0; bj < 2; ++bj)
#pragma unroll
                    for (int n = 0; n < 2; ++n) { const f32x4 bs = *(const f32x4*)(bp + bj * HALF + n * 16); *(f32x4*)(op + bj * HALF + n * 16) = bs + gv[bj][n] * acc[ai][bj][m][n]; }
            }
    }
};
struct EpiSplit {
    static constexpr bool PERM = true, AFTER_DRAIN = false;
    bf16_t *zb, *xbcr, *cq, *ckv, *misc;
    __device__ __forceinline__ void operator()(const f32x4 (&acc)[2][2][4][2], const Unit& u, int wr, int wc, int fr, int fq) const {
        const int pn = u.pn; bf16_t* base; int ld;
        if (pn < 2) { base = zb + pn * 256; ld = 512; } else if (pn < 6) { base = xbcr + (pn - 2) * 256; ld = 1024; } else if (pn < 9) { base = cq + (pn - 6) * 256; ld = 768; }
        else if (pn == 9) { base = ckv; ld = 256; } else { base = misc; ld = 256; }
        const int row0 = u.pm * BM + wr * 64 + fr, col0 = wc * 32 + 8 * fq;
#pragma unroll
        for (int ai = 0; ai < 2; ++ai)
#pragma unroll
            for (int m = 0; m < 4; ++m) {
                bf16_t* rowp = base + (size_t)(row0 + ai * HALF + m * 16) * ld + col0;
#pragma unroll
                for (int bj = 0; bj < 2; ++bj) { const f32x4 v0 = acc[ai][bj][m][0], v1 = acc[ai][bj][m][1];
                    u32x4 w; w.x = cvt_pk_bf16(v0[0], v0[1]); w.y = cvt_pk_bf16(v0[2], v0[3]); w.z = cvt_pk_bf16(v1[0], v1[1]); w.w = cvt_pk_bf16(v1[2], v1[3]);
                    *(u32x4*)(rowp + bj * HALF) = w; }
            }
    }
};
struct EpiScale {
    static constexpr bool PERM = true, AFTER_DRAIN = false;
    bf16_t* O; int ldc; const float* rs; const float* cs;
    __device__ __forceinline__ void operator()(const f32x4 (&acc)[2][2][4][2], const Unit& u, int wr, int wc, int fr, int fq) const {
        const int row0 = u.pm * BM + wr * 64 + fr, col0 = u.pn * BM + wc * 32 + 8 * fq;
        f32x4 cv[2][2];
#pragma unroll
        for (int bj = 0; bj < 2; ++bj)
#pragma unroll
            for (int n = 0; n < 2; ++n) cv[bj][n] = cs ? *(const f32x4*)(cs + col0 + bj * HALF + 4 * n) : (f32x4){1.f, 1.f, 1.f, 1.f};
#pragma unroll
        for (int ai = 0; ai < 2; ++ai)
#pragma unroll
            for (int m = 0; m < 4; ++m) {
                const int r = row0 + ai * HALF + m * 16; const float rv = rs ? rs[r] : 1.f;
                bf16_t* rowp = O + (size_t)r * ldc + col0;
#pragma unroll
                for (int bj = 0; bj < 2; ++bj) { const f32x4 v0 = acc[ai][bj][m][0] * cv[bj][0] * rv, v1 = acc[ai][bj][m][1] * cv[bj][1] * rv;
                    u32x4 w; w.x = cvt_pk_bf16(v0[0], v0[1]); w.y = cvt_pk_bf16(v0[2], v0[3]); w.z = cvt_pk_bf16(v1[0], v1[1]); w.w = cvt_pk_bf16(v1[2], v1[3]);
                    *(u32x4*)(rowp + bj * HALF) = w; }
            }
    }
};
struct EpiQ {
    static constexpr bool PERM = true, AFTER_DRAIN = false;
    bf16_t* O; const float* rs; const f32x2* rope;
    __device__ __forceinline__ void operator()(const f32x4 (&acc)[2][2][4][2], const Unit& u, int wr, int wc, int fr, int fq) const {
        const int row0 = u.pm * BM + wr * 64 + fr, col0 = u.pn * BM + wc * 32 + 8 * fq;
#pragma unroll
        for (int ai = 0; ai < 2; ++ai)
#pragma unroll
            for (int m = 0; m < 4; ++m) {
                const int r = row0 + ai * HALF + m * 16; const float rv = rs[r] * QSCALE; const int t = r & (SEQ - 1);
                bf16_t* rowp = O + (size_t)r * 768 + col0;
#pragma unroll
                for (int bj = 0; bj < 2; ++bj) {
                    f32x4 v0 = acc[ai][bj][m][0] * rv, v1 = acc[ai][bj][m][1] * rv;
                    const int cc = (col0 + bj * HALF) % 96;
                    if (cc >= 64) {
                        const int q = cc - 64, half = q >> 4, jj = (q & 15) >> 1, pos = half ? (t & 63) : (t >> 6);
                        const f32x2* rp = rope + pos * 8 + jj;
                        const f32x2 c0 = rp[0], c1 = rp[1], c2 = rp[2], c3 = rp[3];
                        f32x4 o0, o1;
                        o0[0] = v0[0] * c0.x - v0[1] * c0.y; o0[1] = v0[0] * c0.y + v0[1] * c0.x; o0[2] = v0[2] * c1.x - v0[3] * c1.y; o0[3] = v0[2] * c1.y + v0[3] * c1.x;
                        o1[0] = v1[0] * c2.x - v1[1] * c2.y; o1[1] = v1[0] * c2.y + v1[1] * c2.x; o1[2] = v1[2] * c3.x - v1[3] * c3.y; o1[3] = v1[2] * c3.y + v1[3] * c3.x;
                        v0 = o0; v1 = o1;
                    }
                    u32x4 w; w.x = cvt_pk_bf16(v0[0], v0[1]); w.y = cvt_pk_bf16(v0[2], v0[3]); w.z = cvt_pk_bf16(v1[0], v1[1]); w.w = cvt_pk_bf16(v1[2], v1[3]);
                    *(u32x4*)(rowp + bj * HALF) = w;
                }
            }
    }
};
}

__device__ __forceinline__ int cmap(int id, int n) {
    switch (id) {
    case 0: return ((n >> 7) & 1) * DFF + (n >> 8) * 128 + (n & 127);
    case 1: return n;
    case 2: {
        if (n < 1536) return n;
        if (n < 2304) return 1552 + (n - 1536);
        if (n < 2560) return 2320 + (n - 2304);
        if (n < 2592) { const int q = n - 2560, half = q >> 4, jj = (q & 15) >> 1, which = q & 1; return 2576 + half * 16 + which * 8 + jj; }
        if (n < 2608) return 1536 + (n - 2592);
        return -1; }
    case 3: { const int hh = n / 96, cc = n % 96; if (cc < 64) return hh * 96 + cc;
        const int q = cc - 64, half = q >> 4, jj = (q & 15) >> 1, which = q & 1; return hh * 96 + 64 + half * 16 + which * 8 + jj; }
    case 4: return (n >> 6) * 128 + (n & 63);
    default: return (n >> 6) * 128 + 64 + (n & 63);
    }
}
__device__ __forceinline__ void titem(const float* W, int K, int N, bf16* WT, const float* gk, LAS float* scr, int item, int nblk, int lane, int id, float mulc = 1.f) {
    const int kb = item / nblk, nb = item % nblk, k0 = 64 * kb, n0 = 32 * nb;
    const int src = cmap(id, n0 + (lane & 31));
#pragma unroll 8
    for (int i = 0; i < 32; ++i) { const int kk = 2 * i + (lane >> 5); float v = src >= 0 ? W[(size_t)(k0 + kk) * N + src] : 0.f; if (gk) v *= gk[k0 + kk] * mulc; scr[kk * 33 + (lane & 31)] = v; }
    LDS_FENCE();
    const int c = lane & 7;
#pragma unroll
    for (int j = 0; j < 4; ++j) { const int n = (lane >> 3) + 8 * j; const LAS float* s = scr + (8 * c) * 33 + n;
        u32x4 o; o.x = pk2(s[0 * 33], s[1 * 33]); o.y = pk2(s[2 * 33], s[3 * 33]); o.z = pk2(s[4 * 33], s[5 * 33]); o.w = pk2(s[6 * 33], s[7 * 33]);
        *(u32x4*)(WT + (size_t)(n0 + n) * K + k0 + 8 * c) = o; }
    LDS_FENCE();
}
__device__ __forceinline__ void phase0(const Args& a, LAS unsigned char* lds, int gw, int NGW, int tid, int lane, int wave) {
    unsigned char* ws = a.ws;
    LAS float* scr = (LAS float*)(lds + wave * 16384);
    constexpr int I_W1A = 16 * 176, I_W1B = 44 * 32, I_WIN = 16 * 88, I_WUQ = 12 * 24, I_WK = 4 * 16, I_WOUT = 16 * 32;
    constexpr int NITEMS = 2 * I_W1A + 2 * I_W1B + I_WIN + I_WUQ + 2 * I_WK + I_WOUT;
    for (int rep0 = 0; rep0 < (PROBE_PHASE == 201 ? 2 : 1); ++rep0)
    for (int it = gw; it < NITEMS; it += NGW) {
        int r = it;
        if (r < I_W1A) { titem(a.in[7], 1024, 5632, (bf16*)(ws + WS_W1A), nullptr, scr, r, 176, lane, 0); continue; } r -= I_W1A;
        if (r < I_W1A) { titem(a.in[23], 1024, 5632, (bf16*)(ws + WS_W2A), nullptr, scr, r, 176, lane, 0); continue; } r -= I_W1A;
        if (r < I_W1B) { titem(a.in[8], 2816, 1024, (bf16*)(ws + WS_W1B), nullptr, scr, r, 32, lane, 1); continue; } r -= I_W1B;
        if (r < I_W1B) { titem(a.in[24], 2816, 1024, (bf16*)(ws + WS_W2B), nullptr, scr, r, 32, lane, 1); continue; } r -= I_W1B;
        if (r < I_WIN) { titem(a.in[10], 1024, 2608, (bf16*)(ws + WS_WIN), nullptr, scr, r, 88, lane, 2); continue; } r -= I_WIN;
        if (r < I_WUQ) { titem(a.in[18], 768, 768, (bf16*)(ws + WS_WUQ), a.in[17], scr, r, 24, lane, 3, QSCALE); continue; } r -= I_WUQ;
        if (r < I_WK) { titem(a.in[20], 256, 1024, (bf16*)(ws + WS_WK), a.in[19], scr, r, 16, lane, 4); continue; } r -= I_WK;
        if (r < I_WK) { titem(a.in[20], 256, 1024, (bf16*)(ws + WS_WV), a.in[19], scr, r, 16, lane, 5); continue; } r -= I_WK;
        titem(a.in[21], 1024, 1024, (bf16*)(ws + WS_WOUT), nullptr, scr, r, 32, lane, 1);
    }
    float* MOD = (float*)(ws + WS_MOD);
    const float* cin = a.in[1]; const float* cctx = a.in[3]; const float* wada = a.in[4]; const float* bada = a.in[5];
    for (int it = gw; it < 576; it += NGW) {
        const int kc = it / 36, nc = it % 36, k0 = kc * 64, n0 = nc * 256 + 4 * lane;
        float sv[9];
#pragma unroll
        for (int bb = 0; bb < 8; ++bb) sv[bb] = silu_f(cin[bb * 1024 + k0 + lane]);
        sv[8] = silu_f(cctx[k0 + lane]);
        f32x4 acc[9];
#pragma unroll
        for (int bb = 0; bb < 9; ++bb) acc[bb] = (f32x4){0.f, 0.f, 0.f, 0.f};
#pragma unroll 4
        for (int k = 0; k < 64; ++k) {
            const f32x4 w = *(const f32x4*)(wada + (size_t)(k0 + k) * 9216 + n0);
#pragma unroll
            for (int bb = 0; bb < 9; ++bb) { const float s = __shfl(sv[bb], k); acc[bb] += w * s; }
        }
        if (kc == 0) { const f32x4 bv = *(const f32x4*)(bada + n0);
#pragma unroll
            for (int bb = 0; bb < 9; ++bb) acc[bb] += bv; }
#pragma unroll
        for (int bb = 0; bb < 9; ++bb) { float* p = MOD + bb * 9216 + n0; atomicAdd(p, acc[bb][0]); atomicAdd(p + 1, acc[bb][1]); atomicAdd(p + 2, acc[bb][2]); atomicAdd(p + 3, acc[bb][3]); }
    }
    if (blockIdx.x == 0) {
        const int pos = tid >> 3, jj = tid & 7; const float inv = __builtin_amdgcn_exp2f(-(float)jj * 1.6609640474436813f);
        const float ang = (float)pos * inv;
        ((f32x2*)(ws + WS_ROPE))[tid] = (f32x2){__cosf(ang), __sinf(ang)};
    }
}

__device__ __forceinline__ void norm_rows(const float* src_lat, const float* src_ctx, int nrows, const float* gvec, const float* mod, int kshift, bf16* out, int gw, int NGW, int lane) {
    for (int row = gw; row < nrows; row += NGW) {
        const float* xr = (row < NLAT ? src_lat + (size_t)row * D : src_ctx + (size_t)(row - NLAT) * D) + 4 * lane;
        const int bb = row < NLAT ? row / SEQ : 8;
        const float* sh = mod + bb * 9216 + kshift * 1024 + 4 * lane; const float* sc = sh + 1024;
        f32x4 v[4]; float s = 0.f;
#pragma unroll
        for (int j = 0; j < 4; ++j) { v[j] = *(const f32x4*)(xr + 256 * j); s += (v[j][0] * v[j][0] + v[j][1] * v[j][1]) + (v[j][2] * v[j][2] + v[j][3] * v[j][3]); }
        const float rstd = 1.0f / sqrtf(wave_sum(s) * (1.f / D) + EPS);
        bf16* orow = out + (size_t)row * D + 4 * lane;
#pragma unroll
        for (int j = 0; j < 4; ++j) {
            const f32x4 g = *(const f32x4*)(gvec + 4 * lane + 256 * j), scv = *(const f32x4*)(sc + 256 * j), shv = *(const f32x4*)(sh + 256 * j);
            const f32x4 y = (v[j] * rstd) * g * (scv + 1.f) + shv;
            u32x2 w; w.x = pk2(y[0], y[1]); w.y = pk2(y[2], y[3]); *(u32x2*)(orow + 256 * j) = w;
        }
    }
}
__device__ __forceinline__ void final_norm_rows(float* io, const float* gvec, int gw, int NGW, int lane) {
    for (int row = gw; row < NLAT; row += NGW) {
        float* xr = io + (size_t)row * D + 4 * lane;
        f32x4 v[4]; float s = 0.f;
#pragma unroll
        for (int j = 0; j < 4; ++j) { v[j] = *(const f32x4*)(xr + 256 * j); s += (v[j][0] * v[j][0] + v[j][1] * v[j][1]) + (v[j][2] * v[j][2] + v[j][3] * v[j][3]); }
        const float rstd = 1.0f / sqrtf(wave_sum(s) * (1.f / D) + EPS);
#pragma unroll
        for (int j = 0; j < 4; ++j) { const f32x4 g = *(const f32x4*)(gvec + 4 * lane + 256 * j); *(f32x4*)(xr + 256 * j) = (v[j] * rstd) * g; }
    }
}

__device__ __forceinline__ float softplus_f(float x) { return fmaxf(x, 0.f) + log1pf(__expf(-fabsf(x))); }
__device__ __forceinline__ void phase6(const Args& a, LAS unsigned char* lds, int G, int bx, int tid, int lane, int wave) {
    unsigned char* ws = a.ws;
    const bf16* XBCR = (const bf16*)(ws + WS_XBCR); const bf16* MISC = (const bf16*)(ws + WS_MISC); const bf16* CQ = (const bf16*)(ws + WS_CQ); const bf16* CKV = (const bf16*)(ws + WS_CKV);
    bf16* XT = (bf16*)(ws + WS_XT); bf16* BT = (bf16*)(ws + WS_BT); bf16* BROW = (bf16*)(ws + WS_BROW); bf16* CROW = (bf16*)(ws + WS_CROW); bf16* KPE = (bf16*)(ws + WS_KPE);
    float* DT = (float*)(ws + WS_DT); float* RSTDQ = (float*)(ws + WS_RSTDQ); float* RSTDKV = (float*)(ws + WS_RSTDKV); const f32x2* ROPE = (const f32x2*)(ws + WS_ROPE);
    const float* conv_w = a.in[11]; const float* conv_b = a.in[12]; const float* dt_bias = a.in[13];
    LAS bf16* T = (LAS bf16*)lds;
    const int ch = 2 * tid;
    float w0[5], w1[5];
#pragma unroll
    for (int k = 0; k < 5; ++k) { w0[k] = conv_w[k * 1024 + ch]; w1[k] = conv_w[k * 1024 + ch + 1]; }
    const float b0 = conv_b[ch], b1 = conv_b[ch + 1];
    for (int unit = bx; unit < NB * 68; unit += G) {
        const int b = unit / 68, ut = unit % 68, u0 = ut * 64;
        const int seg_lo = u0 < CTXL ? 0 : CTXL, seg_hi = u0 < CTXL ? CTXL : UL;
        const int rb = u0 < CTXL ? NLAT + b * CTXL : b * SEQ - CTXL;
#define P6_LD(u) (((u) >= seg_lo && (u) < seg_hi) ? *(const unsigned*)(XBCR + (size_t)(rb + (u)) * 1024 + ch) : 0u)
        unsigned xm2 = P6_LD(u0 - 2), xm1 = P6_LD(u0 - 1), x0 = P6_LD(u0), xp1 = P6_LD(u0 + 1);
#pragma unroll 8
        for (int t = 0; t < 64; ++t) {
            const unsigned xp2 = P6_LD(u0 + t + 2);
            float y0 = b0 + w0[0] * bflo(xm2) + w0[1] * bflo(xm1) + w0[2] * bflo(x0) + w0[3] * bflo(xp1) + w0[4] * bflo(xp2);
            float y1 = b1 + w1[0] * bfhi(xm2) + w1[1] * bfhi(xm1) + w1[2] * bfhi(x0) + w1[3] * bfhi(xp1) + w1[4] * bfhi(xp2);
            const unsigned pk = pk2(silu_f(y0), silu_f(y1));
            if (tid < 384) { T[ch * 72 + t] = (bf16)(pk & 0xffffu); T[(ch + 1) * 72 + t] = (bf16)(pk >> 16); }
            if (tid >= 256) { bf16* dst = tid < 384 ? BROW + (ch - 512) : CROW + (ch - 768); *(unsigned*)(dst + (size_t)(b * UL + u0 + t) * 256) = pk; }
            xm2 = xm1; xm1 = x0; x0 = xp1; xp1 = xp2;
        }
#undef P6_LD
        __syncthreads();
#pragma unroll
        for (int i = 0; i < 12; ++i) { const int q = tid + 512 * i, c = q >> 3, part = q & 7;
            const u32x4 v = *(const LAS u32x4*)(T + c * 72 + part * 8);
            bf16* dst = c < 512 ? XT + (size_t)(b * 512 + c) * UL : BT + (size_t)(b * 256 + c - 512) * UL;
            *(u32x4*)(dst + u0 + part * 8) = v; }
        {
            const int uu = tid >> 3, k = (tid & 7) * 2; const size_t row = (size_t)(rb + u0 + uu);
            const unsigned raw = *(const unsigned*)(MISC + row * 256 + 32 + k);
            f32x2 o; o.x = softplus_f(bflo(raw) + dt_bias[k]); o.y = softplus_f(bfhi(raw) + dt_bias[k + 1]);
            *(f32x2*)(DT + (size_t)(b * UL + u0 + uu) * 16 + k) = o;
        }
        {
            const int uu = tid >> 3, pp = (tid & 7) * 2; const size_t row = (size_t)(rb + u0 + uu);
            u32x2 raw = *(const u32x2*)(MISC + row * 256 + 2 * pp);
            if (u0 >= CTXL) {
                const int t = u0 + uu - CTXL, half = pp >> 3, jj = pp & 7, pos = half ? (t & 63) : (t >> 6);
                const f32x2 c0 = ROPE[pos * 8 + jj], c1 = ROPE[pos * 8 + jj + 1];
                const float a0 = bflo(raw.x), a1 = bfhi(raw.x), a2 = bflo(raw.y), a3 = bfhi(raw.y);
                raw.x = pk2(a0 * c0.x - a1 * c0.y, a0 * c0.y + a1 * c0.x); raw.y = pk2(a2 * c1.x - a3 * c1.y, a2 * c1.y + a3 * c1.x);
            }
            *(u32x2*)(KPE + row * 32 + 2 * pp) = raw;
        }
#pragma unroll 2
        for (int rr = 0; rr < 8; ++rr) {
            const size_t row = (size_t)(rb + u0 + wave * 8 + rr);
            { const u32x2 w = *(const u32x2*)(CKV + row * 256 + 4 * lane); const float c0 = bflo(w.x), c1 = bfhi(w.x), c2 = bflo(w.y), c3 = bfhi(w.y);
              const float s = wave_sum((c0 * c0 + c1 * c1) + (c2 * c2 + c3 * c3)); if (lane == 0) RSTDKV[row] = 1.0f / sqrtf(s * (1.f / 256.f) + EPS); }
            if (u0 >= CTXL) { float s = 0.f;
#pragma unroll
                for (int i = 0; i < 3; ++i) { const u32x2 w = *(const u32x2*)(CQ + row * 768 + 4 * lane + 256 * i); const float c0 = bflo(w.x), c1 = bfhi(w.x), c2 = bflo(w.y), c3 = bfhi(w.y);
                    s += (c0 * c0 + c1 * c1) + (c2 * c2 + c3 * c3); }
                s = wave_sum(s); if (lane == 0) RSTDQ[row] = 1.0f / sqrtf(s * (1.f / 768.f) + EPS); }
        }
        __syncthreads();
    }
}

__device__ __forceinline__ void acum_wave(const float* DT, size_t dtrow0, int h, float anf, float anb, LAS float* sc, int lane) {
    const float df0 = DT[(dtrow0 + lane) * 16 + h], df1 = DT[(dtrow0 + 64 + lane) * 16 + h];
    const float db0 = DT[(dtrow0 + lane) * 16 + 8 + h], db1 = DT[(dtrow0 + 64 + lane) * 16 + 8 + h];
    const float f0 = incl_scan(df0 * anf, lane); float f1 = incl_scan(df1 * anf, lane); f1 += __shfl(f0, 63);
    const float a0 = db0 * anb, a1 = db1 * anb; const float g0 = incl_scan(a0, lane), g1 = incl_scan(a1, lane);
    const float t0 = __shfl(g0, 63), t1 = __shfl(g1, 63), tot = t0 + t1;
    sc[lane] = f0; sc[64 + lane] = f1; sc[128 + lane] = tot - g0 + a0; sc[192 + lane] = t1 - g1 + a1;
    sc[256 + lane] = df0; sc[320 + lane] = df1; sc[384 + lane] = db0; sc[448 + lane] = db1;
    LDS_FENCE();
}
#define MFMA32(a, b, c) __builtin_amdgcn_mfma_f32_32x32x16_bf16((a), (b), (c), 0, 0, 0)
__device__ __forceinline__ f32x16 zero16() { f32x16 z;
#pragma unroll
    for (int r = 0; r < 16; ++r) z[r] = 0.f; return z; }

__device__ __forceinline__ void phase8(const Args& a, LAS unsigned char* lds, int G, int bx, int lane, int wave) {
    unsigned char* ws = a.ws;
    const bf16* XT = (const bf16*)(ws + WS_XT); const bf16* BT = (const bf16*)(ws + WS_BT); const float* DT = (const float*)(ws + WS_DT);
    bf16* ST = (bf16*)(ws + WS_ST); float* CD = (float*)(ws + WS_CD);
    LAS float* sc = (LAS float*)lds + wave * 512;
    const int h = wave, g = h >> 2, r32 = lane & 31, hi = lane >> 5;
    const float anf = -__expf(a.in[14][h]), anb = -__expf(a.in[14][8 + h]);
    for (int unit = bx; unit < NB * NCH; unit += G) {
        const int b = unit / NCH, c = unit % NCH;
        acum_wave(DT, (size_t)b * UL + c * 128, h, anf, anb, sc, lane);
        const float af_last = sc[127], ab_first = sc[128];
#pragma unroll
        for (int hf = 0; hf < 2; ++hf) { const int j = lane + 64 * hf;
            const float wf = __expf(af_last - sc[j]) * sc[256 + j], wb = __expf(ab_first - sc[128 + j]) * sc[384 + j];
            sc[256 + j] = wf; sc[384 + j] = wb; }
        if (lane == 0) { CD[((b * 2 + 0) * 8 + h) * NCH + c] = __expf(af_last); CD[((b * 2 + 1) * 8 + h) * NCH + c] = __expf(ab_first); }
        LDS_FENCE();
        const bf16* xbase = XT + (size_t)(b * 512 + h * 64 + r32) * UL + c * 128 + 8 * hi;
        const bf16* bbase = BT + (size_t)(b * 256 + g * 128 + r32) * UL + c * 128 + 8 * hi;
#pragma unroll 1
        for (int dir = 0; dir < 2; ++dir) {
            const LAS float* w = sc + 256 + 128 * dir + 8 * hi;
            f32x16 acc[4][2];
#pragma unroll
            for (int nb = 0; nb < 4; ++nb) { acc[nb][0] = zero16(); acc[nb][1] = zero16(); }
#pragma unroll 2
            for (int s = 0; s < 8; ++s) {
                const f32x4 wa = *(const LAS f32x4*)(w + 16 * s), wb = *(const LAS f32x4*)(w + 16 * s + 4);
                bf16x8 xw[2];
#pragma unroll
                for (int pb = 0; pb < 2; ++pb) { const u32x4 raw = *(const u32x4*)(xbase + (size_t)pb * 32 * UL + 16 * s);
                    xw[pb] = pack8(bflo(raw.x) * wa[0], bfhi(raw.x) * wa[1], bflo(raw.y) * wa[2], bfhi(raw.y) * wa[3], bflo(raw.z) * wb[0], bfhi(raw.z) * wb[1], bflo(raw.w) * wb[2], bfhi(raw.w) * wb[3]); }
#pragma unroll
                for (int nb = 0; nb < 4; ++nb) { const bf16x8 bt = *(const bf16x8*)(bbase + (size_t)nb * 32 * UL + 16 * s);
                    acc[nb][0] = MFMA32(bt, xw[0], acc[nb][0]); acc[nb][1] = MFMA32(bt, xw[1], acc[nb][1]); }
            }
            bf16* so = ST + ((size_t)(((b * 2 + dir) * 8 + h) * NCH + c) * 64) * 128;
#pragma unroll
            for (int nb = 0; nb < 4; ++nb)
#pragma unroll
                for (int pb = 0; pb < 2; ++pb)
#pragma unroll
                    for (int g4 = 0; g4 < 4; ++g4) { u32x2 o; o.x = pk2(acc[nb][pb][4 * g4], acc[nb][pb][4 * g4 + 1]); o.y = pk2(acc[nb][pb][4 * g4 + 2], acc[nb][pb][4 * g4 + 3]);
                        *(u32x2*)(so + (size_t)(32 * pb + r32) * 128 + 32 * nb + 8 * g4 + 4 * hi) = o; }
        }
        LDS_FENCE();
    }
}
__device__ __forceinline__ void phase9(const Args& a, int G, int bx, int tid) {
    unsigned char* ws = a.ws;
    const bf16* ST = (const bf16*)(ws + WS_ST); bf16* HE = (bf16*)(ws + WS_HE); const float* CD = (const float*)(ws + WS_CD);
    for (int idx = bx * 512 + tid; idx < NB * 2 * 8 * 8192; idx += G * 512) {
        const int e = idx & 8191, bdh = idx >> 13, dir = (bdh >> 3) & 1;
        const bf16* st = ST + (size_t)bdh * NCH * 8192 + e; bf16* he = HE + (size_t)bdh * 32 * 8192 + e; const float* cd = CD + bdh * NCH;
        float hs;
        if (dir == 0) {
            hs = bf2f(st[0]); hs = cd[1] * hs + bf2f(st[8192]);
#pragma unroll 8
            for (int c = 2; c < NCH; ++c) { he[(size_t)(c - 2) * 8192] = (bf16)(pk2(hs, 0.f) & 0xffffu); hs = cd[c] * hs + bf2f(st[(size_t)c * 8192]); }
        } else {
            hs = bf2f(st[8192]); hs = cd[0] * hs + bf2f(st[0]);
#pragma unroll 8
            for (int c = NCH - 1; c >= 2; --c) { he[(size_t)(c - 2) * 8192] = (bf16)(pk2(hs, 0.f) & 0xffffu); hs = cd[c] * hs + bf2f(st[(size_t)c * 8192]); }
        }
    }
}
__device__ __forceinline__ void phase10_ssd(const Args& a, LAS unsigned char* lds, int G, int bx, int lane, int wave) {
    unsigned char* ws = a.ws;
    const bf16* XT = (const bf16*)(ws + WS_XT); const bf16* BROW = (const bf16*)(ws + WS_BROW); const bf16* CROW = (const bf16*)(ws + WS_CROW); const float* DT = (const float*)(ws + WS_DT);
    const bf16* HE = (const bf16*)(ws + WS_HE); const bf16* Z = (const bf16*)(ws + WS_Z); bf16* MIX = (bf16*)(ws + WS_MIX);
    LAS float* sc = (LAS float*)lds + wave * 512;
    LAS float* SS = (LAS float*)(lds + 16384);
    const int h = wave, g = h >> 2, r32 = lane & 31, hi = lane >> 5;
    const float anf = -__expf(a.in[14][h]), anb = -__expf(a.in[14][8 + h]);
    const float dskip = a.in[15][h]; const float* snorm = a.in[16] + h * 64;
    for (int unit = bx; unit < NB * 32; unit += G) {
        const int b = unit >> 5, lc = unit & 31, c = lc + 2; const size_t u0 = (size_t)b * UL + c * 128;
        acum_wave(DT, u0, h, anf, anb, sc, lane);
#pragma unroll 1
        for (int ib = 0; ib < 4; ++ib) {
            const int i = 32 * ib + r32;
            const float afi = sc[i], abi = sc[128 + i];
            bf16x8 cfr[8];
            { const bf16* cp = CROW + (u0 + i) * 256 + g * 128 + 8 * hi;
#pragma unroll
              for (int s = 0; s < 8; ++s) cfr[s] = *(const bf16x8*)(cp + 16 * s); }
            f32x16 acc[2]; acc[0] = zero16(); acc[1] = zero16();
#pragma unroll 1
            for (int jb = 0; jb < 4; ++jb) {
                f32x16 ga = zero16();
                { const bf16* bp = BROW + (u0 + 32 * jb + r32) * 256 + g * 128 + 8 * hi;
#pragma unroll
                  for (int s = 0; s < 8; ++s) { const bf16x8 bfr = *(const bf16x8*)(bp + 16 * s); ga = MFMA32(bfr, cfr[s], ga); } }
                float mm[16];
#pragma unroll
                for (int r = 0; r < 16; ++r) {
                    const int jl = crow(r, hi), j = 32 * jb + jl;
                    float mf = 0.f, mb = 0.f;
                    if (jb <= ib) { const float e = __expf(afi - sc[j]) * sc[256 + j]; mf = (jb < ib || jl <= r32) ? e : 0.f; }
                    if (jb >= ib) { const float e = __expf(abi - sc[128 + j]) * sc[384 + j]; mb = (jb > ib || jl >= r32) ? e : 0.f; }
                    float mt = ga[r] * (mf + mb);
                    if (jb == ib && jl == r32) mt += dskip;
                    mm[r] = mt;
                }
                const bf16x8 pf0 = pack8(mm[0], mm[1], mm[2], mm[3], mm[4], mm[5], mm[6], mm[7]), pf1 = pack8(mm[8], mm[9], mm[10], mm[11], mm[12], mm[13], mm[14], mm[15]);
#pragma unroll
                for (int pb = 0; pb < 2; ++pb) {
                    const bf16* xp = XT + (size_t)(b * 512 + h * 64 + 32 * pb + r32) * UL + c * 128 + 32 * jb + 4 * hi;
                    const u32x2 a0 = *(const u32x2*)(xp), a1 = *(const u32x2*)(xp + 8), a2 = *(const u32x2*)(xp + 16), a3 = *(const u32x2*)(xp + 24);
                    const bf16x8 xa0 = __builtin_bit_cast(bf16x8, (u32x4){a0.x, a0.y, a1.x, a1.y}), xa1 = __builtin_bit_cast(bf16x8, (u32x4){a2.x, a2.y, a3.x, a3.y});
                    acc[pb] = MFMA32(xa0, pf0, acc[pb]); acc[pb] = MFMA32(xa1, pf1, acc[pb]);
                }
            }
#pragma unroll
            for (int dir = 0; dir < 2; ++dir) {
                const float e = __expf(dir ? abi : afi);
#pragma unroll
                for (int pb = 0; pb < 2; ++pb) {
                    const bf16* hp = HE + ((size_t)(((b * 2 + dir) * 8 + h) * 32 + lc) * 64 + 32 * pb + r32) * 128 + 8 * hi;
                    f32x16 ta = zero16();
#pragma unroll
                    for (int s = 0; s < 8; ++s) { const bf16x8 hf = *(const bf16x8*)(hp + 16 * s); ta = MFMA32(hf, cfr[s], ta); }
#pragma unroll
                    for (int r = 0; r < 16; ++r) acc[pb][r] += e * ta[r];
                }
            }
            const size_t row = (size_t)b * SEQ + lc * 128 + i;
            float ss = 0.f;
#pragma unroll
            for (int pb = 0; pb < 2; ++pb)
#pragma unroll
                for (int g4 = 0; g4 < 4; ++g4) { const u32x2 zw = *(const u32x2*)(Z + row * 512 + h * 64 + 32 * pb + 8 * g4 + 4 * hi);
                    const float z0 = bflo(zw.x), z1 = bfhi(zw.x), z2 = bflo(zw.y), z3 = bfhi(zw.y);
                    float v0 = acc[pb][4 * g4] * silu_f(z0), v1 = acc[pb][4 * g4 + 1] * silu_f(z1), v2 = acc[pb][4 * g4 + 2] * silu_f(z2), v3 = acc[pb][4 * g4 + 3] * silu_f(z3);
                    ss += (v0 * v0 + v1 * v1) + (v2 * v2 + v3 * v3);
                    acc[pb][4 * g4] = v0; acc[pb][4 * g4 + 1] = v1; acc[pb][4 * g4 + 2] = v2; acc[pb][4 * g4 + 3] = v3; }
            ss += __shfl_xor(ss, 32);
            LAS float* ssb = SS + (ib & 1) * 256;
            if (hi == 0) ssb[wave * 32 + r32] = ss;
            __syncthreads();
            float tot = 0.f;
#pragma unroll
            for (int w = 0; w < 8; ++w) tot += ssb[w * 32 + r32];
            const float rstd = 1.0f / sqrtf(tot * (1.f / 512.f) + EPS);
#pragma unroll
            for (int pb = 0; pb < 2; ++pb)
#pragma unroll
                for (int g4 = 0; g4 < 4; ++g4) { const int p0 = 32 * pb + 8 * g4 + 4 * hi; const f32x4 gn = *(const f32x4*)(snorm + p0);
                    u32x2 o; o.x = pk2(acc[pb][4 * g4] * rstd * gn[0], acc[pb][4 * g4 + 1] * rstd * gn[1]); o.y = pk2(acc[pb][4 * g4 + 2] * rstd * gn[2], acc[pb][4 * g4 + 3] * rstd * gn[3]);
                    *(u32x2*)(MIX + row * 1024 + h * 64 + p0) = o; }
        }
        __syncthreads();
    }
}

constexpr int AT_KS = 104, AT_VS = 68, AT_KB = 64 * AT_KS * 2, AT_BUF = AT_KB + 64 * AT_VS * 2;
__device__ __forceinline__ void phase10_attn(const Args& a, LAS unsigned char* lds, int G, int vcu, int tid, int lane, int wave) {
    unsigned char* ws = a.ws; unsigned char* ob = (unsigned char*)a.out;
    const bf16* Q = (const bf16*)(ob + OUT_Q); const bf16* KN = (const bf16*)(ob + OUT_KN); const bf16* VT = (const bf16*)(ob + OUT_VT); const bf16* KPE = (const bf16*)(ws + WS_KPE);
    bf16* MIX = (bf16*)(ws + WS_MIX); const f32x2* ROPE = (const f32x2*)(ws + WS_ROPE);
    const int r32 = lane & 31, hi = lane >> 5;
    for (int unit = vcu; unit < NB * 8 * 16; unit += G) {
        const int bh = unit >> 4, qb = unit & 15, b = bh >> 3, h = bh & 7;
        const size_t qrow = (size_t)b * SEQ + qb * 256 + wave * 32 + r32;
        bf16x8 qr[6];
        { const bf16* qp = Q + qrow * 768 + h * 96 + 8 * hi;
#pragma unroll
          for (int s = 0; s < 6; ++s) qr[s] = *(const bf16x8*)(qp + 16 * s);
          const int tq = qb * 256 + wave * 32 + r32;
#pragma unroll
          for (int s = 4; s < 6; ++s) { const int pos = (s == 4) ? (tq >> 6) : (tq & 63); const f32x2* rp = ROPE + pos * 8 + 4 * hi;
              const u32x4 w = __builtin_bit_cast(u32x4, qr[s]); const f32x2 c0 = rp[0], c1 = rp[1], c2 = rp[2], c3 = rp[3]; u32x4 o;
              o.x = pk2(bflo(w.x) * c0.x - bfhi(w.x) * c0.y, bflo(w.x) * c0.y + bfhi(w.x) * c0.x); o.y = pk2(bflo(w.y) * c1.x - bfhi(w.y) * c1.y, bflo(w.y) * c1.y + bfhi(w.y) * c1.x);
              o.z = pk2(bflo(w.z) * c2.x - bfhi(w.z) * c2.y, bflo(w.z) * c2.y + bfhi(w.z) * c2.x); o.w = pk2(bflo(w.w) * c3.x - bfhi(w.w) * c3.y, bflo(w.w) * c3.y + bfhi(w.w) * c3.x);
              qr[s] = __builtin_bit_cast(bf16x8, o); } }
        const int kr = tid >> 3, kpart = tid & 7;
        const int pr = tid >> 2, ppart = tid & 3;
#define AT_ROW0(t) ((t) < 4 ? (size_t)NLAT + b * CTXL + (t) * 64 : (size_t)b * SEQ + ((t) - 4) * 64)
#define AT_LOAD(t) do { const size_t r0_ = AT_ROW0(t); \
        gk = *(const u32x4*)(KN + (r0_ + kr) * 512 + h * 64 + kpart * 8); \
        gv = *(const u32x4*)(VT + (size_t)(h * 64 + kr) * MTOT + r0_ + kpart * 8); \
        if (tid < 256) gp = *(const u32x4*)(KPE + (r0_ + pr) * 32 + ppart * 8); } while (0)
#define AT_STORE(bufi) do { LAS unsigned char* B_ = lds + (bufi) * AT_BUF; \
        *(LAS u32x4*)(B_ + (kr * AT_KS + kpart * 8) * 2) = gk; \
        *(LAS u32x2*)(B_ + AT_KB + (kr * AT_VS + kpart * 8) * 2) = (u32x2){gv.x, gv.y}; *(LAS u32x2*)(B_ + AT_KB + (kr * AT_VS + kpart * 8 + 4) * 2) = (u32x2){gv.z, gv.w}; \
        if (tid < 256) *(LAS u32x4*)(B_ + (pr * AT_KS + 64 + ppart * 8) * 2) = gp; } while (0)
        u32x4 gk, gv, gp = (u32x4){0u, 0u, 0u, 0u};
        AT_LOAD(0); AT_STORE(0);
        __syncthreads();
        float mrun = -INFINITY, lrun = 0.f;
        f32x16 o[2]; o[0] = zero16(); o[1] = zero16();
#pragma unroll 1
        for (int t = 0; t < 68; ++t) {
            if (t + 1 < 68) AT_LOAD(t + 1);
            const LAS unsigned char* Bc = lds + (t & 1) * AT_BUF;
            f32x16 p0 = zero16(), p1 = zero16();
#pragma unroll
            for (int s = 0; s < 6; ++s) {
                const bf16x8 k0 = *(const LAS bf16x8*)(Bc + (r32 * AT_KS + 16 * s + 8 * hi) * 2), k1 = *(const LAS bf16x8*)(Bc + ((32 + r32) * AT_KS + 16 * s + 8 * hi) * 2);
                p0 = MFMA32(k0, qr[s], p0); p1 = MFMA32(k1, qr[s], p1);
            }
            float mx = fmaxf(p0[0], p1[0]);
#pragma unroll
            for (int r = 1; r < 16; ++r) mx = fmaxf(mx, fmaxf(p0[r], p1[r]));
            mx = fmaxf(mx, __shfl_xor(mx, 32));
            const float mnew = fmaxf(mrun, mx), alpha = __builtin_amdgcn_exp2f(mrun - mnew);
            mrun = mnew;
            float rs = 0.f;
#pragma unroll
            for (int r = 0; r < 16; ++r) { p0[r] = __builtin_amdgcn_exp2f(p0[r] - mnew); p1[r] = __builtin_amdgcn_exp2f(p1[r] - mnew); rs += p0[r] + p1[r]; }
            lrun = lrun * alpha + rs;
#pragma unroll
            for (int r = 0; r < 16; ++r) { o[0][r] *= alpha; o[1][r] *= alpha; }
            bf16x8 pf[4];
            pf[0] = pack8(p0[0], p0[1], p0[2], p0[3], p0[4], p0[5], p0[6], p0[7]); pf[1] = pack8(p0[8], p0[9], p0[10], p0[11], p0[12], p0[13], p0[14], p0[15]);
            pf[2] = pack8(p1[0], p1[1], p1[2], p1[3], p1[4], p1[5], p1[6], p1[7]); pf[3] = pack8(p1[8], p1[9], p1[10], p1[11], p1[12], p1[13], p1[14], p1[15]);
#pragma unroll
            for (int db = 0; db < 2; ++db)
#pragma unroll
                for (int s = 0; s < 4; ++s) {
                    const LAS unsigned char* vp = Bc + AT_KB + ((32 * db + r32) * AT_VS + 16 * s + 4 * hi) * 2;
                    const u32x2 v0 = *(const LAS u32x2*)vp, v1 = *(const LAS u32x2*)(vp + 16);
                    o[db] = MFMA32(__builtin_bit_cast(bf16x8, (u32x4){v0.x, v0.y, v1.x, v1.y}), pf[s], o[db]);
                }
            if (t + 1 < 68) AT_STORE((t + 1) & 1);
            __syncthreads();
        }
#undef AT_ROW0
#undef AT_LOAD
#undef AT_STORE
        const float ltot = lrun + __shfl_xor(lrun, 32), rl = 1.0f / ltot;
        bf16* op = MIX + qrow * 1024 + 512 + h * 64 + 4 * hi;
#pragma unroll
        for (int db = 0; db < 2; ++db)
#pragma unroll
            for (int g4 = 0; g4 < 4; ++g4) { u32x2 w; w.x = pk2(o[db][4 * g4] * rl, o[db][4 * g4 + 1] * rl); w.y = pk2(o[db][4 * g4 + 2] * rl, o[db][4 * g4 + 3] * rl);
                *(u32x2*)(op + 32 * db + 8 * g4) = w; }
    }
}

#define XB_TMO      128
#define XB_XCNT(j)  (256  + 64 * (j))
#define XB_XSUB(j)  (1280 + 64 * (j))
#define XB_XGEN(j)  (2304 + 64 * (j))
#define XB_TOP      3328
#define XB_TOPGEN   3392
#define XCD_BAR_WORDS 3456
#define XB_SPIN_CAP (1u << 18)

__device__ __forceinline__ unsigned xb_ld(unsigned* p)              { return __hip_atomic_load(p, __ATOMIC_RELAXED, __HIP_MEMORY_SCOPE_AGENT); }
__device__ __forceinline__ unsigned xb_add(unsigned* p, unsigned v) { return __hip_atomic_fetch_add(p, v, __ATOMIC_RELAXED, __HIP_MEMORY_SCOPE_AGENT); }
__device__ __forceinline__ unsigned xb_xcc_id() { return (unsigned)__builtin_amdgcn_s_getreg((3 << 11) | 20) & 0xFu; }
#define XB_SPIN(cond, bar) do { unsigned _sp = 0; while (cond) { __builtin_amdgcn_s_sleep(1); \
    if ((++_sp & 255u) == 0u) { if (xb_ld(&(bar)[XB_TMO])) break; if (_sp > XB_SPIN_CAP) { atomicAdd(&(bar)[XB_TMO], 1u); break; } } } } while (0)

struct XcdBarrier {
    unsigned* bar; unsigned x;
    volatile LAS unsigned* st;
};

__device__ __forceinline__ XcdBarrier xcd_barrier_post(unsigned* bar, volatile LAS unsigned* st) {
    XcdBarrier b; b.bar = bar; b.x = xb_xcc_id(); b.st = st;
    if (threadIdx.x == 0) (void)xb_add(&bar[XB_XCNT(b.x)], 1u);
    return b;
}
__device__ __forceinline__ void xcd_barrier_complete(unsigned* bar, unsigned x, unsigned& nloc, unsigned& nx) {
    const unsigned G = gridDim.x * gridDim.y * gridDim.z;
    unsigned sum, cnt, mine, sp = 0u;
    for (;;) {
        sum = 0u; cnt = 0u; mine = 0u;
#pragma unroll
        for (unsigned j = 0; j < 16; ++j) { const unsigned c = xb_ld(&bar[XB_XCNT(j)]); sum += c; cnt += (c > 0u) ? 1u : 0u; mine = (j == x) ? c : mine; }
        if (sum == G) break;
        __builtin_amdgcn_s_sleep(1);
        if ((++sp & 255u) == 0u) { if (xb_ld(&bar[XB_TMO])) break; if (sp > XB_SPIN_CAP) { atomicAdd(&bar[XB_TMO], 1u); break; } }
    }
    nloc = mine > 0u ? mine : 1u; nx = cnt > 0u ? cnt : 1u;
}

__device__ __forceinline__ void xcd_barrier(const XcdBarrier& b) {
    asm volatile("s_waitcnt vmcnt(0)" ::: "memory");
    __syncthreads();
    if (threadIdx.x == 0) {
        unsigned* bar = b.bar;
        __builtin_amdgcn_s_waitcnt(0);
        unsigned nloc = b.st[0], nx = b.st[1];
        if (nloc == 0u) { xcd_barrier_complete(bar, b.x, nloc, nx); b.st[0] = nloc; b.st[1] = nx; }
        const unsigned old = xb_add(&bar[XB_XSUB(b.x)], 1u);
        const unsigned gen = old / nloc;
        if (old + 1u == (gen + 1u) * nloc) {
            __builtin_amdgcn_fence(__ATOMIC_RELEASE, "agent");
            asm volatile("s_waitcnt vmcnt(0)" ::: "memory");
            const unsigned og = xb_add(&bar[XB_TOP], 1u);
            const unsigned tg = og / nx;
            if (og + 1u == (tg + 1u) * nx) xb_add(&bar[XB_TOPGEN], 1u);
            else XB_SPIN(xb_ld(&bar[XB_TOPGEN]) == tg, bar);
            __builtin_amdgcn_fence(__ATOMIC_ACQUIRE, "agent");
            xb_add(&bar[XB_XGEN(b.x)], 1u);
            asm volatile("s_waitcnt vmcnt(0)" ::: "memory");
        } else {
            XB_SPIN(xb_ld(&bar[XB_XGEN(b.x)]) == gen, bar);
            __builtin_amdgcn_fence(__ATOMIC_ACQUIRE, "agent");
            asm volatile("s_waitcnt vmcnt(0)" ::: "memory");
        }
    }
    __syncthreads();
}

__global__ void __launch_bounds__(512, 2) hymba_fwd(Args args) {
    extern __shared__ __attribute__((aligned(16))) unsigned char lds_raw[];
    LAS unsigned char* lds = (LAS unsigned char*)lds_raw;
    cg::grid_group grid = cg::this_grid();
    const int tid = threadIdx.x, lane = tid & 63, wave = __builtin_amdgcn_readfirstlane(tid >> 6);
    const int G = gridDim.x, bx = blockIdx.x, vcu = (G % 8 == 0) ? (bx % 8) * (G / 8) + bx / 8 : bx;
    const int gw = bx * 8 + wave, NGW = G * 8;
    unsigned char* ws = args.ws;
    const int lo = args.ph_lo, hi = args.ph_hi;
    const float* MOD = (const float*)(ws + WS_MOD);
    volatile LAS unsigned* bst = (volatile LAS unsigned*)(lds + 131072 + 320);
    if (tid < 2) bst[tid] = 0u;
    __syncthreads();
    const XcdBarrier xbar = xcd_barrier_post((unsigned*)(ws + WS_BAR), bst);
    bf16* XN = (bf16*)(ws + WS_A); bf16* HB = (bf16*)(ws + WS_B); float* X1 = (float*)(ws + WS_C);
#ifndef PHMASK
#define PHMASK 0xFFFF
#endif
#define IN(k) (((PHMASK >> (k)) & 1) && lo <= (k) && (k) < hi)
#define GSYNC(k) do { if ((k) == 0) grid.sync(); else xcd_barrier(xbar); } while (0)
#define SEAM(k) do { if (IN(k) && IN((k) + 1)) GSYNC(k); } while (0)
#define PH_BEGIN(k) if (IN(k)) for (int rep_ = 0; rep_ < ((k) == PROBE_PHASE ? 2 : 1); ++rep_) { if (rep_) xcd_barrier(xbar);
#define PH_END(k) } SEAM(k)
    if (PROBE_PHASE == 200) { for (int r3 = 0; r3 < 16; ++r3) xcd_barrier(xbar); }
    PH_BEGIN(0) { phase0(args, lds, gw, NGW, tid, lane, wave); } PH_END(0);
    PH_BEGIN(1) { norm_rows(args.in[0], args.in[2], MTOT, args.in[6], MOD, 0, XN, gw, NGW, lane); } PH_END(1);
    PH_BEGIN(2) { pg8::Gemm g{XN, (const bf16*)(ws + WS_W1A), MTOT, 2 * DFF, D}; pg8::StaticOrder S; S.init(MTOT, 2 * DFF, G, bx);
        pg8::EpiSwiglu E{HB, DFF}; pg8::gemm_phase<pg8::EpiSwiglu, pg8::StaticOrder, true, true>(lds, g, S, E); } PH_END(2);
    PH_BEGIN(3) { pg8::Gemm g{HB, (const bf16*)(ws + WS_W1B), MTOT, D, DFF}; pg8::StaticOrder S; S.init(MTOT, D, G, bx);
        pg8::EpiRes E{args.in[0], args.in[2], X1, MOD, 2, 0.5f}; pg8::gemm_phase<pg8::EpiRes, pg8::StaticOrder, true, true>(lds, g, S, E); } PH_END(3);
    PH_BEGIN(4) { norm_rows(X1, X1 + (size_t)NLAT * D, MTOT, args.in[9], MOD, 3, XN, gw, NGW, lane); } PH_END(4);
    PH_BEGIN(5) { pg8::Gemm g{XN, (const bf16*)(ws + WS_WIN), MTOT, 2816, D}; pg8::StaticOrder S; S.init(MTOT, 2816, G, bx);
        pg8::EpiSplit E{(bf16*)(ws + WS_Z), (bf16*)(ws + WS_XBCR), (bf16*)(ws + WS_CQ), (bf16*)(ws + WS_CKV), (bf16*)(ws + WS_MISC)};
        pg8::gemm_phase<pg8::EpiSplit, pg8::StaticOrder, true, true>(lds, g, S, E); } PH_END(5);
    PH_BEGIN(6) { phase6(args, lds, G, bx, tid, lane, wave); } PH_END(6);
    PH_BEGIN(7) {
        unsigned char* ob = (unsigned char*)args.out;
        { pg8::Gemm g{(const bf16*)(ws + WS_CQ), (const bf16*)(ws + WS_WUQ), NLAT, 768, 768}; pg8::StaticOrder S; S.init(NLAT, 768, G, bx);
          pg8::EpiScale E{(bf16*)(ob + OUT_Q), 768, (const float*)(ws + WS_RSTDQ), nullptr}; pg8::gemm_phase<pg8::EpiScale, pg8::StaticOrder, true, true>(lds, g, S, E); }
        { pg8::Gemm g{(const bf16*)(ws + WS_CKV), (const bf16*)(ws + WS_WK), MTOT, 512, 256}; pg8::StaticOrder S; S.init(MTOT, 512, G, bx);
          pg8::EpiScale E{(bf16*)(ob + OUT_KN), 512, (const float*)(ws + WS_RSTDKV), nullptr}; pg8::gemm_phase<pg8::EpiScale, pg8::StaticOrder, true, true>(lds, g, S, E); }
        { pg8::Gemm g{(const bf16*)(ws + WS_WV), (const bf16*)(ws + WS_CKV), 512, MTOT, 256}; pg8::StaticOrder S; S.init(512, MTOT, G, bx);
          pg8::EpiScale E{(bf16*)(ob + OUT_VT), MTOT, nullptr, (const float*)(ws + WS_RSTDKV)}; pg8::gemm_phase<pg8::EpiScale, pg8::StaticOrder, true, true>(lds, g, S, E); }
        phase8(args, lds, G, bx, lane, wave);
    } PH_END(7);
    PH_BEGIN(9) { phase9(args, G, bx, tid); } PH_END(9);
    PH_BEGIN(10) { for (int r2 = 0; r2 < (PROBE_PHASE == 100 ? 2 : 1); ++r2) phase10_ssd(args, lds, G, bx, lane, wave); for (int r2 = 0; r2 < (PROBE_PHASE == 101 ? 2 : 1); ++r2) phase10_attn(args, lds, G, vcu, tid, lane, wave); } PH_END(10);
    PH_BEGIN(11) { pg8::Gemm g{(const bf16*)(ws + WS_MIX), (const bf16*)(ws + WS_WOUT), NLAT, D, D}; pg8::StaticOrder S; S.init(NLAT, D, G, bx);
        pg8::EpiRes E{X1, X1, X1, MOD, 5, 1.0f}; pg8::gemm_phase<pg8::EpiRes, pg8::StaticOrder, true, true>(lds, g, S, E); } PH_END(11);
    PH_BEGIN(12) { norm_rows(X1, X1, NLAT, args.in[22], MOD, 6, XN, gw, NGW, lane); } PH_END(12);
    PH_BEGIN(13) { pg8::Gemm g{XN, (const bf16*)(ws + WS_W2A), NLAT, 2 * DFF, D}; pg8::StaticOrder S; S.init(NLAT, 2 * DFF, G, bx);
        pg8::EpiSwiglu E{HB, DFF}; pg8::gemm_phase<pg8::EpiSwiglu, pg8::StaticOrder, true, true>(lds, g, S, E); } PH_END(13);
    PH_BEGIN(14) { pg8::Gemm g{HB, (const bf16*)(ws + WS_W2B), NLAT, D, DFF}; pg8::StaticOrder S; S.init(NLAT, D, G, bx);
        pg8::EpiRes E{X1, X1, args.out, MOD, 8, 0.5f}; pg8::gemm_phase<pg8::EpiRes, pg8::StaticOrder, true, true>(lds, g, S, E); } PH_END(14);
    PH_BEGIN(15) { final_norm_rows(args.out, args.in[25], gw, NGW, lane); } PH_END(15);
#undef IN
#undef SEAM
}

#ifndef N_LAUNCHES
#define N_LAUNCHES 1
#endif
extern "C" void kernel_launch(void* const* d_in, const int* in_sizes, int n_in, void* d_out, int out_size, void* d_ws, size_t ws_size, hipStream_t stream) {
    static int grid = 0;
    if (grid == 0) {
        if (n_in != 26 || out_size != NLAT * D || ws_size < WS_END) { fprintf(stderr, "kernel_launch: unexpected shapes (n_in %d out %d ws %zu)\n", n_in, out_size, ws_size); grid = -1; return; }
        int dev = 0, cus = 0, per_cu = 0;
        (void)hipGetDevice(&dev); (void)hipDeviceGetAttribute(&cus, hipDeviceAttributeMultiprocessorCount, dev);
        if (hipFuncSetAttribute((const void*)hymba_fwd, hipFuncAttributeMaxDynamicSharedMemorySize, LDS_BYTES) != hipSuccess) { fprintf(stderr, "kernel_launch: hipFuncSetAttribute failed\n"); grid = -1; return; }
        if (hipOccupancyMaxActiveBlocksPerMultiprocessor(&per_cu, (const void*)hymba_fwd, 512, LDS_BYTES) != hipSuccess || per_cu < 1) { fprintf(stderr, "kernel_launch: occupancy query failed (%d)\n", per_cu); grid = -1; (void)hipGetLastError(); return; }
        grid = cus;
    }
    if (grid < 0) return;
    (void)hipMemsetAsync((char*)d_ws, 0, WS_ZERO_BYTES, stream);
    Args a{};
    for (int i = 0; i < 26; ++i) a.in[i] = (const float*)d_in[i];
    a.out = (float*)d_out; a.ws = (unsigned char*)d_ws;
    for (int li = 0; li < N_LAUNCHES; ++li) {
        a.ph_lo = (N_LAUNCHES == 1) ? 0 : li; a.ph_hi = (N_LAUNCHES == 1) ? NPHASE : li + 1;
        void* kargs[] = {&a};
        hipError_t e = hipLaunchCooperativeKernel((const void*)hymba_fwd, dim3(grid), dim3(512), kargs, LDS_BYTES, stream);
        if (e != hipSuccess) { fprintf(stderr, "kernel_launch: cooperative launch %d failed: %s (grid %d)\n", li, hipGetErrorString(e), grid); break; }
    }
}
```

```cpp
#include <hip/hip_runtime.h>
#include <hip/hip_cooperative_groups.h>
#include <cstdio>
#include <cstdint>
namespace cg = cooperative_groups;
namespace pg8 {
#define PG8_LAS __attribute__((address_space(3)))
typedef unsigned short bf16_t;
typedef short bf16x8 __attribute__((ext_vector_type(8)));
typedef float f32x4 __attribute__((ext_vector_type(4)));
typedef unsigned u32x4 __attribute__((ext_vector_type(4)));
constexpr int BM = 256, BK = 64, HALF = 128, HTB = HALF * BK * 2  , STAGE_BYTES = 8 * HTB, NXCD = 8, WGM = 8;

__host__ __device__ __forceinline__ int lds_byte(int r, int c) { const int st = (r >> 4) * 2 + (c >> 5), rr = r & 15, cc = c & 31, ob = rr * 64 + cc * 2; return st * 1024 + (ob ^ (((ob >> 9) & 1) << 5)); }
__host__ __device__ __forceinline__ void stage_rc(int b, int& R, int& C) { const int st = b / 1024, sb = b % 1024, swz = sb ^ (((sb >> 9) & 1) << 5); R = (st >> 1) * 16 + swz / 64; C = (st & 1) * 32 + (swz % 64) / 2; }
__host__ __device__ __forceinline__ int perm32(int rho) { const int n = rho >> 4, i = rho & 15; return 8 * (i >> 2) + 4 * n + (i & 3); }

struct Unit { int pm, pn; };
struct Gemm { const bf16_t* A; const bf16_t* Bt; int M, N, K; };

struct StaticOrder {
    int nM, nN, nwg, G, c;
    __host__ __device__ void init(int M, int N, int G_, int c_) { nM = M / BM; nN = N / BM; nwg = nM * nN; G = G_; c = c_; }
    __host__ __device__ bool next(int i, Unit& u) const {
        const long L = (long)i * G + c; if (L >= nwg) return false;
        int wgid = (int)L; { const int q = nwg / NXCD, r = nwg % NXCD, xcd = wgid % NXCD, off = wgid / NXCD; wgid = (xcd < r ? xcd * (q + 1) : r * (q + 1) + (xcd - r) * q) + off; }
        const int nig = WGM * nN, gid = wgid / nig, fm = gid * WGM, gsz = (nM - fm) < WGM ? (nM - fm) : WGM;
        u.pm = fm + ((wgid % nig) % gsz); u.pn = (wgid % nig) / gsz; return true;
    }
    __device__ __forceinline__ void a_ready(const Unit&) const {}
    __device__ __forceinline__ void done(const Unit&) const {}
};

__device__ __forceinline__ unsigned cvt_pk_bf16(float lo, float hi) { unsigned r; asm volatile("v_cvt_pk_bf16_f32 %0, %1, %2" : "=v"(r) : "v"(lo), "v"(hi)); return r; }
typedef float f32x2 __attribute__((ext_vector_type(2)));
__device__ __forceinline__ f32x2 gelu_pk(f32x2 v) {
    const f32x2 av = __builtin_elementwise_abs(v), d = av * 0.2316418882f + 1.0f;
    f32x2 t; t.x = __builtin_amdgcn_rcpf(d.x); t.y = __builtin_amdgcn_rcpf(d.y);
    f32x2 q = t * 0.5307027145f + (-0.7265760135f); q = q * t + 0.7107068705f; q = q * t + (-0.142248368f); q = q * t + 0.127414796f; q = q * t;
    const f32x2 s = (v * v) * (-0.72134752044f);
    f32x2 e; e.x = __builtin_amdgcn_exp2f(s.x); e.y = __builtin_amdgcn_exp2f(s.y);
    const f32x2 m = v * (q * e), r = v - m;
    f32x2 o; o.x = v.x < 0.f ? m.x : r.x; o.y = v.y < 0.f ? m.y : r.y; return o;
}

template <int ACT  > struct EpiBf16 {
    static constexpr bool PERM = true, AFTER_DRAIN = false; static_assert(ACT == 0 || ACT == 1, "EpiBf16: ACT is 0 (none) or 1 (gelu_pk)");
    bf16_t* O; int ldc; const float* bias; int split_cols; size_t split_stride; float scale0;
    __device__ __forceinline__ void operator()(const f32x4 (&acc)[2][2][4][2], const Unit& u, int wr, int wc, int fr, int fq) const {
        const int row0 = u.pm * BM + wr * 64 + fr; int colt = u.pn * BM; bf16_t* base = O;
        float sc = 1.f; if (split_cols) { const int t = colt / split_cols; base += (size_t)t * split_stride; colt -= t * split_cols; if (t == 0) sc = scale0; }
        const int col0 = colt + wc * 32 + 8 * fq, bcol0 = u.pn * BM + wc * 32 + 8 * fq;
        f32x4 bv[2][2];
#pragma unroll
        for (int bj = 0; bj < 2; ++bj)
#pragma unroll
            for (int n = 0; n < 2; ++n) bv[bj][n] = bias ? *(const f32x4*)(bias + bcol0 + bj * HALF + 4 * n) : (f32x4){0.f, 0.f, 0.f, 0.f};
#pragma unroll
        for (int ai = 0; ai < 2; ++ai)
#pragma unroll
            for (int m = 0; m < 4; ++m) { bf16_t* rowp = base + (size_t)(row0 + ai * HALF + m * 16) * ldc + col0;
#pragma unroll
                for (int bj = 0; bj < 2; ++bj) { f32x4 v0 = acc[ai][bj][m][0] + bv[bj][0], v1 = acc[ai][bj][m][1] + bv[bj][1];
                    if (ACT == 1) { f32x2 a = gelu_pk((f32x2){v0[0], v0[1]}), b = gelu_pk((f32x2){v0[2], v0[3]}), c = gelu_pk((f32x2){v1[0], v1[1]}), d = gelu_pk((f32x2){v1[2], v1[3]});
                        v0 = (f32x4){a.x, a.y, b.x, b.y}; v1 = (f32x4){c.x, c.y, d.x, d.y}; }
                    v0 = v0 * sc; v1 = v1 * sc; u32x4 w; w.x = cvt_pk_bf16(v0[0], v0[1]); w.y = cvt_pk_bf16(v0[2], v0[3]); w.z = cvt_pk_bf16(v1[0], v1[1]); w.w = cvt_pk_bf16(v1[2], v1[3]);
                    *(u32x4*)(rowp + bj * HALF) = w; } }
    }
};
template <class Epi, class Sched, bool ALIGN_EPI = false, bool SP2 = false>
__device__ __forceinline__ void gemm_phase(PG8_LAS unsigned char* lds, const Gemm g, const Sched& S, const Epi& E) {
    const int tid = threadIdx.x, wid = __builtin_amdgcn_readfirstlane(tid >> 6), lane = tid & 63, wr = wid >> 2, wc = wid & 3, fr = lane & 15, fq = lane >> 4;
    const int K = g.K, nt = K / BK;
    unsigned voffA[2], voffB[2];
#pragma unroll
    for (int i = 0; i < 2; ++i) { int R, C; stage_rc(tid * 16 + i * 8192, R, C); const int Rb = Epi::PERM ? ((R & ~31) + perm32(R & 31)) : R;
        voffA[i] = (unsigned)(R * K + C) * 2u; voffB[i] = (unsigned)(Rb * K + C) * 2u; }
    const size_t kstep = (size_t)(BK * 2);
    const size_t hstep = (size_t)HALF * K * 2;
    const size_t tstep = 2 * hstep;
    const unsigned ldsw = (unsigned)wid * 1024u;
    const int aoff = lds_byte(wr * 64 + fr, fq * 8), boff = lds_byte(wc * 32 + fr, fq * 8);
#define PG8_SA(b, h) (((b) * 2 + (h)) * HTB)
#define PG8_SB(b, h) ((4 + (b) * 2 + (h)) * HTB)
#define PG8_STAGE(bufoff, gbase, voff) do { _Pragma("unroll") for (int _i = 0; _i < 2; ++_i) \
        __builtin_amdgcn_global_load_lds((const unsigned*)((const char*)(gbase) + (voff)[_i]), (PG8_LAS unsigned*)(lds + (bufoff) + ldsw + _i * 8192), 16, 0, 0); } while (0)
#define PG8_LDA(dst, b, h) do { _Pragma("unroll") for (int m = 0; m < 4; ++m) _Pragma("unroll") for (int k = 0; k < 2; ++k) dst[m][k] = *(const PG8_LAS bf16x8*)(lds + PG8_SA(b, h) + aoff + m * 2048 + k * 1024); } while (0)
#define PG8_LDB(dst, b, h) do { _Pragma("unroll") for (int n = 0; n < 2; ++n) _Pragma("unroll") for (int k = 0; k < 2; ++k) dst[n][k] = *(const PG8_LAS bf16x8*)(lds + PG8_SB(b, h) + boff + n * 2048 + k * 1024); } while (0)
#define PG8_MMA(ai, bj, At, Bt) do { __builtin_amdgcn_s_setprio(1); _Pragma("unroll") for (int m = 0; m < 4; ++m) _Pragma("unroll") for (int n = 0; n < 2; ++n) _Pragma("unroll") for (int k = 0; k < 2; ++k) \
        acc[ai][bj][m][n] = __builtin_amdgcn_mfma_f32_16x16x32_bf16(Bt[n][k], At[m][k], acc[ai][bj][m][n], 0, 0, 0); __builtin_amdgcn_s_setprio(0); } while (0)
#define PG8_WAIT_V(n) asm volatile("s_waitcnt vmcnt(" #n ")" ::: "memory")
#define PG8_WAIT_L(n) asm volatile("s_waitcnt lgkmcnt(" #n ")" ::: "memory")
#define PG8_BAR __builtin_amdgcn_s_barrier()
#define PG8_SCHED __builtin_amdgcn_sched_barrier(0)
    Unit cur, nxt; int ui = 0;
    if (!S.next(0, cur)) return;
    f32x4 acc[2][2][4][2];
#pragma unroll
    for (int a = 0; a < 2; ++a)
#pragma unroll
        for (int b = 0; b < 2; ++b)
#pragma unroll
            for (int m = 0; m < 4; ++m)
#pragma unroll
                for (int n = 0; n < 2; ++n) acc[a][b][m][n] = (f32x4){0.f, 0.f, 0.f, 0.f};
    bf16x8 At[4][2], B0[2][2], B1[2][2];
    const char* cA = (const char*)g.A + (size_t)cur.pm * tstep; const char* cB = (const char*)g.Bt + (size_t)cur.pn * tstep;
    S.a_ready(cur);
    if constexpr (SP2) {
        PG8_STAGE(PG8_SB(0, 0), cB, voffB); PG8_STAGE(PG8_SB(0, 1), cB + hstep, voffB); PG8_STAGE(PG8_SA(0, 0), cA, voffA); PG8_STAGE(PG8_SA(0, 1), cA + hstep, voffA);
        if (wr == 1) PG8_BAR;
        PG8_WAIT_V(2); PG8_BAR;
        PG8_STAGE(PG8_SB(1, 0), cB + kstep, voffB); PG8_STAGE(PG8_SA(1, 0), cA + kstep, voffA); PG8_STAGE(PG8_SB(1, 1), cB + hstep + kstep, voffB);
        PG8_WAIT_V(6); PG8_BAR;
    } else {
        PG8_STAGE(PG8_SB(0, 0), cB, voffB); PG8_STAGE(PG8_SA(0, 0), cA, voffA); PG8_STAGE(PG8_SB(0, 1), cB + hstep, voffB); PG8_STAGE(PG8_SA(0, 1), cA + hstep, voffA);
        if (wr == 1) PG8_BAR;
        PG8_WAIT_V(4); PG8_BAR;
        PG8_STAGE(PG8_SB(1, 0), cB + kstep, voffB); PG8_STAGE(PG8_SA(1, 0), cA + kstep, voffA); PG8_STAGE(PG8_SB(1, 1), cB + hstep + kstep, voffB);
        PG8_WAIT_V(6); PG8_BAR;
    }
    for (;;) {
        const bool has_next = S.next(ui + 1, nxt);
        const char* nA = has_next ? (const char*)g.A + (size_t)nxt.pm * tstep : cA; const char* nB = has_next ? (const char*)g.Bt + (size_t)nxt.pn * tstep : cB;
        for (int t = 0; t < nt; t += 2) {
            const bool last = (t == nt - 2);
            const char* a1 = cA + (size_t)(t + 1) * kstep;
            const char* a2 = last ? nA : cA + (size_t)(t + 2) * kstep; const char* b2 = last ? nB : cB + (size_t)(t + 2) * kstep;
            const char* a3 = a2 + kstep; const char* b3 = b2 + kstep;
            if (last && has_next) S.a_ready(nxt);
            if constexpr (SP2) {
            PG8_LDB(B0, 0, 0); PG8_LDB(B1, 0, 1); PG8_SCHED; PG8_LDA(At, 0, 0); PG8_STAGE(PG8_SA(1, 1), a1 + hstep, voffA);
            PG8_WAIT_V(8); PG8_WAIT_L(0); PG8_BAR; PG8_MMA(0, 0, At, B0); PG8_MMA(0, 1, At, B1); PG8_BAR; PG8_SCHED;
            PG8_LDA(At, 0, 1); PG8_STAGE(PG8_SB(0, 0), b2, voffB); PG8_STAGE(PG8_SB(0, 1), b2 + hstep, voffB); PG8_STAGE(PG8_SA(0, 0), a2, voffA);
            PG8_WAIT_V(8); PG8_WAIT_L(0); PG8_BAR; PG8_MMA(1, 0, At, B0); PG8_MMA(1, 1, At, B1); PG8_BAR; PG8_SCHED;
            PG8_LDB(B0, 1, 0); PG8_LDB(B1, 1, 1); PG8_SCHED; PG8_LDA(At, 1, 0); PG8_STAGE(PG8_SA(0, 1), a2 + hstep, voffA);
            PG8_WAIT_V(8); PG8_WAIT_L(0); PG8_BAR; PG8_MMA(0, 0, At, B0); PG8_MMA(0, 1, At, B1); PG8_BAR; PG8_SCHED;
            PG8_LDA(At, 1, 1); PG8_STAGE(PG8_SB(1, 0), b3, voffB); PG8_STAGE(PG8_SB(1, 1), b3 + hstep, voffB); PG8_STAGE(PG8_SA(1, 0), a3, voffA);
            PG8_WAIT_V(8); PG8_WAIT_L(0); PG8_BAR; PG8_MMA(1, 0, At, B0); PG8_MMA(1, 1, At, B1); PG8_BAR; PG8_SCHED;
            } else {
            PG8_LDB(B0, 0, 0); PG8_SCHED; PG8_LDA(At, 0, 0); PG8_STAGE(PG8_SA(1, 1), a1 + hstep, voffA);
            PG8_WAIT_L(8); PG8_BAR; PG8_WAIT_L(0); PG8_MMA(0, 0, At, B0); PG8_BAR; PG8_SCHED;
            PG8_LDB(B1, 0, 1); PG8_STAGE(PG8_SB(0, 0), b2, voffB);
            PG8_BAR; PG8_WAIT_L(0); PG8_MMA(0, 1, At, B1); PG8_BAR;
            PG8_LDA(At, 0, 1); PG8_STAGE(PG8_SA(0, 0), a2, voffA);
            PG8_BAR; PG8_WAIT_L(0); PG8_MMA(1, 0, At, B0); PG8_BAR; PG8_SCHED;
            PG8_STAGE(PG8_SB(0, 1), b2 + hstep, voffB);
            PG8_WAIT_V(6); PG8_BAR; PG8_MMA(1, 1, At, B1); PG8_BAR;
            PG8_LDB(B0, 1, 0); PG8_SCHED; PG8_LDA(At, 1, 0); PG8_STAGE(PG8_SA(0, 1), a2 + hstep, voffA);
            PG8_WAIT_L(8); PG8_BAR; PG8_WAIT_L(0); PG8_MMA(0, 0, At, B0); PG8_BAR; PG8_SCHED;
            PG8_LDB(B1, 1, 1); PG8_STAGE(PG8_SB(1, 0), b3, voffB);
            PG8_BAR; PG8_WAIT_L(0); PG8_MMA(0, 1, At, B1); PG8_BAR;
            PG8_LDA(At, 1, 1); PG8_STAGE(PG8_SA(1, 0), a3, voffA);
            PG8_BAR; PG8_WAIT_L(0); PG8_MMA(1, 0, At, B0); PG8_BAR; PG8_SCHED;
            PG8_STAGE(PG8_SB(1, 1), b3 + hstep, voffB);
            PG8_WAIT_V(6); PG8_BAR; PG8_MMA(1, 1, At, B1); PG8_BAR;
            }
        }
        if constexpr (ALIGN_EPI) { if (wr == 0) PG8_BAR; }
        if constexpr (!Epi::AFTER_DRAIN) { E(acc, cur, wr, wc, fr, fq); S.done(cur); }
        if (!has_next) break;
#pragma unroll
        for (int a = 0; a < 2; ++a)
#pragma unroll
            for (int b = 0; b < 2; ++b)
#pragma unroll
                for (int m = 0; m < 4; ++m)
#pragma unroll
                    for (int n = 0; n < 2; ++n) acc[a][b][m][n] = (f32x4){0.f, 0.f, 0.f, 0.f};
        cur = nxt; cA = nA; cB = nB; ++ui;
        if constexpr (ALIGN_EPI) { if (wr == 1) PG8_BAR; }
    }
    PG8_WAIT_V(0);
    if constexpr (!ALIGN_EPI) { if (wr == 0) PG8_BAR; }
    PG8_BAR;
    if constexpr (Epi::AFTER_DRAIN) { E.fused(acc, cur, wr, wc, fr, fq, lds, wid, lane); S.done(cur); }
#undef PG8_SA
#undef PG8_SB
#undef PG8_STAGE
#undef PG8_LDA
#undef PG8_LDB
#undef PG8_MMA
#undef PG8_WAIT_V
#undef PG8_WAIT_L
#undef PG8_BAR
#undef PG8_SCHED
}
}
#ifndef PROBE_PHASE
#define PROBE_PHASE -1
#endif

#define LAS __attribute__((address_space(3)))
typedef unsigned short bf16;
typedef short bf16x8 __attribute__((ext_vector_type(8)));
typedef float f32x2 __attribute__((ext_vector_type(2)));
typedef float f32x4 __attribute__((ext_vector_type(4)));
typedef float f32x16 __attribute__((ext_vector_type(16)));
typedef unsigned u32x2 __attribute__((ext_vector_type(2)));
typedef unsigned u32x4 __attribute__((ext_vector_type(4)));
typedef __bf16 bf16x2_t __attribute__((ext_vector_type(2)));

constexpr int D = 1024, NB = 8, SEQ = 4096, CTXL = 256, NLAT = NB * SEQ, NCTX = NB * CTXL, MTOT = NLAT + NCTX;
constexpr int DFF = 2816, UL = SEQ + CTXL, NCH = UL / 128;
constexpr float EPS = 1e-6f;
constexpr float QSCALE = 0.10206207261596575f * 1.4426950408889634f;
constexpr int NPHASE = 16;

constexpr size_t MiB = (size_t)1 << 20, KiB = 1024;
constexpr size_t WS_BAR = 1 * MiB, WS_ZERO_BYTES = 1 * MiB + 16 * KiB;
constexpr size_t WS_MOD = 0, WS_ROPE = 384 * KiB, WS_CD = 448 * KiB, WS_RSTDQ = 512 * KiB, WS_RSTDKV = 768 * KiB;
constexpr size_t WS_W1A = 2 * MiB, WS_W1B = 13 * MiB, WS_WIN = 18 * MiB + 512 * KiB, WS_WUQ = 24 * MiB, WS_WK = 25 * MiB + 512 * KiB, WS_WV = 25 * MiB + 768 * KiB,
                 WS_WOUT = 26 * MiB, WS_W2A = 28 * MiB, WS_W2B = 39 * MiB;
constexpr size_t WS_A = 45 * MiB;
constexpr size_t WS_B = 113 * MiB;
constexpr size_t WS_Z = WS_B, WS_XBCR = WS_B + 34 * MiB, WS_CQ = WS_B + 102 * MiB, WS_CKV = WS_B + 153 * MiB, WS_MISC = WS_B + 170 * MiB;
constexpr size_t WS_ST = WS_XBCR, WS_MIX = WS_XBCR, WS_HE = WS_CQ;
constexpr size_t WS_C = 300 * MiB;
constexpr size_t WS_XT = 436 * MiB, WS_BT = 470 * MiB, WS_CROW = 487 * MiB, WS_DT = 504 * MiB, WS_KPE = 506 * MiB + 256 * KiB, WS_END = 512 * MiB;
constexpr size_t WS_BROW = WS_A;
constexpr size_t OUT_Q = 0, OUT_KN = 48 * MiB, OUT_VT = 82 * MiB;
constexpr int LDS_BYTES = 147456;

__device__ __forceinline__ unsigned pk2(float lo, float hi) { f32x2 v = {lo, hi}; bf16x2_t b = __builtin_convertvector(v, bf16x2_t); return __builtin_bit_cast(unsigned, b); }
__device__ __forceinline__ float bflo(unsigned w) { return __uint_as_float(w << 16); }
__device__ __forceinline__ float bfhi(unsigned w) { return __uint_as_float(w & 0xffff0000u); }
__device__ __forceinline__ float bf2f(bf16 u) { return __uint_as_float((unsigned)u << 16); }
__device__ __forceinline__ float silu_f(float x) { return x / (1.f + __expf(-x)); }
__device__ __forceinline__ float wave_sum(float v) {
#pragma unroll
    for (int o = 1; o < 64; o <<= 1) v += __shfl_xor(v, o);
    return v;
}
__device__ __forceinline__ float incl_scan(float v, int lane) {
#pragma unroll
    for (int o = 1; o < 64; o <<= 1) { float t = __shfl_up(v, o); if (lane >= o) v += t; }
    return v;
}
#define LDS_FENCE() asm volatile("s_waitcnt lgkmcnt(0)" ::: "memory")
__device__ __forceinline__ int crow(int r, int hi) { return (r & 3) + 8 * (r >> 2) + 4 * hi; }
__device__ __forceinline__ bf16x8 pack8(float a0, float a1, float a2, float a3, float a4, float a5, float a6, float a7) {
    u32x4 w; w.x = pk2(a0, a1); w.y = pk2(a2, a3); w.z = pk2(a4, a5); w.w = pk2(a6, a7); return __builtin_bit_cast(bf16x8, w);
}

struct Args { const float* in[26]; float* out; unsigned char* ws; int ph_lo, ph_hi; };

namespace pg8 {
struct EpiSwiglu {
    static constexpr bool PERM = true, AFTER_DRAIN = false;
    bf16_t* O; int ldc;
    __device__ __forceinline__ void operator()(const f32x4 (&acc)[2][2][4][2], const Unit& u, int wr, int wc, int fr, int fq) const {
        const int row0 = u.pm * BM + wr * 64 + fr, col0 = u.pn * HALF + wc * 32 + 8 * fq;
#pragma unroll
        for (int ai = 0; ai < 2; ++ai)
#pragma unroll
            for (int m = 0; m < 4; ++m) {
                bf16_t* rowp = O + (size_t)(row0 + ai * HALF + m * 16) * ldc + col0;
                const f32x4 g0 = acc[ai][0][m][0], g1 = acc[ai][0][m][1], u0 = acc[ai][1][m][0], u1 = acc[ai][1][m][1];
                u32x4 w;
                w.x = cvt_pk_bf16(silu_f(g0[0]) * u0[0], silu_f(g0[1]) * u0[1]); w.y = cvt_pk_bf16(silu_f(g0[2]) * u0[2], silu_f(g0[3]) * u0[3]);
                w.z = cvt_pk_bf16(silu_f(g1[0]) * u1[0], silu_f(g1[1]) * u1[1]); w.w = cvt_pk_bf16(silu_f(g1[2]) * u1[2], silu_f(g1[3]) * u1[3]);
                *(u32x4*)rowp = w;
            }
    }
};
struct EpiRes {
    static constexpr bool PERM = false, AFTER_DRAIN = false;
    const float* base_lat; const float* base_ctx; float* out; const float* mod; int kg; float mul;
    __device__ __forceinline__ void operator()(const f32x4 (&acc)[2][2][4][2], const Unit& u, int wr, int wc, int fr, int fq) const {
        const int row0 = u.pm * BM + wr * 64 + fr, col0 = u.pn * BM + wc * 32 + 4 * fq;
        const int bb = u.pm < (NLAT / BM) ? u.pm / (SEQ / BM) : 8;
        const float* gp = mod + bb * 9216 + kg * 1024 + col0;
        f32x4 gv[2][2];
#pragma unroll
        for (int bj = 0; bj < 2; ++bj)
#pragma unroll
            for (int n = 0; n < 2; ++n) gv[bj][n] = *(const f32x4*)(gp + bj * HALF + n * 16) * mul;
#pragma unroll
        for (int ai = 0; ai < 2; ++ai)
#pragma unroll
            for (int m = 0; m < 4; ++m) {
                const int r = row0 + ai * HALF + m * 16;
                const float* bp = (r < NLAT ? base_lat + (size_t)r * D : base_ctx + (size_t)(r - NLAT) * D) + col0;
                float* op = out + (size_t)r * D + col0;
#pragma unroll
                for (int bj = 0; bj < 2; ++bj)
#pragma unroll
                    for (int n = 0; n < 2; ++n) { const f32x4 bs = *(const f32x4*)(bp + bj * HALF + n * 16); *(f32x4*)(op + bj * HALF + n * 16) = bs + gv[bj][n] * acc[ai][bj][m][n]; }
            }
    }
};
struct EpiSplit {
    static constexpr bool PERM = true, AFTER_DRAIN = false;
    bf16_t *zb, *xbcr, *cq, *ckv, *misc;
    __device__ __forceinline__ void operator()(const f32x4 (&acc)[2][2][4][2], const Unit& u, int wr, int wc, int fr, int fq) const {
        const int pn = u.pn; bf16_t* base; int ld;
        if (pn < 2) { base = zb + pn * 256; ld = 512; } else if (pn < 6) { base = xbcr + (pn - 2) * 256; ld = 1024; } else if (pn < 9) { base = cq + (pn - 6) * 256; ld = 768; }
        else if (pn == 9) { base = ckv; ld = 256; } else { base = misc; ld = 256; }
        const int row0 = u.pm * BM + wr * 64 + fr, col0 = wc * 32 + 8 * fq;
#pragma unroll
        for (int ai = 0; ai < 2; ++ai)
#pragma unroll
            for (int m = 0; m < 4; ++m) {
                bf16_t* rowp = base + (size_t)(row0 + ai * HALF + m * 16) * ld + col0;
#pragma unroll
                for (int bj = 0; bj < 2; ++bj) { const f32x4 v0 = acc[ai][bj][m][0], v1 = acc[ai][bj][m][1];
                    u32x4 w; w.x = cvt_pk_bf16(v0[0], v0[1]); w.y = cvt_pk_bf16(v0[2], v0[3]); w.z = cvt_pk_bf16(v1[0], v1[1]); w.w = cvt_pk_bf16(v1[2], v1[3]);
                    *(u32x4*)(rowp + bj * HALF) = w; }
            }
    }
};
struct EpiScale {
    static constexpr bool PERM = true, AFTER_DRAIN = false;
    bf16_t* O; int ldc; const float* rs; const float* cs;
    __device__ __forceinline__ void operator()(const f32x4 (&acc)[2][2][4][2], const Unit& u, int wr, int wc, int fr, int fq) const {
        const int row0 = u.pm * BM + wr * 64 + fr, col0 = u.pn * BM + wc * 32 + 8 * fq;
        f32x4 cv[2][2];
#pragma unroll
        for (int bj = 0; bj < 2; ++bj)
#pragma unroll
            for (int n = 0; n < 2; ++n) cv[bj][n] = cs ? *(const f32x4*)(cs + col0 + bj * HALF + 4 * n) : (f32x4){1.f, 1.f, 1.f, 1.f};
#pragma unroll
        for (int ai = 0; ai < 2; ++ai)
#pragma unroll
            for (int m = 0; m < 4; ++m) {
                const int r = row0 + ai * HALF + m * 16; const float rv = rs ? rs[r] : 1.f;
                bf16_t* rowp = O + (size_t)r * ldc + col0;
#pragma unroll
                for (int bj = 0; bj < 2; ++bj) { const f32x4 v0 = acc[ai][bj][m][0] * cv[bj][0] * rv, v1 = acc[ai][bj][m][1] * cv[bj][1] * rv;
                    u32x4 w; w.x = cvt_pk_bf16(v0[0], v0[1]); w.y = cvt_pk_bf16(v0[2], v0[3]); w.z = cvt_pk_bf16(v1[0], v1[1]); w.w = cvt_pk_bf16(v1[2], v1[3]);
                    *(u32x4*)(rowp + bj * HALF) = w; }
            }
    }
};
struct EpiQ {
    static constexpr bool PERM = true, AFTER_DRAIN = false;
    bf16_t* O; const float* rs; const f32x2* rope;
    __device__ __forceinline__ void operator()(const f32x4 (&acc)[2][2][4][2], const Unit& u, int wr, int wc, int fr, int fq) const {
        const int row0 = u.pm * BM + wr * 64 + fr, col0 = u.pn * BM + wc * 32 + 8 * fq;
#pragma unroll
        for (int ai = 0; ai < 2; ++ai)
#pragma unroll
            for (int m = 0; m < 4; ++m) {
                const int r = row0 + ai * HALF + m * 16; const float rv = rs[r] * QSCALE; const int t = r & (SEQ - 1);
                bf16_t* rowp = O + (size_t)r * 768 + col0;
#pragma unroll
                for (int bj = 0; bj < 2; ++bj) {
                    f32x4 v0 = acc[ai][bj][m][0] * rv, v1 = acc[ai][bj][m][1] * rv;
                    const int cc = (col0 + bj * HALF) % 96;
                    if (cc >= 64) {
                        const int q = cc - 64, half = q >> 4, jj = (q & 15) >> 1, pos = half ? (t & 63) : (t >> 6);
                        const f32x2* rp = rope + pos * 8 + jj;
                        const f32x2 c0 = rp[0], c1 = rp[1], c2 = rp[2], c3 = rp[3];
                        f32x4 o0, o1;
                        o0[0] = v0[0] * c0.x - v0[1] * c0.y; o0[1] = v0[0] * c0.y + v0[1] * c0.x; o0[2] = v0[2] * c1.x - v0[3] * c1.y; o0[3] = v0[2] * c1.y + v0[3] * c1.x;
                        o1[0] = v1[0] * c2.x - v1[1] * c2.y; o1[1] = v1[0] * c2.y + v1[1] * c2.x; o1[2] = v1[2] * c3.x - v1[3] * c3.y; o1[3] = v1[2] * c3.y + v1[3] * c3.x;
                        v0 = o0; v1 = o1;
                    }
                    u32x4 w; w.x = cvt_pk_bf16(v0[0], v0[1]); w.y = cvt_pk_bf16(v0[2], v0[3]); w.z = cvt_pk_bf16(v1[0], v1[1]); w.w = cvt_pk_bf16(v1[2], v1[3]);
                    *(u32x4*)(rowp + bj * HALF) = w;
                }
            }
    }
};
}

__device__ __forceinline__ int cmap(int id, int n) {
    switch (id) {
    case 0: return ((n >> 7) & 1) * DFF + (n >> 8) * 128 + (n & 127);
    case 1: return n;
    case 2: {
        if (n < 1536) return n;
        if (n < 2304) return 1552 + (n - 1536);
        if (n < 2560) return 2320 + (n - 2304);
        if (n < 2592) { const int q = n - 2560, half = q >> 4, jj = (q & 15) >> 1, which = q & 1; return 2576 + half * 16 + which * 8 + jj; }
        if (n < 2608) return 1536 + (n - 2592);
        return -1; }
    case 3: { const int hh = n / 96, cc = n % 96; if (cc < 64) return hh * 96 + cc;
        const int q = cc - 64, half = q >> 4, jj = (q & 15) >> 1, which = q & 1; return hh * 96 + 64 + half * 16 + which * 8 + jj; }
    case 4: return (n >> 6) * 128 + (n & 63);
    default: return (n >> 6) * 128 + 64 + (n & 63);
    }
}
__device__ __forceinline__ void titem(const float* W, int K, int N, bf16* WT, const float* gk, LAS float* scr, int item, int nblk, int lane, int id, float mulc = 1.f) {
    const int kb = item / nblk, nb = item % nblk, k0 = 64 * kb, n0 = 32 * nb;
    const int src = cmap(id, n0 + (lane & 31));
#pragma unroll 8
    for (int i = 0; i < 32; ++i) { const int kk = 2 * i + (lane >> 5); float v = src >= 0 ? W[(size_t)(k0 + kk) * N + src] : 0.f; if (gk) v *= gk[k0 + kk] * mulc; scr[kk * 33 + (lane & 31)] = v; }
    LDS_FENCE();
    const int c = lane & 7;
#pragma unroll
    for (int j = 0; j < 4; ++j) { const int n = (lane >> 3) + 8 * j; const LAS float* s = scr + (8 * c) * 33 + n;
        u32x4 o; o.x = pk2(s[0 * 33], s[1 * 33]); o.y = pk2(s[2 * 33], s[3 * 33]); o.z = pk2(s[4 * 33], s[5 * 33]); o.w = pk2(s[6 * 33], s[7 * 33]);
        *(u32x4*)(WT + (size_t)(n0 + n) * K + k0 + 8 * c) = o; }
    LDS_FENCE();
}
__device__ __forceinline__ void phase0(const Args& a, LAS unsigned char* lds, int gw, int NGW, int tid, int lane, int wave) {
    unsigned char* ws = a.ws;
    LAS float* scr = (LAS float*)(lds + wave * 16384);
    if (blockIdx.x < 144) {
        float* MOD = (float*)(ws + WS_MOD);
        const float* cin = a.in[1]; const float* cctx = a.in[3]; const float* wada = a.in[4]; const float* bada = a.in[5];
        const int n = blockIdx.x * 64 + lane, kw = wave * 128;
        float acc[9];
#pragma unroll
        for (int bb = 0; bb < 9; ++bb) acc[bb] = 0.f;
#pragma unroll 1
        for (int hf = 0; hf < 2; ++hf) {
            const int k0 = kw + 64 * hf;
            float sv[9];
#pragma unroll
            for (int bb = 0; bb < 8; ++bb) sv[bb] = silu_f(cin[bb * 1024 + k0 + lane]);
            sv[8] = silu_f(cctx[k0 + lane]);
#pragma unroll 16
            for (int k = 0; k < 64; ++k) {
                const float w = wada[(size_t)(k0 + k) * 9216 + n];
#pragma unroll
                for (int bb = 0; bb < 9; ++bb) acc[bb] += w * __shfl(sv[bb], k);
            }
        }
        LAS float* red = (LAS float*)lds;
#pragma unroll
        for (int bb = 0; bb < 9; ++bb) red[(wave * 9 + bb) * 64 + lane] = acc[bb];
        __syncthreads();
        for (int o = tid; o < 576; o += 512) { float t = bada[blockIdx.x * 64 + (o & 63)];
#pragma unroll
            for (int w = 0; w < 8; ++w) t += red[w * 576 + o];
            MOD[(o >> 6) * 9216 + blockIdx.x * 64 + (o & 63)] = t; }
        __syncthreads();
    }
    constexpr int I_W1A = 16 * 176, I_W1B = 44 * 32, I_WIN = 16 * 88, I_WUQ = 12 * 24, I_WK = 4 * 16, I_WOUT = 16 * 32;
    constexpr int NITEMS = 2 * I_W1A + 2 * I_W1B + I_WIN + I_WUQ + 2 * I_WK + I_WOUT;
    for (int rep0 = 0; rep0 < (PROBE_PHASE == 201 ? 2 : 1); ++rep0)
    for (int it = gw; it < NITEMS; it += NGW) {
        int r = it;
        if (r < I_W1A) { titem(a.in[7], 1024, 5632, (bf16*)(ws + WS_W1A), nullptr, scr, r, 176, lane, 0); continue; } r -= I_W1A;
        if (r < I_W1A) { titem(a.in[23], 1024, 5632, (bf16*)(ws + WS_W2A), nullptr, scr, r, 176, lane, 0); continue; } r -= I_W1A;
        if (r < I_W1B) { titem(a.in[8], 2816, 1024, (bf16*)(ws + WS_W1B), nullptr, scr, r, 32, lane, 1); continue; } r -= I_W1B;
        if (r < I_W1B) { titem(a.in[24], 2816, 1024, (bf16*)(ws + WS_W2B), nullptr, scr, r, 32, lane, 1); continue; } r -= I_W1B;
        if (r < I_WIN) { titem(a.in[10], 1024, 2608, (bf16*)(ws + WS_WIN), nullptr, scr, r, 88, lane, 2); continue; } r -= I_WIN;
        if (r < I_WUQ) { titem(a.in[18], 768, 768, (bf16*)(ws + WS_WUQ), a.in[17], scr, r, 24, lane, 3, QSCALE); continue; } r -= I_WUQ;
        if (r < I_WK) { titem(a.in[20], 256, 1024, (bf16*)(ws + WS_WK), a.in[19], scr, r, 16, lane, 4); continue; } r -= I_WK;
        if (r < I_WK) { titem(a.in[20], 256, 1024, (bf16*)(ws + WS_WV), a.in[19], scr, r, 16, lane, 5); continue; } r -= I_WK;
        titem(a.in[21], 1024, 1024, (bf16*)(ws + WS_WOUT), nullptr, scr, r, 32, lane, 1);
    }
    if (blockIdx.x == 0) {
        const int pos = tid >> 3, jj = tid & 7; const float inv = __builtin_amdgcn_exp2f(-(float)jj * 1.6609640474436813f);
        const float ang = (float)pos * inv;
        ((f32x2*)(ws + WS_ROPE))[tid] = (f32x2){__cosf(ang), __sinf(ang)};
    }
}

__device__ __forceinline__ void norm_rows(const float* src_lat, const float* src_ctx, int nrows, const float* gvec, const float* mod, int kshift, bf16* out, int gw, int NGW, int lane) {
    for (int row = gw; row < nrows; row += NGW) {
        const float* xr = (row < NLAT ? src_lat + (size_t)row * D : src_ctx + (size_t)(row - NLAT) * D) + 4 * lane;
        const int bb = row < NLAT ? row / SEQ : 8;
        const float* sh = mod + bb * 9216 + kshift * 1024 + 4 * lane; const float* sc = sh + 1024;
        f32x4 v[4]; float s = 0.f;
#pragma unroll
        for (int j = 0; j < 4; ++j) { v[j] = *(const f32x4*)(xr + 256 * j); s += (v[j][0] * v[j][0] + v[j][1] * v[j][1]) + (v[j][2] * v[j][2] + v[j][3] * v[j][3]); }
        const float rstd = 1.0f / sqrtf(wave_sum(s) * (1.f / D) + EPS);
        bf16* orow = out + (size_t)row * D + 4 * lane;
#pragma unroll
        for (int j = 0; j < 4; ++j) {
            const f32x4 g = *(const f32x4*)(gvec + 4 * lane + 256 * j), scv = *(const f32x4*)(sc + 256 * j), shv = *(const f32x4*)(sh + 256 * j);
            const f32x4 y = (v[j] * rstd) * g * (scv + 1.f) + shv;
            u32x2 w; w.x = pk2(y[0], y[1]); w.y = pk2(y[2], y[3]); *(u32x2*)(orow + 256 * j) = w;
        }
    }
}
__device__ __forceinline__ void final_norm_rows(float* io, const float* gvec, int gw, int NGW, int lane) {
    for (int row = gw; row < NLAT; row += NGW) {
        float* xr = io + (size_t)row * D + 4 * lane;
        f32x4 v[4]; float s = 0.f;
#pragma unroll
        for (int j = 0; j < 4; ++j) { v[j] = *(const f32x4*)(xr + 256 * j); s += (v[j][0] * v[j][0] + v[j][1] * v[j][1]) + (v[j][2] * v[j][2] + v[j][3] * v[j][3]); }
        const float rstd = 1.0f / sqrtf(wave_sum(s) * (1.f / D) + EPS);
#pragma unroll
        for (int j = 0; j < 4; ++j) { const f32x4 g = *(const f32x4*)(gvec + 4 * lane + 256 * j); *(f32x4*)(xr + 256 * j) = (v[j] * rstd) * g; }
    }
}

__device__ __forceinline__ float softplus_f(float x) { return fmaxf(x, 0.f) + log1pf(__expf(-fabsf(x))); }
__device__ __forceinline__ void phase6(const Args& a, LAS unsigned char* lds, int G, int bx, int tid, int lane, int wave) {
    unsigned char* ws = a.ws;
    const bf16* XBCR = (const bf16*)(ws + WS_XBCR); const bf16* MISC = (const bf16*)(ws + WS_MISC); const bf16* CQ = (const bf16*)(ws + WS_CQ); const bf16* CKV = (const bf16*)(ws + WS_CKV);
    bf16* XT = (bf16*)(ws + WS_XT); bf16* BT = (bf16*)(ws + WS_BT); bf16* BROW = (bf16*)(ws + WS_BROW); bf16* CROW = (bf16*)(ws + WS_CROW); bf16* KPE = (bf16*)(ws + WS_KPE);
    float* DT = (float*)(ws + WS_DT); float* RSTDQ = (float*)(ws + WS_RSTDQ); float* RSTDKV = (float*)(ws + WS_RSTDKV); const f32x2* ROPE = (const f32x2*)(ws + WS_ROPE);
    const float* conv_w = a.in[11]; const float* conv_b = a.in[12]; const float* dt_bias = a.in[13];
    LAS bf16* T = (LAS bf16*)lds;
    const int ch = 4 * (tid & 255), tseg = (tid >> 8) * 32;
    float cw[5][4], cb[4];
#pragma unroll
    for (int k = 0; k < 5; ++k) { const f32x4 w = *(const f32x4*)(conv_w + k * 1024 + ch); cw[k][0] = w[0]; cw[k][1] = w[1]; cw[k][2] = w[2]; cw[k][3] = w[3]; }
    { const f32x4 w = *(const f32x4*)(conv_b + ch); cb[0] = w[0]; cb[1] = w[1]; cb[2] = w[2]; cb[3] = w[3]; }
    for (int unit = bx; unit < NB * 68; unit += G) {
        const int b = unit / 68, ut = unit % 68, u0 = ut * 64;
        const int seg_lo = u0 < CTXL ? 0 : CTXL, seg_hi = u0 < CTXL ? CTXL : UL;
        const int rb = u0 < CTXL ? NLAT + b * CTXL : b * SEQ - CTXL;
#define P6_LD(u) (((u) >= seg_lo && (u) < seg_hi) ? *(const u32x2*)(XBCR + (size_t)(rb + (u)) * 1024 + ch) : (u32x2){0u, 0u})
        const int ub = u0 + tseg;
        u32x2 xm2 = P6_LD(ub - 2), xm1 = P6_LD(ub - 1), x0 = P6_LD(ub), xp1 = P6_LD(ub + 1);
#pragma unroll 16
        for (int t = 0; t < 32; ++t) {
            const u32x2 xp2 = P6_LD(ub + t + 2);
            const float y0 = cb[0] + cw[0][0] * bflo(xm2.x) + cw[1][0] * bflo(xm1.x) + cw[2][0] * bflo(x0.x) + cw[3][0] * bflo(xp1.x) + cw[4][0] * bflo(xp2.x);
            const float y1 = cb[1] + cw[0][1] * bfhi(xm2.x) + cw[1][1] * bfhi(xm1.x) + cw[2][1] * bfhi(x0.x) + cw[3][1] * bfhi(xp1.x) + cw[4][1] * bfhi(xp2.x);
            const float y2 = cb[2] + cw[0][2] * bflo(xm2.y) + cw[1][2] * bflo(xm1.y) + cw[2][2] * bflo(x0.y) + cw[3][2] * bflo(xp1.y) + cw[4][2] * bflo(xp2.y);
            const float y3 = cb[3] + cw[0][3] * bfhi(xm2.y) + cw[1][3] * bfhi(xm1.y) + cw[2][3] * bfhi(x0.y) + cw[3][3] * bfhi(xp1.y) + cw[4][3] * bfhi(xp2.y);
            u32x2 pk; pk.x = pk2(silu_f(y0), silu_f(y1)); pk.y = pk2(silu_f(y2), silu_f(y3));
            const int tt = tseg + t;
            if (ch < 768) { T[ch * 72 + tt] = (bf16)(pk.x & 0xffffu); T[(ch + 1) * 72 + tt] = (bf16)(pk.x >> 16); T[(ch + 2) * 72 + tt] = (bf16)(pk.y & 0xffffu); T[(ch + 3) * 72 + tt] = (bf16)(pk.y >> 16); }
            if (ch >= 512) { bf16* dst = ch < 768 ? BROW + (ch - 512) : CROW + (ch - 768); *(u32x2*)(dst + (size_t)(b * UL + u0 + tt) * 256) = pk; }
            xm2 = xm1; xm1 = x0; x0 = xp1; xp1 = xp2;
        }
#undef P6_LD
        __syncthreads();
#pragma unroll
        for (int i = 0; i < 12; ++i) { const int q = tid + 512 * i, c = q >> 3, part = q & 7;
            const u32x4 v = *(const LAS u32x4*)(T + c * 72 + part * 8);
            bf16* dst = c < 512 ? XT + (size_t)(b * 512 + c) * UL : BT + (size_t)(b * 256 + c - 512) * UL;
            *(u32x4*)(dst + u0 + part * 8) = v; }
        {
            const int uu = tid >> 3, k = (tid & 7) * 2; const size_t row = (size_t)(rb + u0 + uu);
            const unsigned raw = *(const unsigned*)(MISC + row * 256 + 32 + k);
            f32x2 o; o.x = softplus_f(bflo(raw) + dt_bias[k]); o.y = softplus_f(bfhi(raw) + dt_bias[k + 1]);
            *(f32x2*)(DT + (size_t)(b * UL + u0 + uu) * 16 + k) = o;
        }
        {
            const int uu = tid >> 3, pp = (tid & 7) * 2; const size_t row = (size_t)(rb + u0 + uu);
            u32x2 raw = *(const u32x2*)(MISC + row * 256 + 2 * pp);
            if (u0 >= CTXL) {
                const int t = u0 + uu - CTXL, half = pp >> 3, jj = pp & 7, pos = half ? (t & 63) : (t >> 6);
                const f32x2 c0 = ROPE[pos * 8 + jj], c1 = ROPE[pos * 8 + jj + 1];
                const float a0 = bflo(raw.x), a1 = bfhi(raw.x), a2 = bflo(raw.y), a3 = bfhi(raw.y);
                raw.x = pk2(a0 * c0.x - a1 * c0.y, a0 * c0.y + a1 * c0.x); raw.y = pk2(a2 * c1.x - a3 * c1.y, a2 * c1.y + a3 * c1.x);
            }
            *(u32x2*)(KPE + row * 32 + 2 * pp) = raw;
        }
#pragma unroll 2
        for (int rr = 0; rr < 8; ++rr) {
            const size_t row = (size_t)(rb + u0 + wave * 8 + rr);
            { const u32x2 w = *(const u32x2*)(CKV + row * 256 + 4 * lane); const float c0 = bflo(w.x), c1 = bfhi(w.x), c2 = bflo(w.y), c3 = bfhi(w.y);
              const float s = wave_sum((c0 * c0 + c1 * c1) + (c2 * c2 + c3 * c3)); if (lane == 0) RSTDKV[row] = 1.0f / sqrtf(s * (1.f / 256.f) + EPS); }
            if (u0 >= CTXL) { float s = 0.f;
#pragma unroll
                for (int i = 0; i < 3; ++i) { const u32x2 w = *(const u32x2*)(CQ + row * 768 + 4 * lane + 256 * i); const float c0 = bflo(w.x), c1 = bfhi(w.x), c2 = bflo(w.y), c3 = bfhi(w.y);
                    s += (c0 * c0 + c1 * c1) + (c2 * c2 + c3 * c3); }
                s = wave_sum(s); if (lane == 0) RSTDQ[row] = 1.0f / sqrtf(s * (1.f / 768.f) + EPS); }
        }
        __syncthreads();
    }
}

__device__ __forceinline__ void acum_wave(const float* DT, size_t dtrow0, int h, float anf, float anb, LAS float* sc, int lane) {
    const float df0 = DT[(dtrow0 + lane) * 16 + h], df1 = DT[(dtrow0 + 64 + lane) * 16 + h];
    const float db0 = DT[(dtrow0 + lane) * 16 + 8 + h], db1 = DT[(dtrow0 + 64 + lane) * 16 + 8 + h];
    const float f0 = incl_scan(df0 * anf, lane); float f1 = incl_scan(df1 * anf, lane); f1 += __shfl(f0, 63);
    const float a0 = db0 * anb, a1 = db1 * anb; const float g0 = incl_scan(a0, lane), g1 = incl_scan(a1, lane);
    const float t0 = __shfl(g0, 63), t1 = __shfl(g1, 63), tot = t0 + t1;
    sc[lane] = f0; sc[64 + lane] = f1; sc[128 + lane] = tot - g0 + a0; sc[192 + lane] = t1 - g1 + a1;
    sc[256 + lane] = df0; sc[320 + lane] = df1; sc[384 + lane] = db0; sc[448 + lane] = db1;
    LDS_FENCE();
}
#define MFMA32(a, b, c) __builtin_amdgcn_mfma_f32_32x32x16_bf16((a), (b), (c), 0, 0, 0)
__device__ __forceinline__ f32x16 zero16() { f32x16 z;
#pragma unroll
    for (int r = 0; r < 16; ++r) z[r] = 0.f; return z; }

__device__ __forceinline__ void phase8(const Args& a, LAS unsigned char* lds, int G, int bx, int lane, int wave) {
    unsigned char* ws = a.ws;
    const bf16* XT = (const bf16*)(ws + WS_XT); const bf16* BT = (const bf16*)(ws + WS_BT); const float* DT = (const float*)(ws + WS_DT);
    bf16* ST = (bf16*)(ws + WS_ST); float* CD = (float*)(ws + WS_CD);
    LAS float* sc = (LAS float*)lds + wave * 512;
    const int h = wave, g = h >> 2, r32 = lane & 31, hi = lane >> 5;
    const float anf = -__expf(a.in[14][h]), anb = -__expf(a.in[14][8 + h]);
    for (int unit = bx; unit < NB * NCH; unit += G) {
        const int b = unit / NCH, c = unit % NCH;
        acum_wave(DT, (size_t)b * UL + c * 128, h, anf, anb, sc, lane);
        const float af_last = sc[127], ab_first = sc[128];
#pragma unroll
        for (int hf = 0; hf < 2; ++hf) { const int j = lane + 64 * hf;
            const float wf = __expf(af_last - sc[j]) * sc[256 + j], wb = __expf(ab_first - sc[128 + j]) * sc[384 + j];
            sc[256 + j] = wf; sc[384 + j] = wb; }
        if (lane == 0) { CD[((b * 2 + 0) * 8 + h) * NCH + c] = __expf(af_last); CD[((b * 2 + 1) * 8 + h) * NCH + c] = __expf(ab_first); }
        LDS_FENCE();
        const bf16* xbase = XT + (size_t)(b * 512 + h * 64 + r32) * UL + c * 128 + 8 * hi;
        const bf16* bbase = BT + (size_t)(b * 256 + g * 128 + r32) * UL + c * 128 + 8 * hi;
#pragma unroll 1
        for (int dir = 0; dir < 2; ++dir) {
            const LAS float* w = sc + 256 + 128 * dir + 8 * hi;
            f32x16 acc[4][2];
#pragma unroll
            for (int nb = 0; nb < 4; ++nb) { acc[nb][0] = zero16(); acc[nb][1] = zero16(); }
#pragma unroll 2
            for (int s = 0; s < 8; ++s) {
                const f32x4 wa = *(const LAS f32x4*)(w + 16 * s), wb = *(const LAS f32x4*)(w + 16 * s + 4);
                bf16x8 xw[2];
#pragma unroll
                for (int pb = 0; pb < 2; ++pb) { const u32x4 raw = *(const u32x4*)(xbase + (size_t)pb * 32 * UL + 16 * s);
                    xw[pb] = pack8(bflo(raw.x) * wa[0], bfhi(raw.x) * wa[1], bflo(raw.y) * wa[2], bfhi(raw.y) * wa[3], bflo(raw.z) * wb[0], bfhi(raw.z) * wb[1], bflo(raw.w) * wb[2], bfhi(raw.w) * wb[3]); }
#pragma unroll
                for (int nb = 0; nb < 4; ++nb) { const bf16x8 bt = *(const bf16x8*)(bbase + (size_t)nb * 32 * UL + 16 * s);
                    acc[nb][0] = MFMA32(bt, xw[0], acc[nb][0]); acc[nb][1] = MFMA32(bt, xw[1], acc[nb][1]); }
            }
            bf16* so = ST + ((size_t)(((b * 2 + dir) * 8 + h) * NCH + c) * 64) * 128;
#pragma unroll
            for (int nb = 0; nb < 4; ++nb)
#pragma unroll
                for (int pb = 0; pb < 2; ++pb)
#pragma unroll
                    for (int g4 = 0; g4 < 4; ++g4) { u32x2 o; o.x = pk2(acc[nb][pb][4 * g4], acc[nb][pb][4 * g4 + 1]); o.y = pk2(acc[nb][pb][4 * g4 + 2], acc[nb][pb][4 * g4 + 3]);
                        *(u32x2*)(so + (size_t)(32 * pb + r32) * 128 + 32 * nb + 8 * g4 + 4 * hi) = o; }
        }
        LDS_FENCE();
    }
}
__device__ __forceinline__ void phase9(const Args& a, int G, int bx, int tid) {
    unsigned char* ws = a.ws;
    const bf16* ST = (const bf16*)(ws + WS_ST); bf16* HE = (bf16*)(ws + WS_HE); const float* CD = (const float*)(ws + WS_CD);
    for (int idx = bx * 512 + tid; idx < NB * 2 * 8 * 2048; idx += G * 512) {
        const int e = (idx & 2047) * 4, bdh = idx >> 11, dir = (bdh >> 3) & 1;
        const bf16* st = ST + (size_t)bdh * NCH * 8192 + e; bf16* he = HE + (size_t)bdh * 32 * 8192 + e; const float* cd = CD + bdh * NCH;
#define P9_LD(c) (*(const u32x2*)(st + (size_t)(c) * 8192))
#define P9_STEP(c) do { const u32x2 w_ = P9_LD(c); const float d_ = cd[c]; h0 = d_ * h0 + bflo(w_.x); h1 = d_ * h1 + bfhi(w_.x); h2 = d_ * h2 + bflo(w_.y); h3 = d_ * h3 + bfhi(w_.y); } while (0)
#define P9_OUT(c) do { u32x2 o_; o_.x = pk2(h0, h1); o_.y = pk2(h2, h3); *(u32x2*)(he + (size_t)((c) - 2) * 8192) = o_; } while (0)
        float h0 = 0.f, h1 = 0.f, h2 = 0.f, h3 = 0.f;
        if (dir == 0) {
            P9_STEP(0); P9_STEP(1);
#pragma unroll 8
            for (int c = 2; c < NCH; ++c) { P9_OUT(c); P9_STEP(c); }
        } else {
            P9_STEP(1); P9_STEP(0);
#pragma unroll 8
            for (int c = NCH - 1; c >= 2; --c) { P9_OUT(c); P9_STEP(c); }
        }
#undef P9_LD
#undef P9_STEP
#undef P9_OUT
    }
}
__device__ __forceinline__ void phase10_ssd(const Args& a, LAS unsigned char* lds, int G, int bx, int lane, int wave) {
    unsigned char* ws = a.ws;
    const bf16* XT = (const bf16*)(ws + WS_XT); const bf16* BROW = (const bf16*)(ws + WS_BROW); const bf16* CROW = (const bf16*)(ws + WS_CROW); const float* DT = (const float*)(ws + WS_DT);
    const bf16* HE = (const bf16*)(ws + WS_HE); const bf16* Z = (const bf16*)(ws + WS_Z); bf16* MIX = (bf16*)(ws + WS_MIX);
    LAS float* sc = (LAS float*)lds + wave * 512;
    LAS float* SS = (LAS float*)(lds + 16384);
    const int h = wave, g = h >> 2, r32 = lane & 31, hi = lane >> 5;
    const float anf = -__expf(a.in[14][h]), anb = -__expf(a.in[14][8 + h]);
    const float dskip = a.in[15][h]; const float* snorm = a.in[16] + h * 64;
    for (int unit = bx; unit < NB * 32; unit += G) {
        const int b = unit >> 5, lc = unit & 31, c = lc + 2; const size_t u0 = (size_t)b * UL + c * 128;
        acum_wave(DT, u0, h, anf, anb, sc, lane);
#pragma unroll 1
        for (int ib = 0; ib < 4; ++ib) {
            const int i = 32 * ib + r32;
            const float afi = sc[i], abi = sc[128 + i];
            bf16x8 cfr[8];
            { const bf16* cp = CROW + (u0 + i) * 256 + g * 128 + 8 * hi;
#pragma unroll
              for (int s = 0; s < 8; ++s) cfr[s] = *(const bf16x8*)(cp + 16 * s); }
            f32x16 acc[2]; acc[0] = zero16(); acc[1] = zero16();
#pragma unroll 1
            for (int jb = 0; jb < 4; ++jb) {
                f32x16 ga = zero16();
                { const bf16* bp = BROW + (u0 + 32 * jb + r32) * 256 + g * 128 + 8 * hi;
#pragma unroll
                  for (int s = 0; s < 8; ++s) { const bf16x8 bfr = *(const bf16x8*)(bp + 16 * s); ga = MFMA32(bfr, cfr[s], ga); } }
                float mm[16];
#pragma unroll
                for (int r = 0; r < 16; ++r) {
                    const int jl = crow(r, hi), j = 32 * jb + jl;
                    float mf = 0.f, mb = 0.f;
                    if (jb <= ib) { const float e = __expf(afi - sc[j]) * sc[256 + j]; mf = (jb < ib || jl <= r32) ? e : 0.f; }
                    if (jb >= ib) { const float e = __expf(abi - sc[128 + j]) * sc[384 + j]; mb = (jb > ib || jl >= r32) ? e : 0.f; }
                    float mt = ga[r] * (mf + mb);
                    if (jb == ib && jl == r32) mt += dskip;
                    mm[r] = mt;
                }
                const bf16x8 pf0 = pack8(mm[0], mm[1], mm[2], mm[3], mm[4], mm[5], mm[6], mm[7]), pf1 = pack8(mm[8], mm[9], mm[10], mm[11], mm[12], mm[13], mm[14], mm[15]);
#pragma unroll
                for (int pb = 0; pb < 2; ++pb) {
                    const bf16* xp = XT + (size_t)(b * 512 + h * 64 + 32 * pb + r32) * UL + c * 128 + 32 * jb + 4 * hi;
                    const u32x2 a0 = *(const u32x2*)(xp), a1 = *(const u32x2*)(xp + 8), a2 = *(const u32x2*)(xp + 16), a3 = *(const u32x2*)(xp + 24);
                    const bf16x8 xa0 = __builtin_bit_cast(bf16x8, (u32x4){a0.x, a0.y, a1.x, a1.y}), xa1 = __builtin_bit_cast(bf16x8, (u32x4){a2.x, a2.y, a3.x, a3.y});
                    acc[pb] = MFMA32(xa0, pf0, acc[pb]); acc[pb] = MFMA32(xa1, pf1, acc[pb]);
                }
            }
#pragma unroll
            for (int dir = 0; dir < 2; ++dir) {
                const float e = __expf(dir ? abi : afi);
#pragma unroll
                for (int pb = 0; pb < 2; ++pb) {
                    const bf16* hp = HE + ((size_t)(((b * 2 + dir) * 8 + h) * 32 + lc) * 64 + 32 * pb + r32) * 128 + 8 * hi;
                    f32x16 ta = zero16();
#pragma unroll
                    for (int s = 0; s < 8; ++s) { const bf16x8 hf = *(const bf16x8*)(hp + 16 * s); ta = MFMA32(hf, cfr[s], ta); }
#pragma unroll
                    for (int r = 0; r < 16; ++r) acc[pb][r] += e * ta[r];
                }
            }
            const size_t row = (size_t)b * SEQ + lc * 128 + i;
            float ss = 0.f;
#pragma unroll
            for (int pb = 0; pb < 2; ++pb)
#pragma unroll
                for (int g4 = 0; g4 < 4; ++g4) { const u32x2 zw = *(const u32x2*)(Z + row * 512 + h * 64 + 32 * pb + 8 * g4 + 4 * hi);
                    const float z0 = bflo(zw.x), z1 = bfhi(zw.x), z2 = bflo(zw.y), z3 = bfhi(zw.y);
                    float v0 = acc[pb][4 * g4] * silu_f(z0), v1 = acc[pb][4 * g4 + 1] * silu_f(z1), v2 = acc[pb][4 * g4 + 2] * silu_f(z2), v3 = acc[pb][4 * g4 + 3] * silu_f(z3);
                    ss += (v0 * v0 + v1 * v1) + (v2 * v2 + v3 * v3);
                    acc[pb][4 * g4] = v0; acc[pb][4 * g4 + 1] = v1; acc[pb][4 * g4 + 2] = v2; acc[pb][4 * g4 + 3] = v3; }
            ss += __shfl_xor(ss, 32);
            LAS float* ssb = SS + (ib & 1) * 256;
            if (hi == 0) ssb[wave * 32 + r32] = ss;
            __syncthreads();
            float tot = 0.f;
#pragma unroll
            for (int w = 0; w < 8; ++w) tot += ssb[w * 32 + r32];
            const float rstd = 1.0f / sqrtf(tot * (1.f / 512.f) + EPS);
#pragma unroll
            for (int pb = 0; pb < 2; ++pb)
#pragma unroll
                for (int g4 = 0; g4 < 4; ++g4) { const int p0 = 32 * pb + 8 * g4 + 4 * hi; const f32x4 gn = *(const f32x4*)(snorm + p0);
                    u32x2 o; o.x = pk2(acc[pb][4 * g4] * rstd * gn[0], acc[pb][4 * g4 + 1] * rstd * gn[1]); o.y = pk2(acc[pb][4 * g4 + 2] * rstd * gn[2], acc[pb][4 * g4 + 3] * rstd * gn[3]);
                    *(u32x2*)(MIX + row * 1024 + h * 64 + p0) = o; }
        }
        __syncthreads();
    }
}

constexpr int AT_KS = 104, AT_VS = 68, AT_KB = 64 * AT_KS * 2, AT_BUF = AT_KB + 64 * AT_VS * 2;
__device__ __forceinline__ void phase10_attn(const Args& a, LAS unsigned char* lds, int G, int vcu, int tid, int lane, int wave) {
    unsigned char* ws = a.ws; unsigned char* ob = (unsigned char*)a.out;
    const bf16* Q = (const bf16*)(ob + OUT_Q); const bf16* KN = (const bf16*)(ob + OUT_KN); const bf16* VT = (const bf16*)(ob + OUT_VT); const bf16* KPE = (const bf16*)(ws + WS_KPE);
    bf16* MIX = (bf16*)(ws + WS_MIX); const f32x2* ROPE = (const f32x2*)(ws + WS_ROPE);
    const int r32 = lane & 31, hi = lane >> 5;
    for (int unit = vcu; unit < NB * 8 * 16; unit += G) {
        const int bh = unit >> 4, qb = unit & 15, b = bh >> 3, h = bh & 7;
        const size_t qrow = (size_t)b * SEQ + qb * 256 + wave * 32 + r32;
        bf16x8 qr[6];
        { const bf16* qp = Q + qrow * 768 + h * 96 + 8 * hi;
#pragma unroll
          for (int s = 0; s < 6; ++s) qr[s] = *(const bf16x8*)(qp + 16 * s);
          const int tq = qb * 256 + wave * 32 + r32;
#pragma unroll
          for (int s = 4; s < 6; ++s) { const int pos = (s == 4) ? (tq >> 6) : (tq & 63); const f32x2* rp = ROPE + pos * 8 + 4 * hi;
              const u32x4 w = __builtin_bit_cast(u32x4, qr[s]); const f32x2 c0 = rp[0], c1 = rp[1], c2 = rp[2], c3 = rp[3]; u32x4 o;
              o.x = pk2(bflo(w.x) * c0.x - bfhi(w.x) * c0.y, bflo(w.x) * c0.y + bfhi(w.x) * c0.x); o.y = pk2(bflo(w.y) * c1.x - bfhi(w.y) * c1.y, bflo(w.y) * c1.y + bfhi(w.y) * c1.x);
              o.z = pk2(bflo(w.z) * c2.x - bfhi(w.z) * c2.y, bflo(w.z) * c2.y + bfhi(w.z) * c2.x); o.w = pk2(bflo(w.w) * c3.x - bfhi(w.w) * c3.y, bflo(w.w) * c3.y + bfhi(w.w) * c3.x);
              qr[s] = __builtin_bit_cast(bf16x8, o); } }
        const int kr = tid >> 3, kpart = tid & 7;
        const int pr = tid >> 2, ppart = tid & 3;
#define AT_ROW0(t) ((t) < 4 ? (size_t)NLAT + b * CTXL + (t) * 64 : (size_t)b * SEQ + ((t) - 4) * 64)
#define AT_LOAD(t) do { const size_t r0_ = AT_ROW0(t); \
        gk = *(const u32x4*)(KN + (r0_ + kr) * 512 + h * 64 + kpart * 8); \
        gv = *(const u32x4*)(VT + (size_t)(h * 64 + kr) * MTOT + r0_ + kpart * 8); \
        if (tid < 256) gp = *(const u32x4*)(KPE + (r0_ + pr) * 32 + ppart * 8); } while (0)
#define AT_STORE(bufi) do { LAS unsigned char* B_ = lds + (bufi) * AT_BUF; \
        *(LAS u32x4*)(B_ + (kr * AT_KS + kpart * 8) * 2) = gk; \
        *(LAS u32x2*)(B_ + AT_KB + (kr * AT_VS + kpart * 8) * 2) = (u32x2){gv.x, gv.y}; *(LAS u32x2*)(B_ + AT_KB + (kr * AT_VS + kpart * 8 + 4) * 2) = (u32x2){gv.z, gv.w}; \
        if (tid < 256) *(LAS u32x4*)(B_ + (pr * AT_KS + 64 + ppart * 8) * 2) = gp; } while (0)
        u32x4 gk, gv, gp = (u32x4){0u, 0u, 0u, 0u};
        AT_LOAD(0); AT_STORE(0);
        __syncthreads();
        float mrun = -INFINITY, lrun = 0.f;
        f32x16 o[2]; o[0] = zero16(); o[1] = zero16();
#pragma unroll 1
        for (int t = 0; t < 68; ++t) {
            if (t + 1 < 68) AT_LOAD(t + 1);
            const LAS unsigned char* Bc = lds + (t & 1) * AT_BUF;
            f32x16 p0 = zero16(), p1 = zero16();
#pragma unroll
            for (int s = 0; s < 6; ++s) {
                const bf16x8 k0 = *(const LAS bf16x8*)(Bc + (r32 * AT_KS + 16 * s + 8 * hi) * 2), k1 = *(const LAS bf16x8*)(Bc + ((32 + r32) * AT_KS + 16 * s + 8 * hi) * 2);
                p0 = MFMA32(k0, qr[s], p0); p1 = MFMA32(k1, qr[s], p1);
            }
            float mx = fmaxf(p0[0], p1[0]);
#pragma unroll
            for (int r = 1; r < 16; ++r) mx = fmaxf(mx, fmaxf(p0[r], p1[r]));
            mx = fmaxf(mx, __shfl_xor(mx, 32));
            const float mnew = fmaxf(mrun, mx), alpha = __builtin_amdgcn_exp2f(mrun - mnew);
            mrun = mnew;
            float rs = 0.f;
#pragma unroll
            for (int r = 0; r < 16; ++r) { p0[r] = __builtin_amdgcn_exp2f(p0[r] - mnew); p1[r] = __builtin_amdgcn_exp2f(p1[r] - mnew); rs += p0[r] + p1[r]; }
            lrun = lrun * alpha + rs;
#pragma unroll
            for (int r = 0; r < 16; ++r) { o[0][r] *= alpha; o[1][r] *= alpha; }
            bf16x8 pf[4];
            pf[0] = pack8(p0[0], p0[1], p0[2], p0[3], p0[4], p0[5], p0[6], p0[7]); pf[1] = pack8(p0[8], p0[9], p0[10], p0[11], p0[12], p0[13], p0[14], p0[15]);
            pf[2] = pack8(p1[0], p1[1], p1[2], p1[3], p1[4], p1[5], p1[6], p1[7]); pf[3] = pack8(p1[8], p1[9], p1[10], p1[11], p1[12], p1[13], p1[14], p1[15]);
#pragma unroll
            for (int db = 0; db < 2; ++db)
#pragma unroll
                for (int s = 0; s < 4; ++s) {
                    const LAS unsigned char* vp = Bc + AT_KB + ((32 * db + r32) * AT_VS + 16 * s + 4 * hi) * 2;
                    const u32x2 v0 = *(const LAS u32x2*)vp, v1 = *(const LAS u32x2*)(vp + 16);
                    o[db] = MFMA32(__builtin_bit_cast(bf16x8, (u32x4){v0.x, v0.y, v1.x, v1.y}), pf[s], o[db]);
                }
            if (t + 1 < 68) AT_STORE((t + 1) & 1);
            __syncthreads();
        }
#undef AT_ROW0
#undef AT_LOAD
#undef AT_STORE
        const float ltot = lrun + __shfl_xor(lrun, 32), rl = 1.0f / ltot;
        bf16* op = MIX + qrow * 1024 + 512 + h * 64 + 4 * hi;
#pragma unroll
        for (int db = 0; db < 2; ++db)
#pragma unroll
            for (int g4 = 0; g4 < 4; ++g4) { u32x2 w; w.x = pk2(o[db][4 * g4] * rl, o[db][4 * g4 + 1] * rl); w.y = pk2(o[db][4 * g4 + 2] * rl, o[db][4 * g4 + 3] * rl);
                *(u32x2*)(op + 32 * db + 8 * g4) = w; }
    }
}

#define XB_TMO      128
#define XB_XCNT(j)  (256  + 64 * (j))
#define XB_XSUB(j)  (1280 + 64 * (j))
#define XB_XGEN(j)  (2304 + 64 * (j))
#define XB_TOP      3328
#define XB_TOPGEN   3392
#define XCD_BAR_WORDS 3456
#define XB_SPIN_CAP (1u << 18)

__device__ __forceinline__ unsigned xb_ld(unsigned* p)              { return __hip_atomic_load(p, __ATOMIC_RELAXED, __HIP_MEMORY_SCOPE_AGENT); }
__device__ __forceinline__ unsigned xb_add(unsigned* p, unsigned v) { return __hip_atomic_fetch_add(p, v, __ATOMIC_RELAXED, __HIP_MEMORY_SCOPE_AGENT); }
__device__ __forceinline__ unsigned xb_xcc_id() { return (unsigned)__builtin_amdgcn_s_getreg((3 << 11) | 20) & 0xFu; }
#define XB_SPIN(cond, bar) do { unsigned _sp = 0; while (cond) { __builtin_amdgcn_s_sleep(1); \
    if ((++_sp & 255u) == 0u) { if (xb_ld(&(bar)[XB_TMO])) break; if (_sp > XB_SPIN_CAP) { atomicAdd(&(bar)[XB_TMO], 1u); break; } } } } while (0)

struct XcdBarrier {
    unsigned* bar; unsigned x;
    volatile LAS unsigned* st;
};

__device__ __forceinline__ XcdBarrier xcd_barrier_post(unsigned* bar, volatile LAS unsigned* st) {
    XcdBarrier b; b.bar = bar; b.x = xb_xcc_id(); b.st = st;
    if (threadIdx.x == 0) (void)xb_add(&bar[XB_XCNT(b.x)], 1u);
    return b;
}
__device__ __forceinline__ void xcd_barrier_complete(unsigned* bar, unsigned x, unsigned& nloc, unsigned& nx) {
    const unsigned G = gridDim.x * gridDim.y * gridDim.z;
    unsigned sum, cnt, mine, sp = 0u;
    for (;;) {
        sum = 0u; cnt = 0u; mine = 0u;
#pragma unroll
        for (unsigned j = 0; j < 16; ++j) { const unsigned c = xb_ld(&bar[XB_XCNT(j)]); sum += c; cnt += (c > 0u) ? 1u : 0u; mine = (j == x) ? c : mine; }
        if (sum == G) break;
        __builtin_amdgcn_s_sleep(1);
        if ((++sp & 255u) == 0u) { if (xb_ld(&bar[XB_TMO])) break; if (sp > XB_SPIN_CAP) { atomicAdd(&bar[XB_TMO], 1u); break; } }
    }
    nloc = mine > 0u ? mine : 1u; nx = cnt > 0u ? cnt : 1u;
}

__device__ __forceinline__ void xcd_barrier(const XcdBarrier& b) {
    asm volatile("s_waitcnt vmcnt(0)" ::: "memory");
    __syncthreads();
    if (threadIdx.x == 0) {
        unsigned* bar = b.bar;
        __builtin_amdgcn_s_waitcnt(0);
        unsigned nloc = b.st[0], nx = b.st[1];
        if (nloc == 0u) { xcd_barrier_complete(bar, b.x, nloc, nx); b.st[0] = nloc; b.st[1] = nx; }
        const unsigned old = xb_add(&bar[XB_XSUB(b.x)], 1u);
        const unsigned gen = old / nloc;
        if (old + 1u == (gen + 1u) * nloc) {
            __builtin_amdgcn_fence(__ATOMIC_RELEASE, "agent");
            asm volatile("s_waitcnt vmcnt(0)" ::: "memory");
            const unsigned og = xb_add(&bar[XB_TOP], 1u);
            const unsigned tg = og / nx;
            if (og + 1u == (tg + 1u) * nx) xb_add(&bar[XB_TOPGEN], 1u);
            else XB_SPIN(xb_ld(&bar[XB_TOPGEN]) == tg, bar);
            __builtin_amdgcn_fence(__ATOMIC_ACQUIRE, "agent");
            xb_add(&bar[XB_XGEN(b.x)], 1u);
            asm volatile("s_waitcnt vmcnt(0)" ::: "memory");
        } else {
            XB_SPIN(xb_ld(&bar[XB_XGEN(b.x)]) == gen, bar);
            __builtin_amdgcn_fence(__ATOMIC_ACQUIRE, "agent");
            asm volatile("s_waitcnt vmcnt(0)" ::: "memory");
        }
    }
    __syncthreads();
}

__global__ void __launch_bounds__(512, 2) hymba_fwd(Args args) {
    extern __shared__ __attribute__((aligned(16))) unsigned char lds_raw[];
    LAS unsigned char* lds = (LAS unsigned char*)lds_raw;
    cg::grid_group grid = cg::this_grid();
    const int tid = threadIdx.x, lane = tid & 63, wave = __builtin_amdgcn_readfirstlane(tid >> 6);
    const int G = gridDim.x, bx = blockIdx.x, vcu = (G % 8 == 0) ? (bx % 8) * (G / 8) + bx / 8 : bx;
    const int gw = bx * 8 + wave, NGW = G * 8;
    unsigned char* ws = args.ws;
    const int lo = args.ph_lo, hi = args.ph_hi;
    const float* MOD = (const float*)(ws + WS_MOD);
    volatile LAS unsigned* bst = (volatile LAS unsigned*)(lds + 131072 + 320);
    if (tid < 2) bst[tid] = 0u;
    __syncthreads();
    const XcdBarrier xbar = xcd_barrier_post((unsigned*)(ws + WS_BAR), bst);
    bf16* XN = (bf16*)(ws + WS_A); bf16* HB = (bf16*)(ws + WS_B); float* X1 = (float*)(ws + WS_C);
#ifndef PHMASK
#define PHMASK 0xFFFF
#endif
#define IN(k) (((PHMASK >> (k)) & 1) && lo <= (k) && (k) < hi)
#define GSYNC(k) do { if ((k) == 0) grid.sync(); else xcd_barrier(xbar); } while (0)
#define SEAM(k) do { if (IN(k) && IN((k) + 1)) GSYNC(k); } while (0)
#define PH_BEGIN(k) if (IN(k)) for (int rep_ = 0; rep_ < ((k) == PROBE_PHASE ? 2 : 1); ++rep_) { if (rep_) xcd_barrier(xbar);
#define PH_END(k) } SEAM(k)
    if (PROBE_PHASE == 200) { for (int r3 = 0; r3 < 16; ++r3) xcd_barrier(xbar); }
    PH_BEGIN(0) { phase0(args, lds, gw, NGW, tid, lane, wave); } PH_END(0);
    PH_BEGIN(1) { norm_rows(args.in[0], args.in[2], MTOT, args.in[6], MOD, 0, XN, gw, NGW, lane); } PH_END(1);
    PH_BEGIN(2) { pg8::Gemm g{XN, (const bf16*)(ws + WS_W1A), MTOT, 2 * DFF, D}; pg8::StaticOrder S; S.init(MTOT, 2 * DFF, G, bx);
        pg8::EpiSwiglu E{HB, DFF}; pg8::gemm_phase<pg8::EpiSwiglu, pg8::StaticOrder, true, true>(lds, g, S, E); } PH_END(2);
    PH_BEGIN(3) { pg8::Gemm g{HB, (const bf16*)(ws + WS_W1B), MTOT, D, DFF}; pg8::StaticOrder S; S.init(MTOT, D, G, bx);
        pg8::EpiRes E{args.in[0], args.in[2], X1, MOD, 2, 0.5f}; pg8::gemm_phase<pg8::EpiRes, pg8::StaticOrder, true, true>(lds, g, S, E); } PH_END(3);
    PH_BEGIN(4) { norm_rows(X1, X1 + (size_t)NLAT * D, MTOT, args.in[9], MOD, 3, XN, gw, NGW, lane); } PH_END(4);
    PH_BEGIN(5) { pg8::Gemm g{XN, (const bf16*)(ws + WS_WIN), MTOT, 2816, D}; pg8::StaticOrder S; S.init(MTOT, 2816, G, bx);
        pg8::EpiSplit E{(bf16*)(ws + WS_Z), (bf16*)(ws + WS_XBCR), (bf16*)(ws + WS_CQ), (bf16*)(ws + WS_CKV), (bf16*)(ws + WS_MISC)};
        pg8::gemm_phase<pg8::EpiSplit, pg8::StaticOrder, true, true>(lds, g, S, E); } PH_END(5);
    PH_BEGIN(6) { phase6(args, lds, G, bx, tid, lane, wave); } PH_END(6);
    PH_BEGIN(7) {
        unsigned char* ob = (unsigned char*)args.out;
        { pg8::Gemm g{(const bf16*)(ws + WS_CQ), (const bf16*)(ws + WS_WUQ), NLAT, 768, 768}; pg8::StaticOrder S; S.init(NLAT, 768, G, bx);
          pg8::EpiScale E{(bf16*)(ob + OUT_Q), 768, (const float*)(ws + WS_RSTDQ), nullptr}; pg8::gemm_phase<pg8::EpiScale, pg8::StaticOrder, true, true>(lds, g, S, E); }
        { pg8::Gemm g{(const bf16*)(ws + WS_CKV), (const bf16*)(ws + WS_WK), MTOT, 512, 256}; pg8::StaticOrder S; S.init(MTOT, 512, G, bx);
          pg8::EpiScale E{(bf16*)(ob + OUT_KN), 512, (const float*)(ws + WS_RSTDKV), nullptr}; pg8::gemm_phase<pg8::EpiScale, pg8::StaticOrder, true, true>(lds, g, S, E); }
        { pg8::Gemm g{(const bf16*)(ws + WS_WV), (const bf16*)(ws + WS_CKV), 512, MTOT, 256}; pg8::StaticOrder S; S.init(512, MTOT, G, bx);
          pg8::EpiScale E{(bf16*)(ob + OUT_VT), MTOT, nullptr, (const float*)(ws + WS_RSTDKV)}; pg8::gemm_phase<pg8::EpiScale, pg8::StaticOrder, true, true>(lds, g, S, E); }
        phase8(args, lds, G, bx, lane, wave);
    } PH_END(7);
    PH_BEGIN(9) { phase9(args, G, bx, tid); } PH_END(9);
    PH_BEGIN(10) { for (int r2 = 0; r2 < (PROBE_PHASE == 100 ? 2 : 1); ++r2) phase10_ssd(args, lds, G, bx, lane, wave); for (int r2 = 0; r2 < (PROBE_PHASE == 101 ? 2 : 1); ++r2) phase10_attn(args, lds, G, vcu, tid, lane, wave); } PH_END(10);
    PH_BEGIN(11) { pg8::Gemm g{(const bf16*)(ws + WS_MIX), (const bf16*)(ws + WS_WOUT), NLAT, D, D}; pg8::StaticOrder S; S.init(NLAT, D, G, bx);
        pg8::EpiRes E{X1, X1, X1, MOD, 5, 1.0f}; pg8::gemm_phase<pg8::EpiRes, pg8::StaticOrder, true, true>(lds, g, S, E); } PH_END(11);
    PH_BEGIN(12) { norm_rows(X1, X1, NLAT, args.in[22], MOD, 6, XN, gw, NGW, lane); } PH_END(12);
    PH_BEGIN(13) { pg8::Gemm g{XN, (const bf16*)(ws + WS_W2A), NLAT, 2 * DFF, D}; pg8::StaticOrder S; S.init(NLAT, 2 * DFF, G, bx);
        pg8::EpiSwiglu E{HB, DFF}; pg8::gemm_phase<pg8::EpiSwiglu, pg8::StaticOrder, true, true>(lds, g, S, E); } PH_END(13);
    PH_BEGIN(14) { pg8::Gemm g{HB, (const bf16*)(ws + WS_W2B), NLAT, D, DFF}; pg8::StaticOrder S; S.init(NLAT, D, G, bx);
        pg8::EpiRes E{X1, X1, args.out, MOD, 8, 0.5f}; pg8::gemm_phase<pg8::EpiRes, pg8::StaticOrder, true, true>(lds, g, S, E); } PH_END(14);
    PH_BEGIN(15) { final_norm_rows(args.out, args.in[25], gw, NGW, lane); } PH_END(15);
#undef IN
#undef SEAM
}

#ifndef N_LAUNCHES
#define N_LAUNCHES 1
#endif
extern "C" void kernel_launch(void* const* d_in, const int* in_sizes, int n_in, void* d_out, int out_size, void* d_ws, size_t ws_size, hipStream_t stream) {
    static int grid = 0;
    if (grid == 0) {
        if (n_in != 26 || out_size != NLAT * D || ws_size < WS_END) { fprintf(stderr, "kernel_launch: unexpected shapes (n_in %d out %d ws %zu)\n", n_in, out_size, ws_size); grid = -1; return; }
        int dev = 0, cus = 0, per_cu = 0;
        (void)hipGetDevice(&dev); (void)hipDeviceGetAttribute(&cus, hipDeviceAttributeMultiprocessorCount, dev);
        if (hipFuncSetAttribute((const void*)hymba_fwd, hipFuncAttributeMaxDynamicSharedMemorySize, LDS_BYTES) != hipSuccess) { fprintf(stderr, "kernel_launch: hipFuncSetAttribute failed\n"); grid = -1; return; }
        if (hipOccupancyMaxActiveBlocksPerMultiprocessor(&per_cu, (const void*)hymba_fwd, 512, LDS_BYTES) != hipSuccess || per_cu < 1) { fprintf(stderr, "kernel_launch: occupancy query failed (%d)\n", per_cu); grid = -1; (void)hipGetLastError(); return; }
        grid = cus;
    }
    if (grid < 0) return;
    (void)hipMemsetAsync((char*)d_ws + WS_BAR, 0, 16 * KiB, stream);
    Args a{};
    for (int i = 0; i < 26; ++i) a.in[i] = (const float*)d_in[i];
    a.out = (float*)d_out; a.ws = (unsigned char*)d_ws;
    for (int li = 0; li < N_LAUNCHES; ++li) {
        a.ph_lo = (N_LAUNCHES == 1) ? 0 : li; a.ph_hi = (N_LAUNCHES == 1) ? NPHASE : li + 1;
        void* kargs[] = {&a};
        hipError_t e = hipLaunchCooperativeKernel((const void*)hymba_fwd, dim3(grid), dim3(512), kargs, LDS_BYTES, stream);
        if (e != hipSuccess) { fprintf(stderr, "kernel_launch: cooperative launch %d failed: %s (grid %d)\n", li, hipGetErrorString(e), grid); break; }
    }
}
```

```cpp
#include <hip/hip_runtime.h>
#include <hip/hip_cooperative_groups.h>
#include <cstdio>
#include <cstdint>
namespace cg = cooperative_groups;
namespace pg8 {
#define PG8_LAS __attribute__((address_space(3)))
typedef unsigned short bf16_t;
typedef short bf16x8 __attribute__((ext_vector_type(8)));
typedef float f32x4 __attribute__((ext_vector_type(4)));
typedef unsigned u32x4 __attribute__((ext_vector_type(4)));
constexpr int BM = 256, BK = 64, HALF = 128, HTB = HALF * BK * 2  , STAGE_BYTES = 8 * HTB, NXCD = 8, WGM = 8;

__host__ __device__ __forceinline__ int lds_byte(int r, int c) { const int st = (r >> 4) * 2 + (c >> 5), rr = r & 15, cc = c & 31, ob = rr * 64 + cc * 2; return st * 1024 + (ob ^ (((ob >> 9) & 1) << 5)); }
__host__ __device__ __forceinline__ void stage_rc(int b, int& R, int& C) { const int st = b / 1024, sb = b % 1024, swz = sb ^ (((sb >> 9) & 1) << 5); R = (st >> 1) * 16 + swz / 64; C = (st & 1) * 32 + (swz % 64) / 2; }
__host__ __device__ __forceinline__ int perm32(int rho) { const int n = rho >> 4, i = rho & 15; return 8 * (i >> 2) + 4 * n + (i & 3); }

struct Unit { int pm, pn; };
struct Gemm { const bf16_t* A; const bf16_t* Bt; int M, N, K; };

struct StaticOrder {
    int nM, nN, nwg, G, c;
    __host__ __device__ void init(int M, int N, int G_, int c_) { nM = M / BM; nN = N / BM; nwg = nM * nN; G = G_; c = c_; }
    __host__ __device__ bool next(int i, Unit& u) const {
        const long L = (long)i * G + c; if (L >= nwg) return false;
        int wgid = (int)L; { const int q = nwg / NXCD, r = nwg % NXCD, xcd = wgid % NXCD, off = wgid / NXCD; wgid = (xcd < r ? xcd * (q + 1) : r * (q + 1) + (xcd - r) * q) + off; }
        const int nig = WGM * nN, gid = wgid / nig, fm = gid * WGM, gsz = (nM - fm) < WGM ? (nM - fm) : WGM;
        u.pm = fm + ((wgid % nig) % gsz); u.pn = (wgid % nig) / gsz; return true;
    }
    __device__ __forceinline__ void a_ready(const Unit&) const {}
    __device__ __forceinline__ void done(const Unit&) const {}
};

__device__ __forceinline__ unsigned cvt_pk_bf16(float lo, float hi) { unsigned r; asm volatile("v_cvt_pk_bf16_f32 %0, %1, %2" : "=v"(r) : "v"(lo), "v"(hi)); return r; }
typedef float f32x2 __attribute__((ext_vector_type(2)));
__device__ __forceinline__ f32x2 gelu_pk(f32x2 v) {
    const f32x2 av = __builtin_elementwise_abs(v), d = av * 0.2316418882f + 1.0f;
    f32x2 t; t.x = __builtin_amdgcn_rcpf(d.x); t.y = __builtin_amdgcn_rcpf(d.y);
    f32x2 q = t * 0.5307027145f + (-0.7265760135f); q = q * t + 0.7107068705f; q = q * t + (-0.142248368f); q = q * t + 0.127414796f; q = q * t;
    const f32x2 s = (v * v) * (-0.72134752044f);
    f32x2 e; e.x = __builtin_amdgcn_exp2f(s.x); e.y = __builtin_amdgcn_exp2f(s.y);
    const f32x2 m = v * (q * e), r = v - m;
    f32x2 o; o.x = v.x < 0.f ? m.x : r.x; o.y = v.y < 0.f ? m.y : r.y; return o;
}

template <int ACT  > struct EpiBf16 {
    static constexpr bool PERM = true, AFTER_DRAIN = false; static_assert(ACT == 0 || ACT == 1, "EpiBf16: ACT is 0 (none) or 1 (gelu_pk)");
    bf16_t* O; int ldc; const float* bias; int split_cols; size_t split_stride; float scale0;
    __device__ __forceinline__ void operator()(const f32x4 (&acc)[2][2][4][2], const Unit& u, int wr, int wc, int fr, int fq) const {
        const int row0 = u.pm * BM + wr * 64 + fr; int colt = u.pn * BM; bf16_t* base = O;
        float sc = 1.f; if (split_cols) { const int t = colt / split_cols; base += (size_t)t * split_stride; colt -= t * split_cols; if (t == 0) sc = scale0; }
        const int col0 = colt + wc * 32 + 8 * fq, bcol0 = u.pn * BM + wc * 32 + 8 * fq;
        f32x4 bv[2][2];
#pragma unroll
        for (int bj = 0; bj < 2; ++bj)
#pragma unroll
            for (int n = 0; n < 2; ++n) bv[bj][n] = bias ? *(const f32x4*)(bias + bcol0 + bj * HALF + 4 * n) : (f32x4){0.f, 0.f, 0.f, 0.f};
#pragma unroll
        for (int ai = 0; ai < 2; ++ai)
#pragma unroll
            for (int m = 0; m < 4; ++m) { bf16_t* rowp = base + (size_t)(row0 + ai * HALF + m * 16) * ldc + col0;
#pragma unroll
                for (int bj = 0; bj < 2; ++bj) { f32x4 v0 = acc[ai][bj][m][0] + bv[bj][0], v1 = acc[ai][bj][m][1] + bv[bj][1];
                    if (ACT == 1) { f32x2 a = gelu_pk((f32x2){v0[0], v0[1]}), b = gelu_pk((f32x2){v0[2], v0[3]}), c = gelu_pk((f32x2){v1[0], v1[1]}), d = gelu_pk((f32x2){v1[2], v1[3]});
                        v0 = (f32x4){a.x, a.y, b.x, b.y}; v1 = (f32x4){c.x, c.y, d.x, d.y}; }
                    v0 = v0 * sc; v1 = v1 * sc; u32x4 w; w.x = cvt_pk_bf16(v0[0], v0[1]); w.y = cvt_pk_bf16(v0[2], v0[3]); w.z = cvt_pk_bf16(v1[0], v1[1]); w.w = cvt_pk_bf16(v1[2], v1[3]);
                    *(u32x4*)(rowp + bj * HALF) = w; } }
    }
};
template <class Epi, class Sched, bool ALIGN_EPI = false, bool SP2 = false>
__device__ __forceinline__ void gemm_phase(PG8_LAS unsigned char* lds, const Gemm g, const Sched& S, const Epi& E) {
    const int tid = threadIdx.x, wid = __builtin_amdgcn_readfirstlane(tid >> 6), lane = tid & 63, wr = wid >> 2, wc = wid & 3, fr = lane & 15, fq = lane >> 4;
    const int K = g.K, nt = K / BK;
    unsigned voffA[2], voffB[2];
#pragma unroll
    for (int i = 0; i < 2; ++i) { int R, C; stage_rc(tid * 16 + i * 8192, R, C); const int Rb = Epi::PERM ? ((R & ~31) + perm32(R & 31)) : R;
        voffA[i] = (unsigned)(R * K + C) * 2u; voffB[i] = (unsigned)(Rb * K + C) * 2u; }
    const size_t kstep = (size_t)(BK * 2);
    const size_t hstep = (size_t)HALF * K * 2;
    const size_t tstep = 2 * hstep;
    const unsigned ldsw = (unsigned)wid * 1024u;
    const int aoff = lds_byte(wr * 64 + fr, fq * 8), boff = lds_byte(wc * 32 + fr, fq * 8);
#define PG8_SA(b, h) (((b) * 2 + (h)) * HTB)
#define PG8_SB(b, h) ((4 + (b) * 2 + (h)) * HTB)
#define PG8_STAGE(bufoff, gbase, voff) do { _Pragma("unroll") for (int _i = 0; _i < 2; ++_i) \
        __builtin_amdgcn_global_load_lds((const unsigned*)((const char*)(gbase) + (voff)[_i]), (PG8_LAS unsigned*)(lds + (bufoff) + ldsw + _i * 8192), 16, 0, 0); } while (0)
#define PG8_LDA(dst, b, h) do { _Pragma("unroll") for (int m = 0; m < 4; ++m) _Pragma("unroll") for (int k = 0; k < 2; ++k) dst[m][k] = *(const PG8_LAS bf16x8*)(lds + PG8_SA(b, h) + aoff + m * 2048 + k * 1024); } while (0)
#define PG8_LDB(dst, b, h) do { _Pragma("unroll") for (int n = 0; n < 2; ++n) _Pragma("unroll") for (int k = 0; k < 2; ++k) dst[n][k] = *(const PG8_LAS bf16x8*)(lds + PG8_SB(b, h) + boff + n * 2048 + k * 1024); } while (0)
#define PG8_MMA(ai, bj, At, Bt) do { __builtin_amdgcn_s_setprio(1); _Pragma("unroll") for (int m = 0; m < 4; ++m) _Pragma("unroll") for (int n = 0; n < 2; ++n) _Pragma("unroll") for (int k = 0; k < 2; ++k) \
        acc[ai][bj][m][n] = __builtin_amdgcn_mfma_f32_16x16x32_bf16(Bt[n][k], At[m][k], acc[ai][bj][m][n], 0, 0, 0); __builtin_amdgcn_s_setprio(0); } while (0)
#define PG8_WAIT_V(n) asm volatile("s_waitcnt vmcnt(" #n ")" ::: "memory")
#define PG8_WAIT_L(n) asm volatile("s_waitcnt lgkmcnt(" #n ")" ::: "memory")
#define PG8_BAR __builtin_amdgcn_s_barrier()
#define PG8_SCHED __builtin_amdgcn_sched_barrier(0)
    Unit cur, nxt; int ui = 0;
    if (!S.next(0, cur)) return;
    f32x4 acc[2][2][4][2];
#pragma unroll
    for (int a = 0; a < 2; ++a)
#pragma unroll
        for (int b = 0; b < 2; ++b)
#pragma unroll
            for (int m = 0; m < 4; ++m)
#pragma unroll
                for (int n = 0; n < 2; ++n) acc[a][b][m][n] = (f32x4){0.f, 0.f, 0.f, 0.f};
    bf16x8 At[4][2], B0[2][2], B1[2][2];
    const char* cA = (const char*)g.A + (size_t)cur.pm * tstep; const char* cB = (const char*)g.Bt + (size_t)cur.pn * tstep;
    S.a_ready(cur);
    if constexpr (SP2) {
        PG8_STAGE(PG8_SB(0, 0), cB, voffB); PG8_STAGE(PG8_SB(0, 1), cB + hstep, voffB); PG8_STAGE(PG8_SA(0, 0), cA, voffA); PG8_STAGE(PG8_SA(0, 1), cA + hstep, voffA);
        if (wr == 1) PG8_BAR;
        PG8_WAIT_V(2); PG8_BAR;
        PG8_STAGE(PG8_SB(1, 0), cB + kstep, voffB); PG8_STAGE(PG8_SA(1, 0), cA + kstep, voffA); PG8_STAGE(PG8_SB(1, 1), cB + hstep + kstep, voffB);
        PG8_WAIT_V(6); PG8_BAR;
    } else {
        PG8_STAGE(PG8_SB(0, 0), cB, voffB); PG8_STAGE(PG8_SA(0, 0), cA, voffA); PG8_STAGE(PG8_SB(0, 1), cB + hstep, voffB); PG8_STAGE(PG8_SA(0, 1), cA + hstep, voffA);
        if (wr == 1) PG8_BAR;
        PG8_WAIT_V(4); PG8_BAR;
        PG8_STAGE(PG8_SB(1, 0), cB + kstep, voffB); PG8_STAGE(PG8_SA(1, 0), cA + kstep, voffA); PG8_STAGE(PG8_SB(1, 1), cB + hstep + kstep, voffB);
        PG8_WAIT_V(6); PG8_BAR;
    }
    for (;;) {
        const bool has_next = S.next(ui + 1, nxt);
        const char* nA = has_next ? (const char*)g.A + (size_t)nxt.pm * tstep : cA; const char* nB = has_next ? (const char*)g.Bt + (size_t)nxt.pn * tstep : cB;
        for (int t = 0; t < nt; t += 2) {
            const bool last = (t == nt - 2);
            const char* a1 = cA + (size_t)(t + 1) * kstep;
            const char* a2 = last ? nA : cA + (size_t)(t + 2) * kstep; const char* b2 = last ? nB : cB + (size_t)(t + 2) * kstep;
            const char* a3 = a2 + kstep; const char* b3 = b2 + kstep;
            if (last && has_next) S.a_ready(nxt);
            if constexpr (SP2) {
            PG8_LDB(B0, 0, 0); PG8_LDB(B1, 0, 1); PG8_SCHED; PG8_LDA(At, 0, 0); PG8_STAGE(PG8_SA(1, 1), a1 + hstep, voffA);
            PG8_WAIT_V(8); PG8_WAIT_L(0); PG8_BAR; PG8_MMA(0, 0, At, B0); PG8_MMA(0, 1, At, B1); PG8_BAR; PG8_SCHED;
            PG8_LDA(At, 0, 1); PG8_STAGE(PG8_SB(0, 0), b2, voffB); PG8_STAGE(PG8_SB(0, 1), b2 + hstep, voffB); PG8_STAGE(PG8_SA(0, 0), a2, voffA);
            PG8_WAIT_V(8); PG8_WAIT_L(0); PG8_BAR; PG8_MMA(1, 0, At, B0); PG8_MMA(1, 1, At, B1); PG8_BAR; PG8_SCHED;
            PG8_LDB(B0, 1, 0); PG8_LDB(B1, 1, 1); PG8_SCHED; PG8_LDA(At, 1, 0); PG8_STAGE(PG8_SA(0, 1), a2 + hstep, voffA);
            PG8_WAIT_V(8); PG8_WAIT_L(0); PG8_BAR; PG8_MMA(0, 0, At, B0); PG8_MMA(0, 1, At, B1); PG8_BAR; PG8_SCHED;
            PG8_LDA(At, 1, 1); PG8_STAGE(PG8_SB(1, 0), b3, voffB); PG8_STAGE(PG8_SB(1, 1), b3 + hstep, voffB); PG8_STAGE(PG8_SA(1, 0), a3, voffA);
            PG8_WAIT_V(8); PG8_WAIT_L(0); PG8_BAR; PG8_MMA(1, 0, At, B0); PG8_MMA(1, 1, At, B1); PG8_BAR; PG8_SCHED;
            } else {
            PG8_LDB(B0, 0, 0); PG8_SCHED; PG8_LDA(At, 0, 0); PG8_STAGE(PG8_SA(1, 1), a1 + hstep, voffA);
            PG8_WAIT_L(8); PG8_BAR; PG8_WAIT_L(0); PG8_MMA(0, 0, At, B0); PG8_BAR; PG8_SCHED;
            PG8_LDB(B1, 0, 1); PG8_STAGE(PG8_SB(0, 0), b2, voffB);
            PG8_BAR; PG8_WAIT_L(0); PG8_MMA(0, 1, At, B1); PG8_BAR;
            PG8_LDA(At, 0, 1); PG8_STAGE(PG8_SA(0, 0), a2, voffA);
            PG8_BAR; PG8_WAIT_L(0); PG8_MMA(1, 0, At, B0); PG8_BAR; PG8_SCHED;
            PG8_STAGE(PG8_SB(0, 1), b2 + hstep, voffB);
            PG8_WAIT_V(6); PG8_BAR; PG8_MMA(1, 1, At, B1); PG8_BAR;
            PG8_LDB(B0, 1, 0); PG8_SCHED; PG8_LDA(At, 1, 0); PG8_STAGE(PG8_SA(0, 1), a2 + hstep, voffA);
            PG8_WAIT_L(8); PG8_BAR; PG8_WAIT_L(0); PG8_MMA(0, 0, At, B0); PG8_BAR; PG8_SCHED;
            PG8_LDB(B1, 1, 1); PG8_STAGE(PG8_SB(1, 0), b3, voffB);
            PG8_BAR; PG8_WAIT_L(0); PG8_MMA(0, 1, At, B1); PG8_BAR;
            PG8_LDA(At, 1, 1); PG8_STAGE(PG8_SA(1, 0), a3, voffA);
            PG8_BAR; PG8_WAIT_L(0); PG8_MMA(1, 0, At, B0); PG8_BAR; PG8_SCHED;
            PG8_STAGE(PG8_SB(1, 1), b3 + hstep, voffB);
            PG8_WAIT_V(6); PG8_BAR; PG8_MMA(1, 1, At, B1); PG8_BAR;
            }
        }
        if constexpr (ALIGN_EPI) { if (wr == 0) PG8_BAR; }
        if constexpr (!Epi::AFTER_DRAIN) { E(acc, cur, wr, wc, fr, fq); S.done(cur); }
        if (!has_next) break;
#pragma unroll
        for (int a = 0; a < 2; ++a)
#pragma unroll
            for (int b = 0; b < 2; ++b)
#pragma unroll
                for (int m = 0; m < 4; ++m)
#pragma unroll
                    for (int n = 0; n < 2; ++n) acc[a][b][m][n] = (f32x4){0.f, 0.f, 0.f, 0.f};
        cur = nxt; cA = nA; cB = nB; ++ui;
        if constexpr (ALIGN_EPI) { if (wr == 1) PG8_BAR; }
    }
    PG8_WAIT_V(0);
    if constexpr (!ALIGN_EPI) { if (wr == 0) PG8_BAR; }
    PG8_BAR;
    if constexpr (Epi::AFTER_DRAIN) { E.fused(acc, cur, wr, wc, fr, fq, lds, wid, lane); S.done(cur); }
#undef PG8_SA
#undef PG8_SB
#undef PG8_STAGE
#undef PG8_LDA
#undef PG8_LDB
#undef PG8_MMA
#undef PG8_WAIT_V
#undef PG8_WAIT_L
#undef PG8_BAR
#undef PG8_SCHED
}
}
#ifndef PROBE_PHASE
#define PROBE_PHASE -1
#endif

#define LAS __attribute__((address_space(3)))
typedef unsigned short bf16;
typedef short bf16x8 __attribute__((ext_vector_type(8)));
typedef float f32x2 __attribute__((ext_vector_type(2)));
typedef float f32x4 __attribute__((ext_vector_type(4)));
typedef float f32x16 __attribute__((ext_vector_type(16)));
typedef unsigned u32x2 __attribute__((ext_vector_type(2)));
typedef unsigned u32x4 __attribute__((ext_vector_type(4)));
typedef __bf16 bf16x2_t __attribute__((ext_vector_type(2)));

constexpr int D = 1024, NB = 8, SEQ = 4096, CTXL = 256, NLAT = NB * SEQ, NCTX = NB * CTXL, MTOT = NLAT + NCTX;
constexpr int DFF = 2816, UL = SEQ + CTXL, NCH = UL / 128;
constexpr float EPS = 1e-6f;
constexpr float QSCALE = 0.10206207261596575f * 1.4426950408889634f;
constexpr int NPHASE = 16;

constexpr size_t MiB = (size_t)1 << 20, KiB = 1024;
constexpr size_t WS_BAR = 1 * MiB, WS_ZERO_BYTES = 1 * MiB + 16 * KiB;
constexpr size_t WS_MOD = 0, WS_ROPE = 384 * KiB, WS_CD = 448 * KiB, WS_RSTDQ = 512 * KiB, WS_RSTDKV = 768 * KiB;
constexpr size_t WS_W1A = 2 * MiB, WS_W1B = 13 * MiB, WS_WIN = 18 * MiB + 512 * KiB, WS_WUQ = 24 * MiB, WS_WK = 25 * MiB + 512 * KiB, WS_WV = 25 * MiB + 768 * KiB,
                 WS_WOUT = 26 * MiB, WS_W2A = 28 * MiB, WS_W2B = 39 * MiB;
constexpr size_t WS_A = 45 * MiB;
constexpr size_t WS_B = 113 * MiB;
constexpr size_t WS_Z = WS_B, WS_XBCR = WS_B + 34 * MiB, WS_CQ = WS_B + 102 * MiB, WS_CKV = WS_B + 153 * MiB, WS_MISC = WS_B + 170 * MiB;
constexpr size_t WS_ST = WS_XBCR, WS_MIX = WS_XBCR, WS_HE = WS_CQ;
constexpr size_t WS_C = 300 * MiB;
constexpr size_t WS_XT = 436 * MiB, WS_BT = 470 * MiB, WS_CROW = 487 * MiB, WS_DT = 504 * MiB, WS_KPE = 506 * MiB + 256 * KiB, WS_END = 512 * MiB;
constexpr size_t WS_BROW = WS_A;
constexpr size_t OUT_Q = 0, OUT_KN = 48 * MiB, OUT_VT = 82 * MiB;
constexpr int LDS_BYTES = 147456;

__device__ __forceinline__ unsigned pk2(float lo, float hi) { f32x2 v = {lo, hi}; bf16x2_t b = __builtin_convertvector(v, bf16x2_t); return __builtin_bit_cast(unsigned, b); }
__device__ __forceinline__ float bflo(unsigned w) { return __uint_as_float(w << 16); }
__device__ __forceinline__ float bfhi(unsigned w) { return __uint_as_float(w & 0xffff0000u); }
__device__ __forceinline__ float bf2f(bf16 u) { return __uint_as_float((unsigned)u << 16); }
__device__ __forceinline__ float silu_f(float x) { return x * __builtin_amdgcn_rcpf(1.f + __builtin_amdgcn_exp2f(-1.4426950408889634f * x)); }
__device__ __forceinline__ float wave_sum(float v) {
#pragma unroll
    for (int o = 1; o < 64; o <<= 1) v += __shfl_xor(v, o);
    return v;
}
__device__ __forceinline__ float incl_scan(float v, int lane) {
#pragma unroll
    for (int o = 1; o < 64; o <<= 1) { float t = __shfl_up(v, o); if (lane >= o) v += t; }
    return v;
}
#define LDS_FENCE() asm volatile("s_waitcnt lgkmcnt(0)" ::: "memory")
__device__ __forceinline__ int crow(int r, int hi) { return (r & 3) + 8 * (r >> 2) + 4 * hi; }
__device__ __forceinline__ bf16x8 pack8(float a0, float a1, float a2, float a3, float a4, float a5, float a6, float a7) {
    u32x4 w; w.x = pk2(a0, a1); w.y = pk2(a2, a3); w.z = pk2(a4, a5); w.w = pk2(a6, a7); return __builtin_bit_cast(bf16x8, w);
}

struct Args { const float* in[26]; float* out; unsigned char* ws; int ph_lo, ph_hi; };

namespace pg8 {
struct EpiSwiglu {
    static constexpr bool PERM = true, AFTER_DRAIN = false;
    bf16_t* O; int ldc;
    __device__ __forceinline__ void operator()(const f32x4 (&acc)[2][2][4][2], const Unit& u, int wr, int wc, int fr, int fq) const {
        const int row0 = u.pm * BM + wr * 64 + fr, col0 = u.pn * HALF + wc * 32 + 8 * fq;
#pragma unroll
        for (int ai = 0; ai < 2; ++ai)
#pragma unroll
            for (int m = 0; m < 4; ++m) {
                bf16_t* rowp = O + (size_t)(row0 + ai * HALF + m * 16) * ldc + col0;
                const f32x4 g0 = acc[ai][0][m][0], g1 = acc[ai][0][m][1], u0 = acc[ai][1][m][0], u1 = acc[ai][1][m][1];
                u32x4 w;
                w.x = cvt_pk_bf16(silu_f(g0[0]) * u0[0], silu_f(g0[1]) * u0[1]); w.y = cvt_pk_bf16(silu_f(g0[2]) * u0[2], silu_f(g0[3]) * u0[3]);
                w.z = cvt_pk_bf16(silu_f(g1[0]) * u1[0], silu_f(g1[1]) * u1[1]); w.w = cvt_pk_bf16(silu_f(g1[2]) * u1[2], silu_f(g1[3]) * u1[3]);
                *(u32x4*)rowp = w;
            }
    }
};
struct EpiRes {
    static constexpr bool PERM = false, AFTER_DRAIN = false;
    const float* base_lat; const float* base_ctx; float* out; const float* mod; int kg; float mul;
    __device__ __forceinline__ void operator()(const f32x4 (&acc)[2][2][4][2], const Unit& u, int wr, int wc, int fr, int fq) const {
        const int row0 = u.pm * BM + wr * 64 + fr, col0 = u.pn * BM + wc * 32 + 4 * fq;
        const int bb = u.pm < (NLAT / BM) ? u.pm / (SEQ / BM) : 8;
        const float* gp = mod + bb * 9216 + kg * 1024 + col0;
        f32x4 gv[2][2];
#pragma unroll
        for (int bj = 0; bj < 2; ++bj)
#pragma unroll
            for (int n = 0; n < 2; ++n) gv[bj][n] = *(const f32x4*)(gp + bj * HALF + n * 16) * mul;
#pragma unroll
        for (int ai = 0; ai < 2; ++ai)
#pragma unroll
            for (int m = 0; m < 4; ++m) {
                const int r = row0 + ai * HALF + m * 16;
                const float* bp = (r < NLAT ? base_lat + (size_t)r * D : base_ctx + (size_t)(r - NLAT) * D) + col0;
                float* op = out + (size_t)r * D + col0;
#pragma unroll
                for (int bj = 0; bj < 2; ++bj)
#pragma unroll
                    for (int n = 0; n < 2; ++n) { const f32x4 bs = *(const f32x4*)(bp + bj * HALF + n * 16); *(f32x4*)(op + bj * HALF + n * 16) = bs + gv[bj][n] * acc[ai][bj][m][n]; }
            }
    }
};
struct EpiSplit {
    static constexpr bool PERM = true, AFTER_DRAIN = false;
    bf16_t *zb, *xbcr, *cq, *ckv, *misc;
    __device__ __forceinline__ void operator()(const f32x4 (&acc)[2][2][4][2], const Unit& u, int wr, int wc, int fr, int fq) const {
        const int pn = u.pn; bf16_t* base; int ld;
        if (pn < 2) { base = zb + pn * 256; ld = 512; } else if (pn < 6) { base = xbcr + (pn - 2) * 256; ld = 1024; } else if (pn < 9) { base = cq + (pn - 6) * 256; ld = 768; }
        else if (pn == 9) { base = ckv; ld = 256; } else { base = misc; ld = 256; }
        const int row0 = u.pm * BM + wr * 64 + fr, col0 = wc * 32 + 8 * fq;
#pragma unroll
        for (int ai = 0; ai < 2; ++ai)
#pragma unroll
            for (int m = 0; m < 4; ++m) {
                bf16_t* rowp = base + (size_t)(row0 + ai * HALF + m * 16) * ld + col0;
#pragma unroll
                for (int bj = 0; bj < 2; ++bj) { const f32x4 v0 = acc[ai][bj][m][0], v1 = acc[ai][bj][m][1];
                    u32x4 w; w.x = cvt_pk_bf16(v0[0], v0[1]); w.y = cvt_pk_bf16(v0[2], v0[3]); w.z = cvt_pk_bf16(v1[0], v1[1]); w.w = cvt_pk_bf16(v1[2], v1[3]);
                    *(u32x4*)(rowp + bj * HALF) = w; }
            }
    }
};
struct EpiScale {
    static constexpr bool PERM = true, AFTER_DRAIN = false;
    bf16_t* O; int ldc; const float* rs; const float* cs;
    __device__ __forceinline__ void operator()(const f32x4 (&acc)[2][2][4][2], const Unit& u, int wr, int wc, int fr, int fq) const {
        const int row0 = u.pm * BM + wr * 64 + fr, col0 = u.pn * BM + wc * 32 + 8 * fq;
        f32x4 cv[2][2];
#pragma unroll
        for (int bj = 0; bj < 2; ++bj)
#pragma unroll
            for (int n = 0; n < 2; ++n) cv[bj][n] = cs ? *(const f32x4*)(cs + col0 + bj * HALF + 4 * n) : (f32x4){1.f, 1.f, 1.f, 1.f};
#pragma unroll
        for (int ai = 0; ai < 2; ++ai)
#pragma unroll
            for (int m = 0; m < 4; ++m) {
                const int r = row0 + ai * HALF + m * 16; const float rv = rs ? rs[r] : 1.f;
                bf16_t* rowp = O + (size_t)r * ldc + col0;
#pragma unroll
                for (int bj = 0; bj < 2; ++bj) { const f32x4 v0 = acc[ai][bj][m][0] * cv[bj][0] * rv, v1 = acc[ai][bj][m][1] * cv[bj][1] * rv;
                    u32x4 w; w.x = cvt_pk_bf16(v0[0], v0[1]); w.y = cvt_pk_bf16(v0[2], v0[3]); w.z = cvt_pk_bf16(v1[0], v1[1]); w.w = cvt_pk_bf16(v1[2], v1[3]);
                    *(u32x4*)(rowp + bj * HALF) = w; }
            }
    }
};
struct EpiQ {
    static constexpr bool PERM = true, AFTER_DRAIN = false;
    bf16_t* O; const float* rs; const f32x2* rope;
    __device__ __forceinline__ void operator()(const f32x4 (&acc)[2][2][4][2], const Unit& u, int wr, int wc, int fr, int fq) const {
        const int row0 = u.pm * BM + wr * 64 + fr, col0 = u.pn * BM + wc * 32 + 8 * fq;
#pragma unroll
        for (int ai = 0; ai < 2; ++ai)
#pragma unroll
            for (int m = 0; m < 4; ++m) {
                const int r = row0 + ai * HALF + m * 16; const float rv = rs[r] * QSCALE; const int t = r & (SEQ - 1);
                bf16_t* rowp = O + (size_t)r * 768 + col0;
#pragma unroll
                for (int bj = 0; bj < 2; ++bj) {
                    f32x4 v0 = acc[ai][bj][m][0] * rv, v1 = acc[ai][bj][m][1] * rv;
                    const int cc = (col0 + bj * HALF) % 96;
                    if (cc >= 64) {
                        const int q = cc - 64, half = q >> 4, jj = (q & 15) >> 1, pos = half ? (t & 63) : (t >> 6);
                        const f32x2* rp = rope + pos * 8 + jj;
                        const f32x2 c0 = rp[0], c1 = rp[1], c2 = rp[2], c3 = rp[3];
                        f32x4 o0, o1;
                        o0[0] = v0[0] * c0.x - v0[1] * c0.y; o0[1] = v0[0] * c0.y + v0[1] * c0.x; o0[2] = v0[2] * c1.x - v0[3] * c1.y; o0[3] = v0[2] * c1.y + v0[3] * c1.x;
                        o1[0] = v1[0] * c2.x - v1[1] * c2.y; o1[1] = v1[0] * c2.y + v1[1] * c2.x; o1[2] = v1[2] * c3.x - v1[3] * c3.y; o1[3] = v1[2] * c3.y + v1[3] * c3.x;
                        v0 = o0; v1 = o1;
                    }
                    u32x4 w; w.x = cvt_pk_bf16(v0[0], v0[1]); w.y = cvt_pk_bf16(v0[2], v0[3]); w.z = cvt_pk_bf16(v1[0], v1[1]); w.w = cvt_pk_bf16(v1[2], v1[3]);
                    *(u32x4*)(rowp + bj * HALF) = w;
                }
            }
    }
};
}

__device__ __forceinline__ int cmap(int id, int n) {
    switch (id) {
    case 0: return ((n >> 7) & 1) * DFF + (n >> 8) * 128 + (n & 127);
    case 1: return n;
    case 2: {
        if (n < 1536) return n;
        if (n < 2304) return 1552 + (n - 1536);
        if (n < 2560) return 2320 + (n - 2304);
        if (n < 2592) { const int q = n - 2560, half = q >> 4, jj = (q & 15) >> 1, which = q & 1; return 2576 + half * 16 + which * 8 + jj; }
        if (n < 2608) return 1536 + (n - 2592);
        return -1; }
    case 3: { const int hh = n / 96, cc = n % 96; if (cc < 64) return hh * 96 + cc;
        const int q = cc - 64, half = q >> 4, jj = (q & 15) >> 1, which = q & 1; return hh * 96 + 64 + half * 16 + which * 8 + jj; }
    case 4: return (n >> 6) * 128 + (n & 63);
    default: return (n >> 6) * 128 + 64 + (n & 63);
    }
}
__device__ __forceinline__ void titem(const float* W, int K, int N, bf16* WT, const float* gk, LAS float* scr, int item, int nblk, int lane, int id, float mulc = 1.f) {
    const int kb = item / nblk, nb = item % nblk, k0 = 64 * kb, n0 = 32 * nb;
    const int src = cmap(id, n0 + (lane & 31));
#pragma unroll 8
    for (int i = 0; i < 32; ++i) { const int kk = 2 * i + (lane >> 5); float v = src >= 0 ? W[(size_t)(k0 + kk) * N + src] : 0.f; if (gk) v *= gk[k0 + kk] * mulc; scr[kk * 33 + (lane & 31)] = v; }
    LDS_FENCE();
    const int c = lane & 7;
#pragma unroll
    for (int j = 0; j < 4; ++j) { const int n = (lane >> 3) + 8 * j; const LAS float* s = scr + (8 * c) * 33 + n;
        u32x4 o; o.x = pk2(s[0 * 33], s[1 * 33]); o.y = pk2(s[2 * 33], s[3 * 33]); o.z = pk2(s[4 * 33], s[5 * 33]); o.w = pk2(s[6 * 33], s[7 * 33]);
        *(u32x4*)(WT + (size_t)(n0 + n) * K + k0 + 8 * c) = o; }
    LDS_FENCE();
}
__device__ __forceinline__ void phase0(const Args& a, LAS unsigned char* lds, int gw, int NGW, int tid, int lane, int wave) {
    unsigned char* ws = a.ws;
    LAS float* scr = (LAS float*)(lds + wave * 16384);
    if (blockIdx.x < 144) {
        float* MOD = (float*)(ws + WS_MOD);
        const float* cin = a.in[1]; const float* cctx = a.in[3]; const float* wada = a.in[4]; const float* bada = a.in[5];
        const int n = blockIdx.x * 64 + lane, kw = wave * 128;
        float acc[9];
#pragma unroll
        for (int bb = 0; bb < 9; ++bb) acc[bb] = 0.f;
#pragma unroll 1
        for (int hf = 0; hf < 2; ++hf) {
            const int k0 = kw + 64 * hf;
            float sv[9];
#pragma unroll
            for (int bb = 0; bb < 8; ++bb) sv[bb] = silu_f(cin[bb * 1024 + k0 + lane]);
            sv[8] = silu_f(cctx[k0 + lane]);
#pragma unroll 16
            for (int k = 0; k < 64; ++k) {
                const float w = wada[(size_t)(k0 + k) * 9216 + n];
#pragma unroll
                for (int bb = 0; bb < 9; ++bb) acc[bb] += w * __shfl(sv[bb], k);
            }
        }
        LAS float* red = (LAS float*)lds;
#pragma unroll
        for (int bb = 0; bb < 9; ++bb) red[(wave * 9 + bb) * 64 + lane] = acc[bb];
        __syncthreads();
        for (int o = tid; o < 576; o += 512) { float t = bada[blockIdx.x * 64 + (o & 63)];
#pragma unroll
            for (int w = 0; w < 8; ++w) t += red[w * 576 + o];
            MOD[(o >> 6) * 9216 + blockIdx.x * 64 + (o & 63)] = t; }
        __syncthreads();
    }
    constexpr int I_W1A = 16 * 176, I_W1B = 44 * 32, I_WIN = 16 * 88, I_WUQ = 12 * 24, I_WK = 4 * 16, I_WOUT = 16 * 32;
    constexpr int NITEMS = 2 * I_W1A + 2 * I_W1B + I_WIN + I_WUQ + 2 * I_WK + I_WOUT;
    for (int rep0 = 0; rep0 < (PROBE_PHASE == 201 ? 2 : 1); ++rep0)
    for (int it = gw; it < NITEMS; it += NGW) {
        int r = it;
        if (r < I_W1A) { titem(a.in[7], 1024, 5632, (bf16*)(ws + WS_W1A), nullptr, scr, r, 176, lane, 0); continue; } r -= I_W1A;
        if (r < I_W1A) { titem(a.in[23], 1024, 5632, (bf16*)(ws + WS_W2A), nullptr, scr, r, 176, lane, 0); continue; } r -= I_W1A;
        if (r < I_W1B) { titem(a.in[8], 2816, 1024, (bf16*)(ws + WS_W1B), nullptr, scr, r, 32, lane, 1); continue; } r -= I_W1B;
        if (r < I_W1B) { titem(a.in[24], 2816, 1024, (bf16*)(ws + WS_W2B), nullptr, scr, r, 32, lane, 1); continue; } r -= I_W1B;
        if (r < I_WIN) { titem(a.in[10], 1024, 2608, (bf16*)(ws + WS_WIN), nullptr, scr, r, 88, lane, 2); continue; } r -= I_WIN;
        if (r < I_WUQ) { titem(a.in[18], 768, 768, (bf16*)(ws + WS_WUQ), a.in[17], scr, r, 24, lane, 3, QSCALE); continue; } r -= I_WUQ;
        if (r < I_WK) { titem(a.in[20], 256, 1024, (bf16*)(ws + WS_WK), a.in[19], scr, r, 16, lane, 4); continue; } r -= I_WK;
        if (r < I_WK) { titem(a.in[20], 256, 1024, (bf16*)(ws + WS_WV), a.in[19], scr, r, 16, lane, 5); continue; } r -= I_WK;
        titem(a.in[21], 1024, 1024, (bf16*)(ws + WS_WOUT), nullptr, scr, r, 32, lane, 1);
    }
    if (blockIdx.x == 0) {
        const int pos = tid >> 3, jj = tid & 7; const float inv = __builtin_amdgcn_exp2f(-(float)jj * 1.6609640474436813f);
        const float ang = (float)pos * inv;
        ((f32x2*)(ws + WS_ROPE))[tid] = (f32x2){__cosf(ang), __sinf(ang)};
    }
}

__device__ __forceinline__ void norm_rows(const float* src_lat, const float* src_ctx, int nrows, const float* gvec, const float* mod, int kshift, bf16* out, int gw, int NGW, int lane) {
    for (int row = gw; row < nrows; row += NGW) {
        const float* xr = (row < NLAT ? src_lat + (size_t)row * D : src_ctx + (size_t)(row - NLAT) * D) + 4 * lane;
        const int bb = row < NLAT ? row / SEQ : 8;
        const float* sh = mod + bb * 9216 + kshift * 1024 + 4 * lane; const float* sc = sh + 1024;
        f32x4 v[4]; float s = 0.f;
#pragma unroll
        for (int j = 0; j < 4; ++j) { v[j] = *(const f32x4*)(xr + 256 * j); s += (v[j][0] * v[j][0] + v[j][1] * v[j][1]) + (v[j][2] * v[j][2] + v[j][3] * v[j][3]); }
        const float rstd = 1.0f / sqrtf(wave_sum(s) * (1.f / D) + EPS);
        bf16* orow = out + (size_t)row * D + 4 * lane;
#pragma unroll
        for (int j = 0; j < 4; ++j) {
            const f32x4 g = *(const f32x4*)(gvec + 4 * lane + 256 * j), scv = *(const f32x4*)(sc + 256 * j), shv = *(const f32x4*)(sh + 256 * j);
            const f32x4 y = (v[j] * rstd) * g * (scv + 1.f) + shv;
            u32x2 w; w.x = pk2(y[0], y[1]); w.y = pk2(y[2], y[3]); *(u32x2*)(orow + 256 * j) = w;
        }
    }
}
__device__ __forceinline__ void final_norm_rows(float* io, const float* gvec, int gw, int NGW, int lane) {
    for (int row = gw; row < NLAT; row += NGW) {
        float* xr = io + (size_t)row * D + 4 * lane;
        f32x4 v[4]; float s = 0.f;
#pragma unroll
        for (int j = 0; j < 4; ++j) { v[j] = *(const f32x4*)(xr + 256 * j); s += (v[j][0] * v[j][0] + v[j][1] * v[j][1]) + (v[j][2] * v[j][2] + v[j][3] * v[j][3]); }
        const float rstd = 1.0f / sqrtf(wave_sum(s) * (1.f / D) + EPS);
#pragma unroll
        for (int j = 0; j < 4; ++j) { const f32x4 g = *(const f32x4*)(gvec + 4 * lane + 256 * j); *(f32x4*)(xr + 256 * j) = (v[j] * rstd) * g; }
    }
}

__device__ __forceinline__ float softplus_f(float x) { return fmaxf(x, 0.f) + log1pf(__expf(-fabsf(x))); }
__device__ __forceinline__ void phase6(const Args& a, LAS unsigned char* lds, int G, int bx, int tid, int lane, int wave) {
    unsigned char* ws = a.ws;
    const bf16* XBCR = (const bf16*)(ws + WS_XBCR); const bf16* MISC = (const bf16*)(ws + WS_MISC); const bf16* CQ = (const bf16*)(ws + WS_CQ); const bf16* CKV = (const bf16*)(ws + WS_CKV);
    bf16* XT = (bf16*)(ws + WS_XT); bf16* BT = (bf16*)(ws + WS_BT); bf16* BROW = (bf16*)(ws + WS_BROW); bf16* CROW = (bf16*)(ws + WS_CROW); bf16* KPE = (bf16*)(ws + WS_KPE);
    float* DT = (float*)(ws + WS_DT); float* RSTDQ = (float*)(ws + WS_RSTDQ); float* RSTDKV = (float*)(ws + WS_RSTDKV); const f32x2* ROPE = (const f32x2*)(ws + WS_ROPE);
    const float* conv_w = a.in[11]; const float* conv_b = a.in[12]; const float* dt_bias = a.in[13];
    LAS bf16* T = (LAS bf16*)lds;
    const int ch = 4 * (tid & 255), tseg = (tid >> 8) * 32;
    float cw[5][4], cb[4];
#pragma unroll
    for (int k = 0; k < 5; ++k) { const f32x4 w = *(const f32x4*)(conv_w + k * 1024 + ch); cw[k][0] = w[0]; cw[k][1] = w[1]; cw[k][2] = w[2]; cw[k][3] = w[3]; }
    { const f32x4 w = *(const f32x4*)(conv_b + ch); cb[0] = w[0]; cb[1] = w[1]; cb[2] = w[2]; cb[3] = w[3]; }
    for (int unit = bx; unit < NB * 68; unit += G) {
        const int b = unit / 68, ut = unit % 68, u0 = ut * 64;
        const int seg_lo = u0 < CTXL ? 0 : CTXL, seg_hi = u0 < CTXL ? CTXL : UL;
        const int rb = u0 < CTXL ? NLAT + b * CTXL : b * SEQ - CTXL;
#define P6_LD(u) (((u) >= seg_lo && (u) < seg_hi) ? *(const u32x2*)(XBCR + (size_t)(rb + (u)) * 1024 + ch) : (u32x2){0u, 0u})
        const int ub = u0 + tseg;
        u32x2 xm2 = P6_LD(ub - 2), xm1 = P6_LD(ub - 1), x0 = P6_LD(ub), xp1 = P6_LD(ub + 1);
#pragma unroll 16
        for (int t = 0; t < 32; ++t) {
            const u32x2 xp2 = P6_LD(ub + t + 2);
            const float y0 = cb[0] + cw[0][0] * bflo(xm2.x) + cw[1][0] * bflo(xm1.x) + cw[2][0] * bflo(x0.x) + cw[3][0] * bflo(xp1.x) + cw[4][0] * bflo(xp2.x);
            const float y1 = cb[1] + cw[0][1] * bfhi(xm2.x) + cw[1][1] * bfhi(xm1.x) + cw[2][1] * bfhi(x0.x) + cw[3][1] * bfhi(xp1.x) + cw[4][1] * bfhi(xp2.x);
            const float y2 = cb[2] + cw[0][2] * bflo(xm2.y) + cw[1][2] * bflo(xm1.y) + cw[2][2] * bflo(x0.y) + cw[3][2] * bflo(xp1.y) + cw[4][2] * bflo(xp2.y);
            const float y3 = cb[3] + cw[0][3] * bfhi(xm2.y) + cw[1][3] * bfhi(xm1.y) + cw[2][3] * bfhi(x0.y) + cw[3][3] * bfhi(xp1.y) + cw[4][3] * bfhi(xp2.y);
            u32x2 pk; pk.x = pk2(silu_f(y0), silu_f(y1)); pk.y = pk2(silu_f(y2), silu_f(y3));
            const int tt = tseg + t;
            if (ch < 768) { T[ch * 72 + tt] = (bf16)(pk.x & 0xffffu); T[(ch + 1) * 72 + tt] = (bf16)(pk.x >> 16); T[(ch + 2) * 72 + tt] = (bf16)(pk.y & 0xffffu); T[(ch + 3) * 72 + tt] = (bf16)(pk.y >> 16); }
            if (ch >= 512) { bf16* dst = ch < 768 ? BROW + (ch - 512) : CROW + (ch - 768); *(u32x2*)(dst + (size_t)(b * UL + u0 + tt) * 256) = pk; }
            xm2 = xm1; xm1 = x0; x0 = xp1; xp1 = xp2;
        }
#undef P6_LD
        __syncthreads();
#pragma unroll
        for (int i = 0; i < 12; ++i) { const int q = tid + 512 * i, c = q >> 3, part = q & 7;
            const u32x4 v = *(const LAS u32x4*)(T + c * 72 + part * 8);
            bf16* dst = c < 512 ? XT + (size_t)(b * 512 + c) * UL : BT + (size_t)(b * 256 + c - 512) * UL;
            *(u32x4*)(dst + u0 + part * 8) = v; }
        {
            const int uu = tid >> 3, k = (tid & 7) * 2; const size_t row = (size_t)(rb + u0 + uu);
            const unsigned raw = *(const unsigned*)(MISC + row * 256 + 32 + k);
            f32x2 o; o.x = softplus_f(bflo(raw) + dt_bias[k]); o.y = softplus_f(bfhi(raw) + dt_bias[k + 1]);
            *(f32x2*)(DT + (size_t)(b * UL + u0 + uu) * 16 + k) = o;
        }
        {
            const int uu = tid >> 3, pp = (tid & 7) * 2; const size_t row = (size_t)(rb + u0 + uu);
            u32x2 raw = *(const u32x2*)(MISC + row * 256 + 2 * pp);
            if (u0 >= CTXL) {
                const int t = u0 + uu - CTXL, half = pp >> 3, jj = pp & 7, pos = half ? (t & 63) : (t >> 6);
                const f32x2 c0 = ROPE[pos * 8 + jj], c1 = ROPE[pos * 8 + jj + 1];
                const float a0 = bflo(raw.x), a1 = bfhi(raw.x), a2 = bflo(raw.y), a3 = bfhi(raw.y);
                raw.x = pk2(a0 * c0.x - a1 * c0.y, a0 * c0.y + a1 * c0.x); raw.y = pk2(a2 * c1.x - a3 * c1.y, a2 * c1.y + a3 * c1.x);
            }
            *(u32x2*)(KPE + row * 32 + 2 * pp) = raw;
        }
#pragma unroll 2
        for (int rr = 0; rr < 8; ++rr) {
            const size_t row = (size_t)(rb + u0 + wave * 8 + rr);
            { const u32x2 w = *(const u32x2*)(CKV + row * 256 + 4 * lane); const float c0 = bflo(w.x), c1 = bfhi(w.x), c2 = bflo(w.y), c3 = bfhi(w.y);
              const float s = wave_sum((c0 * c0 + c1 * c1) + (c2 * c2 + c3 * c3)); if (lane == 0) RSTDKV[row] = 1.0f / sqrtf(s * (1.f / 256.f) + EPS); }
            if (u0 >= CTXL) { float s = 0.f;
#pragma unroll
                for (int i = 0; i < 3; ++i) { const u32x2 w = *(const u32x2*)(CQ + row * 768 + 4 * lane + 256 * i); const float c0 = bflo(w.x), c1 = bfhi(w.x), c2 = bflo(w.y), c3 = bfhi(w.y);
                    s += (c0 * c0 + c1 * c1) + (c2 * c2 + c3 * c3); }
                s = wave_sum(s); if (lane == 0) RSTDQ[row] = 1.0f / sqrtf(s * (1.f / 768.f) + EPS); }
        }
        __syncthreads();
    }
}

__device__ __forceinline__ void acum_wave(const float* DT, size_t dtrow0, int h, float anf, float anb, LAS float* sc, int lane) {
    const float df0 = DT[(dtrow0 + lane) * 16 + h], df1 = DT[(dtrow0 + 64 + lane) * 16 + h];
    const float db0 = DT[(dtrow0 + lane) * 16 + 8 + h], db1 = DT[(dtrow0 + 64 + lane) * 16 + 8 + h];
    const float f0 = incl_scan(df0 * anf, lane); float f1 = incl_scan(df1 * anf, lane); f1 += __shfl(f0, 63);
    const float a0 = db0 * anb, a1 = db1 * anb; const float g0 = incl_scan(a0, lane), g1 = incl_scan(a1, lane);
    const float t0 = __shfl(g0, 63), t1 = __shfl(g1, 63), tot = t0 + t1;
    sc[lane] = f0; sc[64 + lane] = f1; sc[128 + lane] = tot - g0 + a0; sc[192 + lane] = t1 - g1 + a1;
    sc[256 + lane] = df0; sc[320 + lane] = df1; sc[384 + lane] = db0; sc[448 + lane] = db1;
    LDS_FENCE();
}
#define MFMA32(a, b, c) __builtin_amdgcn_mfma_f32_32x32x16_bf16((a), (b), (c), 0, 0, 0)
__device__ __forceinline__ f32x16 zero16() { f32x16 z;
#pragma unroll
    for (int r = 0; r < 16; ++r) z[r] = 0.f; return z; }

__device__ __forceinline__ void phase8(const Args& a, LAS unsigned char* lds, int G, int bx, int lane, int wave) {
    unsigned char* ws = a.ws;
    const bf16* XT = (const bf16*)(ws + WS_XT); const bf16* BT = (const bf16*)(ws + WS_BT); const float* DT = (const float*)(ws + WS_DT);
    bf16* ST = (bf16*)(ws + WS_ST); float* CD = (float*)(ws + WS_CD);
    LAS float* sc = (LAS float*)lds + wave * 512;
    const int h = wave, g = h >> 2, r32 = lane & 31, hi = lane >> 5;
    const float anf = -__expf(a.in[14][h]), anb = -__expf(a.in[14][8 + h]);
    for (int unit = bx; unit < NB * NCH; unit += G) {
        const int b = unit / NCH, c = unit % NCH;
        acum_wave(DT, (size_t)b * UL + c * 128, h, anf, anb, sc, lane);
        const float af_last = sc[127], ab_first = sc[128];
#pragma unroll
        for (int hf = 0; hf < 2; ++hf) { const int j = lane + 64 * hf;
            const float wf = __expf(af_last - sc[j]) * sc[256 + j], wb = __expf(ab_first - sc[128 + j]) * sc[384 + j];
            sc[256 + j] = wf; sc[384 + j] = wb; }
        if (lane == 0) { CD[((b * 2 + 0) * 8 + h) * NCH + c] = __expf(af_last); CD[((b * 2 + 1) * 8 + h) * NCH + c] = __expf(ab_first); }
        LDS_FENCE();
        const bf16* xbase = XT + (size_t)(b * 512 + h * 64 + r32) * UL + c * 128 + 8 * hi;
        const bf16* bbase = BT + (size_t)(b * 256 + g * 128 + r32) * UL + c * 128 + 8 * hi;
#pragma unroll 1
        for (int dir = 0; dir < 2; ++dir) {
            const LAS float* w = sc + 256 + 128 * dir + 8 * hi;
            f32x16 acc[4][2];
#pragma unroll
            for (int nb = 0; nb < 4; ++nb) { acc[nb][0] = zero16(); acc[nb][1] = zero16(); }
#pragma unroll 2
            for (int s = 0; s < 8; ++s) {
                const f32x4 wa = *(const LAS f32x4*)(w + 16 * s), wb = *(const LAS f32x4*)(w + 16 * s + 4);
                bf16x8 xw[2];
#pragma unroll
                for (int pb = 0; pb < 2; ++pb) { const u32x4 raw = *(const u32x4*)(xbase + (size_t)pb * 32 * UL + 16 * s);
                    xw[pb] = pack8(bflo(raw.x) * wa[0], bfhi(raw.x) * wa[1], bflo(raw.y) * wa[2], bfhi(raw.y) * wa[3], bflo(raw.z) * wb[0], bfhi(raw.z) * wb[1], bflo(raw.w) * wb[2], bfhi(raw.w) * wb[3]); }
#pragma unroll
                for (int nb = 0; nb < 4; ++nb) { const bf16x8 bt = *(const bf16x8*)(bbase + (size_t)nb * 32 * UL + 16 * s);
                    acc[nb][0] = MFMA32(bt, xw[0], acc[nb][0]); acc[nb][1] = MFMA32(bt, xw[1], acc[nb][1]); }
            }
            bf16* so = ST + ((size_t)(((b * 2 + dir) * 8 + h) * NCH + c) * 64) * 128;
#pragma unroll
            for (int nb = 0; nb < 4; ++nb)
#pragma unroll
                for (int pb = 0; pb < 2; ++pb)
#pragma unroll
                    for (int g4 = 0; g4 < 4; ++g4) { u32x2 o; o.x = pk2(acc[nb][pb][4 * g4], acc[nb][pb][4 * g4 + 1]); o.y = pk2(acc[nb][pb][4 * g4 + 2], acc[nb][pb][4 * g4 + 3]);
                        *(u32x2*)(so + (size_t)(32 * pb + r32) * 128 + 32 * nb + 8 * g4 + 4 * hi) = o; }
        }
        LDS_FENCE();
    }
}
__device__ __forceinline__ void phase9(const Args& a, int G, int bx, int tid) {
    unsigned char* ws = a.ws;
    const bf16* ST = (const bf16*)(ws + WS_ST); bf16* HE = (bf16*)(ws + WS_HE); const float* CD = (const float*)(ws + WS_CD);
    for (int idx = bx * 512 + tid; idx < NB * 2 * 8 * 2048; idx += G * 512) {
        const int e = (idx & 2047) * 4, bdh = idx >> 11, dir = (bdh >> 3) & 1;
        const bf16* st = ST + (size_t)bdh * NCH * 8192 + e; bf16* he = HE + (size_t)bdh * 32 * 8192 + e; const float* cd = CD + bdh * NCH;
#define P9_LD(c) (*(const u32x2*)(st + (size_t)(c) * 8192))
#define P9_STEP(c) do { const u32x2 w_ = P9_LD(c); const float d_ = cd[c]; h0 = d_ * h0 + bflo(w_.x); h1 = d_ * h1 + bfhi(w_.x); h2 = d_ * h2 + bflo(w_.y); h3 = d_ * h3 + bfhi(w_.y); } while (0)
#define P9_OUT(c) do { u32x2 o_; o_.x = pk2(h0, h1); o_.y = pk2(h2, h3); *(u32x2*)(he + (size_t)((c) - 2) * 8192) = o_; } while (0)
        float h0 = 0.f, h1 = 0.f, h2 = 0.f, h3 = 0.f;
        if (dir == 0) {
            P9_STEP(0); P9_STEP(1);
#pragma unroll 8
            for (int c = 2; c < NCH; ++c) { P9_OUT(c); P9_STEP(c); }
        } else {
            P9_STEP(1); P9_STEP(0);
#pragma unroll 8
            for (int c = NCH - 1; c >= 2; --c) { P9_OUT(c); P9_STEP(c); }
        }
#undef P9_LD
#undef P9_STEP
#undef P9_OUT
    }
}
__device__ __forceinline__ void phase10_ssd(const Args& a, LAS unsigned char* lds, int G, int bx, int lane, int wave) {
    unsigned char* ws = a.ws;
    const bf16* XT = (const bf16*)(ws + WS_XT); const bf16* BROW = (const bf16*)(ws + WS_BROW); const bf16* CROW = (const bf16*)(ws + WS_CROW); const float* DT = (const float*)(ws + WS_DT);
    const bf16* HE = (const bf16*)(ws + WS_HE); const bf16* Z = (const bf16*)(ws + WS_Z); bf16* MIX = (bf16*)(ws + WS_MIX);
    LAS float* sc = (LAS float*)lds + wave * 512;
    LAS float* SS = (LAS float*)(lds + 16384);
    const int h = wave, g = h >> 2, r32 = lane & 31, hi = lane >> 5;
    const float anf = -__expf(a.in[14][h]), anb = -__expf(a.in[14][8 + h]);
    const float dskip = a.in[15][h]; const float* snorm = a.in[16] + h * 64;
    for (int unit = bx; unit < NB * 32; unit += G) {
        const int b = unit >> 5, lc = unit & 31, c = lc + 2; const size_t u0 = (size_t)b * UL + c * 128;
        acum_wave(DT, u0, h, anf, anb, sc, lane);
#pragma unroll 1
        for (int ib = 0; ib < 4; ++ib) {
            const int i = 32 * ib + r32;
            const float afi = sc[i], abi = sc[128 + i];
            bf16x8 cfr[8];
            { const bf16* cp = CROW + (u0 + i) * 256 + g * 128 + 8 * hi;
#pragma unroll
              for (int s = 0; s < 8; ++s) cfr[s] = *(const bf16x8*)(cp + 16 * s); }
            f32x16 acc[2]; acc[0] = zero16(); acc[1] = zero16();
#pragma unroll 1
            for (int jb = 0; jb < 4; ++jb) {
                f32x16 ga = zero16();
                { const bf16* bp = BROW + (u0 + 32 * jb + r32) * 256 + g * 128 + 8 * hi;
#pragma unroll
                  for (int s = 0; s < 8; ++s) { const bf16x8 bfr = *(const bf16x8*)(bp + 16 * s); ga = MFMA32(bfr, cfr[s], ga); } }
                float mm[16];
#pragma unroll
                for (int r = 0; r < 16; ++r) {
                    const int jl = crow(r, hi), j = 32 * jb + jl;
                    float mf = 0.f, mb = 0.f;
                    if (jb <= ib) { const float e = __expf(afi - sc[j]) * sc[256 + j]; mf = (jb < ib || jl <= r32) ? e : 0.f; }
                    if (jb >= ib) { const float e = __expf(abi - sc[128 + j]) * sc[384 + j]; mb = (jb > ib || jl >= r32) ? e : 0.f; }
                    float mt = ga[r] * (mf + mb);
                    if (jb == ib && jl == r32) mt += dskip;
                    mm[r] = mt;
                }
                const bf16x8 pf0 = pack8(mm[0], mm[1], mm[2], mm[3], mm[4], mm[5], mm[6], mm[7]), pf1 = pack8(mm[8], mm[9], mm[10], mm[11], mm[12], mm[13], mm[14], mm[15]);
#pragma unroll
                for (int pb = 0; pb < 2; ++pb) {
                    const bf16* xp = XT + (size_t)(b * 512 + h * 64 + 32 * pb + r32) * UL + c * 128 + 32 * jb + 4 * hi;
                    const u32x2 a0 = *(const u32x2*)(xp), a1 = *(const u32x2*)(xp + 8), a2 = *(const u32x2*)(xp + 16), a3 = *(const u32x2*)(xp + 24);
                    const bf16x8 xa0 = __builtin_bit_cast(bf16x8, (u32x4){a0.x, a0.y, a1.x, a1.y}), xa1 = __builtin_bit_cast(bf16x8, (u32x4){a2.x, a2.y, a3.x, a3.y});
                    acc[pb] = MFMA32(xa0, pf0, acc[pb]); acc[pb] = MFMA32(xa1, pf1, acc[pb]);
                }
            }
#pragma unroll
            for (int dir = 0; dir < 2; ++dir) {
                const float e = __expf(dir ? abi : afi);
#pragma unroll
                for (int pb = 0; pb < 2; ++pb) {
                    const bf16* hp = HE + ((size_t)(((b * 2 + dir) * 8 + h) * 32 + lc) * 64 + 32 * pb + r32) * 128 + 8 * hi;
                    f32x16 ta = zero16();
#pragma unroll
                    for (int s = 0; s < 8; ++s) { const bf16x8 hf = *(const bf16x8*)(hp + 16 * s); ta = MFMA32(hf, cfr[s], ta); }
#pragma unroll
                    for (int r = 0; r < 16; ++r) acc[pb][r] += e * ta[r];
                }
            }
            const size_t row = (size_t)b * SEQ + lc * 128 + i;
            float ss = 0.f;
#pragma unroll
            for (int pb = 0; pb < 2; ++pb)
#pragma unroll
                for (int g4 = 0; g4 < 4; ++g4) { const u32x2 zw = *(const u32x2*)(Z + row * 512 + h * 64 + 32 * pb + 8 * g4 + 4 * hi);
                    const float z0 = bflo(zw.x), z1 = bfhi(zw.x), z2 = bflo(zw.y), z3 = bfhi(zw.y);
                    float v0 = acc[pb][4 * g4] * silu_f(z0), v1 = acc[pb][4 * g4 + 1] * silu_f(z1), v2 = acc[pb][4 * g4 + 2] * silu_f(z2), v3 = acc[pb][4 * g4 + 3] * silu_f(z3);
                    ss += (v0 * v0 + v1 * v1) + (v2 * v2 + v3 * v3);
                    acc[pb][4 * g4] = v0; acc[pb][4 * g4 + 1] = v1; acc[pb][4 * g4 + 2] = v2; acc[pb][4 * g4 + 3] = v3; }
            ss += __shfl_xor(ss, 32);
            LAS float* ssb = SS + (ib & 1) * 256;
            if (hi == 0) ssb[wave * 32 + r32] = ss;
            __syncthreads();
            float tot = 0.f;
#pragma unroll
            for (int w = 0; w < 8; ++w) tot += ssb[w * 32 + r32];
            const float rstd = 1.0f / sqrtf(tot * (1.f / 512.f) + EPS);
#pragma unroll
            for (int pb = 0; pb < 2; ++pb)
#pragma unroll
                for (int g4 = 0; g4 < 4; ++g4) { const int p0 = 32 * pb + 8 * g4 + 4 * hi; const f32x4 gn = *(const f32x4*)(snorm + p0);
                    u32x2 o; o.x = pk2(acc[pb][4 * g4] * rstd * gn[0], acc[pb][4 * g4 + 1] * rstd * gn[1]); o.y = pk2(acc[pb][4 * g4 + 2] * rstd * gn[2], acc[pb][4 * g4 + 3] * rstd * gn[3]);
                    *(u32x2*)(MIX + row * 1024 + h * 64 + p0) = o; }
        }
        __syncthreads();
    }
}

constexpr int AT_KS = 104, AT_VS = 68, AT_KB = 64 * AT_KS * 2, AT_BUF = AT_KB + 64 * AT_VS * 2;
__device__ __forceinline__ void phase10_attn(const Args& a, LAS unsigned char* lds, int G, int vcu, int tid, int lane, int wave) {
    unsigned char* ws = a.ws; unsigned char* ob = (unsigned char*)a.out;
    const bf16* Q = (const bf16*)(ob + OUT_Q); const bf16* KN = (const bf16*)(ob + OUT_KN); const bf16* VT = (const bf16*)(ob + OUT_VT); const bf16* KPE = (const bf16*)(ws + WS_KPE);
    bf16* MIX = (bf16*)(ws + WS_MIX); const f32x2* ROPE = (const f32x2*)(ws + WS_ROPE);
    const int r32 = lane & 31, hi = lane >> 5;
    for (int unit = vcu; unit < NB * 8 * 16; unit += G) {
        const int bh = unit >> 4, qb = unit & 15, b = bh >> 3, h = bh & 7;
        const size_t qrow = (size_t)b * SEQ + qb * 256 + wave * 32 + r32;
        bf16x8 qr[6];
        { const bf16* qp = Q + qrow * 768 + h * 96 + 8 * hi;
#pragma unroll
          for (int s = 0; s < 6; ++s) qr[s] = *(const bf16x8*)(qp + 16 * s);
          const int tq = qb * 256 + wave * 32 + r32;
#pragma unroll
          for (int s = 4; s < 6; ++s) { const int pos = (s == 4) ? (tq >> 6) : (tq & 63); const f32x2* rp = ROPE + pos * 8 + 4 * hi;
              const u32x4 w = __builtin_bit_cast(u32x4, qr[s]); const f32x2 c0 = rp[0], c1 = rp[1], c2 = rp[2], c3 = rp[3]; u32x4 o;
              o.x = pk2(bflo(w.x) * c0.x - bfhi(w.x) * c0.y, bflo(w.x) * c0.y + bfhi(w.x) * c0.x); o.y = pk2(bflo(w.y) * c1.x - bfhi(w.y) * c1.y, bflo(w.y) * c1.y + bfhi(w.y) * c1.x);
              o.z = pk2(bflo(w.z) * c2.x - bfhi(w.z) * c2.y, bflo(w.z) * c2.y + bfhi(w.z) * c2.x); o.w = pk2(bflo(w.w) * c3.x - bfhi(w.w) * c3.y, bflo(w.w) * c3.y + bfhi(w.w) * c3.x);
              qr[s] = __builtin_bit_cast(bf16x8, o); } }
        const int kr = tid >> 3, kpart = tid & 7;
        const int pr = tid >> 2, ppart = tid & 3;
#define AT_ROW0(t) ((t) < 4 ? (size_t)NLAT + b * CTXL + (t) * 64 : (size_t)b * SEQ + ((t) - 4) * 64)
#define AT_LOAD(t) do { const size_t r0_ = AT_ROW0(t); \
        gk = *(const u32x4*)(KN + (r0_ + kr) * 512 + h * 64 + kpart * 8); \
        gv = *(const u32x4*)(VT + (size_t)(h * 64 + kr) * MTOT + r0_ + kpart * 8); \
        if (tid < 256) gp = *(const u32x4*)(KPE + (r0_ + pr) * 32 + ppart * 8); } while (0)
#define AT_STORE(bufi) do { LAS unsigned char* B_ = lds + (bufi) * AT_BUF; \
        *(LAS u32x4*)(B_ + (kr * AT_KS + kpart * 8) * 2) = gk; \
        *(LAS u32x2*)(B_ + AT_KB + (kr * AT_VS + kpart * 8) * 2) = (u32x2){gv.x, gv.y}; *(LAS u32x2*)(B_ + AT_KB + (kr * AT_VS + kpart * 8 + 4) * 2) = (u32x2){gv.z, gv.w}; \
        if (tid < 256) *(LAS u32x4*)(B_ + (pr * AT_KS + 64 + ppart * 8) * 2) = gp; } while (0)
        u32x4 gk, gv, gp = (u32x4){0u, 0u, 0u, 0u};
        AT_LOAD(0); AT_STORE(0);
        __syncthreads();
        float mrun = -INFINITY, lrun = 0.f;
        f32x16 o[2]; o[0] = zero16(); o[1] = zero16();
#pragma unroll 1
        for (int t = 0; t < 68; ++t) {
            if (t + 1 < 68) AT_LOAD(t + 1);
            const LAS unsigned char* Bc = lds + (t & 1) * AT_BUF;
            f32x16 p0 = zero16(), p1 = zero16();
#pragma unroll
            for (int s = 0; s < 6; ++s) {
                const bf16x8 k0 = *(const LAS bf16x8*)(Bc + (r32 * AT_KS + 16 * s + 8 * hi) * 2), k1 = *(const LAS bf16x8*)(Bc + ((32 + r32) * AT_KS + 16 * s + 8 * hi) * 2);
                p0 = MFMA32(k0, qr[s], p0); p1 = MFMA32(k1, qr[s], p1);
            }
            float mx = fmaxf(p0[0], p1[0]);
#pragma unroll
            for (int r = 1; r < 16; ++r) mx = fmaxf(mx, fmaxf(p0[r], p1[r]));
            mx = fmaxf(mx, __shfl_xor(mx, 32));
            const float mnew = fmaxf(mrun, mx), alpha = __builtin_amdgcn_exp2f(mrun - mnew);
            mrun = mnew;
            float rs = 0.f;
#pragma unroll
            for (int r = 0; r < 16; ++r) { p0[r] = __builtin_amdgcn_exp2f(p0[r] - mnew); p1[r] = __builtin_amdgcn_exp2f(p1[r] - mnew); rs += p0[r] + p1[r]; }
            lrun = lrun * alpha + rs;
#pragma unroll
            for (int r = 0; r < 16; ++r) { o[0][r] *= alpha; o[1][r] *= alpha; }
            bf16x8 pf[4];
            pf[0] = pack8(p0[0], p0[1], p0[2], p0[3], p0[4], p0[5], p0[6], p0[7]); pf[1] = pack8(p0[8], p0[9], p0[10], p0[11], p0[12], p0[13], p0[14], p0[15]);
            pf[2] = pack8(p1[0], p1[1], p1[2], p1[3], p1[4], p1[5], p1[6], p1[7]); pf[3] = pack8(p1[8], p1[9], p1[10], p1[11], p1[12], p1[13], p1[14], p1[15]);
#pragma unroll
            for (int db = 0; db < 2; ++db)
#pragma unroll
                for (int s = 0; s < 4; ++s) {
                    const LAS unsigned char* vp = Bc + AT_KB + ((32 * db + r32) * AT_VS + 16 * s + 4 * hi) * 2;
                    const u32x2 v0 = *(const LAS u32x2*)vp, v1 = *(const LAS u32x2*)(vp + 16);
                    o[db] = MFMA32(__builtin_bit_cast(bf16x8, (u32x4){v0.x, v0.y, v1.x, v1.y}), pf[s], o[db]);
                }
            if (t + 1 < 68) AT_STORE((t + 1) & 1);
            __syncthreads();
        }
#undef AT_ROW0
#undef AT_LOAD
#undef AT_STORE
        const float ltot = lrun + __shfl_xor(lrun, 32), rl = 1.0f / ltot;
        bf16* op = MIX + qrow * 1024 + 512 + h * 64 + 4 * hi;
#pragma unroll
        for (int db = 0; db < 2; ++db)
#pragma unroll
            for (int g4 = 0; g4 < 4; ++g4) { u32x2 w; w.x = pk2(o[db][4 * g4] * rl, o[db][4 * g4 + 1] * rl); w.y = pk2(o[db][4 * g4 + 2] * rl, o[db][4 * g4 + 3] * rl);
                *(u32x2*)(op + 32 * db + 8 * g4) = w; }
    }
}

#define XB_TMO      128
#define XB_XCNT(j)  (256  + 64 * (j))
#define XB_XSUB(j)  (1280 + 64 * (j))
#define XB_XGEN(j)  (2304 + 64 * (j))
#define XB_TOP      3328
#define XB_TOPGEN   3392
#define XCD_BAR_WORDS 3456
#define XB_SPIN_CAP (1u << 18)

__device__ __forceinline__ unsigned xb_ld(unsigned* p)              { return __hip_atomic_load(p, __ATOMIC_RELAXED, __HIP_MEMORY_SCOPE_AGENT); }
__device__ __forceinline__ unsigned xb_add(unsigned* p, unsigned v) { return __hip_atomic_fetch_add(p, v, __ATOMIC_RELAXED, __HIP_MEMORY_SCOPE_AGENT); }
__device__ __forceinline__ unsigned xb_xcc_id() { return (unsigned)__builtin_amdgcn_s_getreg((3 << 11) | 20) & 0xFu; }
#define XB_SPIN(cond, bar) do { unsigned _sp = 0; while (cond) { __builtin_amdgcn_s_sleep(1); \
    if ((++_sp & 255u) == 0u) { if (xb_ld(&(bar)[XB_TMO])) break; if (_sp > XB_SPIN_CAP) { atomicAdd(&(bar)[XB_TMO], 1u); break; } } } } while (0)

struct XcdBarrier {
    unsigned* bar; unsigned x;
    volatile LAS unsigned* st;
};

__device__ __forceinline__ XcdBarrier xcd_barrier_post(unsigned* bar, volatile LAS unsigned* st) {
    XcdBarrier b; b.bar = bar; b.x = xb_xcc_id(); b.st = st;
    if (threadIdx.x == 0) (void)xb_add(&bar[XB_XCNT(b.x)], 1u);
    return b;
}
__device__ __forceinline__ void xcd_barrier_complete(unsigned* bar, unsigned x, unsigned& nloc, unsigned& nx) {
    const unsigned G = gridDim.x * gridDim.y * gridDim.z;
    unsigned sum, cnt, mine, sp = 0u;
    for (;;) {
        sum = 0u; cnt = 0u; mine = 0u;
#pragma unroll
        for (unsigned j = 0; j < 16; ++j) { const unsigned c = xb_ld(&bar[XB_XCNT(j)]); sum += c; cnt += (c > 0u) ? 1u : 0u; mine = (j == x) ? c : mine; }
        if (sum == G) break;
        __builtin_amdgcn_s_sleep(1);
        if ((++sp & 255u) == 0u) { if (xb_ld(&bar[XB_TMO])) break; if (sp > XB_SPIN_CAP) { atomicAdd(&bar[XB_TMO], 1u); break; } }
    }
    nloc = mine > 0u ? mine : 1u; nx = cnt > 0u ? cnt : 1u;
}

__device__ __forceinline__ void xcd_barrier(const XcdBarrier& b) {
    asm volatile("s_waitcnt vmcnt(0)" ::: "memory");
    __syncthreads();
    if (threadIdx.x == 0) {
        unsigned* bar = b.bar;
        __builtin_amdgcn_s_waitcnt(0);
        unsigned nloc = b.st[0], nx = b.st[1];
        if (nloc == 0u) { xcd_barrier_complete(bar, b.x, nloc, nx); b.st[0] = nloc; b.st[1] = nx; }
        const unsigned old = xb_add(&bar[XB_XSUB(b.x)], 1u);
        const unsigned gen = old / nloc;
        if (old + 1u == (gen + 1u) * nloc) {
            __builtin_amdgcn_fence(__ATOMIC_RELEASE, "agent");
            asm volatile("s_waitcnt vmcnt(0)" ::: "memory");
            const unsigned og = xb_add(&bar[XB_TOP], 1u);
            const unsigned tg = og / nx;
            if (og + 1u == (tg + 1u) * nx) xb_add(&bar[XB_TOPGEN], 1u);
            else XB_SPIN(xb_ld(&bar[XB_TOPGEN]) == tg, bar);
            __builtin_amdgcn_fence(__ATOMIC_ACQUIRE, "agent");
            xb_add(&bar[XB_XGEN(b.x)], 1u);
            asm volatile("s_waitcnt vmcnt(0)" ::: "memory");
        } else {
            XB_SPIN(xb_ld(&bar[XB_XGEN(b.x)]) == gen, bar);
            __builtin_amdgcn_fence(__ATOMIC_ACQUIRE, "agent");
            asm volatile("s_waitcnt vmcnt(0)" ::: "memory");
        }
    }
    __syncthreads();
}

__global__ void __launch_bounds__(512, 2) hymba_fwd(Args args) {
    extern __shared__ __attribute__((aligned(16))) unsigned char lds_raw[];
    LAS unsigned char* lds = (LAS unsigned char*)lds_raw;
    cg::grid_group grid = cg::this_grid();
    const int tid = threadIdx.x, lane = tid & 63, wave = __builtin_amdgcn_readfirstlane(tid >> 6);
    const int G = gridDim.x, bx = blockIdx.x, vcu = (G % 8 == 0) ? (bx % 8) * (G / 8) + bx / 8 : bx;
    const int gw = bx * 8 + wave, NGW = G * 8;
    unsigned char* ws = args.ws;
    const int lo = args.ph_lo, hi = args.ph_hi;
    const float* MOD = (const float*)(ws + WS_MOD);
    volatile LAS unsigned* bst = (volatile LAS unsigned*)(lds + 131072 + 320);
    if (tid < 2) bst[tid] = 0u;
    __syncthreads();
    const XcdBarrier xbar = xcd_barrier_post((unsigned*)(ws + WS_BAR), bst);
    bf16* XN = (bf16*)(ws + WS_A); bf16* HB = (bf16*)(ws + WS_B); float* X1 = (float*)(ws + WS_C);
#ifndef PHMASK
#define PHMASK 0xFFFF
#endif
#define IN(k) (((PHMASK >> (k)) & 1) && lo <= (k) && (k) < hi)
#define GSYNC(k) do { if ((k) == 0) grid.sync(); else xcd_barrier(xbar); } while (0)
#define SEAM(k) do { if (IN(k) && IN((k) + 1)) GSYNC(k); } while (0)
#define PH_BEGIN(k) if (IN(k)) for (int rep_ = 0; rep_ < ((k) == PROBE_PHASE ? 2 : 1); ++rep_) { if (rep_) xcd_barrier(xbar);
#define PH_END(k) } SEAM(k)
    if (PROBE_PHASE == 200) { for (int r3 = 0; r3 < 16; ++r3) xcd_barrier(xbar); }
    PH_BEGIN(0) { phase0(args, lds, gw, NGW, tid, lane, wave); } PH_END(0);
    PH_BEGIN(1) { norm_rows(args.in[0], args.in[2], MTOT, args.in[6], MOD, 0, XN, gw, NGW, lane); } PH_END(1);
    PH_BEGIN(2) { pg8::Gemm g{XN, (const bf16*)(ws + WS_W1A), MTOT, 2 * DFF, D}; pg8::StaticOrder S; S.init(MTOT, 2 * DFF, G, bx);
        pg8::EpiSwiglu E{HB, DFF}; pg8::gemm_phase<pg8::EpiSwiglu, pg8::StaticOrder, true, true>(lds, g, S, E); } PH_END(2);
    PH_BEGIN(3) { pg8::Gemm g{HB, (const bf16*)(ws + WS_W1B), MTOT, D, DFF}; pg8::StaticOrder S; S.init(MTOT, D, G, bx);
        pg8::EpiRes E{args.in[0], args.in[2], X1, MOD, 2, 0.5f}; pg8::gemm_phase<pg8::EpiRes, pg8::StaticOrder, true, true>(lds, g, S, E); } PH_END(3);
    PH_BEGIN(4) { norm_rows(X1, X1 + (size_t)NLAT * D, MTOT, args.in[9], MOD, 3, XN, gw, NGW, lane); } PH_END(4);
    PH_BEGIN(5) { pg8::Gemm g{XN, (const bf16*)(ws + WS_WIN), MTOT, 2816, D}; pg8::StaticOrder S; S.init(MTOT, 2816, G, bx);
        pg8::EpiSplit E{(bf16*)(ws + WS_Z), (bf16*)(ws + WS_XBCR), (bf16*)(ws + WS_CQ), (bf16*)(ws + WS_CKV), (bf16*)(ws + WS_MISC)};
        pg8::gemm_phase<pg8::EpiSplit, pg8::StaticOrder, true, true>(lds, g, S, E); } PH_END(5);
    PH_BEGIN(6) { phase6(args, lds, G, bx, tid, lane, wave); } PH_END(6);
    PH_BEGIN(7) {
        unsigned char* ob = (unsigned char*)args.out;
        { pg8::Gemm g{(const bf16*)(ws + WS_CQ), (const bf16*)(ws + WS_WUQ), NLAT, 768, 768}; pg8::StaticOrder S; S.init(NLAT, 768, G, bx);
          pg8::EpiScale E{(bf16*)(ob + OUT_Q), 768, (const float*)(ws + WS_RSTDQ), nullptr}; pg8::gemm_phase<pg8::EpiScale, pg8::StaticOrder, true, true>(lds, g, S, E); }
        { pg8::Gemm g{(const bf16*)(ws + WS_CKV), (const bf16*)(ws + WS_WK), MTOT, 512, 256}; pg8::StaticOrder S; S.init(MTOT, 512, G, bx);
          pg8::EpiScale E{(bf16*)(ob + OUT_KN), 512, (const float*)(ws + WS_RSTDKV), nullptr}; pg8::gemm_phase<pg8::EpiScale, pg8::StaticOrder, true, true>(lds, g, S, E); }
        { pg8::Gemm g{(const bf16*)(ws + WS_WV), (const bf16*)(ws + WS_CKV), 512, MTOT, 256}; pg8::StaticOrder S; S.init(512, MTOT, G, bx);
          pg8::EpiScale E{(bf16*)(ob + OUT_VT), MTOT, nullptr, (const float*)(ws + WS_RSTDKV)}; pg8::gemm_phase<pg8::EpiScale, pg8::StaticOrder, true, true>(lds, g, S, E); }
        phase8(args, lds, G, bx, lane, wave);
    } PH_END(7);
    PH_BEGIN(9) { phase9(args, G, bx, tid); } PH_END(9);
    PH_BEGIN(10) { for (int r2 = 0; r2 < (PROBE_PHASE == 100 ? 2 : 1); ++r2) phase10_ssd(args, lds, G, bx, lane, wave); for (int r2 = 0; r2 < (PROBE_PHASE == 101 ? 2 : 1); ++r2) phase10_attn(args, lds, G, vcu, tid, lane, wave); } PH_END(10);
    PH_BEGIN(11) { pg8::Gemm g{(const bf16*)(ws + WS_MIX), (const bf16*)(ws + WS_WOUT), NLAT, D, D}; pg8::StaticOrder S; S.init(NLAT, D, G, bx);
        pg8::EpiRes E{X1, X1, X1, MOD, 5, 1.0f}; pg8::gemm_phase<pg8::EpiRes, pg8::StaticOrder, true, true>(lds, g, S, E); } PH_END(11);
    PH_BEGIN(12) { norm_rows(X1, X1, NLAT, args.in[22], MOD, 6, XN, gw, NGW, lane); } PH_END(12);
    PH_BEGIN(13) { pg8::Gemm g{XN, (const bf16*)(ws + WS_W2A), NLAT, 2 * DFF, D}; pg8::StaticOrder S; S.init(NLAT, 2 * DFF, G, bx);
        pg8::EpiSwiglu E{HB, DFF}; pg8::gemm_phase<pg8::EpiSwiglu, pg8::StaticOrder, true, true>(lds, g, S, E); } PH_END(13);
    PH_BEGIN(14) { pg8::Gemm g{HB, (const bf16*)(ws + WS_W2B), NLAT, D, DFF}; pg8::StaticOrder S; S.init(NLAT, D, G, bx);
        pg8::EpiRes E{X1, X1, args.out, MOD, 8, 0.5f}; pg8::gemm_phase<pg8::EpiRes, pg8::StaticOrder, true, true>(lds, g, S, E); } PH_END(14);
    PH_BEGIN(15) { final_norm_rows(args.out, args.in[25], gw, NGW, lane); } PH_END(15);
#undef IN
#undef SEAM
}

#ifndef N_LAUNCHES
#define N_LAUNCHES 1
#endif
extern "C" void kernel_launch(void* const* d_in, const int* in_sizes, int n_in, void* d_out, int out_size, void* d_ws, size_t ws_size, hipStream_t stream) {
    static int grid = 0;
    if (grid == 0) {
        if (n_in != 26 || out_size != NLAT * D || ws_size < WS_END) { fprintf(stderr, "kernel_launch: unexpected shapes (n_in %d out %d ws %zu)\n", n_in, out_size, ws_size); grid = -1; return; }
        int dev = 0, cus = 0, per_cu = 0;
        (void)hipGetDevice(&dev); (void)hipDeviceGetAttribute(&cus, hipDeviceAttributeMultiprocessorCount, dev);
        if (hipFuncSetAttribute((const void*)hymba_fwd, hipFuncAttributeMaxDynamicSharedMemorySize, LDS_BYTES) != hipSuccess) { fprintf(stderr, "kernel_launch: hipFuncSetAttribute failed\n"); grid = -1; return; }
        if (hipOccupancyMaxActiveBlocksPerMultiprocessor(&per_cu, (const void*)hymba_fwd, 512, LDS_BYTES) != hipSuccess || per_cu < 1) { fprintf(stderr, "kernel_launch: occupancy query failed (%d)\n", per_cu); grid = -1; (void)hipGetLastError(); return; }
        grid = cus;
    }
    if (grid < 0) return;
    (void)hipMemsetAsync((char*)d_ws + WS_BAR, 0, 16 * KiB, stream);
    Args a{};
    for (int i = 0; i < 26; ++i) a.in[i] = (const float*)d_in[i];
    a.out = (float*)d_out; a.ws = (unsigned char*)d_ws;
    for (int li = 0; li < N_LAUNCHES; ++li) {
        a.ph_lo = (N_LAUNCHES == 1) ? 0 : li; a.ph_hi = (N_LAUNCHES == 1) ? NPHASE : li + 1;
        void* kargs[] = {&a};
        hipError_t e = hipLaunchCooperativeKernel((const void*)hymba_fwd, dim3(grid), dim3(512), kargs, LDS_BYTES, stream);
        if (e != hipSuccess) { fprintf(stderr, "kernel_launch: cooperative launch %d failed: %s (grid %d)\n", li, hipGetErrorString(e), grid); break; }
    }
}
```

```cpp
#include <hip/hip_runtime.h>
#include <hip/hip_cooperative_groups.h>
#include <cstdio>
#include <cstdint>
namespace cg = cooperative_groups;
namespace pg8 {
#define PG8_LAS __attribute__((address_space(3)))
typedef unsigned short bf16_t;
typedef short bf16x8 __attribute__((ext_vector_type(8)));
typedef float f32x4 __attribute__((ext_vector_type(4)));
typedef unsigned u32x4 __attribute__((ext_vector_type(4)));
constexpr int BM = 256, BK = 64, HALF = 128, HTB = HALF * BK * 2  , STAGE_BYTES = 8 * HTB, NXCD = 8, WGM = 8;

__host__ __device__ __forceinline__ int lds_byte(int r, int c) { const int st = (r >> 4) * 2 + (c >> 5), rr = r & 15, cc = c & 31, ob = rr * 64 + cc * 2; return st * 1024 + (ob ^ (((ob >> 9) & 1) << 5)); }
__host__ __device__ __forceinline__ void stage_rc(int b, int& R, int& C) { const int st = b / 1024, sb = b % 1024, swz = sb ^ (((sb >> 9) & 1) << 5); R = (st >> 1) * 16 + swz / 64; C = (st & 1) * 32 + (swz % 64) / 2; }
__host__ __device__ __forceinline__ int perm32(int rho) { const int n = rho >> 4, i = rho & 15; return 8 * (i >> 2) + 4 * n + (i & 3); }

struct Unit { int pm, pn; };
struct Gemm { const bf16_t* A; const bf16_t* Bt; int M, N, K; };

struct StaticOrder {
    int nM, nN, nwg, G, c;
    __host__ __device__ void init(int M, int N, int G_, int c_) { nM = M / BM; nN = N / BM; nwg = nM * nN; G = G_; c = c_; }
    __host__ __device__ bool next(int i, Unit& u) const {
        const long L = (long)i * G + c; if (L >= nwg) return false;
        int wgid = (int)L; { const int q = nwg / NXCD, r = nwg % NXCD, xcd = wgid % NXCD, off = wgid / NXCD; wgid = (xcd < r ? xcd * (q + 1) : r * (q + 1) + (xcd - r) * q) + off; }
        const int nig = WGM * nN, gid = wgid / nig, fm = gid * WGM, gsz = (nM - fm) < WGM ? (nM - fm) : WGM;
        u.pm = fm + ((wgid % nig) % gsz); u.pn = (wgid % nig) / gsz; return true;
    }
    __device__ __forceinline__ void a_ready(const Unit&) const {}
    __device__ __forceinline__ void done(const Unit&) const {}
};

__device__ __forceinline__ unsigned cvt_pk_bf16(float lo, float hi) { unsigned r; asm volatile("v_cvt_pk_bf16_f32 %0, %1, %2" : "=v"(r) : "v"(lo), "v"(hi)); return r; }
typedef float f32x2 __attribute__((ext_vector_type(2)));
__device__ __forceinline__ f32x2 gelu_pk(f32x2 v) {
    const f32x2 av = __builtin_elementwise_abs(v), d = av * 0.2316418882f + 1.0f;
    f32x2 t; t.x = __builtin_amdgcn_rcpf(d.x); t.y = __builtin_amdgcn_rcpf(d.y);
    f32x2 q = t * 0.5307027145f + (-0.7265760135f); q = q * t + 0.7107068705f; q = q * t + (-0.142248368f); q = q * t + 0.127414796f; q = q * t;
    const f32x2 s = (v * v) * (-0.72134752044f);
    f32x2 e; e.x = __builtin_amdgcn_exp2f(s.x); e.y = __builtin_amdgcn_exp2f(s.y);
    const f32x2 m = v * (q * e), r = v - m;
    f32x2 o; o.x = v.x < 0.f ? m.x : r.x; o.y = v.y < 0.f ? m.y : r.y; return o;
}

template <int ACT  > struct EpiBf16 {
    static constexpr bool PERM = true, AFTER_DRAIN = false; static_assert(ACT == 0 || ACT == 1, "EpiBf16: ACT is 0 (none) or 1 (gelu_pk)");
    bf16_t* O; int ldc; const float* bias; int split_cols; size_t split_stride; float scale0;
    __device__ __forceinline__ void operator()(const f32x4 (&acc)[2][2][4][2], const Unit& u, int wr, int wc, int fr, int fq) const {
        const int row0 = u.pm * BM + wr * 64 + fr; int colt = u.pn * BM; bf16_t* base = O;
        float sc = 1.f; if (split_cols) { const int t = colt / split_cols; base += (size_t)t * split_stride; colt -= t * split_cols; if (t == 0) sc = scale0; }
        const int col0 = colt + wc * 32 + 8 * fq, bcol0 = u.pn * BM + wc * 32 + 8 * fq;
        f32x4 bv[2][2];
#pragma unroll
        for (int bj = 0; bj < 2; ++bj)
#pragma unroll
            for (int n = 0; n < 2; ++n) bv[bj][n] = bias ? *(const f32x4*)(bias + bcol0 + bj * HALF + 4 * n) : (f32x4){0.f, 0.f, 0.f, 0.f};
#pragma unroll
        for (int ai = 0; ai < 2; ++ai)
#pragma unroll
            for (int m = 0; m < 4; ++m) { bf16_t* rowp = base + (size_t)(row0 + ai * HALF + m * 16) * ldc + col0;
#pragma unroll
                for (int bj = 0; bj < 2; ++bj) { f32x4 v0 = acc[ai][bj][m][0] + bv[bj][0], v1 = acc[ai][bj][m][1] + bv[bj][1];
                    if (ACT == 1) { f32x2 a = gelu_pk((f32x2){v0[0], v0[1]}), b = gelu_pk((f32x2){v0[2], v0[3]}), c = gelu_pk((f32x2){v1[0], v1[1]}), d = gelu_pk((f32x2){v1[2], v1[3]});
                        v0 = (f32x4){a.x, a.y, b.x, b.y}; v1 = (f32x4){c.x, c.y, d.x, d.y}; }
                    v0 = v0 * sc; v1 = v1 * sc; u32x4 w; w.x = cvt_pk_bf16(v0[0], v0[1]); w.y = cvt_pk_bf16(v0[2], v0[3]); w.z = cvt_pk_bf16(v1[0], v1[1]); w.w = cvt_pk_bf16(v1[2], v1[3]);
                    *(u32x4*)(rowp + bj * HALF) = w; } }
    }
};
template <class Epi, class Sched, bool ALIGN_EPI = false, bool SP2 = false>
__device__ __forceinline__ void gemm_phase(PG8_LAS unsigned char* lds, const Gemm g, const Sched& S, const Epi& E) {
    const int tid = threadIdx.x, wid = __builtin_amdgcn_readfirstlane(tid >> 6), lane = tid & 63, wr = wid >> 2, wc = wid & 3, fr = lane & 15, fq = lane >> 4;
    const int K = g.K, nt = K / BK;
    unsigned voffA[2], voffB[2];
#pragma unroll
    for (int i = 0; i < 2; ++i) { int R, C; stage_rc(tid * 16 + i * 8192, R, C); const int Rb = Epi::PERM ? ((R & ~31) + perm32(R & 31)) : R;
        voffA[i] = (unsigned)(R * K + C) * 2u; voffB[i] = (unsigned)(Rb * K + C) * 2u; }
    const size_t kstep = (size_t)(BK * 2);
    const size_t hstep = (size_t)HALF * K * 2;
    const size_t tstep = 2 * hstep;
    const unsigned ldsw = (unsigned)wid * 1024u;
    const int aoff = lds_byte(wr * 64 + fr, fq * 8), boff = lds_byte(wc * 32 + fr, fq * 8);
#define PG8_SA(b, h) (((b) * 2 + (h)) * HTB)
#define PG8_SB(b, h) ((4 + (b) * 2 + (h)) * HTB)
#define PG8_STAGE(bufoff, gbase, voff) do { _Pragma("unroll") for (int _i = 0; _i < 2; ++_i) \
        __builtin_amdgcn_global_load_lds((const unsigned*)((const char*)(gbase) + (voff)[_i]), (PG8_LAS unsigned*)(lds + (bufoff) + ldsw + _i * 8192), 16, 0, 0); } while (0)
#define PG8_LDA(dst, b, h) do { _Pragma("unroll") for (int m = 0; m < 4; ++m) _Pragma("unroll") for (int k = 0; k < 2; ++k) dst[m][k] = *(const PG8_LAS bf16x8*)(lds + PG8_SA(b, h) + aoff + m * 2048 + k * 1024); } while (0)
#define PG8_LDB(dst, b, h) do { _Pragma("unroll") for (int n = 0; n < 2; ++n) _Pragma("unroll") for (int k = 0; k < 2; ++k) dst[n][k] = *(const PG8_LAS bf16x8*)(lds + PG8_SB(b, h) + boff + n * 2048 + k * 1024); } while (0)
#define PG8_MMA(ai, bj, At, Bt) do { __builtin_amdgcn_s_setprio(1); _Pragma("unroll") for (int m = 0; m < 4; ++m) _Pragma("unroll") for (int n = 0; n < 2; ++n) _Pragma("unroll") for (int k = 0; k < 2; ++k) \
        acc[ai][bj][m][n] = __builtin_amdgcn_mfma_f32_16x16x32_bf16(Bt[n][k], At[m][k], acc[ai][bj][m][n], 0, 0, 0); __builtin_amdgcn_s_setprio(0); } while (0)
#define PG8_WAIT_V(n) asm volatile("s_waitcnt vmcnt(" #n ")" ::: "memory")
#define PG8_WAIT_L(n) asm volatile("s_waitcnt lgkmcnt(" #n ")" ::: "memory")
#define PG8_BAR __builtin_amdgcn_s_barrier()
#define PG8_SCHED __builtin_amdgcn_sched_barrier(0)
    Unit cur, nxt; int ui = 0;
    if (!S.next(0, cur)) return;
    f32x4 acc[2][2][4][2];
#pragma unroll
    for (int a = 0; a < 2; ++a)
#pragma unroll
        for (int b = 0; b < 2; ++b)
#pragma unroll
            for (int m = 0; m < 4; ++m)
#pragma unroll
                for (int n = 0; n < 2; ++n) acc[a][b][m][n] = (f32x4){0.f, 0.f, 0.f, 0.f};
    bf16x8 At[4][2], B0[2][2], B1[2][2];
    const char* cA = (const char*)g.A + (size_t)cur.pm * tstep; const char* cB = (const char*)g.Bt + (size_t)cur.pn * tstep;
    S.a_ready(cur);
    if constexpr (SP2) {
        PG8_STAGE(PG8_SB(0, 0), cB, voffB); PG8_STAGE(PG8_SB(0, 1), cB + hstep, voffB); PG8_STAGE(PG8_SA(0, 0), cA, voffA); PG8_STAGE(PG8_SA(0, 1), cA + hstep, voffA);
        if (wr == 1) PG8_BAR;
        PG8_WAIT_V(2); PG8_BAR;
        PG8_STAGE(PG8_SB(1, 0), cB + kstep, voffB); PG8_STAGE(PG8_SA(1, 0), cA + kstep, voffA); PG8_STAGE(PG8_SB(1, 1), cB + hstep + kstep, voffB);
        PG8_WAIT_V(6); PG8_BAR;
    } else {
        PG8_STAGE(PG8_SB(0, 0), cB, voffB); PG8_STAGE(PG8_SA(0, 0), cA, voffA); PG8_STAGE(PG8_SB(0, 1), cB + hstep, voffB); PG8_STAGE(PG8_SA(0, 1), cA + hstep, voffA);
        if (wr == 1) PG8_BAR;
        PG8_WAIT_V(4); PG8_BAR;
        PG8_STAGE(PG8_SB(1, 0), cB + kstep, voffB); PG8_STAGE(PG8_SA(1, 0), cA + kstep, voffA); PG8_STAGE(PG8_SB(1, 1), cB + hstep + kstep, voffB);
        PG8_WAIT_V(6); PG8_BAR;
    }
    for (;;) {
        const bool has_next = S.next(ui + 1, nxt);
        const char* nA = has_next ? (const char*)g.A + (size_t)nxt.pm * tstep : cA; const char* nB = has_next ? (const char*)g.Bt + (size_t)nxt.pn * tstep : cB;
        for (int t = 0; t < nt; t += 2) {
            const bool last = (t == nt - 2);
            const char* a1 = cA + (size_t)(t + 1) * kstep;
            const char* a2 = last ? nA : cA + (size_t)(t + 2) * kstep; const char* b2 = last ? nB : cB + (size_t)(t + 2) * kstep;
            const char* a3 = a2 + kstep; const char* b3 = b2 + kstep;
            if (last && has_next) S.a_ready(nxt);
            if constexpr (SP2) {
            PG8_LDB(B0, 0, 0); PG8_LDB(B1, 0, 1); PG8_SCHED; PG8_LDA(At, 0, 0); PG8_STAGE(PG8_SA(1, 1), a1 + hstep, voffA);
            PG8_WAIT_V(8); PG8_WAIT_L(0); PG8_BAR; PG8_MMA(0, 0, At, B0); PG8_MMA(0, 1, At, B1); PG8_BAR; PG8_SCHED;
            PG8_LDA(At, 0, 1); PG8_STAGE(PG8_SB(0, 0), b2, voffB); PG8_STAGE(PG8_SB(0, 1), b2 + hstep, voffB); PG8_STAGE(PG8_SA(0, 0), a2, voffA);
            PG8_WAIT_V(8); PG8_WAIT_L(0); PG8_BAR; PG8_MMA(1, 0, At, B0); PG8_MMA(1, 1, At, B1); PG8_BAR; PG8_SCHED;
            PG8_LDB(B0, 1, 0); PG8_LDB(B1, 1, 1); PG8_SCHED; PG8_LDA(At, 1, 0); PG8_STAGE(PG8_SA(0, 1), a2 + hstep, voffA);
            PG8_WAIT_V(8); PG8_WAIT_L(0); PG8_BAR; PG8_MMA(0, 0, At, B0); PG8_MMA(0, 1, At, B1); PG8_BAR; PG8_SCHED;
            PG8_LDA(At, 1, 1); PG8_STAGE(PG8_SB(1, 0), b3, voffB); PG8_STAGE(PG8_SB(1, 1), b3 + hstep, voffB); PG8_STAGE(PG8_SA(1, 0), a3, voffA);
            PG8_WAIT_V(8); PG8_WAIT_L(0); PG8_BAR; PG8_MMA(1, 0, At, B0); PG8_MMA(1, 1, At, B1); PG8_BAR; PG8_SCHED;
            } else {
            PG8_LDB(B0, 0, 0); PG8_SCHED; PG8_LDA(At, 0, 0); PG8_STAGE(PG8_SA(1, 1), a1 + hstep, voffA);
            PG8_WAIT_L(8); PG8_BAR; PG8_WAIT_L(0); PG8_MMA(0, 0, At, B0); PG8_BAR; PG8_SCHED;
            PG8_LDB(B1, 0, 1); PG8_STAGE(PG8_SB(0, 0), b2, voffB);
            PG8_BAR; PG8_WAIT_L(0); PG8_MMA(0, 1, At, B1); PG8_BAR;
            PG8_LDA(At, 0, 1); PG8_STAGE(PG8_SA(0, 0), a2, voffA);
            PG8_BAR; PG8_WAIT_L(0); PG8_MMA(1, 0, At, B0); PG8_BAR; PG8_SCHED;
            PG8_STAGE(PG8_SB(0, 1), b2 + hstep, voffB);
            PG8_WAIT_V(6); PG8_BAR; PG8_MMA(1, 1, At, B1); PG8_BAR;
            PG8_LDB(B0, 1, 0); PG8_SCHED; PG8_LDA(At, 1, 0); PG8_STAGE(PG8_SA(0, 1), a2 + hstep, voffA);
            PG8_WAIT_L(8); PG8_BAR; PG8_WAIT_L(0); PG8_MMA(0, 0, At, B0); PG8_BAR; PG8_SCHED;
            PG8_LDB(B1, 1, 1); PG8_STAGE(PG8_SB(1, 0), b3, voffB);
            PG8_BAR; PG8_WAIT_L(0); PG8_MMA(0, 1, At, B1); PG8_BAR;
            PG8_LDA(At, 1, 1); PG8_STAGE(PG8_SA(1, 0), a3, voffA);
            PG8_BAR; PG8_WAIT_L(0); PG8_MMA(1, 0, At, B0); PG8_BAR; PG8_SCHED;
            PG8_STAGE(PG8_SB(1, 1), b3 + hstep, voffB);
            PG8_WAIT_V(6); PG8_BAR; PG8_MMA(1, 1, At, B1); PG8_BAR;
            }
        }
        if constexpr (ALIGN_EPI) { if (wr == 0) PG8_BAR; }
        if constexpr (!Epi::AFTER_DRAIN) { E(acc, cur, wr, wc, fr, fq); S.done(cur); }
        if (!has_next) break;
#pragma unroll
        for (int a = 0; a < 2; ++a)
#pragma unroll
            for (int b = 0; b < 2; ++b)
#pragma unroll
                for (int m = 0; m < 4; ++m)
#pragma unroll
                    for (int n = 0; n < 2; ++n) acc[a][b][m][n] = (f32x4){0.f, 0.f, 0.f, 0.f};
        cur = nxt; cA = nA; cB = nB; ++ui;
        if constexpr (ALIGN_EPI) { if (wr == 1) PG8_BAR; }
    }
    PG8_WAIT_V(0);
    if constexpr (!ALIGN_EPI) { if (wr == 0) PG8_BAR; }
    PG8_BAR;
    if constexpr (Epi::AFTER_DRAIN) { E.fused(acc, cur, wr, wc, fr, fq, lds, wid, lane); S.done(cur); }
#undef PG8_SA
#undef PG8_SB
#undef PG8_STAGE
#undef PG8_LDA
#undef PG8_LDB
#undef PG8_MMA
#undef PG8_WAIT_V
#undef PG8_WAIT_L
#undef PG8_BAR
#undef PG8_SCHED
}
}
#ifndef PROBE_PHASE
#define PROBE_PHASE -1
#endif

#define LAS __attribute__((address_space(3)))
typedef unsigned short bf16;
typedef short bf16x8 __attribute__((ext_vector_type(8)));
typedef float f32x2 __attribute__((ext_vector_type(2)));
typedef float f32x4 __attribute__((ext_vector_type(4)));
typedef float f32x16 __attribute__((ext_vector_type(16)));
typedef unsigned u32x2 __attribute__((ext_vector_type(2)));
typedef unsigned u32x4 __attribute__((ext_vector_type(4)));
typedef __bf16 bf16x2_t __attribute__((ext_vector_type(2)));

constexpr int D = 1024, NB = 8, SEQ = 4096, CTXL = 256, NLAT = NB * SEQ, NCTX = NB * CTXL, MTOT = NLAT + NCTX;
constexpr int DFF = 2816, UL = SEQ + CTXL, NCH = UL / 128;
constexpr float EPS = 1e-6f;
constexpr float QSCALE = 0.10206207261596575f * 1.4426950408889634f;
constexpr int NPHASE = 16;

constexpr size_t MiB = (size_t)1 << 20, KiB = 1024;
constexpr size_t WS_BAR = 1 * MiB, WS_ZERO_BYTES = 1 * MiB + 16 * KiB;
constexpr size_t WS_MOD = 0, WS_ROPE = 384 * KiB, WS_CD = 448 * KiB, WS_RSTDQ = 512 * KiB, WS_RSTDKV = 768 * KiB;
constexpr size_t WS_W1A = 2 * MiB, WS_W1B = 13 * MiB, WS_WIN = 18 * MiB + 512 * KiB, WS_WUQ = 24 * MiB, WS_WK = 25 * MiB + 512 * KiB, WS_WV = 25 * MiB + 768 * KiB,
                 WS_WOUT = 26 * MiB, WS_W2A = 28 * MiB, WS_W2B = 39 * MiB;
constexpr size_t WS_A = 45 * MiB;
constexpr size_t WS_B = 113 * MiB;
constexpr size_t WS_Z = WS_B, WS_XBCR = WS_B + 34 * MiB, WS_CQ = WS_B + 102 * MiB, WS_CKV = WS_B + 153 * MiB, WS_MISC = WS_B + 170 * MiB;
constexpr size_t WS_ST = WS_XBCR, WS_MIX = WS_XBCR, WS_HE = WS_CQ;
constexpr size_t WS_C = 300 * MiB;
constexpr size_t WS_XT = 436 * MiB, WS_BT = 470 * MiB, WS_CROW = 487 * MiB, WS_DT = 504 * MiB, WS_KPE = 506 * MiB + 256 * KiB, WS_END = 512 * MiB;
constexpr size_t WS_BROW = WS_A;
constexpr size_t OUT_Q = 0, OUT_KN = 48 * MiB, OUT_VT = 82 * MiB;
constexpr int LDS_BYTES = 163840, LDS_BST = LDS_BYTES - 64;

__device__ __forceinline__ unsigned pk2(float lo, float hi) { f32x2 v = {lo, hi}; bf16x2_t b = __builtin_convertvector(v, bf16x2_t); return __builtin_bit_cast(unsigned, b); }
__device__ __forceinline__ float bflo(unsigned w) { return __uint_as_float(w << 16); }
__device__ __forceinline__ float bfhi(unsigned w) { return __uint_as_float(w & 0xffff0000u); }
__device__ __forceinline__ float bf2f(bf16 u) { return __uint_as_float((unsigned)u << 16); }
__device__ __forceinline__ float silu_f(float x) { return x * __builtin_amdgcn_rcpf(1.f + __builtin_amdgcn_exp2f(-1.4426950408889634f * x)); }
__device__ __forceinline__ float wave_sum(float v) {
#pragma unroll
    for (int o = 1; o < 64; o <<= 1) v += __shfl_xor(v, o);
    return v;
}
__device__ __forceinline__ float incl_scan(float v, int lane) {
#pragma unroll
    for (int o = 1; o < 64; o <<= 1) { float t = __shfl_up(v, o); if (lane >= o) v += t; }
    return v;
}
#define LDS_FENCE() asm volatile("s_waitcnt lgkmcnt(0)" ::: "memory")
__device__ __forceinline__ int crow(int r, int hi) { return (r & 3) + 8 * (r >> 2) + 4 * hi; }
__device__ __forceinline__ bf16x8 pack8(float a0, float a1, float a2, float a3, float a4, float a5, float a6, float a7) {
    u32x4 w; w.x = pk2(a0, a1); w.y = pk2(a2, a3); w.z = pk2(a4, a5); w.w = pk2(a6, a7); return __builtin_bit_cast(bf16x8, w);
}

struct Args { const float* in[26]; float* out; unsigned char* ws; int ph_lo, ph_hi; };

namespace pg8 {
struct EpiSwiglu {
    static constexpr bool PERM = true, AFTER_DRAIN = false;
    bf16_t* O; int ldc;
    __device__ __forceinline__ void operator()(const f32x4 (&acc)[2][2][4][2], const Unit& u, int wr, int wc, int fr, int fq) const {
        const int row0 = u.pm * BM + wr * 64 + fr, col0 = u.pn * HALF + wc * 32 + 8 * fq;
#pragma unroll
        for (int ai = 0; ai < 2; ++ai)
#pragma unroll
            for (int m = 0; m < 4; ++m) {
                bf16_t* rowp = O + (size_t)(row0 + ai * HALF + m * 16) * ldc + col0;
                const f32x4 g0 = acc[ai][0][m][0], g1 = acc[ai][0][m][1], u0 = acc[ai][1][m][0], u1 = acc[ai][1][m][1];
                u32x4 w;
                w.x = cvt_pk_bf16(silu_f(g0[0]) * u0[0], silu_f(g0[1]) * u0[1]); w.y = cvt_pk_bf16(silu_f(g0[2]) * u0[2], silu_f(g0[3]) * u0[3]);
                w.z = cvt_pk_bf16(silu_f(g1[0]) * u1[0], silu_f(g1[1]) * u1[1]); w.w = cvt_pk_bf16(silu_f(g1[2]) * u1[2], silu_f(g1[3]) * u1[3]);
                *(u32x4*)rowp = w;
            }
    }
};
struct EpiRes {
    static constexpr bool PERM = false, AFTER_DRAIN = false;
    const float* base_lat; const float* base_ctx; float* out; const float* mod; int kg; float mul;
    __device__ __forceinline__ void operator()(const f32x4 (&acc)[2][2][4][2], const Unit& u, int wr, int wc, int fr, int fq) const {
        const int row0 = u.pm * BM + wr * 64 + fr, col0 = u.pn * BM + wc * 32 + 4 * fq;
        const int bb = u.pm < (NLAT / BM) ? u.pm / (SEQ / BM) : 8;
        const float* gp = mod + bb * 9216 + kg * 1024 + col0;
        f32x4 gv[2][2];
#pragma unroll
        for (int bj = 0; bj < 2; ++bj)
#pragma unroll
            for (int n = 0; n < 2; ++n) gv[bj][n] = *(const f32x4*)(gp + bj * HALF + n * 16) * mul;
#pragma unroll
        for (int ai = 0; ai < 2; ++ai)
#pragma unroll
            for (int m = 0; m < 4; ++m) {
                const int r = row0 + ai * HALF + m * 16;
                const float* bp = (r < NLAT ? base_lat + (size_t)r * D : base_ctx + (size_t)(r - NLAT) * D) + col0;
                float* op = out + (size_t)r * D + col0;
#pragma unroll
                for (int bj = 0; bj < 2; ++bj)
#pragma unroll
                    for (int n = 0; n < 2; ++n) { const f32x4 bs = *(const f32x4*)(bp + bj * HALF + n * 16); *(f32x4*)(op + bj * HALF + n * 16) = bs + gv[bj][n] * acc[ai][bj][m][n]; }
            }
    }
};
struct EpiSplit {
    static constexpr bool PERM = true, AFTER_DRAIN = false;
    bf16_t *zb, *xbcr, *cq, *ckv, *misc;
    __device__ __forceinline__ void operator()(const f32x4 (&acc)[2][2][4][2], const Unit& u, int wr, int wc, int fr, int fq) const {
        const int pn = u.pn; bf16_t* base; int ld;
        if (pn < 2) { base = zb + pn * 256; ld = 512; } else if (pn < 6) { base = xbcr + (pn - 2) * 256; ld = 1024; } else if (pn < 9) { base = cq + (pn - 6) * 256; ld = 768; }
        else if (pn == 9) { base = ckv; ld = 256; } else { base = misc; ld = 256; }
        const int row0 = u.pm * BM + wr * 64 + fr, col0 = wc * 32 + 8 * fq;
#pragma unroll
        for (int ai = 0; ai < 2; ++ai)
#pragma unroll
            for (int m = 0; m < 4; ++m) {
                bf16_t* rowp = base + (size_t)(row0 + ai * HALF + m * 16) * ld + col0;
#pragma unroll
                for (int bj = 0; bj < 2; ++bj) { const f32x4 v0 = acc[ai][bj][m][0], v1 = acc[ai][bj][m][1];
                    u32x4 w; w.x = cvt_pk_bf16(v0[0], v0[1]); w.y = cvt_pk_bf16(v0[2], v0[3]); w.z = cvt_pk_bf16(v1[0], v1[1]); w.w = cvt_pk_bf16(v1[2], v1[3]);
                    *(u32x4*)(rowp + bj * HALF) = w; }
            }
    }
};
struct EpiScale {
    static constexpr bool PERM = true, AFTER_DRAIN = false;
    bf16_t* O; int ldc; const float* rs; const float* cs;
    __device__ __forceinline__ void operator()(const f32x4 (&acc)[2][2][4][2], const Unit& u, int wr, int wc, int fr, int fq) const {
        const int row0 = u.pm * BM + wr * 64 + fr, col0 = u.pn * BM + wc * 32 + 8 * fq;
        f32x4 cv[2][2];
#pragma unroll
        for (int bj = 0; bj < 2; ++bj)
#pragma unroll
            for (int n = 0; n < 2; ++n) cv[bj][n] = cs ? *(const f32x4*)(cs + col0 + bj * HALF + 4 * n) : (f32x4){1.f, 1.f, 1.f, 1.f};
#pragma unroll
        for (int ai = 0; ai < 2; ++ai)
#pragma unroll
            for (int m = 0; m < 4; ++m) {
                const int r = row0 + ai * HALF + m * 16; const float rv = rs ? rs[r] : 1.f;
                bf16_t* rowp = O + (size_t)r * ldc + col0;
#pragma unroll
                for (int bj = 0; bj < 2; ++bj) { const f32x4 v0 = acc[ai][bj][m][0] * cv[bj][0] * rv, v1 = acc[ai][bj][m][1] * cv[bj][1] * rv;
                    u32x4 w; w.x = cvt_pk_bf16(v0[0], v0[1]); w.y = cvt_pk_bf16(v0[2], v0[3]); w.z = cvt_pk_bf16(v1[0], v1[1]); w.w = cvt_pk_bf16(v1[2], v1[3]);
                    *(u32x4*)(rowp + bj * HALF) = w; }
            }
    }
};
struct EpiQ {
    static constexpr bool PERM = true, AFTER_DRAIN = false;
    bf16_t* O; const float* rs; const f32x2* rope;
    __device__ __forceinline__ void operator()(const f32x4 (&acc)[2][2][4][2], const Unit& u, int wr, int wc, int fr, int fq) const {
        const int row0 = u.pm * BM + wr * 64 + fr, col0 = u.pn * BM + wc * 32 + 8 * fq;
#pragma unroll
        for (int ai = 0; ai < 2; ++ai)
#pragma unroll
            for (int m = 0; m < 4; ++m) {
                const int r = row0 + ai * HALF + m * 16; const float rv = rs[r] * QSCALE; const int t = r & (SEQ - 1);
                bf16_t* rowp = O + (size_t)r * 768 + col0;
#pragma unroll
                for (int bj = 0; bj < 2; ++bj) {
                    f32x4 v0 = acc[ai][bj][m][0] * rv, v1 = acc[ai][bj][m][1] * rv;
                    const int cc = (col0 + bj * HALF) % 96;
                    if (cc >= 64) {
                        const int q = cc - 64, half = q >> 4, jj = (q & 15) >> 1, pos = half ? (t & 63) : (t >> 6);
                        const f32x2* rp = rope + pos * 8 + jj;
                        const f32x2 c0 = rp[0], c1 = rp[1], c2 = rp[2], c3 = rp[3];
                        f32x4 o0, o1;
                        o0[0] = v0[0] * c0.x - v0[1] * c0.y; o0[1] = v0[0] * c0.y + v0[1] * c0.x; o0[2] = v0[2] * c1.x - v0[3] * c1.y; o0[3] = v0[2] * c1.y + v0[3] * c1.x;
                        o1[0] = v1[0] * c2.x - v1[1] * c2.y; o1[1] = v1[0] * c2.y + v1[1] * c2.x; o1[2] = v1[2] * c3.x - v1[3] * c3.y; o1[3] = v1[2] * c3.y + v1[3] * c3.x;
                        v0 = o0; v1 = o1;
                    }
                    u32x4 w; w.x = cvt_pk_bf16(v0[0], v0[1]); w.y = cvt_pk_bf16(v0[2], v0[3]); w.z = cvt_pk_bf16(v1[0], v1[1]); w.w = cvt_pk_bf16(v1[2], v1[3]);
                    *(u32x4*)(rowp + bj * HALF) = w;
                }
            }
    }
};
}

__device__ __forceinline__ int cmap(int id, int n) {
    switch (id) {
    case 0: return ((n >> 7) & 1) * DFF + (n >> 8) * 128 + (n & 127);
    case 1: return n;
    case 2: {
        if (n < 1536) return n;
        if (n < 2304) return 1552 + (n - 1536);
        if (n < 2560) return 2320 + (n - 2304);
        if (n < 2592) { const int q = n - 2560, half = q >> 4, jj = (q & 15) >> 1, which = q & 1; return 2576 + half * 16 + which * 8 + jj; }
        if (n < 2608) return 1536 + (n - 2592);
        return -1; }
    case 3: { const int hh = n / 96, cc = n % 96; if (cc < 64) return hh * 96 + cc;
        const int q = cc - 64, half = q >> 4, jj = (q & 15) >> 1, which = q & 1; return hh * 96 + 64 + half * 16 + which * 8 + jj; }
    case 4: return (n >> 6) * 128 + (n & 63);
    default: return (n >> 6) * 128 + 64 + (n & 63);
    }
}
__device__ __forceinline__ void titem(const float* W, int K, int N, bf16* WT, const float* gk, LAS float* scr, int item, int nblk, int lane, int id, float mulc = 1.f) {
    const int kb = item / nblk, nb = item % nblk, k0 = 64 * kb, n0 = 32 * nb;
    const int src = cmap(id, n0 + (lane & 31));
#pragma unroll 8
    for (int i = 0; i < 32; ++i) { const int kk = 2 * i + (lane >> 5); float v = src >= 0 ? W[(size_t)(k0 + kk) * N + src] : 0.f; if (gk) v *= gk[k0 + kk] * mulc; scr[kk * 33 + (lane & 31)] = v; }
    LDS_FENCE();
    const int c = lane & 7;
#pragma unroll
    for (int j = 0; j < 4; ++j) { const int n = (lane >> 3) + 8 * j; const LAS float* s = scr + (8 * c) * 33 + n;
        u32x4 o; o.x = pk2(s[0 * 33], s[1 * 33]); o.y = pk2(s[2 * 33], s[3 * 33]); o.z = pk2(s[4 * 33], s[5 * 33]); o.w = pk2(s[6 * 33], s[7 * 33]);
        *(u32x4*)(WT + (size_t)(n0 + n) * K + k0 + 8 * c) = o; }
    LDS_FENCE();
}
__device__ __forceinline__ void phase0(const Args& a, LAS unsigned char* lds, int gw, int NGW, int tid, int lane, int wave) {
    unsigned char* ws = a.ws;
    LAS float* scr = (LAS float*)(lds + wave * 16384);
    if (blockIdx.x < 144) {
        float* MOD = (float*)(ws + WS_MOD);
        const float* cin = a.in[1]; const float* cctx = a.in[3]; const float* wada = a.in[4]; const float* bada = a.in[5];
        const int n = blockIdx.x * 64 + lane, kw = wave * 128;
        float acc[9];
#pragma unroll
        for (int bb = 0; bb < 9; ++bb) acc[bb] = 0.f;
#pragma unroll 1
        for (int hf = 0; hf < 2; ++hf) {
            const int k0 = kw + 64 * hf;
            float sv[9];
#pragma unroll
            for (int bb = 0; bb < 8; ++bb) sv[bb] = silu_f(cin[bb * 1024 + k0 + lane]);
            sv[8] = silu_f(cctx[k0 + lane]);
#pragma unroll 16
            for (int k = 0; k < 64; ++k) {
                const float w = wada[(size_t)(k0 + k) * 9216 + n];
#pragma unroll
                for (int bb = 0; bb < 9; ++bb) acc[bb] += w * __shfl(sv[bb], k);
            }
        }
        LAS float* red = (LAS float*)lds;
#pragma unroll
        for (int bb = 0; bb < 9; ++bb) red[(wave * 9 + bb) * 64 + lane] = acc[bb];
        __syncthreads();
        for (int o = tid; o < 576; o += 512) { float t = bada[blockIdx.x * 64 + (o & 63)];
#pragma unroll
            for (int w = 0; w < 8; ++w) t += red[w * 576 + o];
            MOD[(o >> 6) * 9216 + blockIdx.x * 64 + (o & 63)] = t; }
        __syncthreads();
    }
    constexpr int I_W1A = 16 * 176, I_W1B = 44 * 32, I_WIN = 16 * 88, I_WUQ = 12 * 24, I_WK = 4 * 16, I_WOUT = 16 * 32;
    constexpr int NITEMS = 2 * I_W1A + 2 * I_W1B + I_WIN + I_WUQ + 2 * I_WK + I_WOUT;
    for (int rep0 = 0; rep0 < (PROBE_PHASE == 201 ? 2 : 1); ++rep0)
    for (int it = gw; it < NITEMS; it += NGW) {
        int r = it;
        if (r < I_W1A) { titem(a.in[7], 1024, 5632, (bf16*)(ws + WS_W1A), nullptr, scr, r, 176, lane, 0); continue; } r -= I_W1A;
        if (r < I_W1A) { titem(a.in[23], 1024, 5632, (bf16*)(ws + WS_W2A), nullptr, scr, r, 176, lane, 0); continue; } r -= I_W1A;
        if (r < I_W1B) { titem(a.in[8], 2816, 1024, (bf16*)(ws + WS_W1B), nullptr, scr, r, 32, lane, 1); continue; } r -= I_W1B;
        if (r < I_W1B) { titem(a.in[24], 2816, 1024, (bf16*)(ws + WS_W2B), nullptr, scr, r, 32, lane, 1); continue; } r -= I_W1B;
        if (r < I_WIN) { titem(a.in[10], 1024, 2608, (bf16*)(ws + WS_WIN), nullptr, scr, r, 88, lane, 2); continue; } r -= I_WIN;
        if (r < I_WUQ) { titem(a.in[18], 768, 768, (bf16*)(ws + WS_WUQ), a.in[17], scr, r, 24, lane, 3, QSCALE); continue; } r -= I_WUQ;
        if (r < I_WK) { titem(a.in[20], 256, 1024, (bf16*)(ws + WS_WK), a.in[19], scr, r, 16, lane, 4); continue; } r -= I_WK;
        if (r < I_WK) { titem(a.in[20], 256, 1024, (bf16*)(ws + WS_WV), a.in[19], scr, r, 16, lane, 5); continue; } r -= I_WK;
        titem(a.in[21], 1024, 1024, (bf16*)(ws + WS_WOUT), nullptr, scr, r, 32, lane, 1);
    }
    if (blockIdx.x == 0) {
        const int pos = tid >> 3, jj = tid & 7; const float inv = __builtin_amdgcn_exp2f(-(float)jj * 1.6609640474436813f);
        const float ang = (float)pos * inv;
        ((f32x2*)(ws + WS_ROPE))[tid] = (f32x2){__cosf(ang), __sinf(ang)};
    }
}

__device__ __forceinline__ void norm_rows(const float* src_lat, const float* src_ctx, int nrows, const float* gvec, const float* mod, int kshift, bf16* out, int gw, int NGW, int lane) {
    for (int row = gw; row < nrows; row += NGW) {
        const float* xr = (row < NLAT ? src_lat + (size_t)row * D : src_ctx + (size_t)(row - NLAT) * D) + 4 * lane;
        const int bb = row < NLAT ? row / SEQ : 8;
        const float* sh = mod + bb * 9216 + kshift * 1024 + 4 * lane; const float* sc = sh + 1024;
        f32x4 v[4]; float s = 0.f;
#pragma unroll
        for (int j = 0; j < 4; ++j) { v[j] = *(const f32x4*)(xr + 256 * j); s += (v[j][0] * v[j][0] + v[j][1] * v[j][1]) + (v[j][2] * v[j][2] + v[j][3] * v[j][3]); }
        const float rstd = 1.0f / sqrtf(wave_sum(s) * (1.f / D) + EPS);
        bf16* orow = out + (size_t)row * D + 4 * lane;
#pragma unroll
        for (int j = 0; j < 4; ++j) {
            const f32x4 g = *(const f32x4*)(gvec + 4 * lane + 256 * j), scv = *(const f32x4*)(sc + 256 * j), shv = *(const f32x4*)(sh + 256 * j);
            const f32x4 y = (v[j] * rstd) * g * (scv + 1.f) + shv;
            u32x2 w; w.x = pk2(y[0], y[1]); w.y = pk2(y[2], y[3]); *(u32x2*)(orow + 256 * j) = w;
        }
    }
}
__device__ __forceinline__ void final_norm_rows(float* io, const float* gvec, int gw, int NGW, int lane) {
    for (int row = gw; row < NLAT; row += NGW) {
        float* xr = io + (size_t)row * D + 4 * lane;
        f32x4 v[4]; float s = 0.f;
#pragma unroll
        for (int j = 0; j < 4; ++j) { v[j] = *(const f32x4*)(xr + 256 * j); s += (v[j][0] * v[j][0] + v[j][1] * v[j][1]) + (v[j][2] * v[j][2] + v[j][3] * v[j][3]); }
        const float rstd = 1.0f / sqrtf(wave_sum(s) * (1.f / D) + EPS);
#pragma unroll
        for (int j = 0; j < 4; ++j) { const f32x4 g = *(const f32x4*)(gvec + 4 * lane + 256 * j); *(f32x4*)(xr + 256 * j) = (v[j] * rstd) * g; }
    }
}

__device__ __forceinline__ float softplus_f(float x) { return fmaxf(x, 0.f) + log1pf(__expf(-fabsf(x))); }
__device__ __forceinline__ void phase6(const Args& a, LAS unsigned char* lds, int G, int bx, int tid, int lane, int wave) {
    unsigned char* ws = a.ws;
    const bf16* XBCR = (const bf16*)(ws + WS_XBCR); const bf16* MISC = (const bf16*)(ws + WS_MISC); const bf16* CQ = (const bf16*)(ws + WS_CQ); const bf16* CKV = (const bf16*)(ws + WS_CKV);
    bf16* XT = (bf16*)(ws + WS_XT); bf16* BT = (bf16*)(ws + WS_BT); bf16* BROW = (bf16*)(ws + WS_BROW); bf16* CROW = (bf16*)(ws + WS_CROW); bf16* KPE = (bf16*)(ws + WS_KPE);
    float* DT = (float*)(ws + WS_DT); float* RSTDQ = (float*)(ws + WS_RSTDQ); float* RSTDKV = (float*)(ws + WS_RSTDKV); const f32x2* ROPE = (const f32x2*)(ws + WS_ROPE);
    const float* conv_w = a.in[11]; const float* conv_b = a.in[12]; const float* dt_bias = a.in[13];
    LAS bf16* T = (LAS bf16*)lds;
    const int ch = 4 * (tid & 255), tseg = (tid >> 8) * 32;
    float cw[5][4], cb[4];
#pragma unroll
    for (int k = 0; k < 5; ++k) { const f32x4 w = *(const f32x4*)(conv_w + k * 1024 + ch); cw[k][0] = w[0]; cw[k][1] = w[1]; cw[k][2] = w[2]; cw[k][3] = w[3]; }
    { const f32x4 w = *(const f32x4*)(conv_b + ch); cb[0] = w[0]; cb[1] = w[1]; cb[2] = w[2]; cb[3] = w[3]; }
    for (int unit = bx; unit < NB * 68; unit += G) {
        const int b = unit / 68, ut = unit % 68, u0 = ut * 64;
        const int seg_lo = u0 < CTXL ? 0 : CTXL, seg_hi = u0 < CTXL ? CTXL : UL;
        const int rb = u0 < CTXL ? NLAT + b * CTXL : b * SEQ - CTXL;
#define P6_LD(u) (((u) >= seg_lo && (u) < seg_hi) ? *(const u32x2*)(XBCR + (size_t)(rb + (u)) * 1024 + ch) : (u32x2){0u, 0u})
        const int ub = u0 + tseg;
        u32x2 xm2 = P6_LD(ub - 2), xm1 = P6_LD(ub - 1), x0 = P6_LD(ub), xp1 = P6_LD(ub + 1);
#pragma unroll 16
        for (int t = 0; t < 32; ++t) {
            const u32x2 xp2 = P6_LD(ub + t + 2);
            const float y0 = cb[0] + cw[0][0] * bflo(xm2.x) + cw[1][0] * bflo(xm1.x) + cw[2][0] * bflo(x0.x) + cw[3][0] * bflo(xp1.x) + cw[4][0] * bflo(xp2.x);
            const float y1 = cb[1] + cw[0][1] * bfhi(xm2.x) + cw[1][1] * bfhi(xm1.x) + cw[2][1] * bfhi(x0.x) + cw[3][1] * bfhi(xp1.x) + cw[4][1] * bfhi(xp2.x);
            const float y2 = cb[2] + cw[0][2] * bflo(xm2.y) + cw[1][2] * bflo(xm1.y) + cw[2][2] * bflo(x0.y) + cw[3][2] * bflo(xp1.y) + cw[4][2] * bflo(xp2.y);
            const float y3 = cb[3] + cw[0][3] * bfhi(xm2.y) + cw[1][3] * bfhi(xm1.y) + cw[2][3] * bfhi(x0.y) + cw[3][3] * bfhi(xp1.y) + cw[4][3] * bfhi(xp2.y);
            u32x2 pk; pk.x = pk2(silu_f(y0), silu_f(y1)); pk.y = pk2(silu_f(y2), silu_f(y3));
            const int tt = tseg + t;
            if (ch < 768) { T[ch * 72 + tt] = (bf16)(pk.x & 0xffffu); T[(ch + 1) * 72 + tt] = (bf16)(pk.x >> 16); T[(ch + 2) * 72 + tt] = (bf16)(pk.y & 0xffffu); T[(ch + 3) * 72 + tt] = (bf16)(pk.y >> 16); }
            if (ch >= 512) { bf16* dst = ch < 768 ? BROW + (ch - 512) : CROW + (ch - 768); *(u32x2*)(dst + (size_t)(b * UL + u0 + tt) * 256) = pk; }
            xm2 = xm1; xm1 = x0; x0 = xp1; xp1 = xp2;
        }
#undef P6_LD
        __syncthreads();
#pragma unroll
        for (int i = 0; i < 12; ++i) { const int q = tid + 512 * i, c = q >> 3, part = q & 7;
            const u32x4 v = *(const LAS u32x4*)(T + c * 72 + part * 8);
            bf16* dst = c < 512 ? XT + (size_t)(b * 512 + c) * UL : BT + (size_t)(b * 256 + c - 512) * UL;
            *(u32x4*)(dst + u0 + part * 8) = v; }
        {
            const int uu = tid >> 3, k = (tid & 7) * 2; const size_t row = (size_t)(rb + u0 + uu);
            const unsigned raw = *(const unsigned*)(MISC + row * 256 + 32 + k);
            f32x2 o; o.x = softplus_f(bflo(raw) + dt_bias[k]); o.y = softplus_f(bfhi(raw) + dt_bias[k + 1]);
            *(f32x2*)(DT + (size_t)(b * UL + u0 + uu) * 16 + k) = o;
        }
        {
            const int uu = tid >> 3, pp = (tid & 7) * 2; const size_t row = (size_t)(rb + u0 + uu);
            u32x2 raw = *(const u32x2*)(MISC + row * 256 + 2 * pp);
            if (u0 >= CTXL) {
                const int t = u0 + uu - CTXL, half = pp >> 3, jj = pp & 7, pos = half ? (t & 63) : (t >> 6);
                const f32x2 c0 = ROPE[pos * 8 + jj], c1 = ROPE[pos * 8 + jj + 1];
                const float a0 = bflo(raw.x), a1 = bfhi(raw.x), a2 = bflo(raw.y), a3 = bfhi(raw.y);
                raw.x = pk2(a0 * c0.x - a1 * c0.y, a0 * c0.y + a1 * c0.x); raw.y = pk2(a2 * c1.x - a3 * c1.y, a2 * c1.y + a3 * c1.x);
            }
            *(u32x2*)(KPE + row * 32 + 2 * pp) = raw;
        }
#pragma unroll 2
        for (int rr = 0; rr < 8; ++rr) {
            const size_t row = (size_t)(rb + u0 + wave * 8 + rr);
            { const u32x2 w = *(const u32x2*)(CKV + row * 256 + 4 * lane); const float c0 = bflo(w.x), c1 = bfhi(w.x), c2 = bflo(w.y), c3 = bfhi(w.y);
              const float s = wave_sum((c0 * c0 + c1 * c1) + (c2 * c2 + c3 * c3)); if (lane == 0) RSTDKV[row] = 1.0f / sqrtf(s * (1.f / 256.f) + EPS); }
            if (u0 >= CTXL) { float s = 0.f;
#pragma unroll
                for (int i = 0; i < 3; ++i) { const u32x2 w = *(const u32x2*)(CQ + row * 768 + 4 * lane + 256 * i); const float c0 = bflo(w.x), c1 = bfhi(w.x), c2 = bflo(w.y), c3 = bfhi(w.y);
                    s += (c0 * c0 + c1 * c1) + (c2 * c2 + c3 * c3); }
                s = wave_sum(s); if (lane == 0) RSTDQ[row] = 1.0f / sqrtf(s * (1.f / 768.f) + EPS); }
        }
        __syncthreads();
    }
}

__device__ __forceinline__ void acum_wave(const float* DT, size_t dtrow0, int h, float anf, float anb, LAS float* sc, int lane) {
    const float df0 = DT[(dtrow0 + lane) * 16 + h], df1 = DT[(dtrow0 + 64 + lane) * 16 + h];
    const float db0 = DT[(dtrow0 + lane) * 16 + 8 + h], db1 = DT[(dtrow0 + 64 + lane) * 16 + 8 + h];
    const float f0 = incl_scan(df0 * anf, lane); float f1 = incl_scan(df1 * anf, lane); f1 += __shfl(f0, 63);
    const float a0 = db0 * anb, a1 = db1 * anb; const float g0 = incl_scan(a0, lane), g1 = incl_scan(a1, lane);
    const float t0 = __shfl(g0, 63), t1 = __shfl(g1, 63), tot = t0 + t1;
    sc[lane] = f0; sc[64 + lane] = f1; sc[128 + lane] = tot - g0 + a0; sc[192 + lane] = t1 - g1 + a1;
    sc[256 + lane] = df0; sc[320 + lane] = df1; sc[384 + lane] = db0; sc[448 + lane] = db1;
    LDS_FENCE();
}
#define MFMA32(a, b, c) __builtin_amdgcn_mfma_f32_32x32x16_bf16((a), (b), (c), 0, 0, 0)
__device__ __forceinline__ f32x16 zero16() { f32x16 z;
#pragma unroll
    for (int r = 0; r < 16; ++r) z[r] = 0.f; return z; }

constexpr int S3_STR = 136, S3_TILE = 128 * S3_STR * 2;
constexpr int S3_CL = 0, S3_BL = 2 * S3_TILE, S3_SC = 4 * S3_TILE, S3_SS = S3_SC + 16384;
__device__ __forceinline__ void phase8(const Args& a, LAS unsigned char* lds, int G, int bx, int tid, int lane, int wave) {
    unsigned char* ws = a.ws;
    const bf16* XT = (const bf16*)(ws + WS_XT); const bf16* BT = (const bf16*)(ws + WS_BT); const float* DT = (const float*)(ws + WS_DT);
    bf16* ST = (bf16*)(ws + WS_ST); float* CD = (float*)(ws + WS_CD);
    LAS float* sc = (LAS float*)(lds + S3_SC) + wave * 512;
    const int h = wave, g = h >> 2, r32 = lane & 31, hi = lane >> 5;
    const float anf = -__expf(a.in[14][h]), anb = -__expf(a.in[14][8 + h]);
    for (int unit = bx; unit < NB * NCH; unit += G) {
        const int b = unit / NCH, c = unit % NCH;
#pragma unroll
        for (int it = 0; it < 8; ++it) { const int q = tid + 512 * it, n = q >> 4, k16 = q & 15;
            const u32x4 v = *(const u32x4*)(BT + (size_t)(b * 256 + n) * UL + c * 128 + 8 * k16);
            *(LAS u32x4*)(lds + (n * S3_STR + 8 * k16) * 2) = v; }
        acum_wave(DT, (size_t)b * UL + c * 128, h, anf, anb, sc, lane);
        const float af_last = sc[127], ab_first = sc[128];
#pragma unroll
        for (int hf = 0; hf < 2; ++hf) { const int j = lane + 64 * hf;
            const float wf = __expf(af_last - sc[j]) * sc[256 + j], wb = __expf(ab_first - sc[128 + j]) * sc[384 + j];
            sc[256 + j] = wf; sc[384 + j] = wb; }
        if (lane == 0) { CD[((b * 2 + 0) * 8 + h) * NCH + c] = __expf(af_last); CD[((b * 2 + 1) * 8 + h) * NCH + c] = __expf(ab_first); }
        __syncthreads();
        const bf16* xbase = XT + (size_t)(b * 512 + h * 64 + r32) * UL + c * 128 + 8 * hi;
        const LAS unsigned char* btl = lds + ((g * 128 + r32) * S3_STR + 8 * hi) * 2;
        const LAS float* wfp = sc + 256 + 8 * hi; const LAS float* wbp = sc + 384 + 8 * hi;
#pragma unroll 1
        for (int half = 0; half < 2; ++half) {
            f32x16 accf[2][2], accb[2][2];
#pragma unroll
            for (int nn = 0; nn < 2; ++nn) { accf[nn][0] = zero16(); accf[nn][1] = zero16(); accb[nn][0] = zero16(); accb[nn][1] = zero16(); }
#pragma unroll 2
            for (int s = 0; s < 8; ++s) {
                const f32x4 fa = *(const LAS f32x4*)(wfp + 16 * s), fb = *(const LAS f32x4*)(wfp + 16 * s + 4), ba = *(const LAS f32x4*)(wbp + 16 * s), bb = *(const LAS f32x4*)(wbp + 16 * s + 4);
                bf16x8 xwf[2], xwb[2];
#pragma unroll
                for (int pb = 0; pb < 2; ++pb) { const u32x4 raw = *(const u32x4*)(xbase + (size_t)pb * 32 * UL + 16 * s);
                    const float x0 = bflo(raw.x), x1 = bfhi(raw.x), x2 = bflo(raw.y), x3 = bfhi(raw.y), x4 = bflo(raw.z), x5 = bfhi(raw.z), x6 = bflo(raw.w), x7 = bfhi(raw.w);
                    xwf[pb] = pack8(x0 * fa[0], x1 * fa[1], x2 * fa[2], x3 * fa[3], x4 * fb[0], x5 * fb[1], x6 * fb[2], x7 * fb[3]);
                    xwb[pb] = pack8(x0 * ba[0], x1 * ba[1], x2 * ba[2], x3 * ba[3], x4 * bb[0], x5 * bb[1], x6 * bb[2], x7 * bb[3]); }
#pragma unroll
                for (int nn = 0; nn < 2; ++nn) { const bf16x8 bt = *(const LAS bf16x8*)(btl + ((2 * half + nn) * 32 * S3_STR + 16 * s) * 2);
                    accf[nn][0] = MFMA32(bt, xwf[0], accf[nn][0]); accf[nn][1] = MFMA32(bt, xwf[1], accf[nn][1]);
                    accb[nn][0] = MFMA32(bt, xwb[0], accb[nn][0]); accb[nn][1] = MFMA32(bt, xwb[1], accb[nn][1]); }
            }
            bf16* sof = ST + ((size_t)(((b * 2 + 0) * 8 + h) * NCH + c) * 64) * 128; bf16* sob = ST + ((size_t)(((b * 2 + 1) * 8 + h) * NCH + c) * 64) * 128;
#pragma unroll
            for (int nn = 0; nn < 2; ++nn)
#pragma unroll
                for (int pb = 0; pb < 2; ++pb)
#pragma unroll
                    for (int g4 = 0; g4 < 4; ++g4) { const size_t off = (size_t)(32 * pb + r32) * 128 + 32 * (2 * half + nn) + 8 * g4 + 4 * hi;
                        u32x2 o; o.x = pk2(accf[nn][pb][4 * g4], accf[nn][pb][4 * g4 + 1]); o.y = pk2(accf[nn][pb][4 * g4 + 2], accf[nn][pb][4 * g4 + 3]); *(u32x2*)(sof + off) = o;
                        o.x = pk2(accb[nn][pb][4 * g4], accb[nn][pb][4 * g4 + 1]); o.y = pk2(accb[nn][pb][4 * g4 + 2], accb[nn][pb][4 * g4 + 3]); *(u32x2*)(sob + off) = o; }
        }
        __syncthreads();
    }
}
__device__ __forceinline__ void phase9(const Args& a, int G, int bx, int tid) {
    unsigned char* ws = a.ws;
    const bf16* ST = (const bf16*)(ws + WS_ST); bf16* HE = (bf16*)(ws + WS_HE); const float* CD = (const float*)(ws + WS_CD);
    for (int idx = bx * 512 + tid; idx < NB * 2 * 8 * 2048; idx += G * 512) {
        const int e = (idx & 2047) * 4, bdh = idx >> 11, dir = (bdh >> 3) & 1;
        const bf16* st = ST + (size_t)bdh * NCH * 8192 + e; bf16* he = HE + (size_t)bdh * 32 * 8192 + e; const float* cd = CD + bdh * NCH;
#define P9_LD(c) (*(const u32x2*)(st + (size_t)(c) * 8192))
#define P9_STEP(c) do { const u32x2 w_ = P9_LD(c); const float d_ = cd[c]; h0 = d_ * h0 + bflo(w_.x); h1 = d_ * h1 + bfhi(w_.x); h2 = d_ * h2 + bflo(w_.y); h3 = d_ * h3 + bfhi(w_.y); } while (0)
#define P9_OUT(c) do { u32x2 o_; o_.x = pk2(h0, h1); o_.y = pk2(h2, h3); *(u32x2*)(he + (size_t)((c) - 2) * 8192) = o_; } while (0)
        float h0 = 0.f, h1 = 0.f, h2 = 0.f, h3 = 0.f;
        if (dir == 0) {
            P9_STEP(0); P9_STEP(1);
#pragma unroll 8
            for (int c = 2; c < NCH; ++c) { P9_OUT(c); P9_STEP(c); }
        } else {
            P9_STEP(1); P9_STEP(0);
#pragma unroll 8
            for (int c = NCH - 1; c >= 2; --c) { P9_OUT(c); P9_STEP(c); }
        }
#undef P9_LD
#undef P9_STEP
#undef P9_OUT
    }
}
__device__ __forceinline__ void phase10_ssd(const Args& a, LAS unsigned char* lds, int G, int bx, int tid, int lane, int wave) {
    unsigned char* ws = a.ws;
    const bf16* XT = (const bf16*)(ws + WS_XT); const bf16* BROW = (const bf16*)(ws + WS_BROW); const bf16* CROW = (const bf16*)(ws + WS_CROW); const float* DT = (const float*)(ws + WS_DT);
    const bf16* HE = (const bf16*)(ws + WS_HE); const bf16* Z = (const bf16*)(ws + WS_Z); bf16* MIX = (bf16*)(ws + WS_MIX);
    LAS float* sc = (LAS float*)(lds + S3_SC) + wave * 512;
    LAS float* SS = (LAS float*)(lds + S3_SS);
    const int h = wave, g = h >> 2, r32 = lane & 31, hi = lane >> 5;
    const float anf = -__expf(a.in[14][h]), anb = -__expf(a.in[14][8 + h]);
    const float dskip = a.in[15][h]; const float* snorm = a.in[16] + h * 64;
    for (int unit = bx; unit < NB * 32; unit += G) {
        const int b = unit >> 5, lc = unit & 31, c = lc + 2; const size_t u0 = (size_t)b * UL + c * 128;
#pragma unroll
        for (int it = 0; it < 8; ++it) { const int q = tid + 512 * it, i = q >> 5, ch16 = q & 31, off = ((ch16 >> 4) * S3_TILE) + (i * S3_STR + (ch16 & 15) * 8) * 2;
            const u32x4 vc = *(const u32x4*)(CROW + (u0 + i) * 256 + 8 * ch16), vb = *(const u32x4*)(BROW + (u0 + i) * 256 + 8 * ch16);
            *(LAS u32x4*)(lds + S3_CL + off) = vc; *(LAS u32x4*)(lds + S3_BL + off) = vb; }
        acum_wave(DT, u0, h, anf, anb, sc, lane);
        {
            float wfv[2], wbv[2];
#pragma unroll
            for (int hf = 0; hf < 2; ++hf) { const int j = lane + 64 * hf, jb = j >> 5;
                const float afb = jb ? sc[32 * jb - 1] : 0.f, abb = jb < 3 ? sc[128 + 32 * jb + 32] : 0.f;
                wfv[hf] = __expf(afb - sc[j]) * sc[256 + j]; wbv[hf] = __expf(abb - sc[128 + j]) * sc[384 + j]; }
            LDS_FENCE();
#pragma unroll
            for (int hf = 0; hf < 2; ++hf) { const int j = lane + 64 * hf; sc[256 + j] = wfv[hf]; sc[384 + j] = wbv[hf]; }
        }
        __syncthreads();
        const LAS unsigned char* CLg = lds + S3_CL + g * S3_TILE + (r32 * S3_STR + 8 * hi) * 2;
        const LAS unsigned char* BLg = lds + S3_BL + g * S3_TILE + (r32 * S3_STR + 8 * hi) * 2;
#pragma unroll 1
        for (int ibp = 0; ibp < 2; ++ibp) {
        f32x16 acc[2][2];
#pragma unroll
        for (int k = 0; k < 2; ++k) { acc[k][0] = zero16(); acc[k][1] = zero16(); }
#ifndef NO_DIAG
#pragma unroll 1
        for (int jb = 0; jb < 4; ++jb) {
            bf16x8 xa[2][2];
#pragma unroll
            for (int pb = 0; pb < 2; ++pb) {
                const bf16* xp = XT + (size_t)(b * 512 + h * 64 + 32 * pb + r32) * UL + c * 128 + 32 * jb + 4 * hi;
                const u32x2 a0 = *(const u32x2*)(xp), a1 = *(const u32x2*)(xp + 8), a2 = *(const u32x2*)(xp + 16), a3 = *(const u32x2*)(xp + 24);
                xa[pb][0] = __builtin_bit_cast(bf16x8, (u32x4){a0.x, a0.y, a1.x, a1.y}); xa[pb][1] = __builtin_bit_cast(bf16x8, (u32x4){a2.x, a2.y, a3.x, a3.y});
            }
#pragma unroll
            for (int k = 0; k < 2; ++k) {
                const int ib = 2 * ibp + k;
                f32x16 ga = zero16();
#pragma unroll
                for (int s = 0; s < 8; ++s) { const bf16x8 bfr = *(const LAS bf16x8*)(BLg + (32 * jb * S3_STR + 16 * s) * 2), cf = *(const LAS bf16x8*)(CLg + (32 * ib * S3_STR + 16 * s) * 2);
                    ga = MFMA32(bfr, cf, ga); }
                float mm[16];
                if (jb < ib) {
                    const float efi = __expf(sc[32 * ib + r32] - sc[32 * jb + 31]);
#pragma unroll
                    for (int r = 0; r < 16; ++r) mm[r] = ga[r] * sc[256 + 32 * jb + crow(r, hi)];
                    const float efb = __expf(sc[32 * ib + r32] - (jb ? sc[32 * jb - 1] : 0.f));
#pragma unroll
                    for (int r = 0; r < 16; ++r) mm[r] *= efb;
                    (void)efi;
                } else if (jb > ib) {
                    const float ebb = __expf(sc[128 + 32 * ib + r32] - (jb < 3 ? sc[128 + 32 * jb + 32] : 0.f));
#pragma unroll
                    for (int r = 0; r < 16; ++r) mm[r] = ga[r] * sc[384 + 32 * jb + crow(r, hi)] * ebb;
                } else {
                    const float efb = __expf(sc[32 * ib + r32] - (jb ? sc[32 * jb - 1] : 0.f)), ebb = __expf(sc[128 + 32 * ib + r32] - (jb < 3 ? sc[128 + 32 * jb + 32] : 0.f));
#pragma unroll
                    for (int r = 0; r < 16; ++r) { const int jl = crow(r, hi);
                        const float mf = jl <= r32 ? efb * sc[256 + 32 * jb + jl] : 0.f, mb = jl >= r32 ? ebb * sc[384 + 32 * jb + jl] : 0.f;
                        mm[r] = ga[r] * (mf + mb) + (jl == r32 ? dskip : 0.f); }
                }
                const bf16x8 pf0 = pack8(mm[0], mm[1], mm[2], mm[3], mm[4], mm[5], mm[6], mm[7]), pf1 = pack8(mm[8], mm[9], mm[10], mm[11], mm[12], mm[13], mm[14], mm[15]);
                acc[k][0] = MFMA32(xa[0][0], pf0, acc[k][0]); acc[k][0] = MFMA32(xa[0][1], pf1, acc[k][0]);
                acc[k][1] = MFMA32(xa[1][0], pf0, acc[k][1]); acc[k][1] = MFMA32(xa[1][1], pf1, acc[k][1]);
                asm volatile("" ::: "memory");
            }
        }
#endif
#ifndef NO_OFF
#pragma unroll 1
        for (int dir = 0; dir < 2; ++dir) {
#pragma unroll
            for (int pb = 0; pb < 2; ++pb) {
                const bf16* hp = HE + ((size_t)(((b * 2 + dir) * 8 + h) * 32 + lc) * 64 + 32 * pb + r32) * 128 + 8 * hi;
                f32x16 ta0 = zero16(), ta1 = zero16();
#pragma unroll
                for (int s = 0; s < 8; ++s) { const bf16x8 hf = *(const bf16x8*)(hp + 16 * s);
                    const bf16x8 cf0 = *(const LAS bf16x8*)(CLg + (32 * (2 * ibp) * S3_STR + 16 * s) * 2), cf1 = *(const LAS bf16x8*)(CLg + (32 * (2 * ibp + 1) * S3_STR + 16 * s) * 2);
                    ta0 = MFMA32(hf, cf0, ta0); ta1 = MFMA32(hf, cf1, ta1);
                    if ((s & 3) == 3) asm volatile("" ::: "memory"); }
                const float e0 = __expf(sc[128 * dir + 32 * (2 * ibp) + r32]), e1 = __expf(sc[128 * dir + 32 * (2 * ibp + 1) + r32]);
#pragma unroll
                for (int r = 0; r < 16; ++r) { acc[0][pb][r] += e0 * ta0[r]; acc[1][pb][r] += e1 * ta1[r]; }
                asm volatile("" ::: "memory");
            }
        }
#endif
#pragma unroll
        for (int k = 0; k < 2; ++k) {
            const int ib = 2 * ibp + k;
            const size_t row = (size_t)b * SEQ + lc * 128 + 32 * ib + r32;
            float ss = 0.f;
#pragma unroll
            for (int pb = 0; pb < 2; ++pb)
#pragma unroll
                for (int g4 = 0; g4 < 4; ++g4) { const u32x2 zw = *(const u32x2*)(Z + row * 512 + h * 64 + 32 * pb + 8 * g4 + 4 * hi);
                    const float v0 = acc[k][pb][4 * g4] * silu_f(bflo(zw.x)), v1 = acc[k][pb][4 * g4 + 1] * silu_f(bfhi(zw.x)), v2 = acc[k][pb][4 * g4 + 2] * silu_f(bflo(zw.y)), v3 = acc[k][pb][4 * g4 + 3] * silu_f(bfhi(zw.y));
                    ss += (v0 * v0 + v1 * v1) + (v2 * v2 + v3 * v3);
                    acc[k][pb][4 * g4] = v0; acc[k][pb][4 * g4 + 1] = v1; acc[k][pb][4 * g4 + 2] = v2; acc[k][pb][4 * g4 + 3] = v3; }
            ss += __shfl_xor(ss, 32);
            if (hi == 0) SS[(ib * 8 + wave) * 32 + r32] = ss;
        }
        __syncthreads();
#pragma unroll
        for (int k = 0; k < 2; ++k) {
            const int ib = 2 * ibp + k;
            const size_t row = (size_t)b * SEQ + lc * 128 + 32 * ib + r32;
            float tot = 0.f;
#pragma unroll
            for (int w = 0; w < 8; ++w) tot += SS[(ib * 8 + w) * 32 + r32];
            const float rstd = 1.0f / sqrtf(tot * (1.f / 512.f) + EPS);
#pragma unroll
            for (int pb = 0; pb < 2; ++pb)
#pragma unroll
                for (int g4 = 0; g4 < 4; ++g4) { const int p0 = 32 * pb + 8 * g4 + 4 * hi; const f32x4 gn = *(const f32x4*)(snorm + p0);
                    u32x2 o; o.x = pk2(acc[k][pb][4 * g4] * rstd * gn[0], acc[k][pb][4 * g4 + 1] * rstd * gn[1]); o.y = pk2(acc[k][pb][4 * g4 + 2] * rstd * gn[2], acc[k][pb][4 * g4 + 3] * rstd * gn[3]);
                    *(u32x2*)(MIX + row * 1024 + h * 64 + p0) = o; }
        }
        }
        __syncthreads();
    }
}

constexpr int AT_KS = 104, AT_VS = 68, AT_KB = 64 * AT_KS * 2, AT_BUF = AT_KB + 64 * AT_VS * 2;
__device__ __forceinline__ void phase10_attn(const Args& a, LAS unsigned char* lds, int G, int vcu, int tid, int lane, int wave) {
    unsigned char* ws = a.ws; unsigned char* ob = (unsigned char*)a.out;
    const bf16* Q = (const bf16*)(ob + OUT_Q); const bf16* KN = (const bf16*)(ob + OUT_KN); const bf16* VT = (const bf16*)(ob + OUT_VT); const bf16* KPE = (const bf16*)(ws + WS_KPE);
    bf16* MIX = (bf16*)(ws + WS_MIX); const f32x2* ROPE = (const f32x2*)(ws + WS_ROPE);
    const int r32 = lane & 31, hi = lane >> 5;
    for (int unit = vcu; unit < NB * 8 * 16; unit += G) {
        const int bh = unit >> 4, qb = unit & 15, b = bh >> 3, h = bh & 7;
        const size_t qrow = (size_t)b * SEQ + qb * 256 + wave * 32 + r32;
        bf16x8 qr[6];
        { const bf16* qp = Q + qrow * 768 + h * 96 + 8 * hi;
#pragma unroll
          for (int s = 0; s < 6; ++s) qr[s] = *(const bf16x8*)(qp + 16 * s);
          const int tq = qb * 256 + wave * 32 + r32;
#pragma unroll
          for (int s = 4; s < 6; ++s) { const int pos = (s == 4) ? (tq >> 6) : (tq & 63); const f32x2* rp = ROPE + pos * 8 + 4 * hi;
              const u32x4 w = __builtin_bit_cast(u32x4, qr[s]); const f32x2 c0 = rp[0], c1 = rp[1], c2 = rp[2], c3 = rp[3]; u32x4 o;
              o.x = pk2(bflo(w.x) * c0.x - bfhi(w.x) * c0.y, bflo(w.x) * c0.y + bfhi(w.x) * c0.x); o.y = pk2(bflo(w.y) * c1.x - bfhi(w.y) * c1.y, bflo(w.y) * c1.y + bfhi(w.y) * c1.x);
              o.z = pk2(bflo(w.z) * c2.x - bfhi(w.z) * c2.y, bflo(w.z) * c2.y + bfhi(w.z) * c2.x); o.w = pk2(bflo(w.w) * c3.x - bfhi(w.w) * c3.y, bflo(w.w) * c3.y + bfhi(w.w) * c3.x);
              qr[s] = __builtin_bit_cast(bf16x8, o); } }
        const int kr = tid >> 3, kpart = tid & 7;
        const int pr = tid >> 2, ppart = tid & 3;
#define AT_ROW0(t) ((t) < 4 ? (size_t)NLAT + b * CTXL + (t) * 64 : (size_t)b * SEQ + ((t) - 4) * 64)
#define AT_LOAD(t) do { const size_t r0_ = AT_ROW0(t); \
        gk = *(const u32x4*)(KN + (r0_ + kr) * 512 + h * 64 + kpart * 8); \
        gv = *(const u32x4*)(VT + (size_t)(h * 64 + kr) * MTOT + r0_ + kpart * 8); \
        if (tid < 256) gp = *(const u32x4*)(KPE + (r0_ + pr) * 32 + ppart * 8); } while (0)
#define AT_STORE(bufi) do { LAS unsigned char* B_ = lds + (bufi) * AT_BUF; \
        *(LAS u32x4*)(B_ + (kr * AT_KS + kpart * 8) * 2) = gk; \
        *(LAS u32x2*)(B_ + AT_KB + (kr * AT_VS + kpart * 8) * 2) = (u32x2){gv.x, gv.y}; *(LAS u32x2*)(B_ + AT_KB + (kr * AT_VS + kpart * 8 + 4) * 2) = (u32x2){gv.z, gv.w}; \
        if (tid < 256) *(LAS u32x4*)(B_ + (pr * AT_KS + 64 + ppart * 8) * 2) = gp; } while (0)
        u32x4 gk, gv, gp = (u32x4){0u, 0u, 0u, 0u};
        AT_LOAD(0); AT_STORE(0);
        __syncthreads();
        float mrun = -INFINITY, lrun = 0.f;
        f32x16 o[2]; o[0] = zero16(); o[1] = zero16();
#pragma unroll 1
        for (int t = 0; t < 68; ++t) {
            if (t + 1 < 68) AT_LOAD(t + 1);
            const LAS unsigned char* Bc = lds + (t & 1) * AT_BUF;
            f32x16 p0 = zero16(), p1 = zero16();
#pragma unroll
            for (int s = 0; s < 6; ++s) {
                const bf16x8 k0 = *(const LAS bf16x8*)(Bc + (r32 * AT_KS + 16 * s + 8 * hi) * 2), k1 = *(const LAS bf16x8*)(Bc + ((32 + r32) * AT_KS + 16 * s + 8 * hi) * 2);
                p0 = MFMA32(k0, qr[s], p0); p1 = MFMA32(k1, qr[s], p1);
            }
            float mx = fmaxf(p0[0], p1[0]);
#pragma unroll
            for (int r = 1; r < 16; ++r) mx = fmaxf(mx, fmaxf(p0[r], p1[r]));
            mx = fmaxf(mx, __shfl_xor(mx, 32));
            const float mnew = fmaxf(mrun, mx), alpha = __builtin_amdgcn_exp2f(mrun - mnew);
            mrun = mnew;
            float rs = 0.f;
#pragma unroll
            for (int r = 0; r < 16; ++r) { p0[r] = __builtin_amdgcn_exp2f(p0[r] - mnew); p1[r] = __builtin_amdgcn_exp2f(p1[r] - mnew); rs += p0[r] + p1[r]; }
            lrun = lrun * alpha + rs;
#pragma unroll
            for (int r = 0; r < 16; ++r) { o[0][r] *= alpha; o[1][r] *= alpha; }
            bf16x8 pf[4];
            pf[0] = pack8(p0[0], p0[1], p0[2], p0[3], p0[4], p0[5], p0[6], p0[7]); pf[1] = pack8(p0[8], p0[9], p0[10], p0[11], p0[12], p0[13], p0[14], p0[15]);
            pf[2] = pack8(p1[0], p1[1], p1[2], p1[3], p1[4], p1[5], p1[6], p1[7]); pf[3] = pack8(p1[8], p1[9], p1[10], p1[11], p1[12], p1[13], p1[14], p1[15]);
#pragma unroll
            for (int db = 0; db < 2; ++db)
#pragma unroll
                for (int s = 0; s < 4; ++s) {
                    const LAS unsigned char* vp = Bc + AT_KB + ((32 * db + r32) * AT_VS + 16 * s + 4 * hi) * 2;
                    const u32x2 v0 = *(const LAS u32x2*)vp, v1 = *(const LAS u32x2*)(vp + 16);
                    o[db] = MFMA32(__builtin_bit_cast(bf16x8, (u32x4){v0.x, v0.y, v1.x, v1.y}), pf[s], o[db]);
                }
            if (t + 1 < 68) AT_STORE((t + 1) & 1);
            __syncthreads();
        }
#undef AT_ROW0
#undef AT_LOAD
#undef AT_STORE
        const float ltot = lrun + __shfl_xor(lrun, 32), rl = 1.0f / ltot;
        bf16* op = MIX + qrow * 1024 + 512 + h * 64 + 4 * hi;
#pragma unroll
        for (int db = 0; db < 2; ++db)
#pragma unroll
            for (int g4 = 0; g4 < 4; ++g4) { u32x2 w; w.x = pk2(o[db][4 * g4] * rl, o[db][4 * g4 + 1] * rl); w.y = pk2(o[db][4 * g4 + 2] * rl, o[db][4 * g4 + 3] * rl);
                *(u32x2*)(op + 32 * db + 8 * g4) = w; }
    }
}

#define XB_TMO      128
#define XB_XCNT(j)  (256  + 64 * (j))
#define XB_XSUB(j)  (1280 + 64 * (j))
#define XB_XGEN(j)  (2304 + 64 * (j))
#define XB_TOP      3328
#define XB_TOPGEN   3392
#define XCD_BAR_WORDS 3456
#define XB_SPIN_CAP (1u << 18)

__device__ __forceinline__ unsigned xb_ld(unsigned* p)              { return __hip_atomic_load(p, __ATOMIC_RELAXED, __HIP_MEMORY_SCOPE_AGENT); }
__device__ __forceinline__ unsigned xb_add(unsigned* p, unsigned v) { return __hip_atomic_fetch_add(p, v, __ATOMIC_RELAXED, __HIP_MEMORY_SCOPE_AGENT); }
__device__ __forceinline__ unsigned xb_xcc_id() { return (unsigned)__builtin_amdgcn_s_getreg((3 << 11) | 20) & 0xFu; }
#define XB_SPIN(cond, bar) do { unsigned _sp = 0; while (cond) { __builtin_amdgcn_s_sleep(1); \
    if ((++_sp & 255u) == 0u) { if (xb_ld(&(bar)[XB_TMO])) break; if (_sp > XB_SPIN_CAP) { atomicAdd(&(bar)[XB_TMO], 1u); break; } } } } while (0)

struct XcdBarrier {
    unsigned* bar; unsigned x;
    volatile LAS unsigned* st;
};

__device__ __forceinline__ XcdBarrier xcd_barrier_post(unsigned* bar, volatile LAS unsigned* st) {
    XcdBarrier b; b.bar = bar; b.x = xb_xcc_id(); b.st = st;
    if (threadIdx.x == 0) (void)xb_add(&bar[XB_XCNT(b.x)], 1u);
    return b;
}
__device__ __forceinline__ void xcd_barrier_complete(unsigned* bar, unsigned x, unsigned& nloc, unsigned& nx) {
    const unsigned G = gridDim.x * gridDim.y * gridDim.z;
    unsigned sum, cnt, mine, sp = 0u;
    for (;;) {
        sum = 0u; cnt = 0u; mine = 0u;
#pragma unroll
        for (unsigned j = 0; j < 16; ++j) { const unsigned c = xb_ld(&bar[XB_XCNT(j)]); sum += c; cnt += (c > 0u) ? 1u : 0u; mine = (j == x) ? c : mine; }
        if (sum == G) break;
        __builtin_amdgcn_s_sleep(1);
        if ((++sp & 255u) == 0u) { if (xb_ld(&bar[XB_TMO])) break; if (sp > XB_SPIN_CAP) { atomicAdd(&bar[XB_TMO], 1u); break; } }
    }
    nloc = mine > 0u ? mine : 1u; nx = cnt > 0u ? cnt : 1u;
}

__device__ __forceinline__ void xcd_barrier(const XcdBarrier& b) {
    asm volatile("s_waitcnt vmcnt(0)" ::: "memory");
    __syncthreads();
    if (threadIdx.x == 0) {
        unsigned* bar = b.bar;
        __builtin_amdgcn_s_waitcnt(0);
        unsigned nloc = b.st[0], nx = b.st[1];
        if (nloc == 0u) { xcd_barrier_complete(bar, b.x, nloc, nx); b.st[0] = nloc; b.st[1] = nx; }
        const unsigned old = xb_add(&bar[XB_XSUB(b.x)], 1u);
        const unsigned gen = old / nloc;
        if (old + 1u == (gen + 1u) * nloc) {
            __builtin_amdgcn_fence(__ATOMIC_RELEASE, "agent");
            asm volatile("s_waitcnt vmcnt(0)" ::: "memory");
            const unsigned og = xb_add(&bar[XB_TOP], 1u);
            const unsigned tg = og / nx;
            if (og + 1u == (tg + 1u) * nx) xb_add(&bar[XB_TOPGEN], 1u);
            else XB_SPIN(xb_ld(&bar[XB_TOPGEN]) == tg, bar);
            __builtin_amdgcn_fence(__ATOMIC_ACQUIRE, "agent");
            xb_add(&bar[XB_XGEN(b.x)], 1u);
            asm volatile("s_waitcnt vmcnt(0)" ::: "memory");
        } else {
            XB_SPIN(xb_ld(&bar[XB_XGEN(b.x)]) == gen, bar);
            __builtin_amdgcn_fence(__ATOMIC_ACQUIRE, "agent");
            asm volatile("s_waitcnt vmcnt(0)" ::: "memory");
        }
    }
    __syncthreads();
}

__global__ void __launch_bounds__(512, 2) hymba_fwd(Args args) {
    extern __shared__ __attribute__((aligned(16))) unsigned char lds_raw[];
    LAS unsigned char* lds = (LAS unsigned char*)lds_raw;
    cg::grid_group grid = cg::this_grid();
    const int tid = threadIdx.x, lane = tid & 63, wave = __builtin_amdgcn_readfirstlane(tid >> 6);
    const int G = gridDim.x, bx = blockIdx.x, vcu = (G % 8 == 0) ? (bx % 8) * (G / 8) + bx / 8 : bx;
    const int gw = bx * 8 + wave, NGW = G * 8;
    unsigned char* ws = args.ws;
    const int lo = args.ph_lo, hi = args.ph_hi;
    const float* MOD = (const float*)(ws + WS_MOD);
    volatile LAS unsigned* bst = (volatile LAS unsigned*)(lds + LDS_BST);
    if (tid < 2) bst[tid] = 0u;
    __syncthreads();
    const XcdBarrier xbar = xcd_barrier_post((unsigned*)(ws + WS_BAR), bst);
    bf16* XN = (bf16*)(ws + WS_A); bf16* HB = (bf16*)(ws + WS_B); float* X1 = (float*)(ws + WS_C);
#ifndef PHMASK
#define PHMASK 0xFFFF
#endif
#define IN(k) (((PHMASK >> (k)) & 1) && lo <= (k) && (k) < hi)
#define GSYNC(k) do { if ((k) == 0) grid.sync(); else xcd_barrier(xbar); } while (0)
#define SEAM(k) do { if (IN(k) && IN((k) + 1)) GSYNC(k); } while (0)
#define PH_BEGIN(k) if (IN(k)) for (int rep_ = 0; rep_ < ((k) == PROBE_PHASE ? 2 : 1); ++rep_) { if (rep_) xcd_barrier(xbar);
#define PH_END(k) } SEAM(k)
    if (PROBE_PHASE == 200) { for (int r3 = 0; r3 < 16; ++r3) xcd_barrier(xbar); }
    PH_BEGIN(0) { phase0(args, lds, gw, NGW, tid, lane, wave); } PH_END(0);
    PH_BEGIN(1) { norm_rows(args.in[0], args.in[2], MTOT, args.in[6], MOD, 0, XN, gw, NGW, lane); } PH_END(1);
    PH_BEGIN(2) { pg8::Gemm g{XN, (const bf16*)(ws + WS_W1A), MTOT, 2 * DFF, D}; pg8::StaticOrder S; S.init(MTOT, 2 * DFF, G, bx);
        pg8::EpiSwiglu E{HB, DFF}; pg8::gemm_phase<pg8::EpiSwiglu, pg8::StaticOrder, true, true>(lds, g, S, E); } PH_END(2);
    PH_BEGIN(3) { pg8::Gemm g{HB, (const bf16*)(ws + WS_W1B), MTOT, D, DFF}; pg8::StaticOrder S; S.init(MTOT, D, G, bx);
        pg8::EpiRes E{args.in[0], args.in[2], X1, MOD, 2, 0.5f}; pg8::gemm_phase<pg8::EpiRes, pg8::StaticOrder, true, true>(lds, g, S, E); } PH_END(3);
    PH_BEGIN(4) { norm_rows(X1, X1 + (size_t)NLAT * D, MTOT, args.in[9], MOD, 3, XN, gw, NGW, lane); } PH_END(4);
    PH_BEGIN(5) { pg8::Gemm g{XN, (const bf16*)(ws + WS_WIN), MTOT, 2816, D}; pg8::StaticOrder S; S.init(MTOT, 2816, G, bx);
        pg8::EpiSplit E{(bf16*)(ws + WS_Z), (bf16*)(ws + WS_XBCR), (bf16*)(ws + WS_CQ), (bf16*)(ws + WS_CKV), (bf16*)(ws + WS_MISC)};
        pg8::gemm_phase<pg8::EpiSplit, pg8::StaticOrder, true, true>(lds, g, S, E); } PH_END(5);
    PH_BEGIN(6) { phase6(args, lds, G, bx, tid, lane, wave); } PH_END(6);
    PH_BEGIN(7) {
        unsigned char* ob = (unsigned char*)args.out;
        { pg8::Gemm g{(const bf16*)(ws + WS_CQ), (const bf16*)(ws + WS_WUQ), NLAT, 768, 768}; pg8::StaticOrder S; S.init(NLAT, 768, G, bx);
          pg8::EpiScale E{(bf16*)(ob + OUT_Q), 768, (const float*)(ws + WS_RSTDQ), nullptr}; pg8::gemm_phase<pg8::EpiScale, pg8::StaticOrder, true, true>(lds, g, S, E); }
        { pg8::Gemm g{(const bf16*)(ws + WS_CKV), (const bf16*)(ws + WS_WK), MTOT, 512, 256}; pg8::StaticOrder S; S.init(MTOT, 512, G, bx);
          pg8::EpiScale E{(bf16*)(ob + OUT_KN), 512, (const float*)(ws + WS_RSTDKV), nullptr}; pg8::gemm_phase<pg8::EpiScale, pg8::StaticOrder, true, true>(lds, g, S, E); }
        { pg8::Gemm g{(const bf16*)(ws + WS_WV), (const bf16*)(ws + WS_CKV), 512, MTOT, 256}; pg8::StaticOrder S; S.init(512, MTOT, G, bx);
          pg8::EpiScale E{(bf16*)(ob + OUT_VT), MTOT, nullptr, (const float*)(ws + WS_RSTDKV)}; pg8::gemm_phase<pg8::EpiScale, pg8::StaticOrder, true, true>(lds, g, S, E); }
        phase8(args, lds, G, bx, tid, lane, wave);
    } PH_END(7);
    PH_BEGIN(9) { phase9(args, G, bx, tid); } PH_END(9);
    PH_BEGIN(10) {
#ifndef NO_SSD
        for (int r2 = 0; r2 < (PROBE_PHASE == 100 ? 2 : 1); ++r2) phase10_ssd(args, lds, G, bx, tid, lane, wave);
#endif

#ifndef NO_ATTN
        for (int r2 = 0; r2 < (PROBE_PHASE == 101 ? 2 : 1); ++r2) phase10_attn(args, lds, G, vcu, tid, lane, wave);
#endif
    } PH_END(10);
    PH_BEGIN(11) { pg8::Gemm g{(const bf16*)(ws + WS_MIX), (const bf16*)(ws + WS_WOUT), NLAT, D, D}; pg8::StaticOrder S; S.init(NLAT, D, G, bx);
        pg8::EpiRes E{X1, X1, X1, MOD, 5, 1.0f}; pg8::gemm_phase<pg8::EpiRes, pg8::StaticOrder, true, true>(lds, g, S, E); } PH_END(11);
    PH_BEGIN(12) { norm_rows(X1, X1, NLAT, args.in[22], MOD, 6, XN, gw, NGW, lane); } PH_END(12);
    PH_BEGIN(13) { pg8::Gemm g{XN, (const bf16*)(ws + WS_W2A), NLAT, 2 * DFF, D}; pg8::StaticOrder S; S.init(NLAT, 2 * DFF, G, bx);
        pg8::EpiSwiglu E{HB, DFF}; pg8::gemm_phase<pg8::EpiSwiglu, pg8::StaticOrder, true, true>(lds, g, S, E); } PH_END(13);
    PH_BEGIN(14) { pg8::Gemm g{HB, (const bf16*)(ws + WS_W2B), NLAT, D, DFF}; pg8::StaticOrder S; S.init(NLAT, D, G, bx);
        pg8::EpiRes E{X1, X1, args.out, MOD, 8, 0.5f}; pg8::gemm_phase<pg8::EpiRes, pg8::StaticOrder, true, true>(lds, g, S, E); } PH_END(14);
    PH_BEGIN(15) { final_norm_rows(args.out, args.in[25], gw, NGW, lane); } PH_END(15);
#undef IN
#undef SEAM
}

#ifndef N_LAUNCHES
#define N_LAUNCHES 1
#endif
extern "C" void kernel_launch(void* const* d_in, const int* in_sizes, int n_in, void* d_out, int out_size, void* d_ws, size_t ws_size, hipStream_t stream) {
    static int grid = 0;
    if (grid == 0) {
        if (n_in != 26 || out_size != NLAT * D || ws_size < WS_END) { fprintf(stderr, "kernel_launch: unexpected shapes (n_in %d out %d ws %zu)\n", n_in, out_size, ws_size); grid = -1; return; }
        int dev = 0, cus = 0, per_cu = 0;
        (void)hipGetDevice(&dev); (void)hipDeviceGetAttribute(&cus, hipDeviceAttributeMultiprocessorCount, dev);
        if (hipFuncSetAttribute((const void*)hymba_fwd, hipFuncAttributeMaxDynamicSharedMemorySize, LDS_BYTES) != hipSuccess) { fprintf(stderr, "kernel_launch: hipFuncSetAttribute failed\n"); grid = -1; return; }
        if (hipOccupancyMaxActiveBlocksPerMultiprocessor(&per_cu, (const void*)hymba_fwd, 512, LDS_BYTES) != hipSuccess || per_cu < 1) { fprintf(stderr, "kernel_launch: occupancy query failed (%d)\n", per_cu); grid = -1; (void)hipGetLastError(); return; }
        grid = cus;
    }
    if (grid < 0) return;
    (void)hipMemsetAsync((char*)d_ws + WS_BAR, 0, 16 * KiB, stream);
    Args a{};
    for (int i = 0; i < 26; ++i) a.in[i] = (const float*)d_in[i];
    a.out = (float*)d_out; a.ws = (unsigned char*)d_ws;
    for (int li = 0; li < N_LAUNCHES; ++li) {
        a.ph_lo = (N_LAUNCHES == 1) ? 0 : li; a.ph_hi = (N_LAUNCHES == 1) ? NPHASE : li + 1;
        void* kargs[] = {&a};
        hipError_t e = hipLaunchCooperativeKernel((const void*)hymba_fwd, dim3(grid), dim3(512), kargs, LDS_BYTES, stream);
        if (e != hipSuccess) { fprintf(stderr, "kernel_launch: cooperative launch %d failed: %s (grid %d)\n", li, hipGetErrorString(e), grid); break; }
    }
}
```

```cpp
#include <hip/hip_runtime.h>
#include <hip/hip_cooperative_groups.h>
#include <cstdio>
#include <cstdint>
namespace cg = cooperative_groups;
namespace pg8 {
#define PG8_LAS __attribute__((address_space(3)))
typedef unsigned short bf16_t;
typedef short bf16x8 __attribute__((ext_vector_type(8)));
typedef float f32x4 __attribute__((ext_vector_type(4)));
typedef unsigned u32x4 __attribute__((ext_vector_type(4)));
constexpr int BM = 256, BK = 64, HALF = 128, HTB = HALF * BK * 2  , STAGE_BYTES = 8 * HTB, NXCD = 8, WGM = 8;

__host__ __device__ __forceinline__ int lds_byte(int r, int c) { const int st = (r >> 4) * 2 + (c >> 5), rr = r & 15, cc = c & 31, ob = rr * 64 + cc * 2; return st * 1024 + (ob ^ (((ob >> 9) & 1) << 5)); }
__host__ __device__ __forceinline__ void stage_rc(int b, int& R, int& C) { const int st = b / 1024, sb = b % 1024, swz = sb ^ (((sb >> 9) & 1) << 5); R = (st >> 1) * 16 + swz / 64; C = (st & 1) * 32 + (swz % 64) / 2; }
__host__ __device__ __forceinline__ int perm32(int rho) { const int n = rho >> 4, i = rho & 15; return 8 * (i >> 2) + 4 * n + (i & 3); }

struct Unit { int pm, pn; };
struct Gemm { const bf16_t* A; const bf16_t* Bt; int M, N, K; };

struct StaticOrder {
    int nM, nN, nwg, G, c;
    __host__ __device__ void init(int M, int N, int G_, int c_) { nM = M / BM; nN = N / BM; nwg = nM * nN; G = G_; c = c_; }
    __host__ __device__ bool next(int i, Unit& u) const {
        const long L = (long)i * G + c; if (L >= nwg) return false;
        int wgid = (int)L; { const int q = nwg / NXCD, r = nwg % NXCD, xcd = wgid % NXCD, off = wgid / NXCD; wgid = (xcd < r ? xcd * (q + 1) : r * (q + 1) + (xcd - r) * q) + off; }
        const int nig = WGM * nN, gid = wgid / nig, fm = gid * WGM, gsz = (nM - fm) < WGM ? (nM - fm) : WGM;
        u.pm = fm + ((wgid % nig) % gsz); u.pn = (wgid % nig) / gsz; return true;
    }
    __device__ __forceinline__ void a_ready(const Unit&) const {}
    __device__ __forceinline__ void done(const Unit&) const {}
};

__device__ __forceinline__ unsigned cvt_pk_bf16(float lo, float hi) { unsigned r; asm volatile("v_cvt_pk_bf16_f32 %0, %1, %2" : "=v"(r) : "v"(lo), "v"(hi)); return r; }
typedef float f32x2 __attribute__((ext_vector_type(2)));
__device__ __forceinline__ f32x2 gelu_pk(f32x2 v) {
    const f32x2 av = __builtin_elementwise_abs(v), d = av * 0.2316418882f + 1.0f;
    f32x2 t; t.x = __builtin_amdgcn_rcpf(d.x); t.y = __builtin_amdgcn_rcpf(d.y);
    f32x2 q = t * 0.5307027145f + (-0.7265760135f); q = q * t + 0.7107068705f; q = q * t + (-0.142248368f); q = q * t + 0.127414796f; q = q * t;
    const f32x2 s = (v * v) * (-0.72134752044f);
    f32x2 e; e.x = __builtin_amdgcn_exp2f(s.x); e.y = __builtin_amdgcn_exp2f(s.y);
    const f32x2 m = v * (q * e), r = v - m;
    f32x2 o; o.x = v.x < 0.f ? m.x : r.x; o.y = v.y < 0.f ? m.y : r.y; return o;
}

template <int ACT  > struct EpiBf16 {
    static constexpr bool PERM = true, AFTER_DRAIN = false; static_assert(ACT == 0 || ACT == 1, "EpiBf16: ACT is 0 (none) or 1 (gelu_pk)");
    bf16_t* O; int ldc; const float* bias; int split_cols; size_t split_stride; float scale0;
    __device__ __forceinline__ void operator()(const f32x4 (&acc)[2][2][4][2], const Unit& u, int wr, int wc, int fr, int fq) const {
        const int row0 = u.pm * BM + wr * 64 + fr; int colt = u.pn * BM; bf16_t* base = O;
        float sc = 1.f; if (split_cols) { const int t = colt / split_cols; base += (size_t)t * split_stride; colt -= t * split_cols; if (t == 0) sc = scale0; }
        const int col0 = colt + wc * 32 + 8 * fq, bcol0 = u.pn * BM + wc * 32 + 8 * fq;
        f32x4 bv[2][2];
#pragma unroll
        for (int bj = 0; bj < 2; ++bj)
#pragma unroll
            for (int n = 0; n < 2; ++n) bv[bj][n] = bias ? *(const f32x4*)(bias + bcol0 + bj * HALF + 4 * n) : (f32x4){0.f, 0.f, 0.f, 0.f};
#pragma unroll
        for (int ai = 0; ai < 2; ++ai)
#pragma unroll
            for (int m = 0; m < 4; ++m) { bf16_t* rowp = base + (size_t)(row0 + ai * HALF + m * 16) * ldc + col0;
#pragma unroll
                for (int bj = 0; bj < 2; ++bj) { f32x4 v0 = acc[ai][bj][m][0] + bv[bj][0], v1 = acc[ai][bj][m][1] + bv[bj][1];
                    if (ACT == 1) { f32x2 a = gelu_pk((f32x2){v0[0], v0[1]}), b = gelu_pk((f32x2){v0[2], v0[3]}), c = gelu_pk((f32x2){v1[0], v1[1]}), d = gelu_pk((f32x2){v1[2], v1[3]});
                        v0 = (f32x4){a.x, a.y, b.x, b.y}; v1 = (f32x4){c.x, c.y, d.x, d.y}; }
                    v0 = v0 * sc; v1 = v1 * sc; u32x4 w; w.x = cvt_pk_bf16(v0[0], v0[1]); w.y = cvt_pk_bf16(v0[2], v0[3]); w.z = cvt_pk_bf16(v1[0], v1[1]); w.w = cvt_pk_bf16(v1[2], v1[3]);
                    *(u32x4*)(rowp + bj * HALF) = w; } }
    }
};
template <class Epi, class Sched, bool ALIGN_EPI = false, bool SP2 = false>
__device__ __forceinline__ void gemm_phase(PG8_LAS unsigned char* lds, const Gemm g, const Sched& S, const Epi& E) {
    const int tid = threadIdx.x, wid = __builtin_amdgcn_readfirstlane(tid >> 6), lane = tid & 63, wr = wid >> 2, wc = wid & 3, fr = lane & 15, fq = lane >> 4;
    const int K = g.K, nt = K / BK;
    unsigned voffA[2], voffB[2];
#pragma unroll
    for (int i = 0; i < 2; ++i) { int R, C; stage_rc(tid * 16 + i * 8192, R, C); const int Rb = Epi::PERM ? ((R & ~31) + perm32(R & 31)) : R;
        voffA[i] = (unsigned)(R * K + C) * 2u; voffB[i] = (unsigned)(Rb * K + C) * 2u; }
    const size_t kstep = (size_t)(BK * 2);
    const size_t hstep = (size_t)HALF * K * 2;
    const size_t tstep = 2 * hstep;
    const unsigned ldsw = (unsigned)wid * 1024u;
    const int aoff = lds_byte(wr * 64 + fr, fq * 8), boff = lds_byte(wc * 32 + fr, fq * 8);
#define PG8_SA(b, h) (((b) * 2 + (h)) * HTB)
#define PG8_SB(b, h) ((4 + (b) * 2 + (h)) * HTB)
#define PG8_STAGE(bufoff, gbase, voff) do { _Pragma("unroll") for (int _i = 0; _i < 2; ++_i) \
        __builtin_amdgcn_global_load_lds((const unsigned*)((const char*)(gbase) + (voff)[_i]), (PG8_LAS unsigned*)(lds + (bufoff) + ldsw + _i * 8192), 16, 0, 0); } while (0)
#define PG8_LDA(dst, b, h) do { _Pragma("unroll") for (int m = 0; m < 4; ++m) _Pragma("unroll") for (int k = 0; k < 2; ++k) dst[m][k] = *(const PG8_LAS bf16x8*)(lds + PG8_SA(b, h) + aoff + m * 2048 + k * 1024); } while (0)
#define PG8_LDB(dst, b, h) do { _Pragma("unroll") for (int n = 0; n < 2; ++n) _Pragma("unroll") for (int k = 0; k < 2; ++k) dst[n][k] = *(const PG8_LAS bf16x8*)(lds + PG8_SB(b, h) + boff + n * 2048 + k * 1024); } while (0)
#define PG8_MMA(ai, bj, At, Bt) do { __builtin_amdgcn_s_setprio(1); _Pragma("unroll") for (int m = 0; m < 4; ++m) _Pragma("unroll") for (int n = 0; n < 2; ++n) _Pragma("unroll") for (int k = 0; k < 2; ++k) \
        acc[ai][bj][m][n] = __builtin_amdgcn_mfma_f32_16x16x32_bf16(Bt[n][k], At[m][k], acc[ai][bj][m][n], 0, 0, 0); __builtin_amdgcn_s_setprio(0); } while (0)
#define PG8_WAIT_V(n) asm volatile("s_waitcnt vmcnt(" #n ")" ::: "memory")
#define PG8_WAIT_L(n) asm volatile("s_waitcnt lgkmcnt(" #n ")" ::: "memory")
#define PG8_BAR __builtin_amdgcn_s_barrier()
#define PG8_SCHED __builtin_amdgcn_sched_barrier(0)
    Unit cur, nxt; int ui = 0;
    if (!S.next(0, cur)) return;
    f32x4 acc[2][2][4][2];
#pragma unroll
    for (int a = 0; a < 2; ++a)
#pragma unroll
        for (int b = 0; b < 2; ++b)
#pragma unroll
            for (int m = 0; m < 4; ++m)
#pragma unroll
                for (int n = 0; n < 2; ++n) acc[a][b][m][n] = (f32x4){0.f, 0.f, 0.f, 0.f};
    bf16x8 At[4][2], B0[2][2], B1[2][2];
    const char* cA = (const char*)g.A + (size_t)cur.pm * tstep; const char* cB = (const char*)g.Bt + (size_t)cur.pn * tstep;
    S.a_ready(cur);
    if constexpr (SP2) {
        PG8_STAGE(PG8_SB(0, 0), cB, voffB); PG8_STAGE(PG8_SB(0, 1), cB + hstep, voffB); PG8_STAGE(PG8_SA(0, 0), cA, voffA); PG8_STAGE(PG8_SA(0, 1), cA + hstep, voffA);
        if (wr == 1) PG8_BAR;
        PG8_WAIT_V(2); PG8_BAR;
        PG8_STAGE(PG8_SB(1, 0), cB + kstep, voffB); PG8_STAGE(PG8_SA(1, 0), cA + kstep, voffA); PG8_STAGE(PG8_SB(1, 1), cB + hstep + kstep, voffB);
        PG8_WAIT_V(6); PG8_BAR;
    } else {
        PG8_STAGE(PG8_SB(0, 0), cB, voffB); PG8_STAGE(PG8_SA(0, 0), cA, voffA); PG8_STAGE(PG8_SB(0, 1), cB + hstep, voffB); PG8_STAGE(PG8_SA(0, 1), cA + hstep, voffA);
        if (wr == 1) PG8_BAR;
        PG8_WAIT_V(4); PG8_BAR;
        PG8_STAGE(PG8_SB(1, 0), cB + kstep, voffB); PG8_STAGE(PG8_SA(1, 0), cA + kstep, voffA); PG8_STAGE(PG8_SB(1, 1), cB + hstep + kstep, voffB);
        PG8_WAIT_V(6); PG8_BAR;
    }
    for (;;) {
        const bool has_next = S.next(ui + 1, nxt);
        const char* nA = has_next ? (const char*)g.A + (size_t)nxt.pm * tstep : cA; const char* nB = has_next ? (const char*)g.Bt + (size_t)nxt.pn * tstep : cB;
        for (int t = 0; t < nt; t += 2) {
            const bool last = (t == nt - 2);
            const char* a1 = cA + (size_t)(t + 1) * kstep;
            const char* a2 = last ? nA : cA + (size_t)(t + 2) * kstep; const char* b2 = last ? nB : cB + (size_t)(t + 2) * kstep;
            const char* a3 = a2 + kstep; const char* b3 = b2 + kstep;
            if (last && has_next) S.a_ready(nxt);
            if constexpr (SP2) {
            PG8_LDB(B0, 0, 0); PG8_LDB(B1, 0, 1); PG8_SCHED; PG8_LDA(At, 0, 0); PG8_STAGE(PG8_SA(1, 1), a1 + hstep, voffA);
            PG8_WAIT_V(8); PG8_WAIT_L(0); PG8_BAR; PG8_MMA(0, 0, At, B0); PG8_MMA(0, 1, At, B1); PG8_BAR; PG8_SCHED;
            PG8_LDA(At, 0, 1); PG8_STAGE(PG8_SB(0, 0), b2, voffB); PG8_STAGE(PG8_SB(0, 1), b2 + hstep, voffB); PG8_STAGE(PG8_SA(0, 0), a2, voffA);
            PG8_WAIT_V(8); PG8_WAIT_L(0); PG8_BAR; PG8_MMA(1, 0, At, B0); PG8_MMA(1, 1, At, B1); PG8_BAR; PG8_SCHED;
            PG8_LDB(B0, 1, 0); PG8_LDB(B1, 1, 1); PG8_SCHED; PG8_LDA(At, 1, 0); PG8_STAGE(PG8_SA(0, 1), a2 + hstep, voffA);
            PG8_WAIT_V(8); PG8_WAIT_L(0); PG8_BAR; PG8_MMA(0, 0, At, B0); PG8_MMA(0, 1, At, B1); PG8_BAR; PG8_SCHED;
            PG8_LDA(At, 1, 1); PG8_STAGE(PG8_SB(1, 0), b3, voffB); PG8_STAGE(PG8_SB(1, 1), b3 + hstep, voffB); PG8_STAGE(PG8_SA(1, 0), a3, voffA);
            PG8_WAIT_V(8); PG8_WAIT_L(0); PG8_BAR; PG8_MMA(1, 0, At, B0); PG8_MMA(1, 1, At, B1); PG8_BAR; PG8_SCHED;
            } else {
            PG8_LDB(B0, 0, 0); PG8_SCHED; PG8_LDA(At, 0, 0); PG8_STAGE(PG8_SA(1, 1), a1 + hstep, voffA);
            PG8_WAIT_L(8); PG8_BAR; PG8_WAIT_L(0); PG8_MMA(0, 0, At, B0); PG8_BAR; PG8_SCHED;
            PG8_LDB(B1, 0, 1); PG8_STAGE(PG8_SB(0, 0), b2, voffB);
            PG8_BAR; PG8_WAIT_L(0); PG8_MMA(0, 1, At, B1); PG8_BAR;
            PG8_LDA(At, 0, 1); PG8_STAGE(PG8_SA(0, 0), a2, voffA);
            PG8_BAR; PG8_WAIT_L(0); PG8_MMA(1, 0, At, B0); PG8_BAR; PG8_SCHED;
            PG8_STAGE(PG8_SB(0, 1), b2 + hstep, voffB);
            PG8_WAIT_V(6); PG8_BAR; PG8_MMA(1, 1, At, B1); PG8_BAR;
            PG8_LDB(B0, 1, 0); PG8_SCHED; PG8_LDA(At, 1, 0); PG8_STAGE(PG8_SA(0, 1), a2 + hstep, voffA);
            PG8_WAIT_L(8); PG8_BAR; PG8_WAIT_L(0); PG8_MMA(0, 0, At, B0); PG8_BAR; PG8_SCHED;
            PG8_LDB(B1, 1, 1); PG8_STAGE(PG8_SB(1, 0), b3, voffB);
            PG8_BAR; PG8_WAIT_L(0); PG8_MMA(0, 1, At, B1); PG8_BAR;
            PG8_LDA(At, 1, 1); PG8_STAGE(PG8_SA(1, 0), a3, voffA);
            PG8_BAR; PG8_WAIT_L(0); PG8_MMA(1, 0, At, B0); PG8_BAR; PG8_SCHED;
            PG8_STAGE(PG8_SB(1, 1), b3 + hstep, voffB);
            PG8_WAIT_V(6); PG8_BAR; PG8_MMA(1, 1, At, B1); PG8_BAR;
            }
        }
        if constexpr (ALIGN_EPI) { if (wr == 0) PG8_BAR; }
        if constexpr (!Epi::AFTER_DRAIN) { E(acc, cur, wr, wc, fr, fq); S.done(cur); }
        if (!has_next) break;
#pragma unroll
        for (int a = 0; a < 2; ++a)
#pragma unroll
            for (int b = 0; b < 2; ++b)
#pragma unroll
                for (int m = 0; m < 4; ++m)
#pragma unroll
                    for (int n = 0; n < 2; ++n) acc[a][b][m][n] = (f32x4){0.f, 0.f, 0.f, 0.f};
        cur = nxt; cA = nA; cB = nB; ++ui;
        if constexpr (ALIGN_EPI) { if (wr == 1) PG8_BAR; }
    }
    PG8_WAIT_V(0);
    if constexpr (!ALIGN_EPI) { if (wr == 0) PG8_BAR; }
    PG8_BAR;
    if constexpr (Epi::AFTER_DRAIN) { E.fused(acc, cur, wr, wc, fr, fq, lds, wid, lane); S.done(cur); }
#undef PG8_SA
#undef PG8_SB
#undef PG8_STAGE
#undef PG8_LDA
#undef PG8_LDB
#undef PG8_MMA
#undef PG8_WAIT_V
#undef PG8_WAIT_L
#undef PG8_BAR
#undef PG8_SCHED
}
}
#ifndef PROBE_PHASE
#define PROBE_PHASE -1
#endif

#define LAS __attribute__((address_space(3)))
typedef unsigned short bf16;
typedef short bf16x8 __attribute__((ext_vector_type(8)));
typedef float f32x2 __attribute__((ext_vector_type(2)));
typedef float f32x4 __attribute__((ext_vector_type(4)));
typedef float f32x16 __attribute__((ext_vector_type(16)));
typedef unsigned u32x2 __attribute__((ext_vector_type(2)));
typedef unsigned u32x4 __attribute__((ext_vector_type(4)));
typedef __bf16 bf16x2_t __attribute__((ext_vector_type(2)));

constexpr int D = 1024, NB = 8, SEQ = 4096, CTXL = 256, NLAT = NB * SEQ, NCTX = NB * CTXL, MTOT = NLAT + NCTX;
constexpr int DFF = 2816, UL = SEQ + CTXL, NCH = UL / 128;
constexpr float EPS = 1e-6f;
constexpr float QSCALE = 0.10206207261596575f * 1.4426950408889634f;
constexpr int NPHASE = 16;

constexpr size_t MiB = (size_t)1 << 20, KiB = 1024;
constexpr size_t WS_BAR = 1 * MiB, WS_ZERO_BYTES = 1 * MiB + 16 * KiB;
constexpr size_t WS_MOD = 0, WS_ROPE = 384 * KiB, WS_CD = 448 * KiB, WS_RSTDQ = 512 * KiB, WS_RSTDKV = 768 * KiB;
constexpr size_t WS_W1A = 2 * MiB, WS_W1B = 13 * MiB, WS_WIN = 18 * MiB + 512 * KiB, WS_WUQ = 24 * MiB, WS_WK = 25 * MiB + 512 * KiB, WS_WV = 25 * MiB + 768 * KiB,
                 WS_WOUT = 26 * MiB, WS_W2A = 28 * MiB, WS_W2B = 39 * MiB;
constexpr size_t WS_A = 45 * MiB;
constexpr size_t WS_B = 113 * MiB;
constexpr size_t WS_Z = WS_B, WS_XBCR = WS_B + 34 * MiB, WS_CQ = WS_B + 102 * MiB, WS_CKV = WS_B + 153 * MiB, WS_MISC = WS_B + 170 * MiB;
constexpr size_t WS_ST = WS_XBCR, WS_MIX = WS_XBCR, WS_HE = WS_CQ;
constexpr size_t WS_C = 300 * MiB;
constexpr size_t WS_XT = 436 * MiB, WS_BT = 470 * MiB, WS_CROW = 487 * MiB, WS_DT = 504 * MiB, WS_KPE = 506 * MiB + 256 * KiB, WS_END = 512 * MiB;
constexpr size_t WS_BROW = WS_A;
constexpr size_t OUT_Q = 0, OUT_KN = 48 * MiB, OUT_VT = 82 * MiB;
constexpr int LDS_BYTES = 163840, LDS_BST = LDS_BYTES - 64;

__device__ __forceinline__ unsigned pk2(float lo, float hi) { f32x2 v = {lo, hi}; bf16x2_t b = __builtin_convertvector(v, bf16x2_t); return __builtin_bit_cast(unsigned, b); }
__device__ __forceinline__ float bflo(unsigned w) { return __uint_as_float(w << 16); }
__device__ __forceinline__ float bfhi(unsigned w) { return __uint_as_float(w & 0xffff0000u); }
__device__ __forceinline__ float bf2f(bf16 u) { return __uint_as_float((unsigned)u << 16); }
__device__ __forceinline__ float silu_f(float x) { return x * __builtin_amdgcn_rcpf(1.f + __builtin_amdgcn_exp2f(-1.4426950408889634f * x)); }
__device__ __forceinline__ float wave_sum(float v) {
#pragma unroll
    for (int o = 1; o < 64; o <<= 1) v += __shfl_xor(v, o);
    return v;
}
__device__ __forceinline__ float incl_scan(float v, int lane) {
#pragma unroll
    for (int o = 1; o < 64; o <<= 1) { float t = __shfl_up(v, o); if (lane >= o) v += t; }
    return v;
}
#define LDS_FENCE() asm volatile("s_waitcnt lgkmcnt(0)" ::: "memory")
__device__ __forceinline__ int crow(int r, int hi) { return (r & 3) + 8 * (r >> 2) + 4 * hi; }
__device__ __forceinline__ bf16x8 pack8(float a0, float a1, float a2, float a3, float a4, float a5, float a6, float a7) {
    u32x4 w; w.x = pk2(a0, a1); w.y = pk2(a2, a3); w.z = pk2(a4, a5); w.w = pk2(a6, a7); return __builtin_bit_cast(bf16x8, w);
}

struct Args { const float* in[26]; float* out; unsigned char* ws; int ph_lo, ph_hi; };

namespace pg8 {
struct EpiSwiglu {
    static constexpr bool PERM = true, AFTER_DRAIN = false;
    bf16_t* O; int ldc;
    __device__ __forceinline__ void operator()(const f32x4 (&acc)[2][2][4][2], const Unit& u, int wr, int wc, int fr, int fq) const {
        const int row0 = u.pm * BM + wr * 64 + fr, col0 = u.pn * HALF + wc * 32 + 8 * fq;
#pragma unroll
        for (int ai = 0; ai < 2; ++ai)
#pragma unroll
            for (int m = 0; m < 4; ++m) {
                bf16_t* rowp = O + (size_t)(row0 + ai * HALF + m * 16) * ldc + col0;
                const f32x4 g0 = acc[ai][0][m][0], g1 = acc[ai][0][m][1], u0 = acc[ai][1][m][0], u1 = acc[ai][1][m][1];
                u32x4 w;
                w.x = cvt_pk_bf16(silu_f(g0[0]) * u0[0], silu_f(g0[1]) * u0[1]); w.y = cvt_pk_bf16(silu_f(g0[2]) * u0[2], silu_f(g0[3]) * u0[3]);
                w.z = cvt_pk_bf16(silu_f(g1[0]) * u1[0], silu_f(g1[1]) * u1[1]); w.w = cvt_pk_bf16(silu_f(g1[2]) * u1[2], silu_f(g1[3]) * u1[3]);
                *(u32x4*)rowp = w;
            }
    }
};
struct EpiRes {
    static constexpr bool PERM = false, AFTER_DRAIN = false;
    const float* base_lat; const float* base_ctx; float* out; const float* mod; int kg; float mul;
    __device__ __forceinline__ void operator()(const f32x4 (&acc)[2][2][4][2], const Unit& u, int wr, int wc, int fr, int fq) const {
        const int row0 = u.pm * BM + wr * 64 + fr, col0 = u.pn * BM + wc * 32 + 4 * fq;
        const int bb = u.pm < (NLAT / BM) ? u.pm / (SEQ / BM) : 8;
        const float* gp = mod + bb * 9216 + kg * 1024 + col0;
        f32x4 gv[2][2];
#pragma unroll
        for (int bj = 0; bj < 2; ++bj)
#pragma unroll
            for (int n = 0; n < 2; ++n) gv[bj][n] = *(const f32x4*)(gp + bj * HALF + n * 16) * mul;
#pragma unroll
        for (int ai = 0; ai < 2; ++ai)
#pragma unroll
            for (int m = 0; m < 4; ++m) {
                const int r = row0 + ai * HALF + m * 16;
                const float* bp = (r < NLAT ? base_lat + (size_t)r * D : base_ctx + (size_t)(r - NLAT) * D) + col0;
                float* op = out + (size_t)r * D + col0;
#pragma unroll
                for (int bj = 0; bj < 2; ++bj)
#pragma unroll
                    for (int n = 0; n < 2; ++n) { const f32x4 bs = *(const f32x4*)(bp + bj * HALF + n * 16); *(f32x4*)(op + bj * HALF + n * 16) = bs + gv[bj][n] * acc[ai][bj][m][n]; }
            }
    }
};
struct EpiSplit {
    static constexpr bool PERM = true, AFTER_DRAIN = false;
    bf16_t *zb, *xbcr, *cq, *ckv, *misc;
    __device__ __forceinline__ void operator()(const f32x4 (&acc)[2][2][4][2], const Unit& u, int wr, int wc, int fr, int fq) const {
        const int pn = u.pn; bf16_t* base; int ld;
        if (pn < 2) { base = zb + pn * 256; ld = 512; } else if (pn < 6) { base = xbcr + (pn - 2) * 256; ld = 1024; } else if (pn < 9) { base = cq + (pn - 6) * 256; ld = 768; }
        else if (pn == 9) { base = ckv; ld = 256; } else { base = misc; ld = 256; }
        const int row0 = u.pm * BM + wr * 64 + fr, col0 = wc * 32 + 8 * fq;
#pragma unroll
        for (int ai = 0; ai < 2; ++ai)
#pragma unroll
            for (int m = 0; m < 4; ++m) {
                bf16_t* rowp = base + (size_t)(row0 + ai * HALF + m * 16) * ld + col0;
#pragma unroll
                for (int bj = 0; bj < 2; ++bj) { const f32x4 v0 = acc[ai][bj][m][0], v1 = acc[ai][bj][m][1];
                    u32x4 w; w.x = cvt_pk_bf16(v0[0], v0[1]); w.y = cvt_pk_bf16(v0[2], v0[3]); w.z = cvt_pk_bf16(v1[0], v1[1]); w.w = cvt_pk_bf16(v1[2], v1[3]);
                    *(u32x4*)(rowp + bj * HALF) = w; }
            }
    }
};
struct EpiScale {
    static constexpr bool PERM = true, AFTER_DRAIN = false;
    bf16_t* O; int ldc; const float* rs; const float* cs;
    __device__ __forceinline__ void operator()(const f32x4 (&acc)[2][2][4][2], const Unit& u, int wr, int wc, int fr, int fq) const {
        const int row0 = u.pm * BM + wr * 64 + fr, col0 = u.pn * BM + wc * 32 + 8 * fq;
        f32x4 cv[2][2];
#pragma unroll
        for (int bj = 0; bj < 2; ++bj)
#pragma unroll
            for (int n = 0; n < 2; ++n) cv[bj][n] = cs ? *(const f32x4*)(cs + col0 + bj * HALF + 4 * n) : (f32x4){1.f, 1.f, 1.f, 1.f};
#pragma unroll
        for (int ai = 0; ai < 2; ++ai)
#pragma unroll
            for (int m = 0; m < 4; ++m) {
                const int r = row0 + ai * HALF + m * 16; const float rv = rs ? rs[r] : 1.f;
                bf16_t* rowp = O + (size_t)r * ldc + col0;
#pragma unroll
                for (int bj = 0; bj < 2; ++bj) { const f32x4 v0 = acc[ai][bj][m][0] * cv[bj][0] * rv, v1 = acc[ai][bj][m][1] * cv[bj][1] * rv;
                    u32x4 w; w.x = cvt_pk_bf16(v0[0], v0[1]); w.y = cvt_pk_bf16(v0[2], v0[3]); w.z = cvt_pk_bf16(v1[0], v1[1]); w.w = cvt_pk_bf16(v1[2], v1[3]);
                    *(u32x4*)(rowp + bj * HALF) = w; }
            }
    }
};
struct EpiQ {
    static constexpr bool PERM = true, AFTER_DRAIN = false;
    bf16_t* O; const float* rs; const f32x2* rope;
    __device__ __forceinline__ void operator()(const f32x4 (&acc)[2][2][4][2], const Unit& u, int wr, int wc, int fr, int fq) const {
        const int row0 = u.pm * BM + wr * 64 + fr, col0 = u.pn * BM + wc * 32 + 8 * fq;
#pragma unroll
        for (int ai = 0; ai < 2; ++ai)
#pragma unroll
            for (int m = 0; m < 4; ++m) {
                const int r = row0 + ai * HALF + m * 16; const float rv = rs[r] * QSCALE; const int t = r & (SEQ - 1);
                bf16_t* rowp = O + (size_t)r * 768 + col0;
#pragma unroll
                for (int bj = 0; bj < 2; ++bj) {
                    f32x4 v0 = acc[ai][bj][m][0] * rv, v1 = acc[ai][bj][m][1] * rv;
                    const int cc = (col0 + bj * HALF) % 96;
                    if (cc >= 64) {
                        const int q = cc - 64, half = q >> 4, jj = (q & 15) >> 1, pos = half ? (t & 63) : (t >> 6);
                        const f32x2* rp = rope + pos * 8 + jj;
                        const f32x2 c0 = rp[0], c1 = rp[1], c2 = rp[2], c3 = rp[3];
                        f32x4 o0, o1;
                        o0[0] = v0[0] * c0.x - v0[1] * c0.y; o0[1] = v0[0] * c0.y + v0[1] * c0.x; o0[2] = v0[2] * c1.x - v0[3] * c1.y; o0[3] = v0[2] * c1.y + v0[3] * c1.x;
                        o1[0] = v1[0] * c2.x - v1[1] * c2.y; o1[1] = v1[0] * c2.y + v1[1] * c2.x; o1[2] = v1[2] * c3.x - v1[3] * c3.y; o1[3] = v1[2] * c3.y + v1[3] * c3.x;
                        v0 = o0; v1 = o1;
                    }
                    u32x4 w; w.x = cvt_pk_bf16(v0[0], v0[1]); w.y = cvt_pk_bf16(v0[2], v0[3]); w.z = cvt_pk_bf16(v1[0], v1[1]); w.w = cvt_pk_bf16(v1[2], v1[3]);
                    *(u32x4*)(rowp + bj * HALF) = w;
                }
            }
    }
};
}

__device__ __forceinline__ int cmap(int id, int n) {
    switch (id) {
    case 0: return ((n >> 7) & 1) * DFF + (n >> 8) * 128 + (n & 127);
    case 1: return n;
    case 2: {
        if (n < 1536) return n;
        if (n < 2304) return 1552 + (n - 1536);
        if (n < 2560) return 2320 + (n - 2304);
        if (n < 2592) { const int q = n - 2560, half = q >> 4, jj = (q & 15) >> 1, which = q & 1; return 2576 + half * 16 + which * 8 + jj; }
        if (n < 2608) return 1536 + (n - 2592);
        return -1; }
    case 3: { const int hh = n / 96, cc = n % 96; if (cc < 64) return hh * 96 + cc;
        const int q = cc - 64, half = q >> 4, jj = (q & 15) >> 1, which = q & 1; return hh * 96 + 64 + half * 16 + which * 8 + jj; }
    case 4: return (n >> 6) * 128 + (n & 63);
    default: return (n >> 6) * 128 + 64 + (n & 63);
    }
}
__device__ __forceinline__ void titem(const float* W, int K, int N, bf16* WT, const float* gk, LAS float* scr, int item, int nblk, int lane, int id, float mulc = 1.f) {
    const int kb = item / nblk, nb = item % nblk, k0 = 64 * kb, n0 = 32 * nb;
    const int src = cmap(id, n0 + (lane & 31));
#pragma unroll 8
    for (int i = 0; i < 32; ++i) { const int kk = 2 * i + (lane >> 5); float v = src >= 0 ? W[(size_t)(k0 + kk) * N + src] : 0.f; if (gk) v *= gk[k0 + kk] * mulc; scr[kk * 33 + (lane & 31)] = v; }
    LDS_FENCE();
    const int c = lane & 7;
#pragma unroll
    for (int j = 0; j < 4; ++j) { const int n = (lane >> 3) + 8 * j; const LAS float* s = scr + (8 * c) * 33 + n;
        u32x4 o; o.x = pk2(s[0 * 33], s[1 * 33]); o.y = pk2(s[2 * 33], s[3 * 33]); o.z = pk2(s[4 * 33], s[5 * 33]); o.w = pk2(s[6 * 33], s[7 * 33]);
        *(u32x4*)(WT + (size_t)(n0 + n) * K + k0 + 8 * c) = o; }
    LDS_FENCE();
}
__device__ __forceinline__ void phase0(const Args& a, LAS unsigned char* lds, int gw, int NGW, int tid, int lane, int wave) {
    unsigned char* ws = a.ws;
    LAS float* scr = (LAS float*)(lds + wave * 16384);
    if (blockIdx.x < 144) {
        float* MOD = (float*)(ws + WS_MOD);
        const float* cin = a.in[1]; const float* cctx = a.in[3]; const float* wada = a.in[4]; const float* bada = a.in[5];
        const int n = blockIdx.x * 64 + lane, kw = wave * 128;
        float acc[9];
#pragma unroll
        for (int bb = 0; bb < 9; ++bb) acc[bb] = 0.f;
#pragma unroll 1
        for (int hf = 0; hf < 2; ++hf) {
            const int k0 = kw + 64 * hf;
            float sv[9];
#pragma unroll
            for (int bb = 0; bb < 8; ++bb) sv[bb] = silu_f(cin[bb * 1024 + k0 + lane]);
            sv[8] = silu_f(cctx[k0 + lane]);
#pragma unroll 16
            for (int k = 0; k < 64; ++k) {
                const float w = wada[(size_t)(k0 + k) * 9216 + n];
#pragma unroll
                for (int bb = 0; bb < 9; ++bb) acc[bb] += w * __shfl(sv[bb], k);
            }
        }
        LAS float* red = (LAS float*)lds;
#pragma unroll
        for (int bb = 0; bb < 9; ++bb) red[(wave * 9 + bb) * 64 + lane] = acc[bb];
        __syncthreads();
        for (int o = tid; o < 576; o += 512) { float t = bada[blockIdx.x * 64 + (o & 63)];
#pragma unroll
            for (int w = 0; w < 8; ++w) t += red[w * 576 + o];
            MOD[(o >> 6) * 9216 + blockIdx.x * 64 + (o & 63)] = t; }
        __syncthreads();
    }
    constexpr int I_W1A = 16 * 176, I_W1B = 44 * 32, I_WIN = 16 * 88, I_WUQ = 12 * 24, I_WK = 4 * 16, I_WOUT = 16 * 32;
    constexpr int NITEMS = 2 * I_W1A + 2 * I_W1B + I_WIN + I_WUQ + 2 * I_WK + I_WOUT;
    for (int rep0 = 0; rep0 < (PROBE_PHASE == 201 ? 2 : 1); ++rep0)
    for (int it = gw; it < NITEMS; it += NGW) {
        int r = it;
        if (r < I_W1A) { titem(a.in[7], 1024, 5632, (bf16*)(ws + WS_W1A), nullptr, scr, r, 176, lane, 0); continue; } r -= I_W1A;
        if (r < I_W1A) { titem(a.in[23], 1024, 5632, (bf16*)(ws + WS_W2A), nullptr, scr, r, 176, lane, 0); continue; } r -= I_W1A;
        if (r < I_W1B) { titem(a.in[8], 2816, 1024, (bf16*)(ws + WS_W1B), nullptr, scr, r, 32, lane, 1); continue; } r -= I_W1B;
        if (r < I_W1B) { titem(a.in[24], 2816, 1024, (bf16*)(ws + WS_W2B), nullptr, scr, r, 32, lane, 1); continue; } r -= I_W1B;
        if (r < I_WIN) { titem(a.in[10], 1024, 2608, (bf16*)(ws + WS_WIN), nullptr, scr, r, 88, lane, 2); continue; } r -= I_WIN;
        if (r < I_WUQ) { titem(a.in[18], 768, 768, (bf16*)(ws + WS_WUQ), a.in[17], scr, r, 24, lane, 3, QSCALE); continue; } r -= I_WUQ;
        if (r < I_WK) { titem(a.in[20], 256, 1024, (bf16*)(ws + WS_WK), a.in[19], scr, r, 16, lane, 4); continue; } r -= I_WK;
        if (r < I_WK) { titem(a.in[20], 256, 1024, (bf16*)(ws + WS_WV), a.in[19], scr, r, 16, lane, 5); continue; } r -= I_WK;
        titem(a.in[21], 1024, 1024, (bf16*)(ws + WS_WOUT), nullptr, scr, r, 32, lane, 1);
    }
    if (blockIdx.x == 0) {
        const int pos = tid >> 3, jj = tid & 7; const float inv = __builtin_amdgcn_exp2f(-(float)jj * 1.6609640474436813f);
        const float ang = (float)pos * inv;
        ((f32x2*)(ws + WS_ROPE))[tid] = (f32x2){__cosf(ang), __sinf(ang)};
    }
}

__device__ __forceinline__ void norm_rows(const float* src_lat, const float* src_ctx, int nrows, const float* gvec, const float* mod, int kshift, bf16* out, int gw, int NGW, int lane) {
    for (int row = gw; row < nrows; row += NGW) {
        const float* xr = (row < NLAT ? src_lat + (size_t)row * D : src_ctx + (size_t)(row - NLAT) * D) + 4 * lane;
        const int bb = row < NLAT ? row / SEQ : 8;
        const float* sh = mod + bb * 9216 + kshift * 1024 + 4 * lane; const float* sc = sh + 1024;
        f32x4 v[4]; float s = 0.f;
#pragma unroll
        for (int j = 0; j < 4; ++j) { v[j] = *(const f32x4*)(xr + 256 * j); s += (v[j][0] * v[j][0] + v[j][1] * v[j][1]) + (v[j][2] * v[j][2] + v[j][3] * v[j][3]); }
        const float rstd = 1.0f / sqrtf(wave_sum(s) * (1.f / D) + EPS);
        bf16* orow = out + (size_t)row * D + 4 * lane;
#pragma unroll
        for (int j = 0; j < 4; ++j) {
            const f32x4 g = *(const f32x4*)(gvec + 4 * lane + 256 * j), scv = *(const f32x4*)(sc + 256 * j), shv = *(const f32x4*)(sh + 256 * j);
            const f32x4 y = (v[j] * rstd) * g * (scv + 1.f) + shv;
            u32x2 w; w.x = pk2(y[0], y[1]); w.y = pk2(y[2], y[3]); *(u32x2*)(orow + 256 * j) = w;
        }
    }
}
__device__ __forceinline__ void final_norm_rows(float* io, const float* gvec, int gw, int NGW, int lane) {
    for (int row = gw; row < NLAT; row += NGW) {
        float* xr = io + (size_t)row * D + 4 * lane;
        f32x4 v[4]; float s = 0.f;
#pragma unroll
        for (int j = 0; j < 4; ++j) { v[j] = *(const f32x4*)(xr + 256 * j); s += (v[j][0] * v[j][0] + v[j][1] * v[j][1]) + (v[j][2] * v[j][2] + v[j][3] * v[j][3]); }
        const float rstd = 1.0f / sqrtf(wave_sum(s) * (1.f / D) + EPS);
#pragma unroll
        for (int j = 0; j < 4; ++j) { const f32x4 g = *(const f32x4*)(gvec + 4 * lane + 256 * j); *(f32x4*)(xr + 256 * j) = (v[j] * rstd) * g; }
    }
}

__device__ __forceinline__ float softplus_f(float x) { return fmaxf(x, 0.f) + log1pf(__expf(-fabsf(x))); }
__device__ __forceinline__ void phase6(const Args& a, LAS unsigned char* lds, int G, int bx, int tid, int lane, int wave) {
    unsigned char* ws = a.ws;
    const bf16* XBCR = (const bf16*)(ws + WS_XBCR); const bf16* MISC = (const bf16*)(ws + WS_MISC); const bf16* CQ = (const bf16*)(ws + WS_CQ); const bf16* CKV = (const bf16*)(ws + WS_CKV);
    bf16* XT = (bf16*)(ws + WS_XT); bf16* BT = (bf16*)(ws + WS_BT); bf16* BROW = (bf16*)(ws + WS_BROW); bf16* CROW = (bf16*)(ws + WS_CROW); bf16* KPE = (bf16*)(ws + WS_KPE);
    float* DT = (float*)(ws + WS_DT); float* RSTDQ = (float*)(ws + WS_RSTDQ); float* RSTDKV = (float*)(ws + WS_RSTDKV); const f32x2* ROPE = (const f32x2*)(ws + WS_ROPE);
    const float* conv_w = a.in[11]; const float* conv_b = a.in[12]; const float* dt_bias = a.in[13];
    LAS bf16* T = (LAS bf16*)lds;
    const int ch = 4 * (tid & 255), tseg = (tid >> 8) * 32;
    float cw[5][4], cb[4];
#pragma unroll
    for (int k = 0; k < 5; ++k) { const f32x4 w = *(const f32x4*)(conv_w + k * 1024 + ch); cw[k][0] = w[0]; cw[k][1] = w[1]; cw[k][2] = w[2]; cw[k][3] = w[3]; }
    { const f32x4 w = *(const f32x4*)(conv_b + ch); cb[0] = w[0]; cb[1] = w[1]; cb[2] = w[2]; cb[3] = w[3]; }
    for (int unit = bx; unit < NB * 68; unit += G) {
        const int b = unit / 68, ut = unit % 68, u0 = ut * 64;
        const int seg_lo = u0 < CTXL ? 0 : CTXL, seg_hi = u0 < CTXL ? CTXL : UL;
        const int rb = u0 < CTXL ? NLAT + b * CTXL : b * SEQ - CTXL;
#define P6_LD(u) (((u) >= seg_lo && (u) < seg_hi) ? *(const u32x2*)(XBCR + (size_t)(rb + (u)) * 1024 + ch) : (u32x2){0u, 0u})
        const int ub = u0 + tseg;
        u32x2 xm2 = P6_LD(ub - 2), xm1 = P6_LD(ub - 1), x0 = P6_LD(ub), xp1 = P6_LD(ub + 1);
#pragma unroll 16
        for (int t = 0; t < 32; ++t) {
            const u32x2 xp2 = P6_LD(ub + t + 2);
            const float y0 = cb[0] + cw[0][0] * bflo(xm2.x) + cw[1][0] * bflo(xm1.x) + cw[2][0] * bflo(x0.x) + cw[3][0] * bflo(xp1.x) + cw[4][0] * bflo(xp2.x);
            const float y1 = cb[1] + cw[0][1] * bfhi(xm2.x) + cw[1][1] * bfhi(xm1.x) + cw[2][1] * bfhi(x0.x) + cw[3][1] * bfhi(xp1.x) + cw[4][1] * bfhi(xp2.x);
            const float y2 = cb[2] + cw[0][2] * bflo(xm2.y) + cw[1][2] * bflo(xm1.y) + cw[2][2] * bflo(x0.y) + cw[3][2] * bflo(xp1.y) + cw[4][2] * bflo(xp2.y);
            const float y3 = cb[3] + cw[0][3] * bfhi(xm2.y) + cw[1][3] * bfhi(xm1.y) + cw[2][3] * bfhi(x0.y) + cw[3][3] * bfhi(xp1.y) + cw[4][3] * bfhi(xp2.y);
            u32x2 pk; pk.x = pk2(silu_f(y0), silu_f(y1)); pk.y = pk2(silu_f(y2), silu_f(y3));
            const int tt = tseg + t;
            if (ch < 768) { T[ch * 72 + tt] = (bf16)(pk.x & 0xffffu); T[(ch + 1) * 72 + tt] = (bf16)(pk.x >> 16); T[(ch + 2) * 72 + tt] = (bf16)(pk.y & 0xffffu); T[(ch + 3) * 72 + tt] = (bf16)(pk.y >> 16); }
            if (ch >= 512) { bf16* dst = ch < 768 ? BROW + (ch - 512) : CROW + (ch - 768); *(u32x2*)(dst + (size_t)(b * UL + u0 + tt) * 256) = pk; }
            xm2 = xm1; xm1 = x0; x0 = xp1; xp1 = xp2;
        }
#undef P6_LD
        __syncthreads();
#pragma unroll
        for (int i = 0; i < 12; ++i) { const int q = tid + 512 * i, c = q >> 3, part = q & 7;
            const u32x4 v = *(const LAS u32x4*)(T + c * 72 + part * 8);
            bf16* dst = c < 512 ? XT + (size_t)(b * 512 + c) * UL : BT + (size_t)(b * 256 + c - 512) * UL;
            *(u32x4*)(dst + u0 + part * 8) = v; }
        {
            const int uu = tid >> 3, k = (tid & 7) * 2; const size_t row = (size_t)(rb + u0 + uu);
            const unsigned raw = *(const unsigned*)(MISC + row * 256 + 32 + k);
            f32x2 o; o.x = softplus_f(bflo(raw) + dt_bias[k]); o.y = softplus_f(bfhi(raw) + dt_bias[k + 1]);
            *(f32x2*)(DT + (size_t)(b * UL + u0 + uu) * 16 + k) = o;
        }
        {
            const int uu = tid >> 3, pp = (tid & 7) * 2; const size_t row = (size_t)(rb + u0 + uu);
            u32x2 raw = *(const u32x2*)(MISC + row * 256 + 2 * pp);
            if (u0 >= CTXL) {
                const int t = u0 + uu - CTXL, half = pp >> 3, jj = pp & 7, pos = half ? (t & 63) : (t >> 6);
                const f32x2 c0 = ROPE[pos * 8 + jj], c1 = ROPE[pos * 8 + jj + 1];
                const float a0 = bflo(raw.x), a1 = bfhi(raw.x), a2 = bflo(raw.y), a3 = bfhi(raw.y);
                raw.x = pk2(a0 * c0.x - a1 * c0.y, a0 * c0.y + a1 * c0.x); raw.y = pk2(a2 * c1.x - a3 * c1.y, a2 * c1.y + a3 * c1.x);
            }
            *(u32x2*)(KPE + row * 32 + 2 * pp) = raw;
        }
#pragma unroll 2
        for (int rr = 0; rr < 8; ++rr) {
            const size_t row = (size_t)(rb + u0 + wave * 8 + rr);
            { const u32x2 w = *(const u32x2*)(CKV + row * 256 + 4 * lane); const float c0 = bflo(w.x), c1 = bfhi(w.x), c2 = bflo(w.y), c3 = bfhi(w.y);
              const float s = wave_sum((c0 * c0 + c1 * c1) + (c2 * c2 + c3 * c3)); if (lane == 0) RSTDKV[row] = 1.0f / sqrtf(s * (1.f / 256.f) + EPS); }
            if (u0 >= CTXL) { float s = 0.f;
#pragma unroll
                for (int i = 0; i < 3; ++i) { const u32x2 w = *(const u32x2*)(CQ + row * 768 + 4 * lane + 256 * i); const float c0 = bflo(w.x), c1 = bfhi(w.x), c2 = bflo(w.y), c3 = bfhi(w.y);
                    s += (c0 * c0 + c1 * c1) + (c2 * c2 + c3 * c3); }
                s = wave_sum(s); if (lane == 0) RSTDQ[row] = 1.0f / sqrtf(s * (1.f / 768.f) + EPS); }
        }
        __syncthreads();
    }
}

__device__ __forceinline__ void acum_wave(const float* DT, size_t dtrow0, int h, float anf, float anb, LAS float* sc, int lane) {
    const float df0 = DT[(dtrow0 + lane) * 16 + h], df1 = DT[(dtrow0 + 64 + lane) * 16 + h];
    const float db0 = DT[(dtrow0 + lane) * 16 + 8 + h], db1 = DT[(dtrow0 + 64 + lane) * 16 + 8 + h];
    const float f0 = incl_scan(df0 * anf, lane); float f1 = incl_scan(df1 * anf, lane); f1 += __shfl(f0, 63);
    const float a0 = db0 * anb, a1 = db1 * anb; const float g0 = incl_scan(a0, lane), g1 = incl_scan(a1, lane);
    const float t0 = __shfl(g0, 63), t1 = __shfl(g1, 63), tot = t0 + t1;
    sc[lane] = f0; sc[64 + lane] = f1; sc[128 + lane] = tot - g0 + a0; sc[192 + lane] = t1 - g1 + a1;
    sc[256 + lane] = df0; sc[320 + lane] = df1; sc[384 + lane] = db0; sc[448 + lane] = db1;
    LDS_FENCE();
}
#define MFMA32(a, b, c) __builtin_amdgcn_mfma_f32_32x32x16_bf16((a), (b), (c), 0, 0, 0)
__device__ __forceinline__ f32x16 zero16() { f32x16 z;
#pragma unroll
    for (int r = 0; r < 16; ++r) z[r] = 0.f; return z; }

constexpr int S3_STR = 136, S3_TILE = 128 * S3_STR * 2;
constexpr int S3_CL = 0, S3_BL = 2 * S3_TILE, S3_SC = 4 * S3_TILE, S3_SS = S3_SC + 16384;
__device__ __forceinline__ void phase8(const Args& a, LAS unsigned char* lds, int G, int bx, int tid, int lane, int wave) {
    unsigned char* ws = a.ws;
    const bf16* XT = (const bf16*)(ws + WS_XT); const bf16* BT = (const bf16*)(ws + WS_BT); const float* DT = (const float*)(ws + WS_DT);
    bf16* ST = (bf16*)(ws + WS_ST); float* CD = (float*)(ws + WS_CD);
    LAS float* sc = (LAS float*)(lds + S3_SC) + wave * 512;
    const int h = wave, g = h >> 2, r32 = lane & 31, hi = lane >> 5;
    const float anf = -__expf(a.in[14][h]), anb = -__expf(a.in[14][8 + h]);
    for (int unit = bx; unit < NB * NCH; unit += G) {
        const int b = unit / NCH, c = unit % NCH;
#pragma unroll
        for (int it = 0; it < 8; ++it) { const int q = tid + 512 * it, n = q >> 4, k16 = q & 15;
            const u32x4 v = *(const u32x4*)(BT + (size_t)(b * 256 + n) * UL + c * 128 + 8 * k16);
            *(LAS u32x4*)(lds + (n * S3_STR + 8 * k16) * 2) = v; }
        acum_wave(DT, (size_t)b * UL + c * 128, h, anf, anb, sc, lane);
        const float af_last = sc[127], ab_first = sc[128];
#pragma unroll
        for (int hf = 0; hf < 2; ++hf) { const int j = lane + 64 * hf;
            const float wf = __expf(af_last - sc[j]) * sc[256 + j], wb = __expf(ab_first - sc[128 + j]) * sc[384 + j];
            sc[256 + j] = wf; sc[384 + j] = wb; }
        if (lane == 0) { CD[((b * 2 + 0) * 8 + h) * NCH + c] = __expf(af_last); CD[((b * 2 + 1) * 8 + h) * NCH + c] = __expf(ab_first); }
        __syncthreads();
        const bf16* xbase = XT + (size_t)(b * 512 + h * 64 + r32) * UL + c * 128 + 8 * hi;
        const LAS unsigned char* btl = lds + ((g * 128 + r32) * S3_STR + 8 * hi) * 2;
        const LAS float* wfp = sc + 256 + 8 * hi; const LAS float* wbp = sc + 384 + 8 * hi;
#pragma unroll 1
        for (int half = 0; half < 2; ++half) {
            f32x16 accf[2][2], accb[2][2];
#pragma unroll
            for (int nn = 0; nn < 2; ++nn) { accf[nn][0] = zero16(); accf[nn][1] = zero16(); accb[nn][0] = zero16(); accb[nn][1] = zero16(); }
#pragma unroll 2
            for (int s = 0; s < 8; ++s) {
                const f32x4 fa = *(const LAS f32x4*)(wfp + 16 * s), fb = *(const LAS f32x4*)(wfp + 16 * s + 4), ba = *(const LAS f32x4*)(wbp + 16 * s), bb = *(const LAS f32x4*)(wbp + 16 * s + 4);
                bf16x8 xwf[2], xwb[2];
#pragma unroll
                for (int pb = 0; pb < 2; ++pb) { const u32x4 raw = *(const u32x4*)(xbase + (size_t)pb * 32 * UL + 16 * s);
                    const float x0 = bflo(raw.x), x1 = bfhi(raw.x), x2 = bflo(raw.y), x3 = bfhi(raw.y), x4 = bflo(raw.z), x5 = bfhi(raw.z), x6 = bflo(raw.w), x7 = bfhi(raw.w);
                    xwf[pb] = pack8(x0 * fa[0], x1 * fa[1], x2 * fa[2], x3 * fa[3], x4 * fb[0], x5 * fb[1], x6 * fb[2], x7 * fb[3]);
                    xwb[pb] = pack8(x0 * ba[0], x1 * ba[1], x2 * ba[2], x3 * ba[3], x4 * bb[0], x5 * bb[1], x6 * bb[2], x7 * bb[3]); }
#pragma unroll
                for (int nn = 0; nn < 2; ++nn) { const bf16x8 bt = *(const LAS bf16x8*)(btl + ((2 * half + nn) * 32 * S3_STR + 16 * s) * 2);
                    accf[nn][0] = MFMA32(bt, xwf[0], accf[nn][0]); accf[nn][1] = MFMA32(bt, xwf[1], accf[nn][1]);
                    accb[nn][0] = MFMA32(bt, xwb[0], accb[nn][0]); accb[nn][1] = MFMA32(bt, xwb[1], accb[nn][1]); }
            }
            bf16* sof = ST + ((size_t)(((b * 2 + 0) * 8 + h) * NCH + c) * 64) * 128; bf16* sob = ST + ((size_t)(((b * 2 + 1) * 8 + h) * NCH + c) * 64) * 128;
#pragma unroll
            for (int nn = 0; nn < 2; ++nn)
#pragma unroll
                for (int pb = 0; pb < 2; ++pb)
#pragma unroll
                    for (int g4 = 0; g4 < 4; ++g4) { const size_t off = (size_t)(32 * pb + r32) * 128 + 32 * (2 * half + nn) + 8 * g4 + 4 * hi;
                        u32x2 o; o.x = pk2(accf[nn][pb][4 * g4], accf[nn][pb][4 * g4 + 1]); o.y = pk2(accf[nn][pb][4 * g4 + 2], accf[nn][pb][4 * g4 + 3]); *(u32x2*)(sof + off) = o;
                        o.x = pk2(accb[nn][pb][4 * g4], accb[nn][pb][4 * g4 + 1]); o.y = pk2(accb[nn][pb][4 * g4 + 2], accb[nn][pb][4 * g4 + 3]); *(u32x2*)(sob + off) = o; }
        }
        __syncthreads();
    }
}
__device__ __forceinline__ void phase9(const Args& a, int G, int bx, int tid) {
    unsigned char* ws = a.ws;
    const bf16* ST = (const bf16*)(ws + WS_ST); bf16* HE = (bf16*)(ws + WS_HE); const float* CD = (const float*)(ws + WS_CD);
    for (int idx = bx * 512 + tid; idx < NB * 2 * 8 * 2048; idx += G * 512) {
        const int e = (idx & 2047) * 4, bdh = idx >> 11, dir = (bdh >> 3) & 1;
        const bf16* st = ST + (size_t)bdh * NCH * 8192 + e; bf16* he = HE + (size_t)bdh * 32 * 8192 + e; const float* cd = CD + bdh * NCH;
#define P9_LD(c) (*(const u32x2*)(st + (size_t)(c) * 8192))
#define P9_STEP(c) do { const u32x2 w_ = P9_LD(c); const float d_ = cd[c]; h0 = d_ * h0 + bflo(w_.x); h1 = d_ * h1 + bfhi(w_.x); h2 = d_ * h2 + bflo(w_.y); h3 = d_ * h3 + bfhi(w_.y); } while (0)
#define P9_OUT(c) do { u32x2 o_; o_.x = pk2(h0, h1); o_.y = pk2(h2, h3); *(u32x2*)(he + (size_t)((c) - 2) * 8192) = o_; } while (0)
        float h0 = 0.f, h1 = 0.f, h2 = 0.f, h3 = 0.f;
        if (dir == 0) {
            P9_STEP(0); P9_STEP(1);
#pragma unroll 8
            for (int c = 2; c < NCH; ++c) { P9_OUT(c); P9_STEP(c); }
        } else {
            P9_STEP(1); P9_STEP(0);
#pragma unroll 8
            for (int c = NCH - 1; c >= 2; --c) { P9_OUT(c); P9_STEP(c); }
        }
#undef P9_LD
#undef P9_STEP
#undef P9_OUT
    }
}
__device__ __forceinline__ void phase10_ssd(const Args& a, LAS unsigned char* lds, int G, int bx, int tid, int lane, int wave) {
    unsigned char* ws = a.ws;
    const bf16* XT = (const bf16*)(ws + WS_XT); const bf16* BROW = (const bf16*)(ws + WS_BROW); const bf16* CROW = (const bf16*)(ws + WS_CROW); const float* DT = (const float*)(ws + WS_DT);
    const bf16* HE = (const bf16*)(ws + WS_HE); const bf16* Z = (const bf16*)(ws + WS_Z); bf16* MIX = (bf16*)(ws + WS_MIX);
    LAS float* sc = (LAS float*)(lds + S3_SC) + wave * 512;
    LAS float* SS = (LAS float*)(lds + S3_SS);
    const int h = wave, g = h >> 2, r32 = lane & 31, hi = lane >> 5;
    const float anf = -__expf(a.in[14][h]), anb = -__expf(a.in[14][8 + h]);
    const float dskip = a.in[15][h]; const float* snorm = a.in[16] + h * 64;
    for (int unit = bx; unit < NB * 32; unit += G) {
        const int b = unit >> 5, lc = unit & 31, c = lc + 2; const size_t u0 = (size_t)b * UL + c * 128;
#pragma unroll
        for (int it = 0; it < 8; ++it) { const int q = tid + 512 * it, i = q >> 5, ch16 = q & 31, off = ((ch16 >> 4) * S3_TILE) + (i * S3_STR + (ch16 & 15) * 8) * 2;
            const u32x4 vc = *(const u32x4*)(CROW + (u0 + i) * 256 + 8 * ch16), vb = *(const u32x4*)(BROW + (u0 + i) * 256 + 8 * ch16);
            *(LAS u32x4*)(lds + S3_CL + off) = vc; *(LAS u32x4*)(lds + S3_BL + off) = vb; }
        acum_wave(DT, u0, h, anf, anb, sc, lane);
        {
            float wfv[2], wbv[2];
#pragma unroll
            for (int hf = 0; hf < 2; ++hf) { const int j = lane + 64 * hf, jb = j >> 5;
                const float afb = jb ? sc[32 * jb - 1] : 0.f, abb = jb < 3 ? sc[128 + 32 * jb + 32] : 0.f;
                wfv[hf] = __expf(afb - sc[j]) * sc[256 + j]; wbv[hf] = __expf(abb - sc[128 + j]) * sc[384 + j]; }
            LDS_FENCE();
#pragma unroll
            for (int hf = 0; hf < 2; ++hf) { const int j = lane + 64 * hf; sc[256 + j] = wfv[hf]; sc[384 + j] = wbv[hf]; }
        }
        __syncthreads();
        const LAS unsigned char* CLg = lds + S3_CL + g * S3_TILE + (r32 * S3_STR + 8 * hi) * 2;
        const LAS unsigned char* BLg = lds + S3_BL + g * S3_TILE + (r32 * S3_STR + 8 * hi) * 2;
#pragma unroll 1
        for (int ibp = 0; ibp < 2; ++ibp) {
        f32x16 acc[2][2];
#pragma unroll
        for (int k = 0; k < 2; ++k) { acc[k][0] = zero16(); acc[k][1] = zero16(); }
#ifndef NO_DIAG
#pragma unroll 1
        for (int jb = 0; jb < 4; ++jb) {
            bf16x8 xa[2][2];
#pragma unroll
            for (int pb = 0; pb < 2; ++pb) {
                const bf16* xp = XT + (size_t)(b * 512 + h * 64 + 32 * pb + r32) * UL + c * 128 + 32 * jb + 4 * hi;
                const u32x2 a0 = *(const u32x2*)(xp), a1 = *(const u32x2*)(xp + 8), a2 = *(const u32x2*)(xp + 16), a3 = *(const u32x2*)(xp + 24);
                xa[pb][0] = __builtin_bit_cast(bf16x8, (u32x4){a0.x, a0.y, a1.x, a1.y}); xa[pb][1] = __builtin_bit_cast(bf16x8, (u32x4){a2.x, a2.y, a3.x, a3.y});
            }
#pragma unroll
            for (int k = 0; k < 2; ++k) {
                const int ib = 2 * ibp + k;
                f32x16 ga = zero16();
#pragma unroll
                for (int s = 0; s < 8; ++s) { const bf16x8 bfr = *(const LAS bf16x8*)(BLg + (32 * jb * S3_STR + 16 * s) * 2), cf = *(const LAS bf16x8*)(CLg + (32 * ib * S3_STR + 16 * s) * 2);
                    ga = MFMA32(bfr, cf, ga); }
                float mm[16];
                if (jb < ib) {
                    const float efi = __expf(sc[32 * ib + r32] - sc[32 * jb + 31]);
#pragma unroll
                    for (int r = 0; r < 16; ++r) mm[r] = ga[r] * sc[256 + 32 * jb + crow(r, hi)];
                    const float efb = __expf(sc[32 * ib + r32] - (jb ? sc[32 * jb - 1] : 0.f));
#pragma unroll
                    for (int r = 0; r < 16; ++r) mm[r] *= efb;
                    (void)efi;
                } else if (jb > ib) {
                    const float ebb = __expf(sc[128 + 32 * ib + r32] - (jb < 3 ? sc[128 + 32 * jb + 32] : 0.f));
#pragma unroll
                    for (int r = 0; r < 16; ++r) mm[r] = ga[r] * sc[384 + 32 * jb + crow(r, hi)] * ebb;
                } else {
                    const float efb = __expf(sc[32 * ib + r32] - (jb ? sc[32 * jb - 1] : 0.f)), ebb = __expf(sc[128 + 32 * ib + r32] - (jb < 3 ? sc[128 + 32 * jb + 32] : 0.f));
#pragma unroll
                    for (int r = 0; r < 16; ++r) { const int jl = crow(r, hi);
                        const float mf = jl <= r32 ? efb * sc[256 + 32 * jb + jl] : 0.f, mb = jl >= r32 ? ebb * sc[384 + 32 * jb + jl] : 0.f;
                        mm[r] = ga[r] * (mf + mb) + (jl == r32 ? dskip : 0.f); }
                }
                const bf16x8 pf0 = pack8(mm[0], mm[1], mm[2], mm[3], mm[4], mm[5], mm[6], mm[7]), pf1 = pack8(mm[8], mm[9], mm[10], mm[11], mm[12], mm[13], mm[14], mm[15]);
                acc[k][0] = MFMA32(xa[0][0], pf0, acc[k][0]); acc[k][0] = MFMA32(xa[0][1], pf1, acc[k][0]);
                acc[k][1] = MFMA32(xa[1][0], pf0, acc[k][1]); acc[k][1] = MFMA32(xa[1][1], pf1, acc[k][1]);
                asm volatile("" ::: "memory");
            }
        }
#endif
#ifndef NO_OFF
#pragma unroll 1
        for (int dir = 0; dir < 2; ++dir) {
#pragma unroll
            for (int pb = 0; pb < 2; ++pb) {
                const bf16* hp = HE + ((size_t)(((b * 2 + dir) * 8 + h) * 32 + lc) * 64 + 32 * pb + r32) * 128 + 8 * hi;
                f32x16 ta0 = zero16(), ta1 = zero16();
#pragma unroll
                for (int s = 0; s < 8; ++s) { const bf16x8 hf = *(const bf16x8*)(hp + 16 * s);
                    const bf16x8 cf0 = *(const LAS bf16x8*)(CLg + (32 * (2 * ibp) * S3_STR + 16 * s) * 2), cf1 = *(const LAS bf16x8*)(CLg + (32 * (2 * ibp + 1) * S3_STR + 16 * s) * 2);
                    ta0 = MFMA32(hf, cf0, ta0); ta1 = MFMA32(hf, cf1, ta1);
                    if ((s & 3) == 3) asm volatile("" ::: "memory"); }
                const float e0 = __expf(sc[128 * dir + 32 * (2 * ibp) + r32]), e1 = __expf(sc[128 * dir + 32 * (2 * ibp + 1) + r32]);
#pragma unroll
                for (int r = 0; r < 16; ++r) { acc[0][pb][r] += e0 * ta0[r]; acc[1][pb][r] += e1 * ta1[r]; }
                asm volatile("" ::: "memory");
            }
        }
#endif
#pragma unroll
        for (int k = 0; k < 2; ++k) {
            const int ib = 2 * ibp + k;
            const size_t row = (size_t)b * SEQ + lc * 128 + 32 * ib + r32;
            float ss = 0.f;
#pragma unroll
            for (int pb = 0; pb < 2; ++pb)
#pragma unroll
                for (int g4 = 0; g4 < 4; ++g4) { const u32x2 zw = *(const u32x2*)(Z + row * 512 + h * 64 + 32 * pb + 8 * g4 + 4 * hi);
                    const float v0 = acc[k][pb][4 * g4] * silu_f(bflo(zw.x)), v1 = acc[k][pb][4 * g4 + 1] * silu_f(bfhi(zw.x)), v2 = acc[k][pb][4 * g4 + 2] * silu_f(bflo(zw.y)), v3 = acc[k][pb][4 * g4 + 3] * silu_f(bfhi(zw.y));
                    ss += (v0 * v0 + v1 * v1) + (v2 * v2 + v3 * v3);
                    acc[k][pb][4 * g4] = v0; acc[k][pb][4 * g4 + 1] = v1; acc[k][pb][4 * g4 + 2] = v2; acc[k][pb][4 * g4 + 3] = v3; }
            ss += __shfl_xor(ss, 32);
            if (hi == 0) SS[(ib * 8 + wave) * 32 + r32] = ss;
        }
        __syncthreads();
#pragma unroll
        for (int k = 0; k < 2; ++k) {
            const int ib = 2 * ibp + k;
            const size_t row = (size_t)b * SEQ + lc * 128 + 32 * ib + r32;
            float tot = 0.f;
#pragma unroll
            for (int w = 0; w < 8; ++w) tot += SS[(ib * 8 + w) * 32 + r32];
            const float rstd = 1.0f / sqrtf(tot * (1.f / 512.f) + EPS);
#pragma unroll
            for (int pb = 0; pb < 2; ++pb)
#pragma unroll
                for (int g4 = 0; g4 < 4; ++g4) { const int p0 = 32 * pb + 8 * g4 + 4 * hi; const f32x4 gn = *(const f32x4*)(snorm + p0);
                    u32x2 o; o.x = pk2(acc[k][pb][4 * g4] * rstd * gn[0], acc[k][pb][4 * g4 + 1] * rstd * gn[1]); o.y = pk2(acc[k][pb][4 * g4 + 2] * rstd * gn[2], acc[k][pb][4 * g4 + 3] * rstd * gn[3]);
                    *(u32x2*)(MIX + row * 1024 + h * 64 + p0) = o; }
        }
        }
        __syncthreads();
    }
}

constexpr int AT_KS = 104, AT_VS = 68, AT_KB = 64 * AT_KS * 2, AT_BUF = AT_KB + 64 * AT_VS * 2;
__device__ __forceinline__ void phase10_attn(const Args& a, LAS unsigned char* lds, int G, int vcu, int tid, int lane, int wave) {
    unsigned char* ws = a.ws; unsigned char* ob = (unsigned char*)a.out;
    const bf16* Q = (const bf16*)(ob + OUT_Q); const bf16* KN = (const bf16*)(ob + OUT_KN); const bf16* VT = (const bf16*)(ob + OUT_VT); const bf16* KPE = (const bf16*)(ws + WS_KPE);
    bf16* MIX = (bf16*)(ws + WS_MIX); const f32x2* ROPE = (const f32x2*)(ws + WS_ROPE);
    const int r32 = lane & 31, hi = lane >> 5;
    for (int unit = vcu; unit < NB * 8 * 16; unit += G) {
        const int bh = unit >> 4, qb = unit & 15, b = bh >> 3, h = bh & 7;
        const size_t qrow = (size_t)b * SEQ + qb * 256 + wave * 32 + r32;
        bf16x8 qr[6];
        { const bf16* qp = Q + qrow * 768 + h * 96 + 8 * hi;
#pragma unroll
          for (int s = 0; s < 6; ++s) qr[s] = *(const bf16x8*)(qp + 16 * s);
          const int tq = qb * 256 + wave * 32 + r32;
#pragma unroll
          for (int s = 4; s < 6; ++s) { const int pos = (s == 4) ? (tq >> 6) : (tq & 63); const f32x2* rp = ROPE + pos * 8 + 4 * hi;
              const u32x4 w = __builtin_bit_cast(u32x4, qr[s]); const f32x2 c0 = rp[0], c1 = rp[1], c2 = rp[2], c3 = rp[3]; u32x4 o;
              o.x = pk2(bflo(w.x) * c0.x - bfhi(w.x) * c0.y, bflo(w.x) * c0.y + bfhi(w.x) * c0.x); o.y = pk2(bflo(w.y) * c1.x - bfhi(w.y) * c1.y, bflo(w.y) * c1.y + bfhi(w.y) * c1.x);
              o.z = pk2(bflo(w.z) * c2.x - bfhi(w.z) * c2.y, bflo(w.z) * c2.y + bfhi(w.z) * c2.x); o.w = pk2(bflo(w.w) * c3.x - bfhi(w.w) * c3.y, bflo(w.w) * c3.y + bfhi(w.w) * c3.x);
              qr[s] = __builtin_bit_cast(bf16x8, o); } }
        const int kr = tid >> 3, kpart = tid & 7;
        const int pr = tid >> 2, ppart = tid & 3;
#define AT_ROW0(t) ((t) < 4 ? (size_t)NLAT + b * CTXL + (t) * 64 : (size_t)b * SEQ + ((t) - 4) * 64)
#define AT_LOAD(t) do { const size_t r0_ = AT_ROW0(t); \
        gk = *(const u32x4*)(KN + (r0_ + kr) * 512 + h * 64 + kpart * 8); \
        gv = *(const u32x4*)(VT + (size_t)(h * 64 + kr) * MTOT + r0_ + kpart * 8); \
        if (tid < 256) gp = *(const u32x4*)(KPE + (r0_ + pr) * 32 + ppart * 8); } while (0)
#define AT_STORE(bufi) do { LAS unsigned char* B_ = lds + (bufi) * AT_BUF; \
        *(LAS u32x4*)(B_ + (kr * AT_KS + kpart * 8) * 2) = gk; \
        *(LAS u32x2*)(B_ + AT_KB + (kr * AT_VS + kpart * 8) * 2) = (u32x2){gv.x, gv.y}; *(LAS u32x2*)(B_ + AT_KB + (kr * AT_VS + kpart * 8 + 4) * 2) = (u32x2){gv.z, gv.w}; \
        if (tid < 256) *(LAS u32x4*)(B_ + (pr * AT_KS + 64 + ppart * 8) * 2) = gp; } while (0)
        u32x4 gk, gv, gp = (u32x4){0u, 0u, 0u, 0u};
        AT_LOAD(0); AT_STORE(0);
        __syncthreads();
        float mrun = -INFINITY, lrun = 0.f;
        f32x16 o[2]; o[0] = zero16(); o[1] = zero16();
#pragma unroll 1
        for (int t = 0; t < 68; ++t) {
            if (t + 1 < 68) AT_LOAD(t + 1);
            const LAS unsigned char* Bc = lds + (t & 1) * AT_BUF;
            f32x16 p0 = zero16(), p1 = zero16();
#pragma unroll
            for (int s = 0; s < 6; ++s) {
                const bf16x8 k0 = *(const LAS bf16x8*)(Bc + (r32 * AT_KS + 16 * s + 8 * hi) * 2), k1 = *(const LAS bf16x8*)(Bc + ((32 + r32) * AT_KS + 16 * s + 8 * hi) * 2);
                p0 = MFMA32(k0, qr[s], p0); p1 = MFMA32(k1, qr[s], p1);
            }
            float mx = fmaxf(p0[0], p1[0]);
#pragma unroll
            for (int r = 1; r < 16; ++r) mx = fmaxf(mx, fmaxf(p0[r], p1[r]));
            mx = fmaxf(mx, __shfl_xor(mx, 32));
            if (__any(mx > mrun)) {
                const float mnew = fmaxf(mrun, mx), alpha = __builtin_amdgcn_exp2f(mrun - mnew);
                mrun = mnew; lrun *= alpha;
#pragma unroll
                for (int r = 0; r < 16; ++r) { o[0][r] *= alpha; o[1][r] *= alpha; }
            }
            float rs = 0.f;
#pragma unroll
            for (int r = 0; r < 16; ++r) { p0[r] = __builtin_amdgcn_exp2f(p0[r] - mrun); p1[r] = __builtin_amdgcn_exp2f(p1[r] - mrun); rs += p0[r] + p1[r]; }
            lrun += rs;
            bf16x8 pf[4];
            pf[0] = pack8(p0[0], p0[1], p0[2], p0[3], p0[4], p0[5], p0[6], p0[7]); pf[1] = pack8(p0[8], p0[9], p0[10], p0[11], p0[12], p0[13], p0[14], p0[15]);
            pf[2] = pack8(p1[0], p1[1], p1[2], p1[3], p1[4], p1[5], p1[6], p1[7]); pf[3] = pack8(p1[8], p1[9], p1[10], p1[11], p1[12], p1[13], p1[14], p1[15]);
#pragma unroll
            for (int db = 0; db < 2; ++db)
#pragma unroll
                for (int s = 0; s < 4; ++s) {
                    const LAS unsigned char* vp = Bc + AT_KB + ((32 * db + r32) * AT_VS + 16 * s + 4 * hi) * 2;
                    const u32x2 v0 = *(const LAS u32x2*)vp, v1 = *(const LAS u32x2*)(vp + 16);
                    o[db] = MFMA32(__builtin_bit_cast(bf16x8, (u32x4){v0.x, v0.y, v1.x, v1.y}), pf[s], o[db]);
                }
            if (t + 1 < 68) AT_STORE((t + 1) & 1);
            __syncthreads();
        }
#undef AT_ROW0
#undef AT_LOAD
#undef AT_STORE
        const float ltot = lrun + __shfl_xor(lrun, 32), rl = 1.0f / ltot;
        bf16* op = MIX + qrow * 1024 + 512 + h * 64 + 4 * hi;
#pragma unroll
        for (int db = 0; db < 2; ++db)
#pragma unroll
            for (int g4 = 0; g4 < 4; ++g4) { u32x2 w; w.x = pk2(o[db][4 * g4] * rl, o[db][4 * g4 + 1] * rl); w.y = pk2(o[db][4 * g4 + 2] * rl, o[db][4 * g4 + 3] * rl);
                *(u32x2*)(op + 32 * db + 8 * g4) = w; }
    }
}

#define XB_TMO      128
#define XB_XCNT(j)  (256  + 64 * (j))
#define XB_XSUB(j)  (1280 + 64 * (j))
#define XB_XGEN(j)  (2304 + 64 * (j))
#define XB_TOP      3328
#define XB_TOPGEN   3392
#define XCD_BAR_WORDS 3456
#define XB_SPIN_CAP (1u << 18)

__device__ __forceinline__ unsigned xb_ld(unsigned* p)              { return __hip_atomic_load(p, __ATOMIC_RELAXED, __HIP_MEMORY_SCOPE_AGENT); }
__device__ __forceinline__ unsigned xb_add(unsigned* p, unsigned v) { return __hip_atomic_fetch_add(p, v, __ATOMIC_RELAXED, __HIP_MEMORY_SCOPE_AGENT); }
__device__ __forceinline__ unsigned xb_xcc_id() { return (unsigned)__builtin_amdgcn_s_getreg((3 << 11) | 20) & 0xFu; }
#define XB_SPIN(cond, bar) do { unsigned _sp = 0; while (cond) { __builtin_amdgcn_s_sleep(1); \
    if ((++_sp & 255u) == 0u) { if (xb_ld(&(bar)[XB_TMO])) break; if (_sp > XB_SPIN_CAP) { atomicAdd(&(bar)[XB_TMO], 1u); break; } } } } while (0)

struct XcdBarrier {
    unsigned* bar; unsigned x;
    volatile LAS unsigned* st;
};

__device__ __forceinline__ XcdBarrier xcd_barrier_post(unsigned* bar, volatile LAS unsigned* st) {
    XcdBarrier b; b.bar = bar; b.x = xb_xcc_id(); b.st = st;
    if (threadIdx.x == 0) (void)xb_add(&bar[XB_XCNT(b.x)], 1u);
    return b;
}
__device__ __forceinline__ void xcd_barrier_complete(unsigned* bar, unsigned x, unsigned& nloc, unsigned& nx) {
    const unsigned G = gridDim.x * gridDim.y * gridDim.z;
    unsigned sum, cnt, mine, sp = 0u;
    for (;;) {
        sum = 0u; cnt = 0u; mine = 0u;
#pragma unroll
        for (unsigned j = 0; j < 16; ++j) { const unsigned c = xb_ld(&bar[XB_XCNT(j)]); sum += c; cnt += (c > 0u) ? 1u : 0u; mine = (j == x) ? c : mine; }
        if (sum == G) break;
        __builtin_amdgcn_s_sleep(1);
        if ((++sp & 255u) == 0u) { if (xb_ld(&bar[XB_TMO])) break; if (sp > XB_SPIN_CAP) { atomicAdd(&bar[XB_TMO], 1u); break; } }
    }
    nloc = mine > 0u ? mine : 1u; nx = cnt > 0u ? cnt : 1u;
}

__device__ __forceinline__ void xcd_barrier(const XcdBarrier& b) {
    asm volatile("s_waitcnt vmcnt(0)" ::: "memory");
    __syncthreads();
    if (threadIdx.x == 0) {
        unsigned* bar = b.bar;
        __builtin_amdgcn_s_waitcnt(0);
        unsigned nloc = b.st[0], nx = b.st[1];
        if (nloc == 0u) { xcd_barrier_complete(bar, b.x, nloc, nx); b.st[0] = nloc; b.st[1] = nx; }
        const unsigned old = xb_add(&bar[XB_XSUB(b.x)], 1u);
        const unsigned gen = old / nloc;
        if (old + 1u == (gen + 1u) * nloc) {
            __builtin_amdgcn_fence(__ATOMIC_RELEASE, "agent");
            asm volatile("s_waitcnt vmcnt(0)" ::: "memory");
            const unsigned og = xb_add(&bar[XB_TOP], 1u);
            const unsigned tg = og / nx;
            if (og + 1u == (tg + 1u) * nx) xb_add(&bar[XB_TOPGEN], 1u);
            else XB_SPIN(xb_ld(&bar[XB_TOPGEN]) == tg, bar);
            __builtin_amdgcn_fence(__ATOMIC_ACQUIRE, "agent");
            xb_add(&bar[XB_XGEN(b.x)], 1u);
            asm volatile("s_waitcnt vmcnt(0)" ::: "memory");
        } else {
            XB_SPIN(xb_ld(&bar[XB_XGEN(b.x)]) == gen, bar);
            __builtin_amdgcn_fence(__ATOMIC_ACQUIRE, "agent");
            asm volatile("s_waitcnt vmcnt(0)" ::: "memory");
        }
    }
    __syncthreads();
}

__global__ void __launch_bounds__(512, 2) hymba_fwd(Args args) {
    extern __shared__ __attribute__((aligned(16))) unsigned char lds_raw[];
    LAS unsigned char* lds = (LAS unsigned char*)lds_raw;
    cg::grid_group grid = cg::this_grid();
    const int tid = threadIdx.x, lane = tid & 63, wave = __builtin_amdgcn_readfirstlane(tid >> 6);
    const int G = gridDim.x, bx = blockIdx.x, vcu = (G % 8 == 0) ? (bx % 8) * (G / 8) + bx / 8 : bx;
    const int gw = bx * 8 + wave, NGW = G * 8;
    unsigned char* ws = args.ws;
    const int lo = args.ph_lo, hi = args.ph_hi;
    const float* MOD = (const float*)(ws + WS_MOD);
    volatile LAS unsigned* bst = (volatile LAS unsigned*)(lds + LDS_BST);
    if (tid < 2) bst[tid] = 0u;
    __syncthreads();
    const XcdBarrier xbar = xcd_barrier_post((unsigned*)(ws + WS_BAR), bst);
    bf16* XN = (bf16*)(ws + WS_A); bf16* HB = (bf16*)(ws + WS_B); float* X1 = (float*)(ws + WS_C);
#ifndef PHMASK
#define PHMASK 0xFFFF
#endif
#define IN(k) (((PHMASK >> (k)) & 1) && lo <= (k) && (k) < hi)
#define GSYNC(k) do { xcd_barrier(xbar); } while (0)
#define SEAM(k) do { if (IN(k) && IN((k) + 1)) GSYNC(k); } while (0)
#define PH_BEGIN(k) if (IN(k)) for (int rep_ = 0; rep_ < ((k) == PROBE_PHASE ? 2 : 1); ++rep_) { if (rep_) xcd_barrier(xbar);
#define PH_END(k) } SEAM(k)
    if (args.ph_lo < 0) grid.sync();
    if (PROBE_PHASE == 200) { for (int r3 = 0; r3 < 16; ++r3) xcd_barrier(xbar); }
    PH_BEGIN(0) { phase0(args, lds, gw, NGW, tid, lane, wave); } PH_END(0);
    PH_BEGIN(1) { norm_rows(args.in[0], args.in[2], MTOT, args.in[6], MOD, 0, XN, gw, NGW, lane); } PH_END(1);
    PH_BEGIN(2) { pg8::Gemm g{XN, (const bf16*)(ws + WS_W1A), MTOT, 2 * DFF, D}; pg8::StaticOrder S; S.init(MTOT, 2 * DFF, G, bx);
        pg8::EpiSwiglu E{HB, DFF}; pg8::gemm_phase<pg8::EpiSwiglu, pg8::StaticOrder, true, true>(lds, g, S, E); } PH_END(2);
    PH_BEGIN(3) { pg8::Gemm g{HB, (const bf16*)(ws + WS_W1B), MTOT, D, DFF}; pg8::StaticOrder S; S.init(MTOT, D, G, bx);
        pg8::EpiRes E{args.in[0], args.in[2], X1, MOD, 2, 0.5f}; pg8::gemm_phase<pg8::EpiRes, pg8::StaticOrder, true, true>(lds, g, S, E); } PH_END(3);
    PH_BEGIN(4) { norm_rows(X1, X1 + (size_t)NLAT * D, MTOT, args.in[9], MOD, 3, XN, gw, NGW, lane); } PH_END(4);
    PH_BEGIN(5) { pg8::Gemm g{XN, (const bf16*)(ws + WS_WIN), MTOT, 2816, D}; pg8::StaticOrder S; S.init(MTOT, 2816, G, bx);
        pg8::EpiSplit E{(bf16*)(ws + WS_Z), (bf16*)(ws + WS_XBCR), (bf16*)(ws + WS_CQ), (bf16*)(ws + WS_CKV), (bf16*)(ws + WS_MISC)};
        pg8::gemm_phase<pg8::EpiSplit, pg8::StaticOrder, true, true>(lds, g, S, E); } PH_END(5);
    PH_BEGIN(6) { phase6(args, lds, G, bx, tid, lane, wave); } PH_END(6);
    PH_BEGIN(7) {
        unsigned char* ob = (unsigned char*)args.out;
        { pg8::Gemm g{(const bf16*)(ws + WS_CQ), (const bf16*)(ws + WS_WUQ), NLAT, 768, 768}; pg8::StaticOrder S; S.init(NLAT, 768, G, bx);
          pg8::EpiScale E{(bf16*)(ob + OUT_Q), 768, (const float*)(ws + WS_RSTDQ), nullptr}; pg8::gemm_phase<pg8::EpiScale, pg8::StaticOrder, true, true>(lds, g, S, E); }
        { pg8::Gemm g{(const bf16*)(ws + WS_CKV), (const bf16*)(ws + WS_WK), MTOT, 512, 256}; pg8::StaticOrder S; S.init(MTOT, 512, G, bx);
          pg8::EpiScale E{(bf16*)(ob + OUT_KN), 512, (const float*)(ws + WS_RSTDKV), nullptr}; pg8::gemm_phase<pg8::EpiScale, pg8::StaticOrder, true, true>(lds, g, S, E); }
        { pg8::Gemm g{(const bf16*)(ws + WS_WV), (const bf16*)(ws + WS_CKV), 512, MTOT, 256}; pg8::StaticOrder S; S.init(512, MTOT, G, bx);
          pg8::EpiScale E{(bf16*)(ob + OUT_VT), MTOT, nullptr, (const float*)(ws + WS_RSTDKV)}; pg8::gemm_phase<pg8::EpiScale, pg8::StaticOrder, true, true>(lds, g, S, E); }
        phase8(args, lds, G, bx, tid, lane, wave);
    } PH_END(7);
    PH_BEGIN(9) { phase9(args, G, bx, tid); } PH_END(9);
    PH_BEGIN(10) {
#ifndef NO_SSD
        for (int r2 = 0; r2 < (PROBE_PHASE == 100 ? 2 : 1); ++r2) phase10_ssd(args, lds, G, bx, tid, lane, wave);
#endif

#ifndef NO_ATTN
        for (int r2 = 0; r2 < (PROBE_PHASE == 101 ? 2 : 1); ++r2) phase10_attn(args, lds, G, vcu, tid, lane, wave);
#endif
    } PH_END(10);
    PH_BEGIN(11) { pg8::Gemm g{(const bf16*)(ws + WS_MIX), (const bf16*)(ws + WS_WOUT), NLAT, D, D}; pg8::StaticOrder S; S.init(NLAT, D, G, bx);
        pg8::EpiRes E{X1, X1, X1, MOD, 5, 1.0f}; pg8::gemm_phase<pg8::EpiRes, pg8::StaticOrder, true, true>(lds, g, S, E); } PH_END(11);
    PH_BEGIN(12) { norm_rows(X1, X1, NLAT, args.in[22], MOD, 6, XN, gw, NGW, lane); } PH_END(12);
    PH_BEGIN(13) { pg8::Gemm g{XN, (const bf16*)(ws + WS_W2A), NLAT, 2 * DFF, D}; pg8::StaticOrder S; S.init(NLAT, 2 * DFF, G, bx);
        pg8::EpiSwiglu E{HB, DFF}; pg8::gemm_phase<pg8::EpiSwiglu, pg8::StaticOrder, true, true>(lds, g, S, E); } PH_END(13);
    PH_BEGIN(14) { pg8::Gemm g{HB, (const bf16*)(ws + WS_W2B), NLAT, D, DFF}; pg8::StaticOrder S; S.init(NLAT, D, G, bx);
        pg8::EpiRes E{X1, X1, args.out, MOD, 8, 0.5f}; pg8::gemm_phase<pg8::EpiRes, pg8::StaticOrder, true, true>(lds, g, S, E); } PH_END(14);
    PH_BEGIN(15) { final_norm_rows(args.out, args.in[25], gw, NGW, lane); } PH_END(15);
#undef IN
#undef SEAM
}

#ifndef N_LAUNCHES
#define N_LAUNCHES 1
#endif
extern "C" void kernel_launch(void* const* d_in, const int* in_sizes, int n_in, void* d_out, int out_size, void* d_ws, size_t ws_size, hipStream_t stream) {
    static int grid = 0;
    if (grid == 0) {
        if (n_in != 26 || out_size != NLAT * D || ws_size < WS_END) { fprintf(stderr, "kernel_launch: unexpected shapes (n_in %d out %d ws %zu)\n", n_in, out_size, ws_size); grid = -1; return; }
        int dev = 0, cus = 0, per_cu = 0;
        (void)hipGetDevice(&dev); (void)hipDeviceGetAttribute(&cus, hipDeviceAttributeMultiprocessorCount, dev);
        if (hipFuncSetAttribute((const void*)hymba_fwd, hipFuncAttributeMaxDynamicSharedMemorySize, LDS_BYTES) != hipSuccess) { fprintf(stderr, "kernel_launch: hipFuncSetAttribute failed\n"); grid = -1; return; }
        if (hipOccupancyMaxActiveBlocksPerMultiprocessor(&per_cu, (const void*)hymba_fwd, 512, LDS_BYTES) != hipSuccess || per_cu < 1) { fprintf(stderr, "kernel_launch: occupancy query failed (%d)\n", per_cu); grid = -1; (void)hipGetLastError(); return; }
        grid = cus;
    }
    if (grid < 0) return;
    (void)hipMemsetAsync((char*)d_ws + WS_BAR, 0, 16 * KiB, stream);
    Args a{};
    for (int i = 0; i < 26; ++i) a.in[i] = (const float*)d_in[i];
    a.out = (float*)d_out; a.ws = (unsigned char*)d_ws;
    for (int li = 0; li < N_LAUNCHES; ++li) {
        a.ph_lo = (N_LAUNCHES == 1) ? 0 : li; a.ph_hi = (N_LAUNCHES == 1) ? NPHASE : li + 1;
        void* kargs[] = {&a};
        hipError_t e = hipLaunchCooperativeKernel((const void*)hymba_fwd, dim3(grid), dim3(512), kargs, LDS_BYTES, stream);
        if (e != hipSuccess) { fprintf(stderr, "kernel_launch: cooperative launch %d failed: %s (grid %d)\n", li, hipGetErrorString(e), grid); break; }
    }
}
```

```cpp
#include <hip/hip_runtime.h>
#include <hip/hip_cooperative_groups.h>
#include <cstdio>
#include <cstdint>
namespace cg = cooperative_groups;
namespace pg8 {
#define PG8_LAS __attribute__((address_space(3)))
typedef unsigned short bf16_t;
typedef short bf16x8 __attribute__((ext_vector_type(8)));
typedef float f32x4 __attribute__((ext_vector_type(4)));
typedef unsigned u32x4 __attribute__((ext_vector_type(4)));
constexpr int BM = 256, BK = 64, HALF = 128, HTB = HALF * BK * 2  , STAGE_BYTES = 8 * HTB, NXCD = 8, WGM = 8;

__host__ __device__ __forceinline__ int lds_byte(int r, int c) { const int st = (r >> 4) * 2 + (c >> 5), rr = r & 15, cc = c & 31, ob = rr * 64 + cc * 2; return st * 1024 + (ob ^ (((ob >> 9) & 1) << 5)); }
__host__ __device__ __forceinline__ void stage_rc(int b, int& R, int& C) { const int st = b / 1024, sb = b % 1024, swz = sb ^ (((sb >> 9) & 1) << 5); R = (st >> 1) * 16 + swz / 64; C = (st & 1) * 32 + (swz % 64) / 2; }
__host__ __device__ __forceinline__ int perm32(int rho) { const int n = rho >> 4, i = rho & 15; return 8 * (i >> 2) + 4 * n + (i & 3); }

struct Unit { int pm, pn, ks; };
struct Gemm { const bf16_t* A; const bf16_t* Bt; int M, N, K; int ld; };

struct StaticOrder {
    int nM, nN, nwg, G, c;
    __host__ __device__ void init(int M, int N, int G_, int c_) { nM = M / BM; nN = N / BM; nwg = nM * nN; G = G_; c = c_; }
    __host__ __device__ bool next(int i, Unit& u) const {
        const long L = (long)i * G + c; if (L >= nwg) return false;
        int wgid = (int)L; { const int q = nwg / NXCD, r = nwg % NXCD, xcd = wgid % NXCD, off = wgid / NXCD; wgid = (xcd < r ? xcd * (q + 1) : r * (q + 1) + (xcd - r) * q) + off; }
        const int nig = WGM * nN, gid = wgid / nig, fm = gid * WGM, gsz = (nM - fm) < WGM ? (nM - fm) : WGM;
        u.pm = fm + ((wgid % nig) % gsz); u.pn = (wgid % nig) / gsz; u.ks = 0; return true;
    }
    __device__ __forceinline__ size_t koff(const Unit&) const { return 0; }
    __device__ __forceinline__ int ntiles(const Unit&, int nt) const { return nt; }
    __device__ __forceinline__ void a_ready(const Unit&) const {}
    __device__ __forceinline__ void done(const Unit&) const {}
};

__device__ __forceinline__ unsigned cvt_pk_bf16(float lo, float hi) { unsigned r; asm volatile("v_cvt_pk_bf16_f32 %0, %1, %2" : "=v"(r) : "v"(lo), "v"(hi)); return r; }
typedef float f32x2 __attribute__((ext_vector_type(2)));
__device__ __forceinline__ f32x2 gelu_pk(f32x2 v) {
    const f32x2 av = __builtin_elementwise_abs(v), d = av * 0.2316418882f + 1.0f;
    f32x2 t; t.x = __builtin_amdgcn_rcpf(d.x); t.y = __builtin_amdgcn_rcpf(d.y);
    f32x2 q = t * 0.5307027145f + (-0.7265760135f); q = q * t + 0.7107068705f; q = q * t + (-0.142248368f); q = q * t + 0.127414796f; q = q * t;
    const f32x2 s = (v * v) * (-0.72134752044f);
    f32x2 e; e.x = __builtin_amdgcn_exp2f(s.x); e.y = __builtin_amdgcn_exp2f(s.y);
    const f32x2 m = v * (q * e), r = v - m;
    f32x2 o; o.x = v.x < 0.f ? m.x : r.x; o.y = v.y < 0.f ? m.y : r.y; return o;
}

template <int ACT  > struct EpiBf16 {
    static constexpr bool PERM = true, AFTER_DRAIN = false; static_assert(ACT == 0 || ACT == 1, "EpiBf16: ACT is 0 (none) or 1 (gelu_pk)");
    bf16_t* O; int ldc; const float* bias; int split_cols; size_t split_stride; float scale0;
    __device__ __forceinline__ void operator()(const f32x4 (&acc)[2][2][4][2], const Unit& u, int wr, int wc, int fr, int fq) const {
        const int row0 = u.pm * BM + wr * 64 + fr; int colt = u.pn * BM; bf16_t* base = O;
        float sc = 1.f; if (split_cols) { const int t = colt / split_cols; base += (size_t)t * split_stride; colt -= t * split_cols; if (t == 0) sc = scale0; }
        const int col0 = colt + wc * 32 + 8 * fq, bcol0 = u.pn * BM + wc * 32 + 8 * fq;
        f32x4 bv[2][2];
#pragma unroll
        for (int bj = 0; bj < 2; ++bj)
#pragma unroll
            for (int n = 0; n < 2; ++n) bv[bj][n] = bias ? *(const f32x4*)(bias + bcol0 + bj * HALF + 4 * n) : (f32x4){0.f, 0.f, 0.f, 0.f};
#pragma unroll
        for (int ai = 0; ai < 2; ++ai)
#pragma unroll
            for (int m = 0; m < 4; ++m) { bf16_t* rowp = base + (size_t)(row0 + ai * HALF + m * 16) * ldc + col0;
#pragma unroll
                for (int bj = 0; bj < 2; ++bj) { f32x4 v0 = acc[ai][bj][m][0] + bv[bj][0], v1 = acc[ai][bj][m][1] + bv[bj][1];
                    if (ACT == 1) { f32x2 a = gelu_pk((f32x2){v0[0], v0[1]}), b = gelu_pk((f32x2){v0[2], v0[3]}), c = gelu_pk((f32x2){v1[0], v1[1]}), d = gelu_pk((f32x2){v1[2], v1[3]});
                        v0 = (f32x4){a.x, a.y, b.x, b.y}; v1 = (f32x4){c.x, c.y, d.x, d.y}; }
                    v0 = v0 * sc; v1 = v1 * sc; u32x4 w; w.x = cvt_pk_bf16(v0[0], v0[1]); w.y = cvt_pk_bf16(v0[2], v0[3]); w.z = cvt_pk_bf16(v1[0], v1[1]); w.w = cvt_pk_bf16(v1[2], v1[3]);
                    *(u32x4*)(rowp + bj * HALF) = w; } }
    }
};
template <class Epi, class Sched, bool ALIGN_EPI = false, bool SP2 = false>
__device__ __forceinline__ void gemm_phase(PG8_LAS unsigned char* lds, const Gemm g, const Sched& S, const Epi& E) {
    const int tid = threadIdx.x, wid = __builtin_amdgcn_readfirstlane(tid >> 6), lane = tid & 63, wr = wid >> 2, wc = wid & 3, fr = lane & 15, fq = lane >> 4;
    const int K = g.K, LD = g.ld ? g.ld : g.K; int nt = K / BK;
    unsigned voffA[2], voffB[2];
#pragma unroll
    for (int i = 0; i < 2; ++i) { int R, C; stage_rc(tid * 16 + i * 8192, R, C); const int Rb = Epi::PERM ? ((R & ~31) + perm32(R & 31)) : R;
        voffA[i] = (unsigned)(R * LD + C) * 2u; voffB[i] = (unsigned)(Rb * LD + C) * 2u; }
    const size_t kstep = (size_t)(BK * 2);
    const size_t hstep = (size_t)HALF * LD * 2;
    const size_t tstep = 2 * hstep;
    const unsigned ldsw = (unsigned)wid * 1024u;
    const int aoff = lds_byte(wr * 64 + fr, fq * 8), boff = lds_byte(wc * 32 + fr, fq * 8);
#define PG8_SA(b, h) (((b) * 2 + (h)) * HTB)
#define PG8_SB(b, h) ((4 + (b) * 2 + (h)) * HTB)
#define PG8_STAGE(bufoff, gbase, voff) do { _Pragma("unroll") for (int _i = 0; _i < 2; ++_i) \
        __builtin_amdgcn_global_load_lds((const unsigned*)((const char*)(gbase) + (voff)[_i]), (PG8_LAS unsigned*)(lds + (bufoff) + ldsw + _i * 8192), 16, 0, 0); } while (0)
#define PG8_LDA(dst, b, h) do { _Pragma("unroll") for (int m = 0; m < 4; ++m) _Pragma("unroll") for (int k = 0; k < 2; ++k) dst[m][k] = *(const PG8_LAS bf16x8*)(lds + PG8_SA(b, h) + aoff + m * 2048 + k * 1024); } while (0)
#define PG8_LDB(dst, b, h) do { _Pragma("unroll") for (int n = 0; n < 2; ++n) _Pragma("unroll") for (int k = 0; k < 2; ++k) dst[n][k] = *(const PG8_LAS bf16x8*)(lds + PG8_SB(b, h) + boff + n * 2048 + k * 1024); } while (0)
#define PG8_MMA(ai, bj, At, Bt) do { __builtin_amdgcn_s_setprio(1); _Pragma("unroll") for (int m = 0; m < 4; ++m) _Pragma("unroll") for (int n = 0; n < 2; ++n) _Pragma("unroll") for (int k = 0; k < 2; ++k) \
        acc[ai][bj][m][n] = __builtin_amdgcn_mfma_f32_16x16x32_bf16(Bt[n][k], At[m][k], acc[ai][bj][m][n], 0, 0, 0); __builtin_amdgcn_s_setprio(0); } while (0)
#define PG8_WAIT_V(n) asm volatile("s_waitcnt vmcnt(" #n ")" ::: "memory")
#define PG8_WAIT_L(n) asm volatile("s_waitcnt lgkmcnt(" #n ")" ::: "memory")
#define PG8_BAR __builtin_amdgcn_s_barrier()
#define PG8_SCHED __builtin_amdgcn_sched_barrier(0)
    Unit cur, nxt; int ui = 0;
    if (!S.next(0, cur)) return;
    f32x4 acc[2][2][4][2];
#pragma unroll
    for (int a = 0; a < 2; ++a)
#pragma unroll
        for (int b = 0; b < 2; ++b)
#pragma unroll
            for (int m = 0; m < 4; ++m)
#pragma unroll
                for (int n = 0; n < 2; ++n) acc[a][b][m][n] = (f32x4){0.f, 0.f, 0.f, 0.f};
    bf16x8 At[4][2], B0[2][2], B1[2][2];
    const char* cA = (const char*)g.A + (size_t)cur.pm * tstep + S.koff(cur); const char* cB = (const char*)g.Bt + (size_t)cur.pn * tstep + S.koff(cur);
    S.a_ready(cur);
    if constexpr (SP2) {
        PG8_STAGE(PG8_SB(0, 0), cB, voffB); PG8_STAGE(PG8_SB(0, 1), cB + hstep, voffB); PG8_STAGE(PG8_SA(0, 0), cA, voffA); PG8_STAGE(PG8_SA(0, 1), cA + hstep, voffA);
        if (wr == 1) PG8_BAR;
        PG8_WAIT_V(2); PG8_BAR;
        PG8_STAGE(PG8_SB(1, 0), cB + kstep, voffB); PG8_STAGE(PG8_SA(1, 0), cA + kstep, voffA); PG8_STAGE(PG8_SB(1, 1), cB + hstep + kstep, voffB);
        PG8_WAIT_V(6); PG8_BAR;
    } else {
        PG8_STAGE(PG8_SB(0, 0), cB, voffB); PG8_STAGE(PG8_SA(0, 0), cA, voffA); PG8_STAGE(PG8_SB(0, 1), cB + hstep, voffB); PG8_STAGE(PG8_SA(0, 1), cA + hstep, voffA);
        if (wr == 1) PG8_BAR;
        PG8_WAIT_V(4); PG8_BAR;
        PG8_STAGE(PG8_SB(1, 0), cB + kstep, voffB); PG8_STAGE(PG8_SA(1, 0), cA + kstep, voffA); PG8_STAGE(PG8_SB(1, 1), cB + hstep + kstep, voffB);
        PG8_WAIT_V(6); PG8_BAR;
    }
    for (;;) {
        const bool has_next = S.next(ui + 1, nxt);
        const char* nA = has_next ? (const char*)g.A + (size_t)nxt.pm * tstep + S.koff(nxt) : cA; const char* nB = has_next ? (const char*)g.Bt + (size_t)nxt.pn * tstep + S.koff(nxt) : cB;
        nt = S.ntiles(cur, K / BK);
        for (int t = 0; t < nt; t += 2) {
            const bool last = (t == nt - 2);
            const char* a1 = cA + (size_t)(t + 1) * kstep;
            const char* a2 = last ? nA : cA + (size_t)(t + 2) * kstep; const char* b2 = last ? nB : cB + (size_t)(t + 2) * kstep;
            const char* a3 = a2 + kstep; const char* b3 = b2 + kstep;
            if (last && has_next) S.a_ready(nxt);
            if constexpr (SP2) {
            PG8_LDB(B0, 0, 0); PG8_LDB(B1, 0, 1); PG8_SCHED; PG8_LDA(At, 0, 0); PG8_STAGE(PG8_SA(1, 1), a1 + hstep, voffA);
            PG8_WAIT_V(8); PG8_WAIT_L(0); PG8_BAR; PG8_MMA(0, 0, At, B0); PG8_MMA(0, 1, At, B1); PG8_BAR; PG8_SCHED;
            PG8_LDA(At, 0, 1); PG8_STAGE(PG8_SB(0, 0), b2, voffB); PG8_STAGE(PG8_SB(0, 1), b2 + hstep, voffB); PG8_STAGE(PG8_SA(0, 0), a2, voffA);
            PG8_WAIT_V(8); PG8_WAIT_L(0); PG8_BAR; PG8_MMA(1, 0, At, B0); PG8_MMA(1, 1, At, B1); PG8_BAR; PG8_SCHED;
            PG8_LDB(B0, 1, 0); PG8_LDB(B1, 1, 1); PG8_SCHED; PG8_LDA(At, 1, 0); PG8_STAGE(PG8_SA(0, 1), a2 + hstep, voffA);
            PG8_WAIT_V(8); PG8_WAIT_L(0); PG8_BAR; PG8_MMA(0, 0, At, B0); PG8_MMA(0, 1, At, B1); PG8_BAR; PG8_SCHED;
            PG8_LDA(At, 1, 1); PG8_STAGE(PG8_SB(1, 0), b3, voffB); PG8_STAGE(PG8_SB(1, 1), b3 + hstep, voffB); PG8_STAGE(PG8_SA(1, 0), a3, voffA);
            PG8_WAIT_V(8); PG8_WAIT_L(0); PG8_BAR; PG8_MMA(1, 0, At, B0); PG8_MMA(1, 1, At, B1); PG8_BAR; PG8_SCHED;
            } else {
            PG8_LDB(B0, 0, 0); PG8_SCHED; PG8_LDA(At, 0, 0); PG8_STAGE(PG8_SA(1, 1), a1 + hstep, voffA);
            PG8_WAIT_L(8); PG8_BAR; PG8_WAIT_L(0); PG8_MMA(0, 0, At, B0); PG8_BAR; PG8_SCHED;
            PG8_LDB(B1, 0, 1); PG8_STAGE(PG8_SB(0, 0), b2, voffB);
            PG8_BAR; PG8_WAIT_L(0); PG8_MMA(0, 1, At, B1); PG8_BAR;
            PG8_LDA(At, 0, 1); PG8_STAGE(PG8_SA(0, 0), a2, voffA);
            PG8_BAR; PG8_WAIT_L(0); PG8_MMA(1, 0, At, B0); PG8_BAR; PG8_SCHED;
            PG8_STAGE(PG8_SB(0, 1), b2 + hstep, voffB);
            PG8_WAIT_V(6); PG8_BAR; PG8_MMA(1, 1, At, B1); PG8_BAR;
            PG8_LDB(B0, 1, 0); PG8_SCHED; PG8_LDA(At, 1, 0); PG8_STAGE(PG8_SA(0, 1), a2 + hstep, voffA);
            PG8_WAIT_L(8); PG8_BAR; PG8_WAIT_L(0); PG8_MMA(0, 0, At, B0); PG8_BAR; PG8_SCHED;
            PG8_LDB(B1, 1, 1); PG8_STAGE(PG8_SB(1, 0), b3, voffB);
            PG8_BAR; PG8_WAIT_L(0); PG8_MMA(0, 1, At, B1); PG8_BAR;
            PG8_LDA(At, 1, 1); PG8_STAGE(PG8_SA(1, 0), a3, voffA);
            PG8_BAR; PG8_WAIT_L(0); PG8_MMA(1, 0, At, B0); PG8_BAR; PG8_SCHED;
            PG8_STAGE(PG8_SB(1, 1), b3 + hstep, voffB);
            PG8_WAIT_V(6); PG8_BAR; PG8_MMA(1, 1, At, B1); PG8_BAR;
            }
        }
        if constexpr (ALIGN_EPI) { if (wr == 0) PG8_BAR; }
        if constexpr (!Epi::AFTER_DRAIN) { E(acc, cur, wr, wc, fr, fq); S.done(cur); }
        if (!has_next) break;
#pragma unroll
        for (int a = 0; a < 2; ++a)
#pragma unroll
            for (int b = 0; b < 2; ++b)
#pragma unroll
                for (int m = 0; m < 4; ++m)
#pragma unroll
                    for (int n = 0; n < 2; ++n) acc[a][b][m][n] = (f32x4){0.f, 0.f, 0.f, 0.f};
        cur = nxt; cA = nA; cB = nB; ++ui;
        if constexpr (ALIGN_EPI) { if (wr == 1) PG8_BAR; }
    }
    PG8_WAIT_V(0);
    if constexpr (!ALIGN_EPI) { if (wr == 0) PG8_BAR; }
    PG8_BAR;
    if constexpr (Epi::AFTER_DRAIN) { E.fused(acc, cur, wr, wc, fr, fq, lds, wid, lane); S.done(cur); }
#undef PG8_SA
#undef PG8_SB
#undef PG8_STAGE
#undef PG8_LDA
#undef PG8_LDB
#undef PG8_MMA
#undef PG8_WAIT_V
#undef PG8_WAIT_L
#undef PG8_BAR
#undef PG8_SCHED
}
}
#ifndef PROBE_PHASE
#define PROBE_PHASE -1
#endif

#define LAS __attribute__((address_space(3)))
typedef unsigned short bf16;
typedef short bf16x8 __attribute__((ext_vector_type(8)));
typedef float f32x2 __attribute__((ext_vector_type(2)));
typedef float f32x4 __attribute__((ext_vector_type(4)));
typedef float f32x16 __attribute__((ext_vector_type(16)));
typedef unsigned u32x2 __attribute__((ext_vector_type(2)));
typedef unsigned u32x4 __attribute__((ext_vector_type(4)));
typedef __bf16 bf16x2_t __attribute__((ext_vector_type(2)));

constexpr int D = 1024, NB = 8, SEQ = 4096, CTXL = 256, NLAT = NB * SEQ, NCTX = NB * CTXL, MTOT = NLAT + NCTX;
constexpr int DFF = 2816, UL = SEQ + CTXL, NCH = UL / 128;
constexpr float EPS = 1e-6f;
constexpr float QSCALE = 0.10206207261596575f * 1.4426950408889634f;
constexpr int NPHASE = 16;

constexpr size_t MiB = (size_t)1 << 20, KiB = 1024;
constexpr size_t WS_BAR = 1 * MiB, WS_ZERO_BYTES = 1 * MiB + 16 * KiB;
constexpr size_t WS_MOD = 0, WS_ROPE = 384 * KiB, WS_CD = 448 * KiB, WS_RSTDQ = 512 * KiB, WS_RSTDKV = 768 * KiB;
constexpr size_t WS_W1A = 2 * MiB, WS_W1B = 13 * MiB, WS_WIN = 18 * MiB + 512 * KiB, WS_WUQ = 24 * MiB, WS_WK = 25 * MiB + 512 * KiB, WS_WV = 25 * MiB + 768 * KiB,
                 WS_WOUT = 26 * MiB, WS_W2A = 28 * MiB, WS_W2B = 39 * MiB;
constexpr size_t WS_A = 45 * MiB;
constexpr size_t WS_B = 113 * MiB;
constexpr size_t WS_Z = WS_B, WS_XBCR = WS_B + 34 * MiB, WS_CQ = WS_B + 102 * MiB, WS_CKV = WS_B + 153 * MiB, WS_MISC = WS_B + 170 * MiB;
constexpr size_t WS_ST = WS_XBCR, WS_MIX = WS_XBCR, WS_HE = WS_CQ;
constexpr size_t WS_C = 300 * MiB;
constexpr size_t WS_XT = 436 * MiB, WS_BT = 470 * MiB, WS_CROW = 487 * MiB, WS_DT = 504 * MiB, WS_KPE = 506 * MiB + 256 * KiB, WS_END = 512 * MiB;
constexpr size_t WS_BROW = WS_A;
constexpr size_t OUT_Q = 0, OUT_KN = 48 * MiB, OUT_VT = 82 * MiB;
constexpr int LDS_BYTES = 163840, LDS_BST = LDS_BYTES - 64;

__device__ __forceinline__ unsigned pk2(float lo, float hi) { f32x2 v = {lo, hi}; bf16x2_t b = __builtin_convertvector(v, bf16x2_t); return __builtin_bit_cast(unsigned, b); }
__device__ __forceinline__ float bflo(unsigned w) { return __uint_as_float(w << 16); }
__device__ __forceinline__ float bfhi(unsigned w) { return __uint_as_float(w & 0xffff0000u); }
__device__ __forceinline__ float bf2f(bf16 u) { return __uint_as_float((unsigned)u << 16); }
__device__ __forceinline__ float silu_f(float x) { return x * __builtin_amdgcn_rcpf(1.f + __builtin_amdgcn_exp2f(-1.4426950408889634f * x)); }
__device__ __forceinline__ float wave_sum(float v) {
#pragma unroll
    for (int o = 1; o < 64; o <<= 1) v += __shfl_xor(v, o);
    return v;
}
__device__ __forceinline__ float incl_scan(float v, int lane) {
#pragma unroll
    for (int o = 1; o < 64; o <<= 1) { float t = __shfl_up(v, o); if (lane >= o) v += t; }
    return v;
}
#define LDS_FENCE() asm volatile("s_waitcnt lgkmcnt(0)" ::: "memory")
__device__ __forceinline__ int crow(int r, int hi) { return (r & 3) + 8 * (r >> 2) + 4 * hi; }
__device__ __forceinline__ bf16x8 pack8(float a0, float a1, float a2, float a3, float a4, float a5, float a6, float a7) {
    u32x4 w; w.x = pk2(a0, a1); w.y = pk2(a2, a3); w.z = pk2(a4, a5); w.w = pk2(a6, a7); return __builtin_bit_cast(bf16x8, w);
}

struct Args { const float* in[26]; float* out; unsigned char* ws; int ph_lo, ph_hi; };

namespace pg8 {
struct EpiSwiglu {
    static constexpr bool PERM = true, AFTER_DRAIN = false;
    bf16_t* O; int ldc;
    __device__ __forceinline__ void operator()(const f32x4 (&acc)[2][2][4][2], const Unit& u, int wr, int wc, int fr, int fq) const {
        const int row0 = u.pm * BM + wr * 64 + fr, col0 = u.pn * HALF + wc * 32 + 8 * fq;
#pragma unroll
        for (int ai = 0; ai < 2; ++ai)
#pragma unroll
            for (int m = 0; m < 4; ++m) {
                bf16_t* rowp = O + (size_t)(row0 + ai * HALF + m * 16) * ldc + col0;
                const f32x4 g0 = acc[ai][0][m][0], g1 = acc[ai][0][m][1], u0 = acc[ai][1][m][0], u1 = acc[ai][1][m][1];
                u32x4 w;
                w.x = cvt_pk_bf16(silu_f(g0[0]) * u0[0], silu_f(g0[1]) * u0[1]); w.y = cvt_pk_bf16(silu_f(g0[2]) * u0[2], silu_f(g0[3]) * u0[3]);
                w.z = cvt_pk_bf16(silu_f(g1[0]) * u1[0], silu_f(g1[1]) * u1[1]); w.w = cvt_pk_bf16(silu_f(g1[2]) * u1[2], silu_f(g1[3]) * u1[3]);
                *(u32x4*)rowp = w;
            }
    }
};
struct EpiRes {
    static constexpr bool PERM = false, AFTER_DRAIN = false;
    const float* base_lat; const float* base_ctx; float* out; const float* mod; int kg; float mul;
    __device__ __forceinline__ void operator()(const f32x4 (&acc)[2][2][4][2], const Unit& u, int wr, int wc, int fr, int fq) const {
        const int row0 = u.pm * BM + wr * 64 + fr, col0 = u.pn * BM + wc * 32 + 4 * fq;
        const int bb = u.pm < (NLAT / BM) ? u.pm / (SEQ / BM) : 8;
        const float* gp = mod + bb * 9216 + kg * 1024 + col0;
        f32x4 gv[2][2];
#pragma unroll
        for (int bj = 0; bj < 2; ++bj)
#pragma unroll
            for (int n = 0; n < 2; ++n) gv[bj][n] = *(const f32x4*)(gp + bj * HALF + n * 16) * mul;
#pragma unroll
        for (int ai = 0; ai < 2; ++ai)
#pragma unroll
            for (int m = 0; m < 4; ++m) {
                const int r = row0 + ai * HALF + m * 16;
                const float* bp = (r < NLAT ? base_lat + (size_t)r * D : base_ctx + (size_t)(r - NLAT) * D) + col0;
                float* op = out + (size_t)r * D + col0;
#pragma unroll
                for (int bj = 0; bj < 2; ++bj)
#pragma unroll
                    for (int n = 0; n < 2; ++n) { const f32x4 bs = *(const f32x4*)(bp + bj * HALF + n * 16); *(f32x4*)(op + bj * HALF + n * 16) = bs + gv[bj][n] * acc[ai][bj][m][n]; }
            }
    }
};
struct EpiSplit {
    static constexpr bool PERM = true, AFTER_DRAIN = false;
    bf16_t *zb, *xbcr, *cq, *ckv, *misc;
    __device__ __forceinline__ void operator()(const f32x4 (&acc)[2][2][4][2], const Unit& u, int wr, int wc, int fr, int fq) const {
        const int pn = u.pn; bf16_t* base; int ld;
        if (pn < 2) { base = zb + pn * 256; ld = 512; } else if (pn < 6) { base = xbcr + (pn - 2) * 256; ld = 1024; } else if (pn < 9) { base = cq + (pn - 6) * 256; ld = 768; }
        else if (pn == 9) { base = ckv; ld = 256; } else { base = misc; ld = 256; }
        const int row0 = u.pm * BM + wr * 64 + fr, col0 = wc * 32 + 8 * fq;
#pragma unroll
        for (int ai = 0; ai < 2; ++ai)
#pragma unroll
            for (int m = 0; m < 4; ++m) {
                bf16_t* rowp = base + (size_t)(row0 + ai * HALF + m * 16) * ld + col0;
#pragma unroll
                for (int bj = 0; bj < 2; ++bj) { const f32x4 v0 = acc[ai][bj][m][0], v1 = acc[ai][bj][m][1];
                    u32x4 w; w.x = cvt_pk_bf16(v0[0], v0[1]); w.y = cvt_pk_bf16(v0[2], v0[3]); w.z = cvt_pk_bf16(v1[0], v1[1]); w.w = cvt_pk_bf16(v1[2], v1[3]);
                    *(u32x4*)(rowp + bj * HALF) = w; }
            }
    }
};
struct EpiScale {
    static constexpr bool PERM = true, AFTER_DRAIN = false;
    bf16_t* O; int ldc; const float* rs; const float* cs;
    __device__ __forceinline__ void operator()(const f32x4 (&acc)[2][2][4][2], const Unit& u, int wr, int wc, int fr, int fq) const {
        const int row0 = u.pm * BM + wr * 64 + fr, col0 = u.pn * BM + wc * 32 + 8 * fq;
        f32x4 cv[2][2];
#pragma unroll
        for (int bj = 0; bj < 2; ++bj)
#pragma unroll
            for (int n = 0; n < 2; ++n) cv[bj][n] = cs ? *(const f32x4*)(cs + col0 + bj * HALF + 4 * n) : (f32x4){1.f, 1.f, 1.f, 1.f};
#pragma unroll
        for (int ai = 0; ai < 2; ++ai)
#pragma unroll
            for (int m = 0; m < 4; ++m) {
                const int r = row0 + ai * HALF + m * 16; const float rv = rs ? rs[r] : 1.f;
                bf16_t* rowp = O + (size_t)r * ldc + col0;
#pragma unroll
                for (int bj = 0; bj < 2; ++bj) { const f32x4 v0 = acc[ai][bj][m][0] * cv[bj][0] * rv, v1 = acc[ai][bj][m][1] * cv[bj][1] * rv;
                    u32x4 w; w.x = cvt_pk_bf16(v0[0], v0[1]); w.y = cvt_pk_bf16(v0[2], v0[3]); w.z = cvt_pk_bf16(v1[0], v1[1]); w.w = cvt_pk_bf16(v1[2], v1[3]);
                    *(u32x4*)(rowp + bj * HALF) = w; }
            }
    }
};
struct CtxSplitOrder {
    int G, c;
    __device__ __forceinline__ bool next(int i, Unit& u) const { const int L = i * G + c; if (L >= 128) return false; u.pm = (NLAT / BM) + (L & 7); u.pn = (L >> 3) & 3; u.ks = L >> 5; return true; }
    __device__ __forceinline__ size_t koff(const Unit& u) const { return (size_t)(u.ks < 2 ? u.ks * 768 : 1536 + (u.ks - 2) * 640) * 2; }
    __device__ __forceinline__ int ntiles(const Unit& u, int) const { return u.ks < 2 ? 12 : 10; }
    __device__ __forceinline__ void a_ready(const Unit&) const {}
    __device__ __forceinline__ void done(const Unit&) const {}
};
struct EpiResCtx {
    static constexpr bool PERM = false, AFTER_DRAIN = false;
    const float* base_ctx; float* out; float* part; const float* mod; int kg; float mul;
    __device__ __forceinline__ void operator()(const f32x4 (&acc)[2][2][4][2], const Unit& u, int wr, int wc, int fr, int fq) const {
        const int row0 = (u.pm - NLAT / BM) * BM + wr * 64 + fr, col0 = u.pn * BM + wc * 32 + 4 * fq;
        const float* gp = mod + 8 * 9216 + kg * 1024 + col0;
        f32x4 gv[2][2];
#pragma unroll
        for (int bj = 0; bj < 2; ++bj)
#pragma unroll
            for (int n = 0; n < 2; ++n) gv[bj][n] = *(const f32x4*)(gp + bj * HALF + n * 16) * mul;
        float* ob = u.ks == 0 ? out + (size_t)NLAT * D : part + (size_t)(u.ks - 1) * NCTX * D;
#pragma unroll
        for (int ai = 0; ai < 2; ++ai)
#pragma unroll
            for (int m = 0; m < 4; ++m) {
                const int r = row0 + ai * HALF + m * 16;
                const float* bp = base_ctx + (size_t)r * D + col0; float* op = ob + (size_t)r * D + col0;
#pragma unroll
                for (int bj = 0; bj < 2; ++bj)
#pragma unroll
                    for (int n = 0; n < 2; ++n) { f32x4 v = gv[bj][n] * acc[ai][bj][m][n]; if (u.ks == 0) v += *(const f32x4*)(bp + bj * HALF + n * 16); *(f32x4*)(op + bj * HALF + n * 16) = v; }
            }
    }
};
struct EpiQ {
    static constexpr bool PERM = true, AFTER_DRAIN = false;
    bf16_t* O; const float* rs; const f32x2* rope;
    __device__ __forceinline__ void operator()(const f32x4 (&acc)[2][2][4][2], const Unit& u, int wr, int wc, int fr, int fq) const {
        const int row0 = u.pm * BM + wr * 64 + fr, col0 = u.pn * BM + wc * 32 + 8 * fq;
#pragma unroll
        for (int ai = 0; ai < 2; ++ai)
#pragma unroll
            for (int m = 0; m < 4; ++m) {
                const int r = row0 + ai * HALF + m * 16; const float rv = rs[r] * QSCALE; const int t = r & (SEQ - 1);
                bf16_t* rowp = O + (size_t)r * 768 + col0;
#pragma unroll
                for (int bj = 0; bj < 2; ++bj) {
                    f32x4 v0 = acc[ai][bj][m][0] * rv, v1 = acc[ai][bj][m][1] * rv;
                    const int cc = (col0 + bj * HALF) % 96;
                    if (cc >= 64) {
                        const int q = cc - 64, half = q >> 4, jj = (q & 15) >> 1, pos = half ? (t & 63) : (t >> 6);
                        const f32x2* rp = rope + pos * 8 + jj;
                        const f32x2 c0 = rp[0], c1 = rp[1], c2 = rp[2], c3 = rp[3];
                        f32x4 o0, o1;
                        o0[0] = v0[0] * c0.x - v0[1] * c0.y; o0[1] = v0[0] * c0.y + v0[1] * c0.x; o0[2] = v0[2] * c1.x - v0[3] * c1.y; o0[3] = v0[2] * c1.y + v0[3] * c1.x;
                        o1[0] = v1[0] * c2.x - v1[1] * c2.y; o1[1] = v1[0] * c2.y + v1[1] * c2.x; o1[2] = v1[2] * c3.x - v1[3] * c3.y; o1[3] = v1[2] * c3.y + v1[3] * c3.x;
                        v0 = o0; v1 = o1;
                    }
                    u32x4 w; w.x = cvt_pk_bf16(v0[0], v0[1]); w.y = cvt_pk_bf16(v0[2], v0[3]); w.z = cvt_pk_bf16(v1[0], v1[1]); w.w = cvt_pk_bf16(v1[2], v1[3]);
                    *(u32x4*)(rowp + bj * HALF) = w;
                }
            }
    }
};
}

__device__ __forceinline__ int cmap(int id, int n) {
    switch (id) {
    case 0: return ((n >> 7) & 1) * DFF + (n >> 8) * 128 + (n & 127);
    case 1: return n;
    case 2: {
        if (n < 1536) return n;
        if (n < 2304) return 1552 + (n - 1536);
        if (n < 2560) return 2320 + (n - 2304);
        if (n < 2592) { const int q = n - 2560, half = q >> 4, jj = (q & 15) >> 1, which = q & 1; return 2576 + half * 16 + which * 8 + jj; }
        if (n < 2608) return 1536 + (n - 2592);
        return -1; }
    case 3: { const int hh = n / 96, cc = n % 96; if (cc < 64) return hh * 96 + cc;
        const int q = cc - 64, half = q >> 4, jj = (q & 15) >> 1, which = q & 1; return hh * 96 + 64 + half * 16 + which * 8 + jj; }
    case 4: return (n >> 6) * 128 + (n & 63);
    default: return (n >> 6) * 128 + 64 + (n & 63);
    }
}
__device__ __forceinline__ void titem(const float* W, int K, int N, bf16* WT, const float* gk, LAS float* scr, int item, int nblk, int lane, int id, float mulc = 1.f) {
    const int kb = item / nblk, nb = item % nblk, k0 = 64 * kb, n0 = 32 * nb;
    const int src = cmap(id, n0 + (lane & 31));
#pragma unroll 8
    for (int i = 0; i < 32; ++i) { const int kk = 2 * i + (lane >> 5); float v = src >= 0 ? W[(size_t)(k0 + kk) * N + src] : 0.f; if (gk) v *= gk[k0 + kk] * mulc; scr[kk * 33 + (lane & 31)] = v; }
    LDS_FENCE();
    const int c = lane & 7;
#pragma unroll
    for (int j = 0; j < 4; ++j) { const int n = (lane >> 3) + 8 * j; const LAS float* s = scr + (8 * c) * 33 + n;
        u32x4 o; o.x = pk2(s[0 * 33], s[1 * 33]); o.y = pk2(s[2 * 33], s[3 * 33]); o.z = pk2(s[4 * 33], s[5 * 33]); o.w = pk2(s[6 * 33], s[7 * 33]);
        *(u32x4*)(WT + (size_t)(n0 + n) * K + k0 + 8 * c) = o; }
    LDS_FENCE();
}
__device__ __forceinline__ void phase0(const Args& a, LAS unsigned char* lds, int gw, int NGW, int tid, int lane, int wave) {
    unsigned char* ws = a.ws;
    LAS float* scr = (LAS float*)(lds + wave * 16384);
    if (blockIdx.x < 144) {
        float* MOD = (float*)(ws + WS_MOD);
        const float* cin = a.in[1]; const float* cctx = a.in[3]; const float* wada = a.in[4]; const float* bada = a.in[5];
        const int n = blockIdx.x * 64 + lane, kw = wave * 128;
        float acc[9];
#pragma unroll
        for (int bb = 0; bb < 9; ++bb) acc[bb] = 0.f;
#pragma unroll 1
        for (int hf = 0; hf < 2; ++hf) {
            const int k0 = kw + 64 * hf;
            float sv[9];
#pragma unroll
            for (int bb = 0; bb < 8; ++bb) sv[bb] = silu_f(cin[bb * 1024 + k0 + lane]);
            sv[8] = silu_f(cctx[k0 + lane]);
#pragma unroll 16
            for (int k = 0; k < 64; ++k) {
                const float w = wada[(size_t)(k0 + k) * 9216 + n];
#pragma unroll
                for (int bb = 0; bb < 9; ++bb) acc[bb] += w * __shfl(sv[bb], k);
            }
        }
        LAS float* red = (LAS float*)lds;
#pragma unroll
        for (int bb = 0; bb < 9; ++bb) red[(wave * 9 + bb) * 64 + lane] = acc[bb];
        __syncthreads();
        for (int o = tid; o < 576; o += 512) { float t = bada[blockIdx.x * 64 + (o & 63)];
#pragma unroll
            for (int w = 0; w < 8; ++w) t += red[w * 576 + o];
            MOD[(o >> 6) * 9216 + blockIdx.x * 64 + (o & 63)] = t; }
        __syncthreads();
    }
    constexpr int I_W1A = 16 * 176, I_W1B = 44 * 32, I_WIN = 16 * 88, I_WUQ = 12 * 24, I_WK = 4 * 16, I_WOUT = 16 * 32;
    constexpr int NITEMS = 2 * I_W1A + 2 * I_W1B + I_WIN + I_WUQ + 2 * I_WK + I_WOUT;
    for (int rep0 = 0; rep0 < (PROBE_PHASE == 201 ? 2 : 1); ++rep0)
    for (int it = gw; it < NITEMS; it += NGW) {
        int r = it;
        if (r < I_W1A) { titem(a.in[7], 1024, 5632, (bf16*)(ws + WS_W1A), nullptr, scr, r, 176, lane, 0); continue; } r -= I_W1A;
        if (r < I_W1A) { titem(a.in[23], 1024, 5632, (bf16*)(ws + WS_W2A), nullptr, scr, r, 176, lane, 0); continue; } r -= I_W1A;
        if (r < I_W1B) { titem(a.in[8], 2816, 1024, (bf16*)(ws + WS_W1B), nullptr, scr, r, 32, lane, 1); continue; } r -= I_W1B;
        if (r < I_W1B) { titem(a.in[24], 2816, 1024, (bf16*)(ws + WS_W2B), nullptr, scr, r, 32, lane, 1); continue; } r -= I_W1B;
        if (r < I_WIN) { titem(a.in[10], 1024, 2608, (bf16*)(ws + WS_WIN), nullptr, scr, r, 88, lane, 2); continue; } r -= I_WIN;
        if (r < I_WUQ) { titem(a.in[18], 768, 768, (bf16*)(ws + WS_WUQ), a.in[17], scr, r, 24, lane, 3, QSCALE); continue; } r -= I_WUQ;
        if (r < I_WK) { titem(a.in[20], 256, 1024, (bf16*)(ws + WS_WK), a.in[19], scr, r, 16, lane, 4); continue; } r -= I_WK;
        if (r < I_WK) { titem(a.in[20], 256, 1024, (bf16*)(ws + WS_WV), a.in[19], scr, r, 16, lane, 5); continue; } r -= I_WK;
        titem(a.in[21], 1024, 1024, (bf16*)(ws + WS_WOUT), nullptr, scr, r, 32, lane, 1);
    }
    if (blockIdx.x == 0) {
        const int pos = tid >> 3, jj = tid & 7; const float inv = __builtin_amdgcn_exp2f(-(float)jj * 1.6609640474436813f);
        const float ang = (float)pos * inv;
        ((f32x2*)(ws + WS_ROPE))[tid] = (f32x2){__cosf(ang), __sinf(ang)};
    }
}

__device__ __forceinline__ void norm_rows(const float* src_lat, const float* src_ctx, int nrows, const float* gvec, const float* mod, int kshift, bf16* out, int gw, int NGW, int lane, const float* part = nullptr) {
    for (int row = gw; row < nrows; row += NGW) {
        const float* xr = (row < NLAT ? src_lat + (size_t)row * D : src_ctx + (size_t)(row - NLAT) * D) + 4 * lane;
        const int bb = row < NLAT ? row / SEQ : 8;
        const float* sh = mod + bb * 9216 + kshift * 1024 + 4 * lane; const float* sc = sh + 1024;
        f32x4 v[4]; float s = 0.f;
#pragma unroll
        for (int j = 0; j < 4; ++j) { v[j] = *(const f32x4*)(xr + 256 * j);
            if (part && row >= NLAT) { const float* pp = part + (size_t)(row - NLAT) * D + 4 * lane + 256 * j;
                v[j] += *(const f32x4*)pp + *(const f32x4*)(pp + (size_t)NCTX * D) + *(const f32x4*)(pp + (size_t)2 * NCTX * D); }
            s += (v[j][0] * v[j][0] + v[j][1] * v[j][1]) + (v[j][2] * v[j][2] + v[j][3] * v[j][3]); }
        const float rstd = 1.0f / sqrtf(wave_sum(s) * (1.f / D) + EPS);
        bf16* orow = out + (size_t)row * D + 4 * lane;
#pragma unroll
        for (int j = 0; j < 4; ++j) {
            const f32x4 g = *(const f32x4*)(gvec + 4 * lane + 256 * j), scv = *(const f32x4*)(sc + 256 * j), shv = *(const f32x4*)(sh + 256 * j);
            const f32x4 y = (v[j] * rstd) * g * (scv + 1.f) + shv;
            u32x2 w; w.x = pk2(y[0], y[1]); w.y = pk2(y[2], y[3]); *(u32x2*)(orow + 256 * j) = w;
        }
    }
}
__device__ __forceinline__ void final_norm_rows(float* io, const float* gvec, int gw, int NGW, int lane) {
    for (int row = gw; row < NLAT; row += NGW) {
        float* xr = io + (size_t)row * D + 4 * lane;
        f32x4 v[4]; float s = 0.f;
#pragma unroll
        for (int j = 0; j < 4; ++j) { v[j] = *(const f32x4*)(xr + 256 * j); s += (v[j][0] * v[j][0] + v[j][1] * v[j][1]) + (v[j][2] * v[j][2] + v[j][3] * v[j][3]); }
        const float rstd = 1.0f / sqrtf(wave_sum(s) * (1.f / D) + EPS);
#pragma unroll
        for (int j = 0; j < 4; ++j) { const f32x4 g = *(const f32x4*)(gvec + 4 * lane + 256 * j); *(f32x4*)(xr + 256 * j) = (v[j] * rstd) * g; }
    }
}

__device__ __forceinline__ float softplus_f(float x) { return fmaxf(x, 0.f) + log1pf(__expf(-fabsf(x))); }
__device__ __forceinline__ void phase6(const Args& a, LAS unsigned char* lds, int G, int bx, int tid, int lane, int wave) {
    unsigned char* ws = a.ws;
    const bf16* XBCR = (const bf16*)(ws + WS_XBCR); const bf16* MISC = (const bf16*)(ws + WS_MISC); const bf16* CQ = (const bf16*)(ws + WS_CQ); const bf16* CKV = (const bf16*)(ws + WS_CKV);
    bf16* XT = (bf16*)(ws + WS_XT); bf16* BT = (bf16*)(ws + WS_BT); bf16* BROW = (bf16*)(ws + WS_BROW); bf16* CROW = (bf16*)(ws + WS_CROW); bf16* KPE = (bf16*)(ws + WS_KPE);
    float* DT = (float*)(ws + WS_DT); float* RSTDQ = (float*)(ws + WS_RSTDQ); float* RSTDKV = (float*)(ws + WS_RSTDKV); const f32x2* ROPE = (const f32x2*)(ws + WS_ROPE);
    const float* conv_w = a.in[11]; const float* conv_b = a.in[12]; const float* dt_bias = a.in[13];
    LAS bf16* T = (LAS bf16*)lds;
    const int ch = 4 * (tid & 255), tseg = (tid >> 8) * 32;
    float cw[5][4], cb[4];
#pragma unroll
    for (int k = 0; k < 5; ++k) { const f32x4 w = *(const f32x4*)(conv_w + k * 1024 + ch); cw[k][0] = w[0]; cw[k][1] = w[1]; cw[k][2] = w[2]; cw[k][3] = w[3]; }
    { const f32x4 w = *(const f32x4*)(conv_b + ch); cb[0] = w[0]; cb[1] = w[1]; cb[2] = w[2]; cb[3] = w[3]; }
    for (int unit = bx; unit < NB * 68; unit += G) {
        const int b = unit / 68, ut = unit % 68, u0 = ut * 64;
        const int seg_lo = u0 < CTXL ? 0 : CTXL, seg_hi = u0 < CTXL ? CTXL : UL;
        const int rb = u0 < CTXL ? NLAT + b * CTXL : b * SEQ - CTXL;
#define P6_LD(u) (((u) >= seg_lo && (u) < seg_hi) ? *(const u32x2*)(XBCR + (size_t)(rb + (u)) * 1024 + ch) : (u32x2){0u, 0u})
        const int ub = u0 + tseg;
        u32x2 xm2 = P6_LD(ub - 2), xm1 = P6_LD(ub - 1), x0 = P6_LD(ub), xp1 = P6_LD(ub + 1);
#pragma unroll 16
        for (int t = 0; t < 32; ++t) {
            const u32x2 xp2 = P6_LD(ub + t + 2);
            const float y0 = cb[0] + cw[0][0] * bflo(xm2.x) + cw[1][0] * bflo(xm1.x) + cw[2][0] * bflo(x0.x) + cw[3][0] * bflo(xp1.x) + cw[4][0] * bflo(xp2.x);
            const float y1 = cb[1] + cw[0][1] * bfhi(xm2.x) + cw[1][1] * bfhi(xm1.x) + cw[2][1] * bfhi(x0.x) + cw[3][1] * bfhi(xp1.x) + cw[4][1] * bfhi(xp2.x);
            const float y2 = cb[2] + cw[0][2] * bflo(xm2.y) + cw[1][2] * bflo(xm1.y) + cw[2][2] * bflo(x0.y) + cw[3][2] * bflo(xp1.y) + cw[4][2] * bflo(xp2.y);
            const float y3 = cb[3] + cw[0][3] * bfhi(xm2.y) + cw[1][3] * bfhi(xm1.y) + cw[2][3] * bfhi(x0.y) + cw[3][3] * bfhi(xp1.y) + cw[4][3] * bfhi(xp2.y);
            u32x2 pk; pk.x = pk2(silu_f(y0), silu_f(y1)); pk.y = pk2(silu_f(y2), silu_f(y3));
            const int tt = tseg + t;
            if (ch < 768) { T[ch * 72 + tt] = (bf16)(pk.x & 0xffffu); T[(ch + 1) * 72 + tt] = (bf16)(pk.x >> 16); T[(ch + 2) * 72 + tt] = (bf16)(pk.y & 0xffffu); T[(ch + 3) * 72 + tt] = (bf16)(pk.y >> 16); }
            if (ch >= 512) { bf16* dst = ch < 768 ? BROW + (ch - 512) : CROW + (ch - 768); *(u32x2*)(dst + (size_t)(b * UL + u0 + tt) * 256) = pk; }
            xm2 = xm1; xm1 = x0; x0 = xp1; xp1 = xp2;
        }
#undef P6_LD
        __syncthreads();
#pragma unroll
        for (int i = 0; i < 12; ++i) { const int q = tid + 512 * i, c = q >> 3, part = q & 7;
            const u32x4 v = *(const LAS u32x4*)(T + c * 72 + part * 8);
            bf16* dst = c < 512 ? XT + (size_t)(b * 512 + c) * UL : BT + (size_t)(b * 256 + c - 512) * UL;
            *(u32x4*)(dst + u0 + part * 8) = v; }
        {
            const int uu = tid >> 3, k = (tid & 7) * 2; const size_t row = (size_t)(rb + u0 + uu);
            const unsigned raw = *(const unsigned*)(MISC + row * 256 + 32 + k);
            f32x2 o; o.x = softplus_f(bflo(raw) + dt_bias[k]); o.y = softplus_f(bfhi(raw) + dt_bias[k + 1]);
            *(f32x2*)(DT + (size_t)(b * UL + u0 + uu) * 16 + k) = o;
        }
        {
            const int uu = tid >> 3, pp = (tid & 7) * 2; const size_t row = (size_t)(rb + u0 + uu);
            u32x2 raw = *(const u32x2*)(MISC + row * 256 + 2 * pp);
            if (u0 >= CTXL) {
                const int t = u0 + uu - CTXL, half = pp >> 3, jj = pp & 7, pos = half ? (t & 63) : (t >> 6);
                const f32x2 c0 = ROPE[pos * 8 + jj], c1 = ROPE[pos * 8 + jj + 1];
                const float a0 = bflo(raw.x), a1 = bfhi(raw.x), a2 = bflo(raw.y), a3 = bfhi(raw.y);
                raw.x = pk2(a0 * c0.x - a1 * c0.y, a0 * c0.y + a1 * c0.x); raw.y = pk2(a2 * c1.x - a3 * c1.y, a2 * c1.y + a3 * c1.x);
            }
            *(u32x2*)(KPE + row * 32 + 2 * pp) = raw;
        }
#pragma unroll 2
        for (int rr = 0; rr < 8; ++rr) {
            const size_t row = (size_t)(rb + u0 + wave * 8 + rr);
            { const u32x2 w = *(const u32x2*)(CKV + row * 256 + 4 * lane); const float c0 = bflo(w.x), c1 = bfhi(w.x), c2 = bflo(w.y), c3 = bfhi(w.y);
              const float s = wave_sum((c0 * c0 + c1 * c1) + (c2 * c2 + c3 * c3)); if (lane == 0) RSTDKV[row] = 1.0f / sqrtf(s * (1.f / 256.f) + EPS); }
            if (u0 >= CTXL) { float s = 0.f;
#pragma unroll
                for (int i = 0; i < 3; ++i) { const u32x2 w = *(const u32x2*)(CQ + row * 768 + 4 * lane + 256 * i); const float c0 = bflo(w.x), c1 = bfhi(w.x), c2 = bflo(w.y), c3 = bfhi(w.y);
                    s += (c0 * c0 + c1 * c1) + (c2 * c2 + c3 * c3); }
                s = wave_sum(s); if (lane == 0) RSTDQ[row] = 1.0f / sqrtf(s * (1.f / 768.f) + EPS); }
        }
        __syncthreads();
    }
}

__device__ __forceinline__ void acum_wave(const float* DT, size_t dtrow0, int h, float anf, float anb, LAS float* sc, int lane) {
    const float df0 = DT[(dtrow0 + lane) * 16 + h], df1 = DT[(dtrow0 + 64 + lane) * 16 + h];
    const float db0 = DT[(dtrow0 + lane) * 16 + 8 + h], db1 = DT[(dtrow0 + 64 + lane) * 16 + 8 + h];
    const float f0 = incl_scan(df0 * anf, lane); float f1 = incl_scan(df1 * anf, lane); f1 += __shfl(f0, 63);
    const float a0 = db0 * anb, a1 = db1 * anb; const float g0 = incl_scan(a0, lane), g1 = incl_scan(a1, lane);
    const float t0 = __shfl(g0, 63), t1 = __shfl(g1, 63), tot = t0 + t1;
    sc[lane] = f0; sc[64 + lane] = f1; sc[128 + lane] = tot - g0 + a0; sc[192 + lane] = t1 - g1 + a1;
    sc[256 + lane] = df0; sc[320 + lane] = df1; sc[384 + lane] = db0; sc[448 + lane] = db1;
    LDS_FENCE();
}
#define MFMA32(a, b, c) __builtin_amdgcn_mfma_f32_32x32x16_bf16((a), (b), (c), 0, 0, 0)
__device__ __forceinline__ f32x16 zero16() { f32x16 z;
#pragma unroll
    for (int r = 0; r < 16; ++r) z[r] = 0.f; return z; }

constexpr int S3_STR = 136, S3_TILE = 128 * S3_STR * 2;
constexpr int S3_CL = 0, S3_BL = 2 * S3_TILE, S3_SC = 4 * S3_TILE, S3_SS = S3_SC + 16384;
__device__ __forceinline__ void phase8(const Args& a, LAS unsigned char* lds, int G, int bx, int tid, int lane, int wave) {
    unsigned char* ws = a.ws;
    const bf16* XT = (const bf16*)(ws + WS_XT); const bf16* BT = (const bf16*)(ws + WS_BT); const float* DT = (const float*)(ws + WS_DT);
    bf16* ST = (bf16*)(ws + WS_ST); float* CD = (float*)(ws + WS_CD);
    LAS float* sc = (LAS float*)(lds + S3_SC) + wave * 512;
    const int h = wave, g = h >> 2, r32 = lane & 31, hi = lane >> 5;
    const float anf = -__expf(a.in[14][h]), anb = -__expf(a.in[14][8 + h]);
    for (int unit = bx; unit < NB * NCH; unit += G) {
        const int b = unit / NCH, c = unit % NCH;
#pragma unroll
        for (int it = 0; it < 8; ++it) { const int q = tid + 512 * it, n = q >> 4, k16 = q & 15;
            const u32x4 v = *(const u32x4*)(BT + (size_t)(b * 256 + n) * UL + c * 128 + 8 * k16);
            *(LAS u32x4*)(lds + (n * S3_STR + 8 * k16) * 2) = v; }
        acum_wave(DT, (size_t)b * UL + c * 128, h, anf, anb, sc, lane);
        const float af_last = sc[127], ab_first = sc[128];
#pragma unroll
        for (int hf = 0; hf < 2; ++hf) { const int j = lane + 64 * hf;
            const float wf = __expf(af_last - sc[j]) * sc[256 + j], wb = __expf(ab_first - sc[128 + j]) * sc[384 + j];
            sc[256 + j] = wf; sc[384 + j] = wb; }
        if (lane == 0) { CD[((b * 2 + 0) * 8 + h) * NCH + c] = __expf(af_last); CD[((b * 2 + 1) * 8 + h) * NCH + c] = __expf(ab_first); }
        __syncthreads();
        const bf16* xbase = XT + (size_t)(b * 512 + h * 64 + r32) * UL + c * 128 + 8 * hi;
        const LAS unsigned char* btl = lds + ((g * 128 + r32) * S3_STR + 8 * hi) * 2;
        const LAS float* wfp = sc + 256 + 8 * hi; const LAS float* wbp = sc + 384 + 8 * hi;
#pragma unroll 1
        for (int half = 0; half < 2; ++half) {
            f32x16 accf[2][2], accb[2][2];
#pragma unroll
            for (int nn = 0; nn < 2; ++nn) { accf[nn][0] = zero16(); accf[nn][1] = zero16(); accb[nn][0] = zero16(); accb[nn][1] = zero16(); }
#pragma unroll 2
            for (int s = 0; s < 8; ++s) {
                const f32x4 fa = *(const LAS f32x4*)(wfp + 16 * s), fb = *(const LAS f32x4*)(wfp + 16 * s + 4), ba = *(const LAS f32x4*)(wbp + 16 * s), bb = *(const LAS f32x4*)(wbp + 16 * s + 4);
                bf16x8 xwf[2], xwb[2];
#pragma unroll
                for (int pb = 0; pb < 2; ++pb) { const u32x4 raw = *(const u32x4*)(xbase + (size_t)pb * 32 * UL + 16 * s);
                    const float x0 = bflo(raw.x), x1 = bfhi(raw.x), x2 = bflo(raw.y), x3 = bfhi(raw.y), x4 = bflo(raw.z), x5 = bfhi(raw.z), x6 = bflo(raw.w), x7 = bfhi(raw.w);
                    xwf[pb] = pack8(x0 * fa[0], x1 * fa[1], x2 * fa[2], x3 * fa[3], x4 * fb[0], x5 * fb[1], x6 * fb[2], x7 * fb[3]);
                    xwb[pb] = pack8(x0 * ba[0], x1 * ba[1], x2 * ba[2], x3 * ba[3], x4 * bb[0], x5 * bb[1], x6 * bb[2], x7 * bb[3]); }
#pragma unroll
                for (int nn = 0; nn < 2; ++nn) { const bf16x8 bt = *(const LAS bf16x8*)(btl + ((2 * half + nn) * 32 * S3_STR + 16 * s) * 2);
                    accf[nn][0] = MFMA32(bt, xwf[0], accf[nn][0]); accf[nn][1] = MFMA32(bt, xwf[1], accf[nn][1]);
                    accb[nn][0] = MFMA32(bt, xwb[0], accb[nn][0]); accb[nn][1] = MFMA32(bt, xwb[1], accb[nn][1]); }
            }
            bf16* sof = ST + ((size_t)(((b * 2 + 0) * 8 + h) * NCH + c) * 64) * 128; bf16* sob = ST + ((size_t)(((b * 2 + 1) * 8 + h) * NCH + c) * 64) * 128;
#pragma unroll
            for (int nn = 0; nn < 2; ++nn)
#pragma unroll
                for (int pb = 0; pb < 2; ++pb)
#pragma unroll
                    for (int g4 = 0; g4 < 4; ++g4) { const size_t off = (size_t)(32 * pb + r32) * 128 + 32 * (2 * half + nn) + 8 * g4 + 4 * hi;
                        u32x2 o; o.x = pk2(accf[nn][pb][4 * g4], accf[nn][pb][4 * g4 + 1]); o.y = pk2(accf[nn][pb][4 * g4 + 2], accf[nn][pb][4 * g4 + 3]); *(u32x2*)(sof + off) = o;
                        o.x = pk2(accb[nn][pb][4 * g4], accb[nn][pb][4 * g4 + 1]); o.y = pk2(accb[nn][pb][4 * g4 + 2], accb[nn][pb][4 * g4 + 3]); *(u32x2*)(sob + off) = o; }
        }
        __syncthreads();
    }
}
__device__ __forceinline__ void phase9(const Args& a, int G, int bx, int tid) {
    unsigned char* ws = a.ws;
    const bf16* ST = (const bf16*)(ws + WS_ST); bf16* HE = (bf16*)(ws + WS_HE); const float* CD = (const float*)(ws + WS_CD);
    for (int idx = bx * 512 + tid; idx < NB * 2 * 8 * 2048; idx += G * 512) {
        const int e = (idx & 2047) * 4, bdh = idx >> 11, dir = (bdh >> 3) & 1;
        const bf16* st = ST + (size_t)bdh * NCH * 8192 + e; bf16* he = HE + (size_t)bdh * 32 * 8192 + e; const float* cd = CD + bdh * NCH;
#define P9_LD(c) (*(const u32x2*)(st + (size_t)(c) * 8192))
#define P9_STEP(c) do { const u32x2 w_ = P9_LD(c); const float d_ = cd[c]; h0 = d_ * h0 + bflo(w_.x); h1 = d_ * h1 + bfhi(w_.x); h2 = d_ * h2 + bflo(w_.y); h3 = d_ * h3 + bfhi(w_.y); } while (0)
#define P9_OUT(c) do { u32x2 o_; o_.x = pk2(h0, h1); o_.y = pk2(h2, h3); *(u32x2*)(he + (size_t)((c) - 2) * 8192) = o_; } while (0)
        float h0 = 0.f, h1 = 0.f, h2 = 0.f, h3 = 0.f;
        if (dir == 0) {
            P9_STEP(0); P9_STEP(1);
#pragma unroll 8
            for (int c = 2; c < NCH; ++c) { P9_OUT(c); P9_STEP(c); }
        } else {
            P9_STEP(1); P9_STEP(0);
#pragma unroll 8
            for (int c = NCH - 1; c >= 2; --c) { P9_OUT(c); P9_STEP(c); }
        }
#undef P9_LD
#undef P9_STEP
#undef P9_OUT
    }
}
__device__ __forceinline__ void phase10_ssd(const Args& a, LAS unsigned char* lds, int G, int bx, int tid, int lane, int wave) {
    unsigned char* ws = a.ws;
    const bf16* XT = (const bf16*)(ws + WS_XT); const bf16* BROW = (const bf16*)(ws + WS_BROW); const bf16* CROW = (const bf16*)(ws + WS_CROW); const float* DT = (const float*)(ws + WS_DT);
    const bf16* HE = (const bf16*)(ws + WS_HE); const bf16* Z = (const bf16*)(ws + WS_Z); bf16* MIX = (bf16*)(ws + WS_MIX);
    LAS float* sc = (LAS float*)(lds + S3_SC) + wave * 512;
    LAS float* SS = (LAS float*)(lds + S3_SS);
    const int h = wave, g = h >> 2, r32 = lane & 31, hi = lane >> 5;
    const float anf = -__expf(a.in[14][h]), anb = -__expf(a.in[14][8 + h]);
    const float dskip = a.in[15][h]; const float* snorm = a.in[16] + h * 64;
    for (int unit = bx; unit < NB * 32; unit += G) {
        const int b = unit >> 5, lc = unit & 31, c = lc + 2; const size_t u0 = (size_t)b * UL + c * 128;
#pragma unroll
        for (int it = 0; it < 8; ++it) { const int q = tid + 512 * it, i = q >> 5, ch16 = q & 31, off = ((ch16 >> 4) * S3_TILE) + (i * S3_STR + (ch16 & 15) * 8) * 2;
            const u32x4 vc = *(const u32x4*)(CROW + (u0 + i) * 256 + 8 * ch16), vb = *(const u32x4*)(BROW + (u0 + i) * 256 + 8 * ch16);
            *(LAS u32x4*)(lds + S3_CL + off) = vc; *(LAS u32x4*)(lds + S3_BL + off) = vb; }
        acum_wave(DT, u0, h, anf, anb, sc, lane);
        {
            float wfv[2], wbv[2];
#pragma unroll
            for (int hf = 0; hf < 2; ++hf) { const int j = lane + 64 * hf, jb = j >> 5;
                const float afb = jb ? sc[32 * jb - 1] : 0.f, abb = jb < 3 ? sc[128 + 32 * jb + 32] : 0.f;
                wfv[hf] = __expf(afb - sc[j]) * sc[256 + j]; wbv[hf] = __expf(abb - sc[128 + j]) * sc[384 + j]; }
            LDS_FENCE();
#pragma unroll
            for (int hf = 0; hf < 2; ++hf) { const int j = lane + 64 * hf; sc[256 + j] = wfv[hf]; sc[384 + j] = wbv[hf]; }
        }
        __syncthreads();
        const LAS unsigned char* CLg = lds + S3_CL + g * S3_TILE + (r32 * S3_STR + 8 * hi) * 2;
        const LAS unsigned char* BLg = lds + S3_BL + g * S3_TILE + (r32 * S3_STR + 8 * hi) * 2;
#pragma unroll 1
        for (int ibp = 0; ibp < 2; ++ibp) {
        f32x16 acc[2][2];
#pragma unroll
        for (int k = 0; k < 2; ++k) { acc[k][0] = zero16(); acc[k][1] = zero16(); }
#ifndef NO_DIAG
#pragma unroll 1
        for (int jb = 0; jb < 4; ++jb) {
            bf16x8 xa[2][2];
#pragma unroll
            for (int pb = 0; pb < 2; ++pb) {
                const bf16* xp = XT + (size_t)(b * 512 + h * 64 + 32 * pb + r32) * UL + c * 128 + 32 * jb + 4 * hi;
                const u32x2 a0 = *(const u32x2*)(xp), a1 = *(const u32x2*)(xp + 8), a2 = *(const u32x2*)(xp + 16), a3 = *(const u32x2*)(xp + 24);
                xa[pb][0] = __builtin_bit_cast(bf16x8, (u32x4){a0.x, a0.y, a1.x, a1.y}); xa[pb][1] = __builtin_bit_cast(bf16x8, (u32x4){a2.x, a2.y, a3.x, a3.y});
            }
#pragma unroll
            for (int k = 0; k < 2; ++k) {
                const int ib = 2 * ibp + k;
                f32x16 ga = zero16();
#pragma unroll
                for (int s = 0; s < 8; ++s) { const bf16x8 bfr = *(const LAS bf16x8*)(BLg + (32 * jb * S3_STR + 16 * s) * 2), cf = *(const LAS bf16x8*)(CLg + (32 * ib * S3_STR + 16 * s) * 2);
                    ga = MFMA32(bfr, cf, ga); }
                float mm[16];
                if (jb < ib) {
                    const float efi = __expf(sc[32 * ib + r32] - sc[32 * jb + 31]);
#pragma unroll
                    for (int r = 0; r < 16; ++r) mm[r] = ga[r] * sc[256 + 32 * jb + crow(r, hi)];
                    const float efb = __expf(sc[32 * ib + r32] - (jb ? sc[32 * jb - 1] : 0.f));
#pragma unroll
                    for (int r = 0; r < 16; ++r) mm[r] *= efb;
                    (void)efi;
                } else if (jb > ib) {
                    const float ebb = __expf(sc[128 + 32 * ib + r32] - (jb < 3 ? sc[128 + 32 * jb + 32] : 0.f));
#pragma unroll
                    for (int r = 0; r < 16; ++r) mm[r] = ga[r] * sc[384 + 32 * jb + crow(r, hi)] * ebb;
                } else {
                    const float efb = __expf(sc[32 * ib + r32] - (jb ? sc[32 * jb - 1] : 0.f)), ebb = __expf(sc[128 + 32 * ib + r32] - (jb < 3 ? sc[128 + 32 * jb + 32] : 0.f));
#pragma unroll
                    for (int r = 0; r < 16; ++r) { const int jl = crow(r, hi);
                        const float mf = jl <= r32 ? efb * sc[256 + 32 * jb + jl] : 0.f, mb = jl >= r32 ? ebb * sc[384 + 32 * jb + jl] : 0.f;
                        mm[r] = ga[r] * (mf + mb) + (jl == r32 ? dskip : 0.f); }
                }
                const bf16x8 pf0 = pack8(mm[0], mm[1], mm[2], mm[3], mm[4], mm[5], mm[6], mm[7]), pf1 = pack8(mm[8], mm[9], mm[10], mm[11], mm[12], mm[13], mm[14], mm[15]);
                acc[k][0] = MFMA32(xa[0][0], pf0, acc[k][0]); acc[k][0] = MFMA32(xa[0][1], pf1, acc[k][0]);
                acc[k][1] = MFMA32(xa[1][0], pf0, acc[k][1]); acc[k][1] = MFMA32(xa[1][1], pf1, acc[k][1]);
                asm volatile("" ::: "memory");
            }
        }
#endif
#ifndef NO_OFF
#pragma unroll 1
        for (int dir = 0; dir < 2; ++dir) {
#pragma unroll
            for (int pb = 0; pb < 2; ++pb) {
                const bf16* hp = HE + ((size_t)(((b * 2 + dir) * 8 + h) * 32 + lc) * 64 + 32 * pb + r32) * 128 + 8 * hi;
                f32x16 ta0 = zero16(), ta1 = zero16();
#pragma unroll
                for (int s = 0; s < 8; ++s) { const bf16x8 hf = *(const bf16x8*)(hp + 16 * s);
                    const bf16x8 cf0 = *(const LAS bf16x8*)(CLg + (32 * (2 * ibp) * S3_STR + 16 * s) * 2), cf1 = *(const LAS bf16x8*)(CLg + (32 * (2 * ibp + 1) * S3_STR + 16 * s) * 2);
                    ta0 = MFMA32(hf, cf0, ta0); ta1 = MFMA32(hf, cf1, ta1);
                    if ((s & 3) == 3) asm volatile("" ::: "memory"); }
                const float e0 = __expf(sc[128 * dir + 32 * (2 * ibp) + r32]), e1 = __expf(sc[128 * dir + 32 * (2 * ibp + 1) + r32]);
#pragma unroll
                for (int r = 0; r < 16; ++r) { acc[0][pb][r] += e0 * ta0[r]; acc[1][pb][r] += e1 * ta1[r]; }
                asm volatile("" ::: "memory");
            }
        }
#endif
#pragma unroll
        for (int k = 0; k < 2; ++k) {
            const int ib = 2 * ibp + k;
            const size_t row = (size_t)b * SEQ + lc * 128 + 32 * ib + r32;
            float ss = 0.f;
#pragma unroll
            for (int pb = 0; pb < 2; ++pb)
#pragma unroll
                for (int g4 = 0; g4 < 4; ++g4) { const u32x2 zw = *(const u32x2*)(Z + row * 512 + h * 64 + 32 * pb + 8 * g4 + 4 * hi);
                    const float v0 = acc[k][pb][4 * g4] * silu_f(bflo(zw.x)), v1 = acc[k][pb][4 * g4 + 1] * silu_f(bfhi(zw.x)), v2 = acc[k][pb][4 * g4 + 2] * silu_f(bflo(zw.y)), v3 = acc[k][pb][4 * g4 + 3] * silu_f(bfhi(zw.y));
                    ss += (v0 * v0 + v1 * v1) + (v2 * v2 + v3 * v3);
                    acc[k][pb][4 * g4] = v0; acc[k][pb][4 * g4 + 1] = v1; acc[k][pb][4 * g4 + 2] = v2; acc[k][pb][4 * g4 + 3] = v3; }
            ss += __shfl_xor(ss, 32);
            if (hi == 0) SS[(ib * 8 + wave) * 32 + r32] = ss;
        }
        __syncthreads();
#pragma unroll
        for (int k = 0; k < 2; ++k) {
            const int ib = 2 * ibp + k;
            const size_t row = (size_t)b * SEQ + lc * 128 + 32 * ib + r32;
            float tot = 0.f;
#pragma unroll
            for (int w = 0; w < 8; ++w) tot += SS[(ib * 8 + w) * 32 + r32];
            const float rstd = 1.0f / sqrtf(tot * (1.f / 512.f) + EPS);
#pragma unroll
            for (int pb = 0; pb < 2; ++pb)
#pragma unroll
                for (int g4 = 0; g4 < 4; ++g4) { const int p0 = 32 * pb + 8 * g4 + 4 * hi; const f32x4 gn = *(const f32x4*)(snorm + p0);
                    u32x2 o; o.x = pk2(acc[k][pb][4 * g4] * rstd * gn[0], acc[k][pb][4 * g4 + 1] * rstd * gn[1]); o.y = pk2(acc[k][pb][4 * g4 + 2] * rstd * gn[2], acc[k][pb][4 * g4 + 3] * rstd * gn[3]);
                    *(u32x2*)(MIX + row * 1024 + h * 64 + p0) = o; }
        }
        }
        __syncthreads();
    }
}

constexpr int AT_KS = 104, AT_VS = 68, AT_KB = 64 * AT_KS * 2, AT_BUF = AT_KB + 64 * AT_VS * 2;
__device__ __forceinline__ void phase10_attn(const Args& a, LAS unsigned char* lds, int G, int vcu, int tid, int lane, int wave) {
    unsigned char* ws = a.ws; unsigned char* ob = (unsigned char*)a.out;
    const bf16* Q = (const bf16*)(ob + OUT_Q); const bf16* KN = (const bf16*)(ob + OUT_KN); const bf16* VT = (const bf16*)(ob + OUT_VT); const bf16* KPE = (const bf16*)(ws + WS_KPE);
    bf16* MIX = (bf16*)(ws + WS_MIX); const f32x2* ROPE = (const f32x2*)(ws + WS_ROPE);
    const int r32 = lane & 31, hi = lane >> 5;
    for (int unit = vcu; unit < NB * 8 * 16; unit += G) {
        const int bh = unit >> 4, qb = unit & 15, b = bh >> 3, h = bh & 7;
        const size_t qrow = (size_t)b * SEQ + qb * 256 + wave * 32 + r32;
        bf16x8 qr[6];
        { const bf16* qp = Q + qrow * 768 + h * 96 + 8 * hi;
#pragma unroll
          for (int s = 0; s < 6; ++s) qr[s] = *(const bf16x8*)(qp + 16 * s);
          const int tq = qb * 256 + wave * 32 + r32;
#pragma unroll
          for (int s = 4; s < 6; ++s) { const int pos = (s == 4) ? (tq >> 6) : (tq & 63); const f32x2* rp = ROPE + pos * 8 + 4 * hi;
              const u32x4 w = __builtin_bit_cast(u32x4, qr[s]); const f32x2 c0 = rp[0], c1 = rp[1], c2 = rp[2], c3 = rp[3]; u32x4 o;
              o.x = pk2(bflo(w.x) * c0.x - bfhi(w.x) * c0.y, bflo(w.x) * c0.y + bfhi(w.x) * c0.x); o.y = pk2(bflo(w.y) * c1.x - bfhi(w.y) * c1.y, bflo(w.y) * c1.y + bfhi(w.y) * c1.x);
              o.z = pk2(bflo(w.z) * c2.x - bfhi(w.z) * c2.y, bflo(w.z) * c2.y + bfhi(w.z) * c2.x); o.w = pk2(bflo(w.w) * c3.x - bfhi(w.w) * c3.y, bflo(w.w) * c3.y + bfhi(w.w) * c3.x);
              qr[s] = __builtin_bit_cast(bf16x8, o); } }
        const int kr = tid >> 3, kpart = tid & 7;
        const int pr = tid >> 2, ppart = tid & 3;
#define AT_ROW0(t) ((t) < 4 ? (size_t)NLAT + b * CTXL + (t) * 64 : (size_t)b * SEQ + ((t) - 4) * 64)
#define AT_LOAD(t) do { const size_t r0_ = AT_ROW0(t); \
        gk = *(const u32x4*)(KN + (r0_ + kr) * 512 + h * 64 + kpart * 8); \
        gv = *(const u32x4*)(VT + (size_t)(h * 64 + kr) * MTOT + r0_ + kpart * 8); \
        if (tid < 256) gp = *(const u32x4*)(KPE + (r0_ + pr) * 32 + ppart * 8); } while (0)
#define AT_STORE(bufi) do { LAS unsigned char* B_ = lds + (bufi) * AT_BUF; \
        *(LAS u32x4*)(B_ + (kr * AT_KS + kpart * 8) * 2) = gk; \
        *(LAS u32x2*)(B_ + AT_KB + (kr * AT_VS + kpart * 8) * 2) = (u32x2){gv.x, gv.y}; *(LAS u32x2*)(B_ + AT_KB + (kr * AT_VS + kpart * 8 + 4) * 2) = (u32x2){gv.z, gv.w}; \
        if (tid < 256) *(LAS u32x4*)(B_ + (pr * AT_KS + 64 + ppart * 8) * 2) = gp; } while (0)
        u32x4 gk, gv, gp = (u32x4){0u, 0u, 0u, 0u};
        AT_LOAD(0); AT_STORE(0);
        __syncthreads();
        float mrun = -INFINITY, lrun = 0.f;
        f32x16 o[2]; o[0] = zero16(); o[1] = zero16();
#pragma unroll 1
        for (int t = 0; t < 68; ++t) {
            if (t + 1 < 68) AT_LOAD(t + 1);
            const LAS unsigned char* Bc = lds + (t & 1) * AT_BUF;
            f32x16 p0 = zero16(), p1 = zero16();
#pragma unroll
            for (int s = 0; s < 6; ++s) {
                const bf16x8 k0 = *(const LAS bf16x8*)(Bc + (r32 * AT_KS + 16 * s + 8 * hi) * 2), k1 = *(const LAS bf16x8*)(Bc + ((32 + r32) * AT_KS + 16 * s + 8 * hi) * 2);
                p0 = MFMA32(k0, qr[s], p0); p1 = MFMA32(k1, qr[s], p1);
            }
            float mx = fmaxf(p0[0], p1[0]);
#pragma unroll
            for (int r = 1; r < 16; ++r) mx = fmaxf(mx, fmaxf(p0[r], p1[r]));
            mx = fmaxf(mx, __shfl_xor(mx, 32));
            if (__any(mx > mrun)) {
                const float mnew = fmaxf(mrun, mx), alpha = __builtin_amdgcn_exp2f(mrun - mnew);
                mrun = mnew; lrun *= alpha;
#pragma unroll
                for (int r = 0; r < 16; ++r) { o[0][r] *= alpha; o[1][r] *= alpha; }
            }
            float rs = 0.f;
#pragma unroll
            for (int r = 0; r < 16; ++r) { p0[r] = __builtin_amdgcn_exp2f(p0[r] - mrun); p1[r] = __builtin_amdgcn_exp2f(p1[r] - mrun); rs += p0[r] + p1[r]; }
            lrun += rs;
            bf16x8 pf[4];
            pf[0] = pack8(p0[0], p0[1], p0[2], p0[3], p0[4], p0[5], p0[6], p0[7]); pf[1] = pack8(p0[8], p0[9], p0[10], p0[11], p0[12], p0[13], p0[14], p0[15]);
            pf[2] = pack8(p1[0], p1[1], p1[2], p1[3], p1[4], p1[5], p1[6], p1[7]); pf[3] = pack8(p1[8], p1[9], p1[10], p1[11], p1[12], p1[13], p1[14], p1[15]);
#pragma unroll
            for (int db = 0; db < 2; ++db)
#pragma unroll
                for (int s = 0; s < 4; ++s) {
                    const LAS unsigned char* vp = Bc + AT_KB + ((32 * db + r32) * AT_VS + 16 * s + 4 * hi) * 2;
                    const u32x2 v0 = *(const LAS u32x2*)vp, v1 = *(const LAS u32x2*)(vp + 16);
                    o[db] = MFMA32(__builtin_bit_cast(bf16x8, (u32x4){v0.x, v0.y, v1.x, v1.y}), pf[s], o[db]);
                }
            if (t + 1 < 68) AT_STORE((t + 1) & 1);
            __syncthreads();
        }
#undef AT_ROW0
#undef AT_LOAD
#undef AT_STORE
        const float ltot = lrun + __shfl_xor(lrun, 32), rl = 1.0f / ltot;
        bf16* op = MIX + qrow * 1024 + 512 + h * 64 + 4 * hi;
#pragma unroll
        for (int db = 0; db < 2; ++db)
#pragma unroll
            for (int g4 = 0; g4 < 4; ++g4) { u32x2 w; w.x = pk2(o[db][4 * g4] * rl, o[db][4 * g4 + 1] * rl); w.y = pk2(o[db][4 * g4 + 2] * rl, o[db][4 * g4 + 3] * rl);
                *(u32x2*)(op + 32 * db + 8 * g4) = w; }
    }
}

#define XB_TMO      128
#define XB_XCNT(j)  (256  + 64 * (j))
#define XB_XSUB(j)  (1280 + 64 * (j))
#define XB_XGEN(j)  (2304 + 64 * (j))
#define XB_TOP      3328
#define XB_TOPGEN   3392
#define XCD_BAR_WORDS 3456
#define XB_SPIN_CAP (1u << 18)

__device__ __forceinline__ unsigned xb_ld(unsigned* p)              { return __hip_atomic_load(p, __ATOMIC_RELAXED, __HIP_MEMORY_SCOPE_AGENT); }
__device__ __forceinline__ unsigned xb_add(unsigned* p, unsigned v) { return __hip_atomic_fetch_add(p, v, __ATOMIC_RELAXED, __HIP_MEMORY_SCOPE_AGENT); }
__device__ __forceinline__ unsigned xb_xcc_id() { return (unsigned)__builtin_amdgcn_s_getreg((3 << 11) | 20) & 0xFu; }
#define XB_SPIN(cond, bar) do { unsigned _sp = 0; while (cond) { __builtin_amdgcn_s_sleep(1); \
    if ((++_sp & 255u) == 0u) { if (xb_ld(&(bar)[XB_TMO])) break; if (_sp > XB_SPIN_CAP) { atomicAdd(&(bar)[XB_TMO], 1u); break; } } } } while (0)

struct XcdBarrier {
    unsigned* bar; unsigned x;
    volatile LAS unsigned* st;
};

__device__ __forceinline__ XcdBarrier xcd_barrier_post(unsigned* bar, volatile LAS unsigned* st) {
    XcdBarrier b; b.bar = bar; b.x = xb_xcc_id(); b.st = st;
    if (threadIdx.x == 0) (void)xb_add(&bar[XB_XCNT(b.x)], 1u);
    return b;
}
__device__ __forceinline__ void xcd_barrier_complete(unsigned* bar, unsigned x, unsigned& nloc, unsigned& nx) {
    const unsigned G = gridDim.x * gridDim.y * gridDim.z;
    unsigned sum, cnt, mine, sp = 0u;
    for (;;) {
        sum = 0u; cnt = 0u; mine = 0u;
#pragma unroll
        for (unsigned j = 0; j < 16; ++j) { const unsigned c = xb_ld(&bar[XB_XCNT(j)]); sum += c; cnt += (c > 0u) ? 1u : 0u; mine = (j == x) ? c : mine; }
        if (sum == G) break;
        __builtin_amdgcn_s_sleep(1);
        if ((++sp & 255u) == 0u) { if (xb_ld(&bar[XB_TMO])) break; if (sp > XB_SPIN_CAP) { atomicAdd(&bar[XB_TMO], 1u); break; } }
    }
    nloc = mine > 0u ? mine : 1u; nx = cnt > 0u ? cnt : 1u;
}

__device__ __forceinline__ void xcd_barrier(const XcdBarrier& b) {
    asm volatile("s_waitcnt vmcnt(0)" ::: "memory");
    __syncthreads();
    if (threadIdx.x == 0) {
        unsigned* bar = b.bar;
        __builtin_amdgcn_s_waitcnt(0);
        unsigned nloc = b.st[0], nx = b.st[1];
        if (nloc == 0u) { xcd_barrier_complete(bar, b.x, nloc, nx); b.st[0] = nloc; b.st[1] = nx; }
        const unsigned old = xb_add(&bar[XB_XSUB(b.x)], 1u);
        const unsigned gen = old / nloc;
        if (old + 1u == (gen + 1u) * nloc) {
            __builtin_amdgcn_fence(__ATOMIC_RELEASE, "agent");
            asm volatile("s_waitcnt vmcnt(0)" ::: "memory");
            const unsigned og = xb_add(&bar[XB_TOP], 1u);
            const unsigned tg = og / nx;
            if (og + 1u == (tg + 1u) * nx) xb_add(&bar[XB_TOPGEN], 1u);
            else XB_SPIN(xb_ld(&bar[XB_TOPGEN]) == tg, bar);
            __builtin_amdgcn_fence(__ATOMIC_ACQUIRE, "agent");
            xb_add(&bar[XB_XGEN(b.x)], 1u);
            asm volatile("s_waitcnt vmcnt(0)" ::: "memory");
        } else {
            XB_SPIN(xb_ld(&bar[XB_XGEN(b.x)]) == gen, bar);
            __builtin_amdgcn_fence(__ATOMIC_ACQUIRE, "agent");
            asm volatile("s_waitcnt vmcnt(0)" ::: "memory");
        }
    }
    __syncthreads();
}

__global__ void __launch_bounds__(512, 2) hymba_fwd(Args args) {
    extern __shared__ __attribute__((aligned(16))) unsigned char lds_raw[];
    LAS unsigned char* lds = (LAS unsigned char*)lds_raw;
    cg::grid_group grid = cg::this_grid();
    const int tid = threadIdx.x, lane = tid & 63, wave = __builtin_amdgcn_readfirstlane(tid >> 6);
    const int G = gridDim.x, bx = blockIdx.x, vcu = (G % 8 == 0) ? (bx % 8) * (G / 8) + bx / 8 : bx;
    const int gw = bx * 8 + wave, NGW = G * 8;
    unsigned char* ws = args.ws;
    const int lo = args.ph_lo, hi = args.ph_hi;
    const float* MOD = (const float*)(ws + WS_MOD);
    volatile LAS unsigned* bst = (volatile LAS unsigned*)(lds + LDS_BST);
    if (tid < 2) bst[tid] = 0u;
    __syncthreads();
    const XcdBarrier xbar = xcd_barrier_post((unsigned*)(ws + WS_BAR), bst);
    bf16* XN = (bf16*)(ws + WS_A); bf16* HB = (bf16*)(ws + WS_B); float* X1 = (float*)(ws + WS_C);
#ifndef PHMASK
#define PHMASK 0xFFFF
#endif
#define IN(k) (((PHMASK >> (k)) & 1) && lo <= (k) && (k) < hi)
#define GSYNC(k) do { xcd_barrier(xbar); } while (0)
#define SEAM(k) do { if (IN(k) && IN((k) + 1)) GSYNC(k); } while (0)
#define PH_BEGIN(k) if (IN(k)) for (int rep_ = 0; rep_ < ((k) == PROBE_PHASE ? 2 : 1); ++rep_) { if (rep_) xcd_barrier(xbar);
#define PH_END(k) } SEAM(k)
    if (args.ph_lo < 0) grid.sync();
    if (PROBE_PHASE == 200) { for (int r3 = 0; r3 < 16; ++r3) xcd_barrier(xbar); }
    PH_BEGIN(0) { phase0(args, lds, gw, NGW, tid, lane, wave); } PH_END(0);
    PH_BEGIN(1) { norm_rows(args.in[0], args.in[2], MTOT, args.in[6], MOD, 0, XN, gw, NGW, lane); } PH_END(1);
    PH_BEGIN(2) { pg8::Gemm g{XN, (const bf16*)(ws + WS_W1A), MTOT, 2 * DFF, D}; pg8::StaticOrder S; S.init(MTOT, 2 * DFF, G, bx);
        pg8::EpiSwiglu E{HB, DFF}; pg8::gemm_phase<pg8::EpiSwiglu, pg8::StaticOrder, true, true>(lds, g, S, E); } PH_END(2);
    PH_BEGIN(3) {
        { pg8::Gemm g{HB, (const bf16*)(ws + WS_W1B), NLAT, D, DFF}; pg8::StaticOrder S; S.init(NLAT, D, G, bx);
          pg8::EpiRes E{args.in[0], args.in[2], X1, MOD, 2, 0.5f}; pg8::gemm_phase<pg8::EpiRes, pg8::StaticOrder, true, true>(lds, g, S, E); }
        { pg8::Gemm g{HB, (const bf16*)(ws + WS_W1B), MTOT, D, DFF, DFF}; pg8::CtxSplitOrder S{G, (bx + G / 2) % G};
          pg8::EpiResCtx E{args.in[2], X1, (float*)args.out, MOD, 2, 0.5f}; pg8::gemm_phase<pg8::EpiResCtx, pg8::CtxSplitOrder, true, true>(lds, g, S, E); }
    } PH_END(3);
    PH_BEGIN(4) { norm_rows(X1, X1 + (size_t)NLAT * D, MTOT, args.in[9], MOD, 3, XN, gw, NGW, lane, (const float*)args.out); } PH_END(4);
    PH_BEGIN(5) { pg8::Gemm g{XN, (const bf16*)(ws + WS_WIN), MTOT, 2816, D}; pg8::StaticOrder S; S.init(MTOT, 2816, G, bx);
        pg8::EpiSplit E{(bf16*)(ws + WS_Z), (bf16*)(ws + WS_XBCR), (bf16*)(ws + WS_CQ), (bf16*)(ws + WS_CKV), (bf16*)(ws + WS_MISC)};
        pg8::gemm_phase<pg8::EpiSplit, pg8::StaticOrder, true, true>(lds, g, S, E); } PH_END(5);
    PH_BEGIN(6) { phase6(args, lds, G, bx, tid, lane, wave); } PH_END(6);
    PH_BEGIN(7) {
        unsigned char* ob = (unsigned char*)args.out;
        { pg8::Gemm g{(const bf16*)(ws + WS_CQ), (const bf16*)(ws + WS_WUQ), NLAT, 768, 768}; pg8::StaticOrder S; S.init(NLAT, 768, G, bx);
          pg8::EpiScale E{(bf16*)(ob + OUT_Q), 768, (const float*)(ws + WS_RSTDQ), nullptr}; pg8::gemm_phase<pg8::EpiScale, pg8::StaticOrder, true, true>(lds, g, S, E); }
        { pg8::Gemm g{(const bf16*)(ws + WS_CKV), (const bf16*)(ws + WS_WK), MTOT, 512, 256}; pg8::StaticOrder S; S.init(MTOT, 512, G, bx);
          pg8::EpiScale E{(bf16*)(ob + OUT_KN), 512, (const float*)(ws + WS_RSTDKV), nullptr}; pg8::gemm_phase<pg8::EpiScale, pg8::StaticOrder, true, true>(lds, g, S, E); }
        { pg8::Gemm g{(const bf16*)(ws + WS_WV), (const bf16*)(ws + WS_CKV), 512, MTOT, 256}; pg8::StaticOrder S; S.init(512, MTOT, G, bx);
          pg8::EpiScale E{(bf16*)(ob + OUT_VT), MTOT, nullptr, (const float*)(ws + WS_RSTDKV)}; pg8::gemm_phase<pg8::EpiScale, pg8::StaticOrder, true, true>(lds, g, S, E); }
        phase8(args, lds, G, bx, tid, lane, wave);
    } PH_END(7);
    PH_BEGIN(9) { phase9(args, G, bx, tid); } PH_END(9);
    PH_BEGIN(10) {
#ifndef NO_SSD
        for (int r2 = 0; r2 < (PROBE_PHASE == 100 ? 2 : 1); ++r2) phase10_ssd(args, lds, G, bx, tid, lane, wave);
#endif

#ifndef NO_ATTN
        for (int r2 = 0; r2 < (PROBE_PHASE == 101 ? 2 : 1); ++r2) phase10_attn(args, lds, G, vcu, tid, lane, wave);
#endif
    } PH_END(10);
    PH_BEGIN(11) { pg8::Gemm g{(const bf16*)(ws + WS_MIX), (const bf16*)(ws + WS_WOUT), NLAT, D, D}; pg8::StaticOrder S; S.init(NLAT, D, G, bx);
        pg8::EpiRes E{X1, X1, X1, MOD, 5, 1.0f}; pg8::gemm_phase<pg8::EpiRes, pg8::StaticOrder, true, true>(lds, g, S, E); } PH_END(11);
    PH_BEGIN(12) { norm_rows(X1, X1, NLAT, args.in[22], MOD, 6, XN, gw, NGW, lane); } PH_END(12);
    PH_BEGIN(13) { pg8::Gemm g{XN, (const bf16*)(ws + WS_W2A), NLAT, 2 * DFF, D}; pg8::StaticOrder S; S.init(NLAT, 2 * DFF, G, bx);
        pg8::EpiSwiglu E{HB, DFF}; pg8::gemm_phase<pg8::EpiSwiglu, pg8::StaticOrder, true, true>(lds, g, S, E); } PH_END(13);
    PH_BEGIN(14) { pg8::Gemm g{HB, (const bf16*)(ws + WS_W2B), NLAT, D, DFF}; pg8::StaticOrder S; S.init(NLAT, D, G, bx);
        pg8::EpiRes E{X1, X1, args.out, MOD, 8, 0.5f}; pg8::gemm_phase<pg8::EpiRes, pg8::StaticOrder, true, true>(lds, g, S, E); } PH_END(14);
    PH_BEGIN(15) { final_norm_rows(args.out, args.in[25], gw, NGW, lane); } PH_END(15);
#undef IN
#undef SEAM
}

#ifndef N_LAUNCHES
#define N_LAUNCHES 1
#endif
extern "C" void kernel_launch(void* const* d_in, const int* in_sizes, int n_in, void* d_out, int out_size, void* d_ws, size_t ws_size, hipStream_t stream) {
    static int grid = 0;
    if (grid == 0) {
        if (n_in != 26 || out_size != NLAT * D || ws_size < WS_END) { fprintf(stderr, "kernel_launch: unexpected shapes (n_in %d out %d ws %zu)\n", n_in, out_size, ws_size); grid = -1; return; }
        int dev = 0, cus = 0, per_cu = 0;
        (void)hipGetDevice(&dev); (void)hipDeviceGetAttribute(&cus, hipDeviceAttributeMultiprocessorCount, dev);
        if (hipFuncSetAttribute((const void*)hymba_fwd, hipFuncAttributeMaxDynamicSharedMemorySize, LDS_BYTES) != hipSuccess) { fprintf(stderr, "kernel_launch: hipFuncSetAttribute failed\n"); grid = -1; return; }
        if (hipOccupancyMaxActiveBlocksPerMultiprocessor(&per_cu, (const void*)hymba_fwd, 512, LDS_BYTES) != hipSuccess || per_cu < 1) { fprintf(stderr, "kernel_launch: occupancy query failed (%d)\n", per_cu); grid = -1; (void)hipGetLastError(); return; }
        grid = cus;
    }
    if (grid < 0) return;
    (void)hipMemsetAsync((char*)d_ws + WS_BAR, 0, 16 * KiB, stream);
    Args a{};
    for (int i = 0; i < 26; ++i) a.in[i] = (const float*)d_in[i];
    a.out = (float*)d_out; a.ws = (unsigned char*)d_ws;
    for (int li = 0; li < N_LAUNCHES; ++li) {
        a.ph_lo = (N_LAUNCHES == 1) ? 0 : li; a.ph_hi = (N_LAUNCHES == 1) ? NPHASE : li + 1;
        void* kargs[] = {&a};
        hipError_t e = hipLaunchCooperativeKernel((const void*)hymba_fwd, dim3(grid), dim3(512), kargs, LDS_BYTES, stream);
        if (e != hipSuccess) { fprintf(stderr, "kernel_launch: cooperative launch %d failed: %s (grid %d)\n", li, hipGetErrorString(e), grid); break; }
    }
}
```

```cpp
#include <hip/hip_runtime.h>
#include <hip/hip_cooperative_groups.h>
#include <cstdio>
#include <cstdint>
namespace cg = cooperative_groups;
namespace pg8 {
#define PG8_LAS __attribute__((address_space(3)))
typedef unsigned short bf16_t;
typedef short bf16x8 __attribute__((ext_vector_type(8)));
typedef float f32x4 __attribute__((ext_vector_type(4)));
typedef unsigned u32x4 __attribute__((ext_vector_type(4)));
constexpr int BM = 256, BK = 64, HALF = 128, HTB = HALF * BK * 2  , STAGE_BYTES = 8 * HTB, NXCD = 8, WGM = 8;

__host__ __device__ __forceinline__ int lds_byte(int r, int c) { const int st = (r >> 4) * 2 + (c >> 5), rr = r & 15, cc = c & 31, ob = rr * 64 + cc * 2; return st * 1024 + (ob ^ (((ob >> 9) & 1) << 5)); }
__host__ __device__ __forceinline__ void stage_rc(int b, int& R, int& C) { const int st = b / 1024, sb = b % 1024, swz = sb ^ (((sb >> 9) & 1) << 5); R = (st >> 1) * 16 + swz / 64; C = (st & 1) * 32 + (swz % 64) / 2; }
__host__ __device__ __forceinline__ int perm32(int rho) { const int n = rho >> 4, i = rho & 15; return 8 * (i >> 2) + 4 * n + (i & 3); }

struct Unit { int pm, pn, ks; };
struct Gemm { const bf16_t* A; const bf16_t* Bt; int M, N, K; int ld; };

struct StaticOrder {
    int nM, nN, nwg, G, c;
    __host__ __device__ void init(int M, int N, int G_, int c_) { nM = M / BM; nN = N / BM; nwg = nM * nN; G = G_; c = c_; }
    __host__ __device__ bool next(int i, Unit& u) const {
        const long L = (long)i * G + c; if (L >= nwg) return false;
        int wgid = (int)L; { const int q = nwg / NXCD, r = nwg % NXCD, xcd = wgid % NXCD, off = wgid / NXCD; wgid = (xcd < r ? xcd * (q + 1) : r * (q + 1) + (xcd - r) * q) + off; }
        const int nig = WGM * nN, gid = wgid / nig, fm = gid * WGM, gsz = (nM - fm) < WGM ? (nM - fm) : WGM;
        u.pm = fm + ((wgid % nig) % gsz); u.pn = (wgid % nig) / gsz; u.ks = 0; return true;
    }
    __device__ __forceinline__ size_t koff(const Unit&) const { return 0; }
    __device__ __forceinline__ int ntiles(const Unit&, int nt) const { return nt; }
    __device__ __forceinline__ void a_ready(const Unit&) const {}
    __device__ __forceinline__ void done(const Unit&) const {}
};

__device__ __forceinline__ unsigned cvt_pk_bf16(float lo, float hi) { unsigned r; asm volatile("v_cvt_pk_bf16_f32 %0, %1, %2" : "=v"(r) : "v"(lo), "v"(hi)); return r; }
typedef float f32x2 __attribute__((ext_vector_type(2)));
__device__ __forceinline__ f32x2 gelu_pk(f32x2 v) {
    const f32x2 av = __builtin_elementwise_abs(v), d = av * 0.2316418882f + 1.0f;
    f32x2 t; t.x = __builtin_amdgcn_rcpf(d.x); t.y = __builtin_amdgcn_rcpf(d.y);
    f32x2 q = t * 0.5307027145f + (-0.7265760135f); q = q * t + 0.7107068705f; q = q * t + (-0.142248368f); q = q * t + 0.127414796f; q = q * t;
    const f32x2 s = (v * v) * (-0.72134752044f);
    f32x2 e; e.x = __builtin_amdgcn_exp2f(s.x); e.y = __builtin_amdgcn_exp2f(s.y);
    const f32x2 m = v * (q * e), r = v - m;
    f32x2 o; o.x = v.x < 0.f ? m.x : r.x; o.y = v.y < 0.f ? m.y : r.y; return o;
}

template <int ACT  > struct EpiBf16 {
    static constexpr bool PERM = true, AFTER_DRAIN = false; static_assert(ACT == 0 || ACT == 1, "EpiBf16: ACT is 0 (none) or 1 (gelu_pk)");
    bf16_t* O; int ldc; const float* bias; int split_cols; size_t split_stride; float scale0;
    __device__ __forceinline__ void operator()(const f32x4 (&acc)[2][2][4][2], const Unit& u, int wr, int wc, int fr, int fq) const {
        const int row0 = u.pm * BM + wr * 64 + fr; int colt = u.pn * BM; bf16_t* base = O;
        float sc = 1.f; if (split_cols) { const int t = colt / split_cols; base += (size_t)t * split_stride; colt -= t * split_cols; if (t == 0) sc = scale0; }
        const int col0 = colt + wc * 32 + 8 * fq, bcol0 = u.pn * BM + wc * 32 + 8 * fq;
        f32x4 bv[2][2];
#pragma unroll
        for (int bj = 0; bj < 2; ++bj)
#pragma unroll
            for (int n = 0; n < 2; ++n) bv[bj][n] = bias ? *(const f32x4*)(bias + bcol0 + bj * HALF + 4 * n) : (f32x4){0.f, 0.f, 0.f, 0.f};
#pragma unroll
        for (int ai = 0; ai < 2; ++ai)
#pragma unroll
            for (int m = 0; m < 4; ++m) { bf16_t* rowp = base + (size_t)(row0 + ai * HALF + m * 16) * ldc + col0;
#pragma unroll
                for (int bj = 0; bj < 2; ++bj) { f32x4 v0 = acc[ai][bj][m][0] + bv[bj][0], v1 = acc[ai][bj][m][1] + bv[bj][1];
                    if (ACT == 1) { f32x2 a = gelu_pk((f32x2){v0[0], v0[1]}), b = gelu_pk((f32x2){v0[2], v0[3]}), c = gelu_pk((f32x2){v1[0], v1[1]}), d = gelu_pk((f32x2){v1[2], v1[3]});
                        v0 = (f32x4){a.x, a.y, b.x, b.y}; v1 = (f32x4){c.x, c.y, d.x, d.y}; }
                    v0 = v0 * sc; v1 = v1 * sc; u32x4 w; w.x = cvt_pk_bf16(v0[0], v0[1]); w.y = cvt_pk_bf16(v0[2], v0[3]); w.z = cvt_pk_bf16(v1[0], v1[1]); w.w = cvt_pk_bf16(v1[2], v1[3]);
                    *(u32x4*)(rowp + bj * HALF) = w; } }
    }
};
template <class Epi, class Sched, bool ALIGN_EPI = false, bool SP2 = false>
__device__ __forceinline__ void gemm_phase(PG8_LAS unsigned char* lds, const Gemm g, const Sched& S, const Epi& E) {
    const int tid = threadIdx.x, wid = __builtin_amdgcn_readfirstlane(tid >> 6), lane = tid & 63, wr = wid >> 2, wc = wid & 3, fr = lane & 15, fq = lane >> 4;
    const int K = g.K, LD = g.ld ? g.ld : g.K; int nt = K / BK;
    unsigned voffA[2], voffB[2];
#pragma unroll
    for (int i = 0; i < 2; ++i) { int R, C; stage_rc(tid * 16 + i * 8192, R, C); const int Rb = Epi::PERM ? ((R & ~31) + perm32(R & 31)) : R;
        voffA[i] = (unsigned)(R * LD + C) * 2u; voffB[i] = (unsigned)(Rb * LD + C) * 2u; }
    const size_t kstep = (size_t)(BK * 2);
    const size_t hstep = (size_t)HALF * LD * 2;
    const size_t tstep = 2 * hstep;
    const unsigned ldsw = (unsigned)wid * 1024u;
    const int aoff = lds_byte(wr * 64 + fr, fq * 8), boff = lds_byte(wc * 32 + fr, fq * 8);
#define PG8_SA(b, h) (((b) * 2 + (h)) * HTB)
#define PG8_SB(b, h) ((4 + (b) * 2 + (h)) * HTB)
#define PG8_STAGE(bufoff, gbase, voff) do { _Pragma("unroll") for (int _i = 0; _i < 2; ++_i) \
        __builtin_amdgcn_global_load_lds((const unsigned*)((const char*)(gbase) + (voff)[_i]), (PG8_LAS unsigned*)(lds + (bufoff) + ldsw + _i * 8192), 16, 0, 0); } while (0)
#define PG8_LDA(dst, b, h) do { _Pragma("unroll") for (int m = 0; m < 4; ++m) _Pragma("unroll") for (int k = 0; k < 2; ++k) dst[m][k] = *(const PG8_LAS bf16x8*)(lds + PG8_SA(b, h) + aoff + m * 2048 + k * 1024); } while (0)
#define PG8_LDB(dst, b, h) do { _Pragma("unroll") for (int n = 0; n < 2; ++n) _Pragma("unroll") for (int k = 0; k < 2; ++k) dst[n][k] = *(const PG8_LAS bf16x8*)(lds + PG8_SB(b, h) + boff + n * 2048 + k * 1024); } while (0)
#define PG8_MMA(ai, bj, At, Bt) do { __builtin_amdgcn_s_setprio(1); _Pragma("unroll") for (int m = 0; m < 4; ++m) _Pragma("unroll") for (int n = 0; n < 2; ++n) _Pragma("unroll") for (int k = 0; k < 2; ++k) \
        acc[ai][bj][m][n] = __builtin_amdgcn_mfma_f32_16x16x32_bf16(Bt[n][k], At[m][k], acc[ai][bj][m][n], 0, 0, 0); __builtin_amdgcn_s_setprio(0); } while (0)
#define PG8_WAIT_V(n) asm volatile("s_waitcnt vmcnt(" #n ")" ::: "memory")
#define PG8_WAIT_L(n) asm volatile("s_waitcnt lgkmcnt(" #n ")" ::: "memory")
#define PG8_BAR __builtin_amdgcn_s_barrier()
#define PG8_SCHED __builtin_amdgcn_sched_barrier(0)
    Unit cur, nxt; int ui = 0;
    if (!S.next(0, cur)) return;
    f32x4 acc[2][2][4][2];
#pragma unroll
    for (int a = 0; a < 2; ++a)
#pragma unroll
        for (int b = 0; b < 2; ++b)
#pragma unroll
            for (int m = 0; m < 4; ++m)
#pragma unroll
                for (int n = 0; n < 2; ++n) acc[a][b][m][n] = (f32x4){0.f, 0.f, 0.f, 0.f};
    bf16x8 At[4][2], B0[2][2], B1[2][2];
    const char* cA = (const char*)g.A + (size_t)cur.pm * tstep + S.koff(cur); const char* cB = (const char*)g.Bt + (size_t)cur.pn * tstep + S.koff(cur);
    S.a_ready(cur);
    if constexpr (SP2) {
        PG8_STAGE(PG8_SB(0, 0), cB, voffB); PG8_STAGE(PG8_SB(0, 1), cB + hstep, voffB); PG8_STAGE(PG8_SA(0, 0), cA, voffA); PG8_STAGE(PG8_SA(0, 1), cA + hstep, voffA);
        if (wr == 1) PG8_BAR;
        PG8_WAIT_V(2); PG8_BAR;
        PG8_STAGE(PG8_SB(1, 0), cB + kstep, voffB); PG8_STAGE(PG8_SA(1, 0), cA + kstep, voffA); PG8_STAGE(PG8_SB(1, 1), cB + hstep + kstep, voffB);
        PG8_WAIT_V(6); PG8_BAR;
    } else {
        PG8_STAGE(PG8_SB(0, 0), cB, voffB); PG8_STAGE(PG8_SA(0, 0), cA, voffA); PG8_STAGE(PG8_SB(0, 1), cB + hstep, voffB); PG8_STAGE(PG8_SA(0, 1), cA + hstep, voffA);
        if (wr == 1) PG8_BAR;
        PG8_WAIT_V(4); PG8_BAR;
        PG8_STAGE(PG8_SB(1, 0), cB + kstep, voffB); PG8_STAGE(PG8_SA(1, 0), cA + kstep, voffA); PG8_STAGE(PG8_SB(1, 1), cB + hstep + kstep, voffB);
        PG8_WAIT_V(6); PG8_BAR;
    }
    for (;;) {
        const bool has_next = S.next(ui + 1, nxt);
        const char* nA = has_next ? (const char*)g.A + (size_t)nxt.pm * tstep + S.koff(nxt) : cA; const char* nB = has_next ? (const char*)g.Bt + (size_t)nxt.pn * tstep + S.koff(nxt) : cB;
        nt = S.ntiles(cur, K / BK);
        for (int t = 0; t < nt; t += 2) {
            const bool last = (t == nt - 2);
            const char* a1 = cA + (size_t)(t + 1) * kstep;
            const char* a2 = last ? nA : cA + (size_t)(t + 2) * kstep; const char* b2 = last ? nB : cB + (size_t)(t + 2) * kstep;
            const char* a3 = a2 + kstep; const char* b3 = b2 + kstep;
            if (last && has_next) S.a_ready(nxt);
            if constexpr (SP2) {
            PG8_LDB(B0, 0, 0); PG8_LDB(B1, 0, 1); PG8_SCHED; PG8_LDA(At, 0, 0); PG8_STAGE(PG8_SA(1, 1), a1 + hstep, voffA);
            PG8_WAIT_V(8); PG8_WAIT_L(0); PG8_BAR; PG8_MMA(0, 0, At, B0); PG8_MMA(0, 1, At, B1); PG8_BAR; PG8_SCHED;
            PG8_LDA(At, 0, 1); PG8_STAGE(PG8_SB(0, 0), b2, voffB); PG8_STAGE(PG8_SB(0, 1), b2 + hstep, voffB); PG8_STAGE(PG8_SA(0, 0), a2, voffA);
            PG8_WAIT_V(8); PG8_WAIT_L(0); PG8_BAR; PG8_MMA(1, 0, At, B0); PG8_MMA(1, 1, At, B1); PG8_BAR; PG8_SCHED;
            PG8_LDB(B0, 1, 0); PG8_LDB(B1, 1, 1); PG8_SCHED; PG8_LDA(At, 1, 0); PG8_STAGE(PG8_SA(0, 1), a2 + hstep, voffA);
            PG8_WAIT_V(8); PG8_WAIT_L(0); PG8_BAR; PG8_MMA(0, 0, At, B0); PG8_MMA(0, 1, At, B1); PG8_BAR; PG8_SCHED;
            PG8_LDA(At, 1, 1); PG8_STAGE(PG8_SB(1, 0), b3, voffB); PG8_STAGE(PG8_SB(1, 1), b3 + hstep, voffB); PG8_STAGE(PG8_SA(1, 0), a3, voffA);
            PG8_WAIT_V(8); PG8_WAIT_L(0); PG8_BAR; PG8_MMA(1, 0, At, B0); PG8_MMA(1, 1, At, B1); PG8_BAR; PG8_SCHED;
            } else {
            PG8_LDB(B0, 0, 0); PG8_SCHED; PG8_LDA(At, 0, 0); PG8_STAGE(PG8_SA(1, 1), a1 + hstep, voffA);
            PG8_WAIT_L(8); PG8_BAR; PG8_WAIT_L(0); PG8_MMA(0, 0, At, B0); PG8_BAR; PG8_SCHED;
            PG8_LDB(B1, 0, 1); PG8_STAGE(PG8_SB(0, 0), b2, voffB);
            PG8_BAR; PG8_WAIT_L(0); PG8_MMA(0, 1, At, B1); PG8_BAR;
            PG8_LDA(At, 0, 1); PG8_STAGE(PG8_SA(0, 0), a2, voffA);
            PG8_BAR; PG8_WAIT_L(0); PG8_MMA(1, 0, At, B0); PG8_BAR; PG8_SCHED;
            PG8_STAGE(PG8_SB(0, 1), b2 + hstep, voffB);
            PG8_WAIT_V(6); PG8_BAR; PG8_MMA(1, 1, At, B1); PG8_BAR;
            PG8_LDB(B0, 1, 0); PG8_SCHED; PG8_LDA(At, 1, 0); PG8_STAGE(PG8_SA(0, 1), a2 + hstep, voffA);
            PG8_WAIT_L(8); PG8_BAR; PG8_WAIT_L(0); PG8_MMA(0, 0, At, B0); PG8_BAR; PG8_SCHED;
            PG8_LDB(B1, 1, 1); PG8_STAGE(PG8_SB(1, 0), b3, voffB);
            PG8_BAR; PG8_WAIT_L(0); PG8_MMA(0, 1, At, B1); PG8_BAR;
            PG8_LDA(At, 1, 1); PG8_STAGE(PG8_SA(1, 0), a3, voffA);
            PG8_BAR; PG8_WAIT_L(0); PG8_MMA(1, 0, At, B0); PG8_BAR; PG8_SCHED;
            PG8_STAGE(PG8_SB(1, 1), b3 + hstep, voffB);
            PG8_WAIT_V(6); PG8_BAR; PG8_MMA(1, 1, At, B1); PG8_BAR;
            }
        }
        if constexpr (ALIGN_EPI) { if (wr == 0) PG8_BAR; }
        if constexpr (!Epi::AFTER_DRAIN) { E(acc, cur, wr, wc, fr, fq); S.done(cur); }
        if (!has_next) break;
#pragma unroll
        for (int a = 0; a < 2; ++a)
#pragma unroll
            for (int b = 0; b < 2; ++b)
#pragma unroll
                for (int m = 0; m < 4; ++m)
#pragma unroll
                    for (int n = 0; n < 2; ++n) acc[a][b][m][n] = (f32x4){0.f, 0.f, 0.f, 0.f};
        cur = nxt; cA = nA; cB = nB; ++ui;
        if constexpr (ALIGN_EPI) { if (wr == 1) PG8_BAR; }
    }
    PG8_WAIT_V(0);
    if constexpr (!ALIGN_EPI) { if (wr == 0) PG8_BAR; }
    PG8_BAR;
    if constexpr (Epi::AFTER_DRAIN) { E.fused(acc, cur, wr, wc, fr, fq, lds, wid, lane); S.done(cur); }
#undef PG8_SA
#undef PG8_SB
#undef PG8_STAGE
#undef PG8_LDA
#undef PG8_LDB
#undef PG8_MMA
#undef PG8_WAIT_V
#undef PG8_WAIT_L
#undef PG8_BAR
#undef PG8_SCHED
}
}
#ifndef PROBE_PHASE
#define PROBE_PHASE -1
#endif

#define LAS __attribute__((address_space(3)))
typedef unsigned short bf16;
typedef short bf16x8 __attribute__((ext_vector_type(8)));
typedef float f32x2 __attribute__((ext_vector_type(2)));
typedef float f32x4 __attribute__((ext_vector_type(4)));
typedef float f32x16 __attribute__((ext_vector_type(16)));
typedef unsigned u32x2 __attribute__((ext_vector_type(2)));
typedef unsigned u32x4 __attribute__((ext_vector_type(4)));
typedef __bf16 bf16x2_t __attribute__((ext_vector_type(2)));

constexpr int D = 1024, NB = 8, SEQ = 4096, CTXL = 256, NLAT = NB * SEQ, NCTX = NB * CTXL, MTOT = NLAT + NCTX;
constexpr int DFF = 2816, UL = SEQ + CTXL, NCH = UL / 128;
constexpr float EPS = 1e-6f;
constexpr float QSCALE = 0.10206207261596575f * 1.4426950408889634f;
constexpr int NPHASE = 16;

constexpr size_t MiB = (size_t)1 << 20, KiB = 1024;
constexpr size_t WS_BAR = 1 * MiB, WS_ZERO_BYTES = 1 * MiB + 16 * KiB;
constexpr size_t WS_MOD = 0, WS_ROPE = 384 * KiB, WS_CD = 448 * KiB, WS_RSTDQ = 512 * KiB, WS_RSTDKV = 768 * KiB;
constexpr size_t WS_W1A = 2 * MiB, WS_W1B = 13 * MiB, WS_WIN = 18 * MiB + 512 * KiB, WS_WUQ = 24 * MiB, WS_WK = 25 * MiB + 512 * KiB, WS_WV = 25 * MiB + 768 * KiB,
                 WS_WOUT = 26 * MiB, WS_W2A = 28 * MiB, WS_W2B = 39 * MiB;
constexpr size_t WS_A = 45 * MiB;
constexpr size_t WS_B = 113 * MiB;
constexpr size_t WS_Z = WS_B, WS_XBCR = WS_B + 34 * MiB, WS_CQ = WS_B + 102 * MiB, WS_CKV = WS_B + 153 * MiB, WS_MISC = WS_B + 170 * MiB;
constexpr size_t WS_ST = WS_XBCR, WS_MIX = WS_XBCR, WS_HE = WS_CQ;
constexpr size_t WS_C = 300 * MiB;
constexpr size_t WS_XT = 436 * MiB, WS_BT = 470 * MiB, WS_CROW = 487 * MiB, WS_DT = 504 * MiB, WS_KPE = 506 * MiB + 256 * KiB, WS_END = 512 * MiB;
constexpr size_t WS_BROW = WS_A;
constexpr size_t OUT_Q = 0, OUT_KN = 48 * MiB, OUT_VT = 82 * MiB;
constexpr int LDS_BYTES = 163840, LDS_BST = LDS_BYTES - 64;

__device__ __forceinline__ unsigned pk2(float lo, float hi) { f32x2 v = {lo, hi}; bf16x2_t b = __builtin_convertvector(v, bf16x2_t); return __builtin_bit_cast(unsigned, b); }
__device__ __forceinline__ float bflo(unsigned w) { return __uint_as_float(w << 16); }
__device__ __forceinline__ float bfhi(unsigned w) { return __uint_as_float(w & 0xffff0000u); }
__device__ __forceinline__ float bf2f(bf16 u) { return __uint_as_float((unsigned)u << 16); }
__device__ __forceinline__ float silu_f(float x) { return x * __builtin_amdgcn_rcpf(1.f + __builtin_amdgcn_exp2f(-1.4426950408889634f * x)); }
__device__ __forceinline__ float wave_sum(float v) {
#pragma unroll
    for (int o = 1; o < 64; o <<= 1) v += __shfl_xor(v, o);
    return v;
}
__device__ __forceinline__ float incl_scan(float v, int lane) {
#pragma unroll
    for (int o = 1; o < 64; o <<= 1) { float t = __shfl_up(v, o); if (lane >= o) v += t; }
    return v;
}
#define LDS_FENCE() asm volatile("s_waitcnt lgkmcnt(0)" ::: "memory")
__device__ __forceinline__ int crow(int r, int hi) { return (r & 3) + 8 * (r >> 2) + 4 * hi; }
__device__ __forceinline__ bf16x8 pack8(float a0, float a1, float a2, float a3, float a4, float a5, float a6, float a7) {
    u32x4 w; w.x = pk2(a0, a1); w.y = pk2(a2, a3); w.z = pk2(a4, a5); w.w = pk2(a6, a7); return __builtin_bit_cast(bf16x8, w);
}

struct Args { const float* in[26]; float* out; unsigned char* ws; int ph_lo, ph_hi; };

namespace pg8 {
struct EpiSwiglu {
    static constexpr bool PERM = true, AFTER_DRAIN = false;
    bf16_t* O; int ldc;
    __device__ __forceinline__ void operator()(const f32x4 (&acc)[2][2][4][2], const Unit& u, int wr, int wc, int fr, int fq) const {
        const int row0 = u.pm * BM + wr * 64 + fr, col0 = u.pn * HALF + wc * 32 + 8 * fq;
#pragma unroll
        for (int ai = 0; ai < 2; ++ai)
#pragma unroll
            for (int m = 0; m < 4; ++m) {
                bf16_t* rowp = O + (size_t)(row0 + ai * HALF + m * 16) * ldc + col0;
                const f32x4 g0 = acc[ai][0][m][0], g1 = acc[ai][0][m][1], u0 = acc[ai][1][m][0], u1 = acc[ai][1][m][1];
                u32x4 w;
                w.x = cvt_pk_bf16(silu_f(g0[0]) * u0[0], silu_f(g0[1]) * u0[1]); w.y = cvt_pk_bf16(silu_f(g0[2]) * u0[2], silu_f(g0[3]) * u0[3]);
                w.z = cvt_pk_bf16(silu_f(g1[0]) * u1[0], silu_f(g1[1]) * u1[1]); w.w = cvt_pk_bf16(silu_f(g1[2]) * u1[2], silu_f(g1[3]) * u1[3]);
                *(u32x4*)rowp = w;
            }
    }
};
struct EpiRes {
    static constexpr bool PERM = false, AFTER_DRAIN = false;
    const float* base_lat; const float* base_ctx; float* out; const float* mod; int kg; float mul;
    __device__ __forceinline__ void operator()(const f32x4 (&acc)[2][2][4][2], const Unit& u, int wr, int wc, int fr, int fq) const {
        const int row0 = u.pm * BM + wr * 64 + fr, col0 = u.pn * BM + wc * 32 + 4 * fq;
        const int bb = u.pm < (NLAT / BM) ? u.pm / (SEQ / BM) : 8;
        const float* gp = mod + bb * 9216 + kg * 1024 + col0;
        f32x4 gv[2][2];
#pragma unroll
        for (int bj = 0; bj < 2; ++bj)
#pragma unroll
            for (int n = 0; n < 2; ++n) gv[bj][n] = *(const f32x4*)(gp + bj * HALF + n * 16) * mul;
#pragma unroll
        for (int ai = 0; ai < 2; ++ai)
#pragma unroll
            for (int m = 0; m < 4; ++m) {
                const int r = row0 + ai * HALF + m * 16;
                const float* bp = (r < NLAT ? base_lat + (size_t)r * D : base_ctx + (size_t)(r - NLAT) * D) + col0;
                float* op = out + (size_t)r * D + col0;
#pragma unroll
                for (int bj = 0; bj < 2; ++bj)
#pragma unroll
                    for (int n = 0; n < 2; ++n) { const f32x4 bs = *(const f32x4*)(bp + bj * HALF + n * 16); *(f32x4*)(op + bj * HALF + n * 16) = bs + gv[bj][n] * acc[ai][bj][m][n]; }
            }
    }
};
struct EpiSplit {
    static constexpr bool PERM = true, AFTER_DRAIN = false;
    bf16_t *zb, *xbcr, *cq, *ckv, *misc;
    __device__ __forceinline__ void operator()(const f32x4 (&acc)[2][2][4][2], const Unit& u, int wr, int wc, int fr, int fq) const {
        const int pn = u.pn; bf16_t* base; int ld;
        if (pn < 2) { base = zb + pn * 256; ld = 512; } else if (pn < 6) { base = xbcr + (pn - 2) * 256; ld = 1024; } else if (pn < 9) { base = cq + (pn - 6) * 256; ld = 768; }
        else if (pn == 9) { base = ckv; ld = 256; } else { base = misc; ld = 256; }
        const int row0 = u.pm * BM + wr * 64 + fr, col0 = wc * 32 + 8 * fq;
#pragma unroll
        for (int ai = 0; ai < 2; ++ai)
#pragma unroll
            for (int m = 0; m < 4; ++m) {
                bf16_t* rowp = base + (size_t)(row0 + ai * HALF + m * 16) * ld + col0;
#pragma unroll
                for (int bj = 0; bj < 2; ++bj) { const f32x4 v0 = acc[ai][bj][m][0], v1 = acc[ai][bj][m][1];
                    u32x4 w; w.x = cvt_pk_bf16(v0[0], v0[1]); w.y = cvt_pk_bf16(v0[2], v0[3]); w.z = cvt_pk_bf16(v1[0], v1[1]); w.w = cvt_pk_bf16(v1[2], v1[3]);
                    *(u32x4*)(rowp + bj * HALF) = w; }
            }
    }
};
struct EpiScale {
    static constexpr bool PERM = true, AFTER_DRAIN = false;
    bf16_t* O; int ldc; const float* rs; const float* cs;
    __device__ __forceinline__ void operator()(const f32x4 (&acc)[2][2][4][2], const Unit& u, int wr, int wc, int fr, int fq) const {
        const int row0 = u.pm * BM + wr * 64 + fr, col0 = u.pn * BM + wc * 32 + 8 * fq;
        f32x4 cv[2][2];
#pragma unroll
        for (int bj = 0; bj < 2; ++bj)
#pragma unroll
            for (int n = 0; n < 2; ++n) cv[bj][n] = cs ? *(const f32x4*)(cs + col0 + bj * HALF + 4 * n) : (f32x4){1.f, 1.f, 1.f, 1.f};
#pragma unroll
        for (int ai = 0; ai < 2; ++ai)
#pragma unroll
            for (int m = 0; m < 4; ++m) {
                const int r = row0 + ai * HALF + m * 16; const float rv = rs ? rs[r] : 1.f;
                bf16_t* rowp = O + (size_t)r * ldc + col0;
#pragma unroll
                for (int bj = 0; bj < 2; ++bj) { const f32x4 v0 = acc[ai][bj][m][0] * cv[bj][0] * rv, v1 = acc[ai][bj][m][1] * cv[bj][1] * rv;
                    u32x4 w; w.x = cvt_pk_bf16(v0[0], v0[1]); w.y = cvt_pk_bf16(v0[2], v0[3]); w.z = cvt_pk_bf16(v1[0], v1[1]); w.w = cvt_pk_bf16(v1[2], v1[3]);
                    *(u32x4*)(rowp + bj * HALF) = w; }
            }
    }
};
struct CtxSplitOrder {
    int G, c;
    __device__ __forceinline__ bool next(int i, Unit& u) const { const int L = i * G + c; if (L >= 128) return false; u.pm = (NLAT / BM) + (L & 7); u.pn = (L >> 3) & 3; u.ks = L >> 5; return true; }
    __device__ __forceinline__ size_t koff(const Unit& u) const { return (size_t)(u.ks < 2 ? u.ks * 768 : 1536 + (u.ks - 2) * 640) * 2; }
    __device__ __forceinline__ int ntiles(const Unit& u, int) const { return u.ks < 2 ? 12 : 10; }
    __device__ __forceinline__ void a_ready(const Unit&) const {}
    __device__ __forceinline__ void done(const Unit&) const {}
};
struct EpiResCtx {
    static constexpr bool PERM = false, AFTER_DRAIN = false;
    const float* base_ctx; float* out; float* part; const float* mod; int kg; float mul;
    __device__ __forceinline__ void operator()(const f32x4 (&acc)[2][2][4][2], const Unit& u, int wr, int wc, int fr, int fq) const {
        const int row0 = (u.pm - NLAT / BM) * BM + wr * 64 + fr, col0 = u.pn * BM + wc * 32 + 4 * fq;
        const float* gp = mod + 8 * 9216 + kg * 1024 + col0;
        f32x4 gv[2][2];
#pragma unroll
        for (int bj = 0; bj < 2; ++bj)
#pragma unroll
            for (int n = 0; n < 2; ++n) gv[bj][n] = *(const f32x4*)(gp + bj * HALF + n * 16) * mul;
        float* ob = u.ks == 0 ? out + (size_t)NLAT * D : part + (size_t)(u.ks - 1) * NCTX * D;
#pragma unroll
        for (int ai = 0; ai < 2; ++ai)
#pragma unroll
            for (int m = 0; m < 4; ++m) {
                const int r = row0 + ai * HALF + m * 16;
                const float* bp = base_ctx + (size_t)r * D + col0; float* op = ob + (size_t)r * D + col0;
#pragma unroll
                for (int bj = 0; bj < 2; ++bj)
#pragma unroll
                    for (int n = 0; n < 2; ++n) { f32x4 v = gv[bj][n] * acc[ai][bj][m][n]; if (u.ks == 0) v += *(const f32x4*)(bp + bj * HALF + n * 16); *(f32x4*)(op + bj * HALF + n * 16) = v; }
            }
    }
};
struct EpiQ {
    static constexpr bool PERM = true, AFTER_DRAIN = false;
    bf16_t* O; const float* rs; const f32x2* rope;
    __device__ __forceinline__ void operator()(const f32x4 (&acc)[2][2][4][2], const Unit& u, int wr, int wc, int fr, int fq) const {
        const int row0 = u.pm * BM + wr * 64 + fr, col0 = u.pn * BM + wc * 32 + 8 * fq;
#pragma unroll
        for (int ai = 0; ai < 2; ++ai)
#pragma unroll
            for (int m = 0; m < 4; ++m) {
                const int r = row0 + ai * HALF + m * 16; const float rv = rs[r] * QSCALE; const int t = r & (SEQ - 1);
                bf16_t* rowp = O + (size_t)r * 768 + col0;
#pragma unroll
                for (int bj = 0; bj < 2; ++bj) {
                    f32x4 v0 = acc[ai][bj][m][0] * rv, v1 = acc[ai][bj][m][1] * rv;
                    const int cc = (col0 + bj * HALF) % 96;
                    if (cc >= 64) {
                        const int q = cc - 64, half = q >> 4, jj = (q & 15) >> 1, pos = half ? (t & 63) : (t >> 6);
                        const f32x2* rp = rope + pos * 8 + jj;
                        const f32x2 c0 = rp[0], c1 = rp[1], c2 = rp[2], c3 = rp[3];
                        f32x4 o0, o1;
                        o0[0] = v0[0] * c0.x - v0[1] * c0.y; o0[1] = v0[0] * c0.y + v0[1] * c0.x; o0[2] = v0[2] * c1.x - v0[3] * c1.y; o0[3] = v0[2] * c1.y + v0[3] * c1.x;
                        o1[0] = v1[0] * c2.x - v1[1] * c2.y; o1[1] = v1[0] * c2.y + v1[1] * c2.x; o1[2] = v1[2] * c3.x - v1[3] * c3.y; o1[3] = v1[2] * c3.y + v1[3] * c3.x;
                        v0 = o0; v1 = o1;
                    }
                    u32x4 w; w.x = cvt_pk_bf16(v0[0], v0[1]); w.y = cvt_pk_bf16(v0[2], v0[3]); w.z = cvt_pk_bf16(v1[0], v1[1]); w.w = cvt_pk_bf16(v1[2], v1[3]);
                    *(u32x4*)(rowp + bj * HALF) = w;
                }
            }
    }
};
}

__device__ __forceinline__ int cmap(int id, int n) {
    switch (id) {
    case 0: return ((n >> 7) & 1) * DFF + (n >> 8) * 128 + (n & 127);
    case 1: return n;
    case 2: {
        if (n < 1536) return n;
        if (n < 2304) return 1552 + (n - 1536);
        if (n < 2560) return 2320 + (n - 2304);
        if (n < 2592) { const int q = n - 2560, half = q >> 4, jj = (q & 15) >> 1, which = q & 1; return 2576 + half * 16 + which * 8 + jj; }
        if (n < 2608) return 1536 + (n - 2592);
        return -1; }
    case 3: { const int hh = n / 96, cc = n % 96; if (cc < 64) return hh * 96 + cc;
        const int q = cc - 64, half = q >> 4, jj = (q & 15) >> 1, which = q & 1; return hh * 96 + 64 + half * 16 + which * 8 + jj; }
    case 4: return (n >> 6) * 128 + (n & 63);
    default: return (n >> 6) * 128 + 64 + (n & 63);
    }
}
__device__ __forceinline__ void titem(const float* W, int K, int N, bf16* WT, const float* gk, LAS float* scr, int item, int nblk, int lane, int id, float mulc = 1.f) {
    const int kb = item / nblk, nb = item % nblk, k0 = 64 * kb, n0 = 32 * nb;
    const int src = cmap(id, n0 + (lane & 31));
#pragma unroll 8
    for (int i = 0; i < 32; ++i) { const int kk = 2 * i + (lane >> 5); float v = src >= 0 ? W[(size_t)(k0 + kk) * N + src] : 0.f; if (gk) v *= gk[k0 + kk] * mulc; scr[kk * 33 + (lane & 31)] = v; }
    LDS_FENCE();
    const int c = lane & 7;
#pragma unroll
    for (int j = 0; j < 4; ++j) { const int n = (lane >> 3) + 8 * j; const LAS float* s = scr + (8 * c) * 33 + n;
        u32x4 o; o.x = pk2(s[0 * 33], s[1 * 33]); o.y = pk2(s[2 * 33], s[3 * 33]); o.z = pk2(s[4 * 33], s[5 * 33]); o.w = pk2(s[6 * 33], s[7 * 33]);
        *(u32x4*)(WT + (size_t)(n0 + n) * K + k0 + 8 * c) = o; }
    LDS_FENCE();
}
__device__ __forceinline__ void phase0(const Args& a, LAS unsigned char* lds, int gw, int NGW, int tid, int lane, int wave) {
    unsigned char* ws = a.ws;
    LAS float* scr = (LAS float*)(lds + wave * 16384);
    if (blockIdx.x < 144) {
        float* MOD = (float*)(ws + WS_MOD);
        const float* cin = a.in[1]; const float* cctx = a.in[3]; const float* wada = a.in[4]; const float* bada = a.in[5];
        const int n = blockIdx.x * 64 + lane, kw = wave * 128;
        float acc[9];
#pragma unroll
        for (int bb = 0; bb < 9; ++bb) acc[bb] = 0.f;
#pragma unroll 1
        for (int hf = 0; hf < 2; ++hf) {
            const int k0 = kw + 64 * hf;
            float sv[9];
#pragma unroll
            for (int bb = 0; bb < 8; ++bb) sv[bb] = silu_f(cin[bb * 1024 + k0 + lane]);
            sv[8] = silu_f(cctx[k0 + lane]);
#pragma unroll 16
            for (int k = 0; k < 64; ++k) {
                const float w = wada[(size_t)(k0 + k) * 9216 + n];
#pragma unroll
                for (int bb = 0; bb < 9; ++bb) acc[bb] += w * __shfl(sv[bb], k);
            }
        }
        LAS float* red = (LAS float*)lds;
#pragma unroll
        for (int bb = 0; bb < 9; ++bb) red[(wave * 9 + bb) * 64 + lane] = acc[bb];
        __syncthreads();
        for (int o = tid; o < 576; o += 512) { float t = bada[blockIdx.x * 64 + (o & 63)];
#pragma unroll
            for (int w = 0; w < 8; ++w) t += red[w * 576 + o];
            MOD[(o >> 6) * 9216 + blockIdx.x * 64 + (o & 63)] = t; }
        __syncthreads();
    }
    constexpr int I_W1A = 16 * 176, I_W1B = 44 * 32, I_WIN = 16 * 88, I_WUQ = 12 * 24, I_WK = 4 * 16, I_WOUT = 16 * 32;
    constexpr int NITEMS = 2 * I_W1A + 2 * I_W1B + I_WIN + I_WUQ + 2 * I_WK + I_WOUT;
    for (int rep0 = 0; rep0 < (PROBE_PHASE == 201 ? 2 : 1); ++rep0)
    for (int it = gw; it < NITEMS; it += NGW) {
        int r = it;
        if (r < I_W1A) { titem(a.in[7], 1024, 5632, (bf16*)(ws + WS_W1A), nullptr, scr, r, 176, lane, 0); continue; } r -= I_W1A;
        if (r < I_W1A) { titem(a.in[23], 1024, 5632, (bf16*)(ws + WS_W2A), nullptr, scr, r, 176, lane, 0); continue; } r -= I_W1A;
        if (r < I_W1B) { titem(a.in[8], 2816, 1024, (bf16*)(ws + WS_W1B), nullptr, scr, r, 32, lane, 1); continue; } r -= I_W1B;
        if (r < I_W1B) { titem(a.in[24], 2816, 1024, (bf16*)(ws + WS_W2B), nullptr, scr, r, 32, lane, 1); continue; } r -= I_W1B;
        if (r < I_WIN) { titem(a.in[10], 1024, 2608, (bf16*)(ws + WS_WIN), nullptr, scr, r, 88, lane, 2); continue; } r -= I_WIN;
        if (r < I_WUQ) { titem(a.in[18], 768, 768, (bf16*)(ws + WS_WUQ), a.in[17], scr, r, 24, lane, 3, QSCALE); continue; } r -= I_WUQ;
        if (r < I_WK) { titem(a.in[20], 256, 1024, (bf16*)(ws + WS_WK), a.in[19], scr, r, 16, lane, 4); continue; } r -= I_WK;
        if (r < I_WK) { titem(a.in[20], 256, 1024, (bf16*)(ws + WS_WV), a.in[19], scr, r, 16, lane, 5); continue; } r -= I_WK;
        titem(a.in[21], 1024, 1024, (bf16*)(ws + WS_WOUT), nullptr, scr, r, 32, lane, 1);
    }
    if (blockIdx.x == 0) {
        const int pos = tid >> 3, jj = tid & 7; const float inv = __builtin_amdgcn_exp2f(-(float)jj * 1.6609640474436813f);
        const float ang = (float)pos * inv;
        ((f32x2*)(ws + WS_ROPE))[tid] = (f32x2){__cosf(ang), __sinf(ang)};
    }
}

__device__ __forceinline__ void norm_rows(const float* src_lat, const float* src_ctx, int nrows, const float* gvec, const float* mod, int kshift, bf16* out, int gw, int NGW, int lane, const float* part = nullptr) {
    for (int row = gw; row < nrows; row += NGW) {
        const float* xr = (row < NLAT ? src_lat + (size_t)row * D : src_ctx + (size_t)(row - NLAT) * D) + 4 * lane;
        const int bb = row < NLAT ? row / SEQ : 8;
        const float* sh = mod + bb * 9216 + kshift * 1024 + 4 * lane; const float* sc = sh + 1024;
        f32x4 v[4]; float s = 0.f;
#pragma unroll
        for (int j = 0; j < 4; ++j) { v[j] = *(const f32x4*)(xr + 256 * j);
            if (part && row >= NLAT) { const float* pp = part + (size_t)(row - NLAT) * D + 4 * lane + 256 * j;
                v[j] += *(const f32x4*)pp + *(const f32x4*)(pp + (size_t)NCTX * D) + *(const f32x4*)(pp + (size_t)2 * NCTX * D); }
            s += (v[j][0] * v[j][0] + v[j][1] * v[j][1]) + (v[j][2] * v[j][2] + v[j][3] * v[j][3]); }
        const float rstd = 1.0f / sqrtf(wave_sum(s) * (1.f / D) + EPS);
        bf16* orow = out + (size_t)row * D + 4 * lane;
#pragma unroll
        for (int j = 0; j < 4; ++j) {
            const f32x4 g = *(const f32x4*)(gvec + 4 * lane + 256 * j), scv = *(const f32x4*)(sc + 256 * j), shv = *(const f32x4*)(sh + 256 * j);
            const f32x4 y = (v[j] * rstd) * g * (scv + 1.f) + shv;
            u32x2 w; w.x = pk2(y[0], y[1]); w.y = pk2(y[2], y[3]); *(u32x2*)(orow + 256 * j) = w;
        }
    }
}
__device__ __forceinline__ void final_norm_rows(float* io, const float* gvec, int gw, int NGW, int lane) {
    for (int row = gw; row < NLAT; row += NGW) {
        float* xr = io + (size_t)row * D + 4 * lane;
        f32x4 v[4]; float s = 0.f;
#pragma unroll
        for (int j = 0; j < 4; ++j) { v[j] = *(const f32x4*)(xr + 256 * j); s += (v[j][0] * v[j][0] + v[j][1] * v[j][1]) + (v[j][2] * v[j][2] + v[j][3] * v[j][3]); }
        const float rstd = 1.0f / sqrtf(wave_sum(s) * (1.f / D) + EPS);
#pragma unroll
        for (int j = 0; j < 4; ++j) { const f32x4 g = *(const f32x4*)(gvec + 4 * lane + 256 * j); *(f32x4*)(xr + 256 * j) = (v[j] * rstd) * g; }
    }
}

__device__ __forceinline__ float softplus_f(float x) { return fmaxf(x, 0.f) + log1pf(__expf(-fabsf(x))); }
__device__ __forceinline__ void phase6(const Args& a, LAS unsigned char* lds, int G, int bx, int tid, int lane, int wave) {
    unsigned char* ws = a.ws;
    const bf16* XBCR = (const bf16*)(ws + WS_XBCR); const bf16* MISC = (const bf16*)(ws + WS_MISC); const bf16* CQ = (const bf16*)(ws + WS_CQ); const bf16* CKV = (const bf16*)(ws + WS_CKV);
    bf16* XT = (bf16*)(ws + WS_XT); bf16* BT = (bf16*)(ws + WS_BT); bf16* BROW = (bf16*)(ws + WS_BROW); bf16* CROW = (bf16*)(ws + WS_CROW); bf16* KPE = (bf16*)(ws + WS_KPE);
    float* DT = (float*)(ws + WS_DT); float* RSTDQ = (float*)(ws + WS_RSTDQ); float* RSTDKV = (float*)(ws + WS_RSTDKV); const f32x2* ROPE = (const f32x2*)(ws + WS_ROPE);
    const float* conv_w = a.in[11]; const float* conv_b = a.in[12]; const float* dt_bias = a.in[13];
    LAS bf16* T = (LAS bf16*)lds;
    const int ch = 4 * (tid & 255), tseg = (tid >> 8) * 32;
    float cw[5][4], cb[4];
#pragma unroll
    for (int k = 0; k < 5; ++k) { const f32x4 w = *(const f32x4*)(conv_w + k * 1024 + ch); cw[k][0] = w[0]; cw[k][1] = w[1]; cw[k][2] = w[2]; cw[k][3] = w[3]; }
    { const f32x4 w = *(const f32x4*)(conv_b + ch); cb[0] = w[0]; cb[1] = w[1]; cb[2] = w[2]; cb[3] = w[3]; }
    for (int unit = bx; unit < NB * 68; unit += G) {
        const int b = unit / 68, ut = unit % 68, u0 = ut * 64;
        const int seg_lo = u0 < CTXL ? 0 : CTXL, seg_hi = u0 < CTXL ? CTXL : UL;
        const int rb = u0 < CTXL ? NLAT + b * CTXL : b * SEQ - CTXL;
#define P6_LD(u) (((u) >= seg_lo && (u) < seg_hi) ? *(const u32x2*)(XBCR + (size_t)(rb + (u)) * 1024 + ch) : (u32x2){0u, 0u})
        const int ub = u0 + tseg;
        u32x2 xm2 = P6_LD(ub - 2), xm1 = P6_LD(ub - 1), x0 = P6_LD(ub), xp1 = P6_LD(ub + 1);
#pragma unroll 16
        for (int t = 0; t < 32; ++t) {
            const u32x2 xp2 = P6_LD(ub + t + 2);
            const float y0 = cb[0] + cw[0][0] * bflo(xm2.x) + cw[1][0] * bflo(xm1.x) + cw[2][0] * bflo(x0.x) + cw[3][0] * bflo(xp1.x) + cw[4][0] * bflo(xp2.x);
            const float y1 = cb[1] + cw[0][1] * bfhi(xm2.x) + cw[1][1] * bfhi(xm1.x) + cw[2][1] * bfhi(x0.x) + cw[3][1] * bfhi(xp1.x) + cw[4][1] * bfhi(xp2.x);
            const float y2 = cb[2] + cw[0][2] * bflo(xm2.y) + cw[1][2] * bflo(xm1.y) + cw[2][2] * bflo(x0.y) + cw[3][2] * bflo(xp1.y) + cw[4][2] * bflo(xp2.y);
            const float y3 = cb[3] + cw[0][3] * bfhi(xm2.y) + cw[1][3] * bfhi(xm1.y) + cw[2][3] * bfhi(x0.y) + cw[3][3] * bfhi(xp1.y) + cw[4][3] * bfhi(xp2.y);
            u32x2 pk; pk.x = pk2(silu_f(y0), silu_f(y1)); pk.y = pk2(silu_f(y2), silu_f(y3));
            const int tt = tseg + t;
            if (ch < 768) { T[ch * 72 + tt] = (bf16)(pk.x & 0xffffu); T[(ch + 1) * 72 + tt] = (bf16)(pk.x >> 16); T[(ch + 2) * 72 + tt] = (bf16)(pk.y & 0xffffu); T[(ch + 3) * 72 + tt] = (bf16)(pk.y >> 16); }
            if (ch >= 512) { bf16* dst = ch < 768 ? BROW + (ch - 512) : CROW + (ch - 768); *(u32x2*)(dst + (size_t)(b * UL + u0 + tt) * 256) = pk; }
            xm2 = xm1; xm1 = x0; x0 = xp1; xp1 = xp2;
        }
#undef P6_LD
        __syncthreads();
#pragma unroll
        for (int i = 0; i < 12; ++i) { const int q = tid + 512 * i, c = q >> 3, part = q & 7;
            const u32x4 v = *(const LAS u32x4*)(T + c * 72 + part * 8);
            bf16* dst = c < 512 ? XT + (size_t)(b * 512 + c) * UL : BT + (size_t)(b * 256 + c - 512) * UL;
            *(u32x4*)(dst + u0 + part * 8) = v; }
        {
            const int uu = tid >> 3, k = (tid & 7) * 2; const size_t row = (size_t)(rb + u0 + uu);
            const unsigned raw = *(const unsigned*)(MISC + row * 256 + 32 + k);
            f32x2 o; o.x = softplus_f(bflo(raw) + dt_bias[k]); o.y = softplus_f(bfhi(raw) + dt_bias[k + 1]);
            *(f32x2*)(DT + (size_t)(b * UL + u0 + uu) * 16 + k) = o;
        }
        {
            const int uu = tid >> 3, pp = (tid & 7) * 2; const size_t row = (size_t)(rb + u0 + uu);
            u32x2 raw = *(const u32x2*)(MISC + row * 256 + 2 * pp);
            if (u0 >= CTXL) {
                const int t = u0 + uu - CTXL, half = pp >> 3, jj = pp & 7, pos = half ? (t & 63) : (t >> 6);
                const f32x2 c0 = ROPE[pos * 8 + jj], c1 = ROPE[pos * 8 + jj + 1];
                const float a0 = bflo(raw.x), a1 = bfhi(raw.x), a2 = bflo(raw.y), a3 = bfhi(raw.y);
                raw.x = pk2(a0 * c0.x - a1 * c0.y, a0 * c0.y + a1 * c0.x); raw.y = pk2(a2 * c1.x - a3 * c1.y, a2 * c1.y + a3 * c1.x);
            }
            *(u32x2*)(KPE + row * 32 + 2 * pp) = raw;
        }
#pragma unroll 2
        for (int rr = 0; rr < 8; ++rr) {
            const size_t row = (size_t)(rb + u0 + wave * 8 + rr);
            { const u32x2 w = *(const u32x2*)(CKV + row * 256 + 4 * lane); const float c0 = bflo(w.x), c1 = bfhi(w.x), c2 = bflo(w.y), c3 = bfhi(w.y);
              const float s = wave_sum((c0 * c0 + c1 * c1) + (c2 * c2 + c3 * c3)); if (lane == 0) RSTDKV[row] = 1.0f / sqrtf(s * (1.f / 256.f) + EPS); }
            if (u0 >= CTXL) { float s = 0.f;
#pragma unroll
                for (int i = 0; i < 3; ++i) { const u32x2 w = *(const u32x2*)(CQ + row * 768 + 4 * lane + 256 * i); const float c0 = bflo(w.x), c1 = bfhi(w.x), c2 = bflo(w.y), c3 = bfhi(w.y);
                    s += (c0 * c0 + c1 * c1) + (c2 * c2 + c3 * c3); }
                s = wave_sum(s); if (lane == 0) RSTDQ[row] = 1.0f / sqrtf(s * (1.f / 768.f) + EPS); }
        }
        __syncthreads();
    }
}

__device__ __forceinline__ void acum_wave(const float* DT, size_t dtrow0, int h, float anf, float anb, LAS float* sc, int lane) {
    const float df0 = DT[(dtrow0 + lane) * 16 + h], df1 = DT[(dtrow0 + 64 + lane) * 16 + h];
    const float db0 = DT[(dtrow0 + lane) * 16 + 8 + h], db1 = DT[(dtrow0 + 64 + lane) * 16 + 8 + h];
    const float f0 = incl_scan(df0 * anf, lane); float f1 = incl_scan(df1 * anf, lane); f1 += __shfl(f0, 63);
    const float a0 = db0 * anb, a1 = db1 * anb; const float g0 = incl_scan(a0, lane), g1 = incl_scan(a1, lane);
    const float t0 = __shfl(g0, 63), t1 = __shfl(g1, 63), tot = t0 + t1;
    sc[lane] = f0; sc[64 + lane] = f1; sc[128 + lane] = tot - g0 + a0; sc[192 + lane] = t1 - g1 + a1;
    sc[256 + lane] = df0; sc[320 + lane] = df1; sc[384 + lane] = db0; sc[448 + lane] = db1;
    LDS_FENCE();
}
#define MFMA32(a, b, c) __builtin_amdgcn_mfma_f32_32x32x16_bf16((a), (b), (c), 0, 0, 0)
__device__ __forceinline__ f32x16 zero16() { f32x16 z;
#pragma unroll
    for (int r = 0; r < 16; ++r) z[r] = 0.f; return z; }

constexpr int S3_STR = 136, S3_TILE = 128 * S3_STR * 2;
constexpr int S3_CL = 0, S3_BL = 2 * S3_TILE, S3_SC = 4 * S3_TILE, S3_SS = S3_SC + 16384;
__device__ __forceinline__ void phase8(const Args& a, LAS unsigned char* lds, int G, int bx, int tid, int lane, int wave) {
    unsigned char* ws = a.ws;
    const bf16* XT = (const bf16*)(ws + WS_XT); const bf16* BT = (const bf16*)(ws + WS_BT); const float* DT = (const float*)(ws + WS_DT);
    bf16* ST = (bf16*)(ws + WS_ST); float* CD = (float*)(ws + WS_CD);
    LAS float* sc = (LAS float*)(lds + S3_SC) + wave * 512;
    const int h = wave, g = h >> 2, r32 = lane & 31, hi = lane >> 5;
    const float anf = -__expf(a.in[14][h]), anb = -__expf(a.in[14][8 + h]);
    for (int unit = G - 1 - bx; unit < NB * NCH; unit += G) {
        const int b = unit / NCH, c = unit % NCH;
#pragma unroll
        for (int it = 0; it < 8; ++it) { const int q = tid + 512 * it, n = q >> 4, k16 = q & 15;
            const u32x4 v = *(const u32x4*)(BT + (size_t)(b * 256 + n) * UL + c * 128 + 8 * k16);
            *(LAS u32x4*)(lds + (n * S3_STR + 8 * k16) * 2) = v; }
        acum_wave(DT, (size_t)b * UL + c * 128, h, anf, anb, sc, lane);
        const float af_last = sc[127], ab_first = sc[128];
#pragma unroll
        for (int hf = 0; hf < 2; ++hf) { const int j = lane + 64 * hf;
            const float wf = __expf(af_last - sc[j]) * sc[256 + j], wb = __expf(ab_first - sc[128 + j]) * sc[384 + j];
            sc[256 + j] = wf; sc[384 + j] = wb; }
        if (lane == 0) { CD[((b * 2 + 0) * 8 + h) * NCH + c] = __expf(af_last); CD[((b * 2 + 1) * 8 + h) * NCH + c] = __expf(ab_first); }
        __syncthreads();
        const bf16* xbase = XT + (size_t)(b * 512 + h * 64 + r32) * UL + c * 128 + 8 * hi;
        const LAS unsigned char* btl = lds + ((g * 128 + r32) * S3_STR + 8 * hi) * 2;
        const LAS float* wfp = sc + 256 + 8 * hi; const LAS float* wbp = sc + 384 + 8 * hi;
#pragma unroll 1
        for (int half = 0; half < 2; ++half) {
            f32x16 accf[2][2], accb[2][2];
#pragma unroll
            for (int nn = 0; nn < 2; ++nn) { accf[nn][0] = zero16(); accf[nn][1] = zero16(); accb[nn][0] = zero16(); accb[nn][1] = zero16(); }
#pragma unroll 2
            for (int s = 0; s < 8; ++s) {
                const f32x4 fa = *(const LAS f32x4*)(wfp + 16 * s), fb = *(const LAS f32x4*)(wfp + 16 * s + 4), ba = *(const LAS f32x4*)(wbp + 16 * s), bb = *(const LAS f32x4*)(wbp + 16 * s + 4);
                bf16x8 xwf[2], xwb[2];
#pragma unroll
                for (int pb = 0; pb < 2; ++pb) { const u32x4 raw = *(const u32x4*)(xbase + (size_t)pb * 32 * UL + 16 * s);
                    const float x0 = bflo(raw.x), x1 = bfhi(raw.x), x2 = bflo(raw.y), x3 = bfhi(raw.y), x4 = bflo(raw.z), x5 = bfhi(raw.z), x6 = bflo(raw.w), x7 = bfhi(raw.w);
                    xwf[pb] = pack8(x0 * fa[0], x1 * fa[1], x2 * fa[2], x3 * fa[3], x4 * fb[0], x5 * fb[1], x6 * fb[2], x7 * fb[3]);
                    xwb[pb] = pack8(x0 * ba[0], x1 * ba[1], x2 * ba[2], x3 * ba[3], x4 * bb[0], x5 * bb[1], x6 * bb[2], x7 * bb[3]); }
#pragma unroll
                for (int nn = 0; nn < 2; ++nn) { const bf16x8 bt = *(const LAS bf16x8*)(btl + ((2 * half + nn) * 32 * S3_STR + 16 * s) * 2);
                    accf[nn][0] = MFMA32(bt, xwf[0], accf[nn][0]); accf[nn][1] = MFMA32(bt, xwf[1], accf[nn][1]);
                    accb[nn][0] = MFMA32(bt, xwb[0], accb[nn][0]); accb[nn][1] = MFMA32(bt, xwb[1], accb[nn][1]); }
            }
            bf16* sof = ST + ((size_t)(((b * 2 + 0) * 8 + h) * NCH + c) * 64) * 128; bf16* sob = ST + ((size_t)(((b * 2 + 1) * 8 + h) * NCH + c) * 64) * 128;
#pragma unroll
            for (int nn = 0; nn < 2; ++nn)
#pragma unroll
                for (int pb = 0; pb < 2; ++pb)
#pragma unroll
                    for (int g4 = 0; g4 < 4; ++g4) { const size_t off = (size_t)(32 * pb + r32) * 128 + 32 * (2 * half + nn) + 8 * g4 + 4 * hi;
                        u32x2 o; o.x = pk2(accf[nn][pb][4 * g4], accf[nn][pb][4 * g4 + 1]); o.y = pk2(accf[nn][pb][4 * g4 + 2], accf[nn][pb][4 * g4 + 3]); *(u32x2*)(sof + off) = o;
                        o.x = pk2(accb[nn][pb][4 * g4], accb[nn][pb][4 * g4 + 1]); o.y = pk2(accb[nn][pb][4 * g4 + 2], accb[nn][pb][4 * g4 + 3]); *(u32x2*)(sob + off) = o; }
        }
        __syncthreads();
    }
}
__device__ __forceinline__ void phase9(const Args& a, int G, int bx, int tid) {
    unsigned char* ws = a.ws;
    const bf16* ST = (const bf16*)(ws + WS_ST); bf16* HE = (bf16*)(ws + WS_HE); const float* CD = (const float*)(ws + WS_CD);
    for (int idx = bx * 512 + tid; idx < NB * 2 * 8 * 2048; idx += G * 512) {
        const int e = (idx & 2047) * 4, bdh = idx >> 11, dir = (bdh >> 3) & 1;
        const bf16* st = ST + (size_t)bdh * NCH * 8192 + e; bf16* he = HE + (size_t)bdh * 32 * 8192 + e; const float* cd = CD + bdh * NCH;
#define P9_LD(c) (*(const u32x2*)(st + (size_t)(c) * 8192))
#define P9_STEP(c) do { const u32x2 w_ = P9_LD(c); const float d_ = cd[c]; h0 = d_ * h0 + bflo(w_.x); h1 = d_ * h1 + bfhi(w_.x); h2 = d_ * h2 + bflo(w_.y); h3 = d_ * h3 + bfhi(w_.y); } while (0)
#define P9_OUT(c) do { u32x2 o_; o_.x = pk2(h0, h1); o_.y = pk2(h2, h3); *(u32x2*)(he + (size_t)((c) - 2) * 8192) = o_; } while (0)
        float h0 = 0.f, h1 = 0.f, h2 = 0.f, h3 = 0.f;
        if (dir == 0) {
            P9_STEP(0); P9_STEP(1);
#pragma unroll 8
            for (int c = 2; c < NCH; ++c) { P9_OUT(c); P9_STEP(c); }
        } else {
            P9_STEP(1); P9_STEP(0);
#pragma unroll 8
            for (int c = NCH - 1; c >= 2; --c) { P9_OUT(c); P9_STEP(c); }
        }
#undef P9_LD
#undef P9_STEP
#undef P9_OUT
    }
}
__device__ __forceinline__ void phase10_ssd(const Args& a, LAS unsigned char* lds, int G, int bx, int tid, int lane, int wave) {
    unsigned char* ws = a.ws;
    const bf16* XT = (const bf16*)(ws + WS_XT); const bf16* BROW = (const bf16*)(ws + WS_BROW); const bf16* CROW = (const bf16*)(ws + WS_CROW); const float* DT = (const float*)(ws + WS_DT);
    const bf16* HE = (const bf16*)(ws + WS_HE); const bf16* Z = (const bf16*)(ws + WS_Z); bf16* MIX = (bf16*)(ws + WS_MIX);
    LAS float* sc = (LAS float*)(lds + S3_SC) + wave * 512;
    LAS float* SS = (LAS float*)(lds + S3_SS);
    const int h = wave, g = h >> 2, r32 = lane & 31, hi = lane >> 5;
    const float anf = -__expf(a.in[14][h]), anb = -__expf(a.in[14][8 + h]);
    const float dskip = a.in[15][h]; const float* snorm = a.in[16] + h * 64;
    for (int unit = bx; unit < NB * 32; unit += G) {
        const int b = unit >> 5, lc = unit & 31, c = lc + 2; const size_t u0 = (size_t)b * UL + c * 128;
#pragma unroll
        for (int it = 0; it < 8; ++it) { const int q = tid + 512 * it, i = q >> 5, ch16 = q & 31, off = ((ch16 >> 4) * S3_TILE) + (i * S3_STR + (ch16 & 15) * 8) * 2;
            const u32x4 vc = *(const u32x4*)(CROW + (u0 + i) * 256 + 8 * ch16), vb = *(const u32x4*)(BROW + (u0 + i) * 256 + 8 * ch16);
            *(LAS u32x4*)(lds + S3_CL + off) = vc; *(LAS u32x4*)(lds + S3_BL + off) = vb; }
        acum_wave(DT, u0, h, anf, anb, sc, lane);
        {
            float wfv[2], wbv[2];
#pragma unroll
            for (int hf = 0; hf < 2; ++hf) { const int j = lane + 64 * hf, jb = j >> 5;
                const float afb = jb ? sc[32 * jb - 1] : 0.f, abb = jb < 3 ? sc[128 + 32 * jb + 32] : 0.f;
                wfv[hf] = __expf(afb - sc[j]) * sc[256 + j]; wbv[hf] = __expf(abb - sc[128 + j]) * sc[384 + j]; }
            LDS_FENCE();
#pragma unroll
            for (int hf = 0; hf < 2; ++hf) { const int j = lane + 64 * hf; sc[256 + j] = wfv[hf]; sc[384 + j] = wbv[hf]; }
        }
        __syncthreads();
        const LAS unsigned char* CLg = lds + S3_CL + g * S3_TILE + (r32 * S3_STR + 8 * hi) * 2;
        const LAS unsigned char* BLg = lds + S3_BL + g * S3_TILE + (r32 * S3_STR + 8 * hi) * 2;
#pragma unroll 1
        for (int ibp = 0; ibp < 2; ++ibp) {
        f32x16 acc[2][2];
#pragma unroll
        for (int k = 0; k < 2; ++k) { acc[k][0] = zero16(); acc[k][1] = zero16(); }
#ifndef NO_DIAG
#pragma unroll 1
        for (int jb = 0; jb < 4; ++jb) {
            bf16x8 xa[2][2];
#pragma unroll
            for (int pb = 0; pb < 2; ++pb) {
                const bf16* xp = XT + (size_t)(b * 512 + h * 64 + 32 * pb + r32) * UL + c * 128 + 32 * jb + 4 * hi;
                const u32x2 a0 = *(const u32x2*)(xp), a1 = *(const u32x2*)(xp + 8), a2 = *(const u32x2*)(xp + 16), a3 = *(const u32x2*)(xp + 24);
                xa[pb][0] = __builtin_bit_cast(bf16x8, (u32x4){a0.x, a0.y, a1.x, a1.y}); xa[pb][1] = __builtin_bit_cast(bf16x8, (u32x4){a2.x, a2.y, a3.x, a3.y});
            }
#pragma unroll
            for (int k = 0; k < 2; ++k) {
                const int ib = 2 * ibp + k;
                f32x16 ga = zero16();
#pragma unroll
                for (int s = 0; s < 8; ++s) { const bf16x8 bfr = *(const LAS bf16x8*)(BLg + (32 * jb * S3_STR + 16 * s) * 2), cf = *(const LAS bf16x8*)(CLg + (32 * ib * S3_STR + 16 * s) * 2);
                    ga = MFMA32(bfr, cf, ga); }
                float mm[16];
                if (jb < ib) {
                    const float efi = __expf(sc[32 * ib + r32] - sc[32 * jb + 31]);
#pragma unroll
                    for (int r = 0; r < 16; ++r) mm[r] = ga[r] * sc[256 + 32 * jb + crow(r, hi)];
                    const float efb = __expf(sc[32 * ib + r32] - (jb ? sc[32 * jb - 1] : 0.f));
#pragma unroll
                    for (int r = 0; r < 16; ++r) mm[r] *= efb;
                    (void)efi;
                } else if (jb > ib) {
                    const float ebb = __expf(sc[128 + 32 * ib + r32] - (jb < 3 ? sc[128 + 32 * jb + 32] : 0.f));
#pragma unroll
                    for (int r = 0; r < 16; ++r) mm[r] = ga[r] * sc[384 + 32 * jb + crow(r, hi)] * ebb;
                } else {
                    const float efb = __expf(sc[32 * ib + r32] - (jb ? sc[32 * jb - 1] : 0.f)), ebb = __expf(sc[128 + 32 * ib + r32] - (jb < 3 ? sc[128 + 32 * jb + 32] : 0.f));
#pragma unroll
                    for (int r = 0; r < 16; ++r) { const int jl = crow(r, hi);
                        const float mf = jl <= r32 ? efb * sc[256 + 32 * jb + jl] : 0.f, mb = jl >= r32 ? ebb * sc[384 + 32 * jb + jl] : 0.f;
                        mm[r] = ga[r] * (mf + mb) + (jl == r32 ? dskip : 0.f); }
                }
                const bf16x8 pf0 = pack8(mm[0], mm[1], mm[2], mm[3], mm[4], mm[5], mm[6], mm[7]), pf1 = pack8(mm[8], mm[9], mm[10], mm[11], mm[12], mm[13], mm[14], mm[15]);
                acc[k][0] = MFMA32(xa[0][0], pf0, acc[k][0]); acc[k][0] = MFMA32(xa[0][1], pf1, acc[k][0]);
                acc[k][1] = MFMA32(xa[1][0], pf0, acc[k][1]); acc[k][1] = MFMA32(xa[1][1], pf1, acc[k][1]);
                asm volatile("" ::: "memory");
            }
        }
#endif
#ifndef NO_OFF
#pragma unroll 1
        for (int dir = 0; dir < 2; ++dir) {
#pragma unroll
            for (int pb = 0; pb < 2; ++pb) {
                const bf16* hp = HE + ((size_t)(((b * 2 + dir) * 8 + h) * 32 + lc) * 64 + 32 * pb + r32) * 128 + 8 * hi;
                f32x16 ta0 = zero16(), ta1 = zero16();
#pragma unroll
                for (int s = 0; s < 8; ++s) { const bf16x8 hf = *(const bf16x8*)(hp + 16 * s);
                    const bf16x8 cf0 = *(const LAS bf16x8*)(CLg + (32 * (2 * ibp) * S3_STR + 16 * s) * 2), cf1 = *(const LAS bf16x8*)(CLg + (32 * (2 * ibp + 1) * S3_STR + 16 * s) * 2);
                    ta0 = MFMA32(hf, cf0, ta0); ta1 = MFMA32(hf, cf1, ta1);
                    if ((s & 3) == 3) asm volatile("" ::: "memory"); }
                const float e0 = __expf(sc[128 * dir + 32 * (2 * ibp) + r32]), e1 = __expf(sc[128 * dir + 32 * (2 * ibp + 1) + r32]);
#pragma unroll
                for (int r = 0; r < 16; ++r) { acc[0][pb][r] += e0 * ta0[r]; acc[1][pb][r] += e1 * ta1[r]; }
                asm volatile("" ::: "memory");
            }
        }
#endif
#pragma unroll
        for (int k = 0; k < 2; ++k) {
            const int ib = 2 * ibp + k;
            const size_t row = (size_t)b * SEQ + lc * 128 + 32 * ib + r32;
            float ss = 0.f;
#pragma unroll
            for (int pb = 0; pb < 2; ++pb)
#pragma unroll
                for (int g4 = 0; g4 < 4; ++g4) { const u32x2 zw = *(const u32x2*)(Z + row * 512 + h * 64 + 32 * pb + 8 * g4 + 4 * hi);
                    const float v0 = acc[k][pb][4 * g4] * silu_f(bflo(zw.x)), v1 = acc[k][pb][4 * g4 + 1] * silu_f(bfhi(zw.x)), v2 = acc[k][pb][4 * g4 + 2] * silu_f(bflo(zw.y)), v3 = acc[k][pb][4 * g4 + 3] * silu_f(bfhi(zw.y));
                    ss += (v0 * v0 + v1 * v1) + (v2 * v2 + v3 * v3);
                    acc[k][pb][4 * g4] = v0; acc[k][pb][4 * g4 + 1] = v1; acc[k][pb][4 * g4 + 2] = v2; acc[k][pb][4 * g4 + 3] = v3; }
            ss += __shfl_xor(ss, 32);
            if (hi == 0) SS[(ib * 8 + wave) * 32 + r32] = ss;
        }
        __syncthreads();
#pragma unroll
        for (int k = 0; k < 2; ++k) {
            const int ib = 2 * ibp + k;
            const size_t row = (size_t)b * SEQ + lc * 128 + 32 * ib + r32;
            float tot = 0.f;
#pragma unroll
            for (int w = 0; w < 8; ++w) tot += SS[(ib * 8 + w) * 32 + r32];
            const float rstd = 1.0f / sqrtf(tot * (1.f / 512.f) + EPS);
#pragma unroll
            for (int pb = 0; pb < 2; ++pb)
#pragma unroll
                for (int g4 = 0; g4 < 4; ++g4) { const int p0 = 32 * pb + 8 * g4 + 4 * hi; const f32x4 gn = *(const f32x4*)(snorm + p0);
                    u32x2 o; o.x = pk2(acc[k][pb][4 * g4] * rstd * gn[0], acc[k][pb][4 * g4 + 1] * rstd * gn[1]); o.y = pk2(acc[k][pb][4 * g4 + 2] * rstd * gn[2], acc[k][pb][4 * g4 + 3] * rstd * gn[3]);
                    *(u32x2*)(MIX + row * 1024 + h * 64 + p0) = o; }
        }
        }
        __syncthreads();
    }
}

__device__ __forceinline__ float at_max3(float a, float b, float c) { float r; asm("v_max3_f32 %0, %1, %2, %3" : "=v"(r) : "v"(a), "v"(b), "v"(c)); return r; }
constexpr int AT_KS = 104, AT_VS = 68, AT_KB = 64 * AT_KS * 2, AT_BUF = AT_KB + 64 * AT_VS * 2;
__device__ __forceinline__ void phase10_attn(const Args& a, LAS unsigned char* lds, int G, int vcu, int tid, int lane, int wave) {
    unsigned char* ws = a.ws; unsigned char* ob = (unsigned char*)a.out;
    const bf16* Q = (const bf16*)(ob + OUT_Q); const bf16* KN = (const bf16*)(ob + OUT_KN); const bf16* VT = (const bf16*)(ob + OUT_VT); const bf16* KPE = (const bf16*)(ws + WS_KPE);
    bf16* MIX = (bf16*)(ws + WS_MIX); const f32x2* ROPE = (const f32x2*)(ws + WS_ROPE);
    const int r32 = lane & 31, hi = lane >> 5;
    for (int unit = vcu; unit < NB * 8 * 16; unit += G) {
        const int bh = unit >> 4, qb = unit & 15, b = bh >> 3, h = bh & 7;
        const size_t qrow = (size_t)b * SEQ + qb * 256 + wave * 32 + r32;
        bf16x8 qr[6];
        { const bf16* qp = Q + qrow * 768 + h * 96 + 8 * hi;
#pragma unroll
          for (int s = 0; s < 6; ++s) qr[s] = *(const bf16x8*)(qp + 16 * s);
          const int tq = qb * 256 + wave * 32 + r32;
#pragma unroll
          for (int s = 4; s < 6; ++s) { const int pos = (s == 4) ? (tq >> 6) : (tq & 63); const f32x2* rp = ROPE + pos * 8 + 4 * hi;
              const u32x4 w = __builtin_bit_cast(u32x4, qr[s]); const f32x2 c0 = rp[0], c1 = rp[1], c2 = rp[2], c3 = rp[3]; u32x4 o;
              o.x = pk2(bflo(w.x) * c0.x - bfhi(w.x) * c0.y, bflo(w.x) * c0.y + bfhi(w.x) * c0.x); o.y = pk2(bflo(w.y) * c1.x - bfhi(w.y) * c1.y, bflo(w.y) * c1.y + bfhi(w.y) * c1.x);
              o.z = pk2(bflo(w.z) * c2.x - bfhi(w.z) * c2.y, bflo(w.z) * c2.y + bfhi(w.z) * c2.x); o.w = pk2(bflo(w.w) * c3.x - bfhi(w.w) * c3.y, bflo(w.w) * c3.y + bfhi(w.w) * c3.x);
              qr[s] = __builtin_bit_cast(bf16x8, o); } }
        const int kr = tid >> 3, kpart = tid & 7;
        const int pr = tid >> 2, ppart = tid & 3;
#define AT_ROW0(t) ((t) < 4 ? (size_t)NLAT + b * CTXL + (t) * 64 : (size_t)b * SEQ + ((t) - 4) * 64)
#define AT_LOAD(t) do { const size_t r0_ = AT_ROW0(t); \
        gk = *(const u32x4*)(KN + (r0_ + kr) * 512 + h * 64 + kpart * 8); \
        gv = *(const u32x4*)(VT + (size_t)(h * 64 + kr) * MTOT + r0_ + kpart * 8); \
        if (tid < 256) gp = *(const u32x4*)(KPE + (r0_ + pr) * 32 + ppart * 8); } while (0)
#define AT_STORE(bufi) do { LAS unsigned char* B_ = lds + (bufi) * AT_BUF; \
        *(LAS u32x4*)(B_ + (kr * AT_KS + kpart * 8) * 2) = gk; \
        *(LAS u32x2*)(B_ + AT_KB + (kr * AT_VS + kpart * 8) * 2) = (u32x2){gv.x, gv.y}; *(LAS u32x2*)(B_ + AT_KB + (kr * AT_VS + kpart * 8 + 4) * 2) = (u32x2){gv.z, gv.w}; \
        if (tid < 256) *(LAS u32x4*)(B_ + (pr * AT_KS + 64 + ppart * 8) * 2) = gp; } while (0)
        u32x4 gk, gv, gp = (u32x4){0u, 0u, 0u, 0u};
        AT_LOAD(0); AT_STORE(0);
        __syncthreads();
        float mrun = -INFINITY, lrun = 0.f;
        f32x16 o[2]; o[0] = zero16(); o[1] = zero16();
#pragma unroll 1
        for (int t = 0; t < 68; ++t) {
            if (t + 1 < 68) AT_LOAD(t + 1);
            const LAS unsigned char* Bc = lds + (t & 1) * AT_BUF;
            f32x16 p0 = zero16(), p1 = zero16();
#pragma unroll
            for (int s = 0; s < 6; ++s) {
                const bf16x8 k0 = *(const LAS bf16x8*)(Bc + (r32 * AT_KS + 16 * s + 8 * hi) * 2), k1 = *(const LAS bf16x8*)(Bc + ((32 + r32) * AT_KS + 16 * s + 8 * hi) * 2);
                p0 = MFMA32(k0, qr[s], p0); p1 = MFMA32(k1, qr[s], p1);
            }
            float mx = fmaxf(p0[0], p1[0]);
#pragma unroll
            for (int r = 1; r < 16; ++r) mx = fmaxf(mx, fmaxf(p0[r], p1[r]));
            mx = fmaxf(mx, __shfl_xor(mx, 32));
            if (__any(mx > mrun)) {
                const float mnew = fmaxf(mrun, mx), alpha = __builtin_amdgcn_exp2f(mrun - mnew);
                mrun = mnew; lrun *= alpha;
#pragma unroll
                for (int r = 0; r < 16; ++r) { o[0][r] *= alpha; o[1][r] *= alpha; }
            }
            float rs = 0.f;
#pragma unroll
            for (int r = 0; r < 16; ++r) { p0[r] = __builtin_amdgcn_exp2f(p0[r] - mrun); p1[r] = __builtin_amdgcn_exp2f(p1[r] - mrun); rs += p0[r] + p1[r]; }
            lrun += rs;
            bf16x8 pf[4];
            pf[0] = pack8(p0[0], p0[1], p0[2], p0[3], p0[4], p0[5], p0[6], p0[7]); pf[1] = pack8(p0[8], p0[9], p0[10], p0[11], p0[12], p0[13], p0[14], p0[15]);
            pf[2] = pack8(p1[0], p1[1], p1[2], p1[3], p1[4], p1[5], p1[6], p1[7]); pf[3] = pack8(p1[8], p1[9], p1[10], p1[11], p1[12], p1[13], p1[14], p1[15]);
#pragma unroll
            for (int db = 0; db < 2; ++db)
#pragma unroll
                for (int s = 0; s < 4; ++s) {
                    const LAS unsigned char* vp = Bc + AT_KB + ((32 * db + r32) * AT_VS + 16 * s + 4 * hi) * 2;
                    const u32x2 v0 = *(const LAS u32x2*)vp, v1 = *(const LAS u32x2*)(vp + 16);
                    o[db] = MFMA32(__builtin_bit_cast(bf16x8, (u32x4){v0.x, v0.y, v1.x, v1.y}), pf[s], o[db]);
                }
            if (t + 1 < 68) AT_STORE((t + 1) & 1);
            __syncthreads();
        }
#undef AT_ROW0
#undef AT_LOAD
#undef AT_STORE
        const float ltot = lrun + __shfl_xor(lrun, 32), rl = 1.0f / ltot;
        bf16* op = MIX + qrow * 1024 + 512 + h * 64 + 4 * hi;
#pragma unroll
        for (int db = 0; db < 2; ++db)
#pragma unroll
            for (int g4 = 0; g4 < 4; ++g4) { u32x2 w; w.x = pk2(o[db][4 * g4] * rl, o[db][4 * g4 + 1] * rl); w.y = pk2(o[db][4 * g4 + 2] * rl, o[db][4 * g4 + 3] * rl);
                *(u32x2*)(op + 32 * db + 8 * g4) = w; }
    }
}

#define XB_TMO      128
#define XB_XCNT(j)  (256  + 64 * (j))
#define XB_XSUB(j)  (1280 + 64 * (j))
#define XB_XGEN(j)  (2304 + 64 * (j))
#define XB_TOP      3328
#define XB_TOPGEN   3392
#define XCD_BAR_WORDS 3456
#define XB_SPIN_CAP (1u << 18)

__device__ __forceinline__ unsigned xb_ld(unsigned* p)              { return __hip_atomic_load(p, __ATOMIC_RELAXED, __HIP_MEMORY_SCOPE_AGENT); }
__device__ __forceinline__ unsigned xb_add(unsigned* p, unsigned v) { return __hip_atomic_fetch_add(p, v, __ATOMIC_RELAXED, __HIP_MEMORY_SCOPE_AGENT); }
__device__ __forceinline__ unsigned xb_xcc_id() { return (unsigned)__builtin_amdgcn_s_getreg((3 << 11) | 20) & 0xFu; }
#define XB_SPIN(cond, bar) do { unsigned _sp = 0; while (cond) { __builtin_amdgcn_s_sleep(1); \
    if ((++_sp & 255u) == 0u) { if (xb_ld(&(bar)[XB_TMO])) break; if (_sp > XB_SPIN_CAP) { atomicAdd(&(bar)[XB_TMO], 1u); break; } } } } while (0)

struct XcdBarrier {
    unsigned* bar; unsigned x;
    volatile LAS unsigned* st;
};

__device__ __forceinline__ XcdBarrier xcd_barrier_post(unsigned* bar, volatile LAS unsigned* st) {
    XcdBarrier b; b.bar = bar; b.x = xb_xcc_id(); b.st = st;
    if (threadIdx.x == 0) (void)xb_add(&bar[XB_XCNT(b.x)], 1u);
    return b;
}
__device__ __forceinline__ void xcd_barrier_complete(unsigned* bar, unsigned x, unsigned& nloc, unsigned& nx) {
    const unsigned G = gridDim.x * gridDim.y * gridDim.z;
    unsigned sum, cnt, mine, sp = 0u;
    for (;;) {
        sum = 0u; cnt = 0u; mine = 0u;
#pragma unroll
        for (unsigned j = 0; j < 16; ++j) { const unsigned c = xb_ld(&bar[XB_XCNT(j)]); sum += c; cnt += (c > 0u) ? 1u : 0u; mine = (j == x) ? c : mine; }
        if (sum == G) break;
        __builtin_amdgcn_s_sleep(1);
        if ((++sp & 255u) == 0u) { if (xb_ld(&bar[XB_TMO])) break; if (sp > XB_SPIN_CAP) { atomicAdd(&bar[XB_TMO], 1u); break; } }
    }
    nloc = mine > 0u ? mine : 1u; nx = cnt > 0u ? cnt : 1u;
}

__device__ __forceinline__ void xcd_barrier(const XcdBarrier& b) {
    asm volatile("s_waitcnt vmcnt(0)" ::: "memory");
    __syncthreads();
    if (threadIdx.x == 0) {
        unsigned* bar = b.bar;
        __builtin_amdgcn_s_waitcnt(0);
        unsigned nloc = b.st[0], nx = b.st[1];
        if (nloc == 0u) { xcd_barrier_complete(bar, b.x, nloc, nx); b.st[0] = nloc; b.st[1] = nx; }
        const unsigned old = xb_add(&bar[XB_XSUB(b.x)], 1u);
        const unsigned gen = old / nloc;
        if (old + 1u == (gen + 1u) * nloc) {
            __builtin_amdgcn_fence(__ATOMIC_RELEASE, "agent");
            asm volatile("s_waitcnt vmcnt(0)" ::: "memory");
            const unsigned og = xb_add(&bar[XB_TOP], 1u);
            const unsigned tg = og / nx;
            if (og + 1u == (tg + 1u) * nx) xb_add(&bar[XB_TOPGEN], 1u);
            else XB_SPIN(xb_ld(&bar[XB_TOPGEN]) == tg, bar);
            __builtin_amdgcn_fence(__ATOMIC_ACQUIRE, "agent");
            xb_add(&bar[XB_XGEN(b.x)], 1u);
            asm volatile("s_waitcnt vmcnt(0)" ::: "memory");
        } else {
            XB_SPIN(xb_ld(&bar[XB_XGEN(b.x)]) == gen, bar);
            __builtin_amdgcn_fence(__ATOMIC_ACQUIRE, "agent");
            asm volatile("s_waitcnt vmcnt(0)" ::: "memory");
        }
    }
    __syncthreads();
}

__global__ void __launch_bounds__(512, 2) hymba_fwd(Args args) {
    extern __shared__ __attribute__((aligned(16))) unsigned char lds_raw[];
    LAS unsigned char* lds = (LAS unsigned char*)lds_raw;
    cg::grid_group grid = cg::this_grid();
    const int tid = threadIdx.x, lane = tid & 63, wave = __builtin_amdgcn_readfirstlane(tid >> 6);
    const int G = gridDim.x, bx = blockIdx.x, vcu = (G % 8 == 0) ? (bx % 8) * (G / 8) + bx / 8 : bx;
    const int gw = bx * 8 + wave, NGW = G * 8;
    unsigned char* ws = args.ws;
    const int lo = args.ph_lo, hi = args.ph_hi;
    const float* MOD = (const float*)(ws + WS_MOD);
    volatile LAS unsigned* bst = (volatile LAS unsigned*)(lds + LDS_BST);
    if (tid < 2) bst[tid] = 0u;
    __syncthreads();
    const XcdBarrier xbar = xcd_barrier_post((unsigned*)(ws + WS_BAR), bst);
    bf16* XN = (bf16*)(ws + WS_A); bf16* HB = (bf16*)(ws + WS_B); float* X1 = (float*)(ws + WS_C);
#ifndef PHMASK
#define PHMASK 0xFFFF
#endif
#define IN(k) (((PHMASK >> (k)) & 1) && lo <= (k) && (k) < hi)
#define GSYNC(k) do { xcd_barrier(xbar); } while (0)
#define SEAM(k) do { if (IN(k) && IN((k) + 1)) GSYNC(k); } while (0)
#define PH_BEGIN(k) if (IN(k)) for (int rep_ = 0; rep_ < ((k) == PROBE_PHASE ? 2 : 1); ++rep_) { if (rep_) xcd_barrier(xbar);
#define PH_END(k) } SEAM(k)
    if (args.ph_lo < 0) grid.sync();
    if (PROBE_PHASE == 200) { for (int r3 = 0; r3 < 16; ++r3) xcd_barrier(xbar); }
    PH_BEGIN(0) { phase0(args, lds, gw, NGW, tid, lane, wave); } PH_END(0);
    PH_BEGIN(1) { norm_rows(args.in[0], args.in[2], MTOT, args.in[6], MOD, 0, XN, gw, NGW, lane); } PH_END(1);
    PH_BEGIN(2) { pg8::Gemm g{XN, (const bf16*)(ws + WS_W1A), MTOT, 2 * DFF, D}; pg8::StaticOrder S; S.init(MTOT, 2 * DFF, G, bx);
        pg8::EpiSwiglu E{HB, DFF}; pg8::gemm_phase<pg8::EpiSwiglu, pg8::StaticOrder, true, true>(lds, g, S, E); } PH_END(2);
    PH_BEGIN(3) {
        { pg8::Gemm g{HB, (const bf16*)(ws + WS_W1B), NLAT, D, DFF}; pg8::StaticOrder S; S.init(NLAT, D, G, bx);
          pg8::EpiRes E{args.in[0], args.in[2], X1, MOD, 2, 0.5f}; pg8::gemm_phase<pg8::EpiRes, pg8::StaticOrder, true, true>(lds, g, S, E); }
        { pg8::Gemm g{HB, (const bf16*)(ws + WS_W1B), MTOT, D, DFF, DFF}; pg8::CtxSplitOrder S{G, (bx + G / 2) % G};
          pg8::EpiResCtx E{args.in[2], X1, (float*)args.out, MOD, 2, 0.5f}; pg8::gemm_phase<pg8::EpiResCtx, pg8::CtxSplitOrder, true, true>(lds, g, S, E); }
    } PH_END(3);
    PH_BEGIN(4) { norm_rows(X1, X1 + (size_t)NLAT * D, MTOT, args.in[9], MOD, 3, XN, gw, NGW, lane, (const float*)args.out); } PH_END(4);
    PH_BEGIN(5) { pg8::Gemm g{XN, (const bf16*)(ws + WS_WIN), MTOT, 2816, D}; pg8::StaticOrder S; S.init(MTOT, 2816, G, bx);
        pg8::EpiSplit E{(bf16*)(ws + WS_Z), (bf16*)(ws + WS_XBCR), (bf16*)(ws + WS_CQ), (bf16*)(ws + WS_CKV), (bf16*)(ws + WS_MISC)};
        pg8::gemm_phase<pg8::EpiSplit, pg8::StaticOrder, true, true>(lds, g, S, E); } PH_END(5);
    PH_BEGIN(6) { phase6(args, lds, G, bx, tid, lane, wave); } PH_END(6);
    PH_BEGIN(7) {
        unsigned char* ob = (unsigned char*)args.out;
        { pg8::Gemm g{(const bf16*)(ws + WS_CQ), (const bf16*)(ws + WS_WUQ), NLAT, 768, 768}; pg8::StaticOrder S; S.init(NLAT, 768, G, bx);
          pg8::EpiScale E{(bf16*)(ob + OUT_Q), 768, (const float*)(ws + WS_RSTDQ), nullptr}; pg8::gemm_phase<pg8::EpiScale, pg8::StaticOrder, true, true>(lds, g, S, E); }
        { pg8::Gemm g{(const bf16*)(ws + WS_CKV), (const bf16*)(ws + WS_WK), MTOT, 512, 256}; pg8::StaticOrder S; S.init(MTOT, 512, G, (bx + 128) % G);
          pg8::EpiScale E{(bf16*)(ob + OUT_KN), 512, (const float*)(ws + WS_RSTDKV), nullptr}; pg8::gemm_phase<pg8::EpiScale, pg8::StaticOrder, true, true>(lds, g, S, E); }
        { pg8::Gemm g{(const bf16*)(ws + WS_WV), (const bf16*)(ws + WS_CKV), 512, MTOT, 256}; pg8::StaticOrder S; S.init(512, MTOT, G, (bx + 112) % G);
          pg8::EpiScale E{(bf16*)(ob + OUT_VT), MTOT, nullptr, (const float*)(ws + WS_RSTDKV)}; pg8::gemm_phase<pg8::EpiScale, pg8::StaticOrder, true, true>(lds, g, S, E); }
        phase8(args, lds, G, bx, tid, lane, wave);
    } PH_END(7);
    PH_BEGIN(9) { phase9(args, G, bx, tid); } PH_END(9);
    PH_BEGIN(10) {
#ifndef NO_SSD
        for (int r2 = 0; r2 < (PROBE_PHASE == 100 ? 2 : 1); ++r2) phase10_ssd(args, lds, G, bx, tid, lane, wave);
#endif

#ifndef NO_ATTN
        for (int r2 = 0; r2 < (PROBE_PHASE == 101 ? 2 : 1); ++r2) phase10_attn(args, lds, G, vcu, tid, lane, wave);
#endif
    } PH_END(10);
    PH_BEGIN(11) { pg8::Gemm g{(const bf16*)(ws + WS_MIX), (const bf16*)(ws + WS_WOUT), NLAT, D, D}; pg8::StaticOrder S; S.init(NLAT, D, G, bx);
        pg8::EpiRes E{X1, X1, X1, MOD, 5, 1.0f}; pg8::gemm_phase<pg8::EpiRes, pg8::StaticOrder, true, true>(lds, g, S, E); } PH_END(11);
    PH_BEGIN(12) { norm_rows(X1, X1, NLAT, args.in[22], MOD, 6, XN, gw, NGW, lane); } PH_END(12);
    PH_BEGIN(13) { pg8::Gemm g{XN, (const bf16*)(ws + WS_W2A), NLAT, 2 * DFF, D}; pg8::StaticOrder S; S.init(NLAT, 2 * DFF, G, bx);
        pg8::EpiSwiglu E{HB, DFF}; pg8::gemm_phase<pg8::EpiSwiglu, pg8::StaticOrder, true, true>(lds, g, S, E); } PH_END(13);
    PH_BEGIN(14) { pg8::Gemm g{HB, (const bf16*)(ws + WS_W2B), NLAT, D, DFF}; pg8::StaticOrder S; S.init(NLAT, D, G, bx);
        pg8::EpiRes E{X1, X1, args.out, MOD, 8, 0.5f}; pg8::gemm_phase<pg8::EpiRes, pg8::StaticOrder, true, true>(lds, g, S, E); } PH_END(14);
    PH_BEGIN(15) { final_norm_rows(args.out, args.in[25], gw, NGW, lane); } PH_END(15);
#undef IN
#undef SEAM
}

#ifndef N_LAUNCHES
#define N_LAUNCHES 1
#endif
extern "C" void kernel_launch(void* const* d_in, const int* in_sizes, int n_in, void* d_out, int out_size, void* d_ws, size_t ws_size, hipStream_t stream) {
    static int grid = 0;
    if (grid == 0) {
        if (n_in != 26 || out_size != NLAT * D || ws_size < WS_END) { fprintf(stderr, "kernel_launch: unexpected shapes (n_in %d out %d ws %zu)\n", n_in, out_size, ws_size); grid = -1; return; }
        int dev = 0, cus = 0, per_cu = 0;
        (void)hipGetDevice(&dev); (void)hipDeviceGetAttribute(&cus, hipDeviceAttributeMultiprocessorCount, dev);
        if (hipFuncSetAttribute((const void*)hymba_fwd, hipFuncAttributeMaxDynamicSharedMemorySize, LDS_BYTES) != hipSuccess) { fprintf(stderr, "kernel_launch: hipFuncSetAttribute failed\n"); grid = -1; return; }
        if (hipOccupancyMaxActiveBlocksPerMultiprocessor(&per_cu, (const void*)hymba_fwd, 512, LDS_BYTES) != hipSuccess || per_cu < 1) { fprintf(stderr, "kernel_launch: occupancy query failed (%d)\n", per_cu); grid = -1; (void)hipGetLastError(); return; }
        grid = cus;
    }
    if (grid < 0) return;
    (void)hipMemsetAsync((char*)d_ws + WS_BAR, 0, 16 * KiB, stream);
    Args a{};
    for (int i = 0; i < 26; ++i) a.in[i] = (const float*)d_in[i];
    a.out = (float*)d_out; a.ws = (unsigned char*)d_ws;
    for (int li = 0; li < N_LAUNCHES; ++li) {
        a.ph_lo = (N_LAUNCHES == 1) ? 0 : li; a.ph_hi = (N_LAUNCHES == 1) ? NPHASE : li + 1;
        void* kargs[] = {&a};
        hipError_t e = hipLaunchCooperativeKernel((const void*)hymba_fwd, dim3(grid), dim3(512), kargs, LDS_BYTES, stream);
        if (e != hipSuccess) { fprintf(stderr, "kernel_launch: cooperative launch %d failed: %s (grid %d)\n", li, hipGetErrorString(e), grid); break; }
    }
}
```

```cpp
#include <hip/hip_runtime.h>
#include <hip/hip_cooperative_groups.h>
#include <cstdio>
#include <cstdint>
namespace cg = cooperative_groups;
namespace pg8 {
#define PG8_LAS __attribute__((address_space(3)))
typedef unsigned short bf16_t;
typedef short bf16x8 __attribute__((ext_vector_type(8)));
typedef float f32x4 __attribute__((ext_vector_type(4)));
typedef unsigned u32x4 __attribute__((ext_vector_type(4)));
constexpr int BM = 256, BK = 64, HALF = 128, HTB = HALF * BK * 2  , STAGE_BYTES = 8 * HTB, NXCD = 8, WGM = 8;

__host__ __device__ __forceinline__ int lds_byte(int r, int c) { const int st = (r >> 4) * 2 + (c >> 5), rr = r & 15, cc = c & 31, ob = rr * 64 + cc * 2; return st * 1024 + (ob ^ (((ob >> 9) & 1) << 5)); }
__host__ __device__ __forceinline__ void stage_rc(int b, int& R, int& C) { const int st = b / 1024, sb = b % 1024, swz = sb ^ (((sb >> 9) & 1) << 5); R = (st >> 1) * 16 + swz / 64; C = (st & 1) * 32 + (swz % 64) / 2; }
__host__ __device__ __forceinline__ int perm32(int rho) { const int n = rho >> 4, i = rho & 15; return 8 * (i >> 2) + 4 * n + (i & 3); }

struct Unit { int pm, pn, ks; };
struct Gemm { const bf16_t* A; const bf16_t* Bt; int M, N, K; int ld; };

struct StaticOrder {
    int nM, nN, nwg, G, c;
    __host__ __device__ void init(int M, int N, int G_, int c_) { nM = M / BM; nN = N / BM; nwg = nM * nN; G = G_; c = c_; }
    __host__ __device__ bool next(int i, Unit& u) const {
        const long L = (long)i * G + c; if (L >= nwg) return false;
        int wgid = (int)L; { const int q = nwg / NXCD, r = nwg % NXCD, xcd = wgid % NXCD, off = wgid / NXCD; wgid = (xcd < r ? xcd * (q + 1) : r * (q + 1) + (xcd - r) * q) + off; }
        const int nig = WGM * nN, gid = wgid / nig, fm = gid * WGM, gsz = (nM - fm) < WGM ? (nM - fm) : WGM;
        u.pm = fm + ((wgid % nig) % gsz); u.pn = (wgid % nig) / gsz; u.ks = 0; return true;
    }
    __device__ __forceinline__ size_t koff(const Unit&) const { return 0; }
    __device__ __forceinline__ int ntiles(const Unit&, int nt) const { return nt; }
    __device__ __forceinline__ void a_ready(const Unit&) const {}
    __device__ __forceinline__ void done(const Unit&) const {}
};

__device__ __forceinline__ unsigned cvt_pk_bf16(float lo, float hi) { unsigned r; asm volatile("v_cvt_pk_bf16_f32 %0, %1, %2" : "=v"(r) : "v"(lo), "v"(hi)); return r; }
typedef float f32x2 __attribute__((ext_vector_type(2)));
__device__ __forceinline__ f32x2 gelu_pk(f32x2 v) {
    const f32x2 av = __builtin_elementwise_abs(v), d = av * 0.2316418882f + 1.0f;
    f32x2 t; t.x = __builtin_amdgcn_rcpf(d.x); t.y = __builtin_amdgcn_rcpf(d.y);
    f32x2 q = t * 0.5307027145f + (-0.7265760135f); q = q * t + 0.7107068705f; q = q * t + (-0.142248368f); q = q * t + 0.127414796f; q = q * t;
    const f32x2 s = (v * v) * (-0.72134752044f);
    f32x2 e; e.x = __builtin_amdgcn_exp2f(s.x); e.y = __builtin_amdgcn_exp2f(s.y);
    const f32x2 m = v * (q * e), r = v - m;
    f32x2 o; o.x = v.x < 0.f ? m.x : r.x; o.y = v.y < 0.f ? m.y : r.y; return o;
}

template <int ACT  > struct EpiBf16 {
    static constexpr bool PERM = true, AFTER_DRAIN = false; static_assert(ACT == 0 || ACT == 1, "EpiBf16: ACT is 0 (none) or 1 (gelu_pk)");
    bf16_t* O; int ldc; const float* bias; int split_cols; size_t split_stride; float scale0;
    __device__ __forceinline__ void operator()(const f32x4 (&acc)[2][2][4][2], const Unit& u, int wr, int wc, int fr, int fq) const {
        const int row0 = u.pm * BM + wr * 64 + fr; int colt = u.pn * BM; bf16_t* base = O;
        float sc = 1.f; if (split_cols) { const int t = colt / split_cols; base += (size_t)t * split_stride; colt -= t * split_cols; if (t == 0) sc = scale0; }
        const int col0 = colt + wc * 32 + 8 * fq, bcol0 = u.pn * BM + wc * 32 + 8 * fq;
        f32x4 bv[2][2];
#pragma unroll
        for (int bj = 0; bj < 2; ++bj)
#pragma unroll
            for (int n = 0; n < 2; ++n) bv[bj][n] = bias ? *(const f32x4*)(bias + bcol0 + bj * HALF + 4 * n) : (f32x4){0.f, 0.f, 0.f, 0.f};
#pragma unroll
        for (int ai = 0; ai < 2; ++ai)
#pragma unroll
            for (int m = 0; m < 4; ++m) { bf16_t* rowp = base + (size_t)(row0 + ai * HALF + m * 16) * ldc + col0;
#pragma unroll
                for (int bj = 0; bj < 2; ++bj) { f32x4 v0 = acc[ai][bj][m][0] + bv[bj][0], v1 = acc[ai][bj][m][1] + bv[bj][1];
                    if (ACT == 1) { f32x2 a = gelu_pk((f32x2){v0[0], v0[1]}), b = gelu_pk((f32x2){v0[2], v0[3]}), c = gelu_pk((f32x2){v1[0], v1[1]}), d = gelu_pk((f32x2){v1[2], v1[3]});
                        v0 = (f32x4){a.x, a.y, b.x, b.y}; v1 = (f32x4){c.x, c.y, d.x, d.y}; }
                    v0 = v0 * sc; v1 = v1 * sc; u32x4 w; w.x = cvt_pk_bf16(v0[0], v0[1]); w.y = cvt_pk_bf16(v0[2], v0[3]); w.z = cvt_pk_bf16(v1[0], v1[1]); w.w = cvt_pk_bf16(v1[2], v1[3]);
                    *(u32x4*)(rowp + bj * HALF) = w; } }
    }
};
template <class Epi, class Sched, bool ALIGN_EPI = false, bool SP2 = false>
__device__ __forceinline__ void gemm_phase(PG8_LAS unsigned char* lds, const Gemm g, const Sched& S, const Epi& E) {
    const int tid = threadIdx.x, wid = __builtin_amdgcn_readfirstlane(tid >> 6), lane = tid & 63, wr = wid >> 2, wc = wid & 3, fr = lane & 15, fq = lane >> 4;
    const int K = g.K, LD = g.ld ? g.ld : g.K; int nt = K / BK;
    unsigned voffA[2], voffB[2];
#pragma unroll
    for (int i = 0; i < 2; ++i) { int R, C; stage_rc(tid * 16 + i * 8192, R, C); const int Rb = Epi::PERM ? ((R & ~31) + perm32(R & 31)) : R;
        voffA[i] = (unsigned)(R * LD + C) * 2u; voffB[i] = (unsigned)(Rb * LD + C) * 2u; }
    const size_t kstep = (size_t)(BK * 2);
    const size_t hstep = (size_t)HALF * LD * 2;
    const size_t tstep = 2 * hstep;
    const unsigned ldsw = (unsigned)wid * 1024u;
    const int aoff = lds_byte(wr * 64 + fr, fq * 8), boff = lds_byte(wc * 32 + fr, fq * 8);
#define PG8_SA(b, h) (((b) * 2 + (h)) * HTB)
#define PG8_SB(b, h) ((4 + (b) * 2 + (h)) * HTB)
#define PG8_STAGE(bufoff, gbase, voff) do { _Pragma("unroll") for (int _i = 0; _i < 2; ++_i) \
        __builtin_amdgcn_global_load_lds((const unsigned*)((const char*)(gbase) + (voff)[_i]), (PG8_LAS unsigned*)(lds + (bufoff) + ldsw + _i * 8192), 16, 0, 0); } while (0)
#define PG8_LDA(dst, b, h) do { _Pragma("unroll") for (int m = 0; m < 4; ++m) _Pragma("unroll") for (int k = 0; k < 2; ++k) dst[m][k] = *(const PG8_LAS bf16x8*)(lds + PG8_SA(b, h) + aoff + m * 2048 + k * 1024); } while (0)
#define PG8_LDB(dst, b, h) do { _Pragma("unroll") for (int n = 0; n < 2; ++n) _Pragma("unroll") for (int k = 0; k < 2; ++k) dst[n][k] = *(const PG8_LAS bf16x8*)(lds + PG8_SB(b, h) + boff + n * 2048 + k * 1024); } while (0)
#define PG8_MMA(ai, bj, At, Bt) do { __builtin_amdgcn_s_setprio(1); _Pragma("unroll") for (int m = 0; m < 4; ++m) _Pragma("unroll") for (int n = 0; n < 2; ++n) _Pragma("unroll") for (int k = 0; k < 2; ++k) \
        acc[ai][bj][m][n] = __builtin_amdgcn_mfma_f32_16x16x32_bf16(Bt[n][k], At[m][k], acc[ai][bj][m][n], 0, 0, 0); __builtin_amdgcn_s_setprio(0); } while (0)
#define PG8_WAIT_V(n) asm volatile("s_waitcnt vmcnt(" #n ")" ::: "memory")
#define PG8_WAIT_L(n) asm volatile("s_waitcnt lgkmcnt(" #n ")" ::: "memory")
#define PG8_BAR __builtin_amdgcn_s_barrier()
#define PG8_SCHED __builtin_amdgcn_sched_barrier(0)
    Unit cur, nxt; int ui = 0;
    if (!S.next(0, cur)) return;
    f32x4 acc[2][2][4][2];
#pragma unroll
    for (int a = 0; a < 2; ++a)
#pragma unroll
        for (int b = 0; b < 2; ++b)
#pragma unroll
            for (int m = 0; m < 4; ++m)
#pragma unroll
                for (int n = 0; n < 2; ++n) acc[a][b][m][n] = (f32x4){0.f, 0.f, 0.f, 0.f};
    bf16x8 At[4][2], B0[2][2], B1[2][2];
    const char* cA = (const char*)g.A + (size_t)cur.pm * tstep + S.koff(cur); const char* cB = (const char*)g.Bt + (size_t)cur.pn * tstep + S.koff(cur);
    S.a_ready(cur);
    if constexpr (SP2) {
        PG8_STAGE(PG8_SB(0, 0), cB, voffB); PG8_STAGE(PG8_SB(0, 1), cB + hstep, voffB); PG8_STAGE(PG8_SA(0, 0), cA, voffA); PG8_STAGE(PG8_SA(0, 1), cA + hstep, voffA);
        if (wr == 1) PG8_BAR;
        PG8_WAIT_V(2); PG8_BAR;
        PG8_STAGE(PG8_SB(1, 0), cB + kstep, voffB); PG8_STAGE(PG8_SA(1, 0), cA + kstep, voffA); PG8_STAGE(PG8_SB(1, 1), cB + hstep + kstep, voffB);
        PG8_WAIT_V(6); PG8_BAR;
    } else {
        PG8_STAGE(PG8_SB(0, 0), cB, voffB); PG8_STAGE(PG8_SA(0, 0), cA, voffA); PG8_STAGE(PG8_SB(0, 1), cB + hstep, voffB); PG8_STAGE(PG8_SA(0, 1), cA + hstep, voffA);
        if (wr == 1) PG8_BAR;
        PG8_WAIT_V(4); PG8_BAR;
        PG8_STAGE(PG8_SB(1, 0), cB + kstep, voffB); PG8_STAGE(PG8_SA(1, 0), cA + kstep, voffA); PG8_STAGE(PG8_SB(1, 1), cB + hstep + kstep, voffB);
        PG8_WAIT_V(6); PG8_BAR;
    }
    for (;;) {
        const bool has_next = S.next(ui + 1, nxt);
        const char* nA = has_next ? (const char*)g.A + (size_t)nxt.pm * tstep + S.koff(nxt) : cA; const char* nB = has_next ? (const char*)g.Bt + (size_t)nxt.pn * tstep + S.koff(nxt) : cB;
        nt = S.ntiles(cur, K / BK);
        for (int t = 0; t < nt; t += 2) {
            const bool last = (t == nt - 2);
            const char* a1 = cA + (size_t)(t + 1) * kstep;
            const char* a2 = last ? nA : cA + (size_t)(t + 2) * kstep; const char* b2 = last ? nB : cB + (size_t)(t + 2) * kstep;
            const char* a3 = a2 + kstep; const char* b3 = b2 + kstep;
            if (last && has_next) S.a_ready(nxt);
            if constexpr (SP2) {
            PG8_LDB(B0, 0, 0); PG8_LDB(B1, 0, 1); PG8_SCHED; PG8_LDA(At, 0, 0); PG8_STAGE(PG8_SA(1, 1), a1 + hstep, voffA);
            PG8_WAIT_V(8); PG8_WAIT_L(0); PG8_BAR; PG8_MMA(0, 0, At, B0); PG8_MMA(0, 1, At, B1); PG8_BAR; PG8_SCHED;
            PG8_LDA(At, 0, 1); PG8_STAGE(PG8_SB(0, 0), b2, voffB); PG8_STAGE(PG8_SB(0, 1), b2 + hstep, voffB); PG8_STAGE(PG8_SA(0, 0), a2, voffA);
            PG8_WAIT_V(8); PG8_WAIT_L(0); PG8_BAR; PG8_MMA(1, 0, At, B0); PG8_MMA(1, 1, At, B1); PG8_BAR; PG8_SCHED;
            PG8_LDB(B0, 1, 0); PG8_LDB(B1, 1, 1); PG8_SCHED; PG8_LDA(At, 1, 0); PG8_STAGE(PG8_SA(0, 1), a2 + hstep, voffA);
            PG8_WAIT_V(8); PG8_WAIT_L(0); PG8_BAR; PG8_MMA(0, 0, At, B0); PG8_MMA(0, 1, At, B1); PG8_BAR; PG8_SCHED;
            PG8_LDA(At, 1, 1); PG8_STAGE(PG8_SB(1, 0), b3, voffB); PG8_STAGE(PG8_SB(1, 1), b3 + hstep, voffB); PG8_STAGE(PG8_SA(1, 0), a3, voffA);
            PG8_WAIT_V(8); PG8_WAIT_L(0); PG8_BAR; PG8_MMA(1, 0, At, B0); PG8_MMA(1, 1, At, B1); PG8_BAR; PG8_SCHED;
            } else {
            PG8_LDB(B0, 0, 0); PG8_SCHED; PG8_LDA(At, 0, 0); PG8_STAGE(PG8_SA(1, 1), a1 + hstep, voffA);
            PG8_WAIT_L(8); PG8_BAR; PG8_WAIT_L(0); PG8_MMA(0, 0, At, B0); PG8_BAR; PG8_SCHED;
            PG8_LDB(B1, 0, 1); PG8_STAGE(PG8_SB(0, 0), b2, voffB);
            PG8_BAR; PG8_WAIT_L(0); PG8_MMA(0, 1, At, B1); PG8_BAR;
            PG8_LDA(At, 0, 1); PG8_STAGE(PG8_SA(0, 0), a2, voffA);
            PG8_BAR; PG8_WAIT_L(0); PG8_MMA(1, 0, At, B0); PG8_BAR; PG8_SCHED;
            PG8_STAGE(PG8_SB(0, 1), b2 + hstep, voffB);
            PG8_WAIT_V(6); PG8_BAR; PG8_MMA(1, 1, At, B1); PG8_BAR;
            PG8_LDB(B0, 1, 0); PG8_SCHED; PG8_LDA(At, 1, 0); PG8_STAGE(PG8_SA(0, 1), a2 + hstep, voffA);
            PG8_WAIT_L(8); PG8_BAR; PG8_WAIT_L(0); PG8_MMA(0, 0, At, B0); PG8_BAR; PG8_SCHED;
            PG8_LDB(B1, 1, 1); PG8_STAGE(PG8_SB(1, 0), b3, voffB);
            PG8_BAR; PG8_WAIT_L(0); PG8_MMA(0, 1, At, B1); PG8_BAR;
            PG8_LDA(At, 1, 1); PG8_STAGE(PG8_SA(1, 0), a3, voffA);
            PG8_BAR; PG8_WAIT_L(0); PG8_MMA(1, 0, At, B0); PG8_BAR; PG8_SCHED;
            PG8_STAGE(PG8_SB(1, 1), b3 + hstep, voffB);
            PG8_WAIT_V(6); PG8_BAR; PG8_MMA(1, 1, At, B1); PG8_BAR;
            }
        }
        if constexpr (ALIGN_EPI) { if (wr == 0) PG8_BAR; }
        if constexpr (!Epi::AFTER_DRAIN) { E(acc, cur, wr, wc, fr, fq); S.done(cur); }
        if (!has_next) break;
#pragma unroll
        for (int a = 0; a < 2; ++a)
#pragma unroll
            for (int b = 0; b < 2; ++b)
#pragma unroll
                for (int m = 0; m < 4; ++m)
#pragma unroll
                    for (int n = 0; n < 2; ++n) acc[a][b][m][n] = (f32x4){0.f, 0.f, 0.f, 0.f};
        cur = nxt; cA = nA; cB = nB; ++ui;
        if constexpr (ALIGN_EPI) { if (wr == 1) PG8_BAR; }
    }
    PG8_WAIT_V(0);
    if constexpr (!ALIGN_EPI) { if (wr == 0) PG8_BAR; }
    PG8_BAR;
    if constexpr (Epi::AFTER_DRAIN) { E.fused(acc, cur, wr, wc, fr, fq, lds, wid, lane); S.done(cur); }
#undef PG8_SA
#undef PG8_SB
#undef PG8_STAGE
#undef PG8_LDA
#undef PG8_LDB
#undef PG8_MMA
#undef PG8_WAIT_V
#undef PG8_WAIT_L
#undef PG8_BAR
#undef PG8_SCHED
}
}
#ifndef PROBE_PHASE
#define PROBE_PHASE -1
#endif

#define LAS __attribute__((address_space(3)))
typedef unsigned short bf16;
typedef short bf16x8 __attribute__((ext_vector_type(8)));
typedef float f32x2 __attribute__((ext_vector_type(2)));
typedef float f32x4 __attribute__((ext_vector_type(4)));
typedef float f32x16 __attribute__((ext_vector_type(16)));
typedef unsigned u32x2 __attribute__((ext_vector_type(2)));
typedef unsigned u32x4 __attribute__((ext_vector_type(4)));
typedef __bf16 bf16x2_t __attribute__((ext_vector_type(2)));

constexpr int D = 1024, NB = 8, SEQ = 4096, CTXL = 256, NLAT = NB * SEQ, NCTX = NB * CTXL, MTOT = NLAT + NCTX;
constexpr int DFF = 2816, UL = SEQ + CTXL, NCH = UL / 128;
constexpr float EPS = 1e-6f;
constexpr float QSCALE = 0.10206207261596575f * 1.4426950408889634f;
constexpr int NPHASE = 16;

constexpr size_t MiB = (size_t)1 << 20, KiB = 1024;
constexpr size_t WS_BAR = 1 * MiB, WS_ZERO_BYTES = 1 * MiB + 16 * KiB;
constexpr size_t WS_MOD = 0, WS_ROPE = 384 * KiB, WS_CD = 448 * KiB, WS_RSTDQ = 512 * KiB, WS_RSTDKV = 768 * KiB;
constexpr size_t WS_W1A = 2 * MiB, WS_W1B = 13 * MiB, WS_WIN = 18 * MiB + 512 * KiB, WS_WUQ = 24 * MiB, WS_WK = 25 * MiB + 512 * KiB, WS_WV = 25 * MiB + 768 * KiB,
                 WS_WOUT = 26 * MiB, WS_W2A = 28 * MiB, WS_W2B = 39 * MiB;
constexpr size_t WS_A = 45 * MiB;
constexpr size_t WS_B = 113 * MiB;
constexpr size_t WS_Z = WS_B, WS_XBCR = WS_B + 34 * MiB, WS_CQ = WS_B + 102 * MiB, WS_CKV = WS_B + 153 * MiB, WS_MISC = WS_B + 170 * MiB;
constexpr size_t WS_ST = WS_XBCR, WS_MIX = WS_XBCR, WS_HE = WS_CQ;
constexpr size_t WS_C = 300 * MiB;
constexpr size_t WS_XT = 436 * MiB, WS_BT = 470 * MiB, WS_CROW = 487 * MiB, WS_DT = 504 * MiB, WS_KPE = 506 * MiB + 256 * KiB, WS_END = 512 * MiB;
constexpr size_t WS_BROW = WS_A;
constexpr size_t OUT_Q = 0, OUT_KN = 48 * MiB, OUT_VT = 82 * MiB;
constexpr int LDS_BYTES = 163840, LDS_BST = LDS_BYTES - 64;

__device__ __forceinline__ unsigned pk2(float lo, float hi) { f32x2 v = {lo, hi}; bf16x2_t b = __builtin_convertvector(v, bf16x2_t); return __builtin_bit_cast(unsigned, b); }
__device__ __forceinline__ float bflo(unsigned w) { return __uint_as_float(w << 16); }
__device__ __forceinline__ float bfhi(unsigned w) { return __uint_as_float(w & 0xffff0000u); }
__device__ __forceinline__ float bf2f(bf16 u) { return __uint_as_float((unsigned)u << 16); }
__device__ __forceinline__ float silu_f(float x) { return x * __builtin_amdgcn_rcpf(1.f + __builtin_amdgcn_exp2f(-1.4426950408889634f * x)); }
__device__ __forceinline__ float wave_sum(float v) {
#pragma unroll
    for (int o = 1; o < 64; o <<= 1) v += __shfl_xor(v, o);
    return v;
}
__device__ __forceinline__ float incl_scan(float v, int lane) {
#pragma unroll
    for (int o = 1; o < 64; o <<= 1) { float t = __shfl_up(v, o); if (lane >= o) v += t; }
    return v;
}
#define LDS_FENCE() asm volatile("s_waitcnt lgkmcnt(0)" ::: "memory")
__device__ __forceinline__ int crow(int r, int hi) { return (r & 3) + 8 * (r >> 2) + 4 * hi; }
__device__ __forceinline__ bf16x8 pack8(float a0, float a1, float a2, float a3, float a4, float a5, float a6, float a7) {
    u32x4 w; w.x = pk2(a0, a1); w.y = pk2(a2, a3); w.z = pk2(a4, a5); w.w = pk2(a6, a7); return __builtin_bit_cast(bf16x8, w);
}

struct Args { const float* in[26]; float* out; unsigned char* ws; int ph_lo, ph_hi; };

namespace pg8 {
typedef unsigned u32x2 __attribute__((ext_vector_type(2)));
struct EpiSwiglu {
    static constexpr bool PERM = true, AFTER_DRAIN = false;
    bf16_t* O; int ldc;
    __device__ __forceinline__ void operator()(const f32x4 (&acc)[2][2][4][2], const Unit& u, int wr, int wc, int fr, int fq) const {
        const int row0 = u.pm * BM + wr * 64 + fr, col0 = u.pn * HALF + wc * 32 + 8 * fq;
#pragma unroll
        for (int ai = 0; ai < 2; ++ai)
#pragma unroll
            for (int m = 0; m < 4; ++m) {
                bf16_t* rowp = O + (size_t)(row0 + ai * HALF + m * 16) * ldc + col0;
                const f32x4 g0 = acc[ai][0][m][0], g1 = acc[ai][0][m][1], u0 = acc[ai][1][m][0], u1 = acc[ai][1][m][1];
                u32x4 w;
                w.x = cvt_pk_bf16(silu_f(g0[0]) * u0[0], silu_f(g0[1]) * u0[1]); w.y = cvt_pk_bf16(silu_f(g0[2]) * u0[2], silu_f(g0[3]) * u0[3]);
                w.z = cvt_pk_bf16(silu_f(g1[0]) * u1[0], silu_f(g1[1]) * u1[1]); w.w = cvt_pk_bf16(silu_f(g1[2]) * u1[2], silu_f(g1[3]) * u1[3]);
                *(u32x4*)rowp = w;
            }
    }
};
template <bool BASE_BF16, bool OUT_BF16> struct EpiRes {
    static constexpr bool PERM = true, AFTER_DRAIN = false;
    const void* base_lat; const void* base_ctx; void* out; const float* mod; int kg; float mul;
    __device__ __forceinline__ void ldb(int r, int coff, f32x4& lo, f32x4& hi) const {
        const size_t off = (r < NLAT ? (size_t)r : (size_t)(r - NLAT)) * D + coff; const void* bsel = r < NLAT ? base_lat : base_ctx;
        constexpr bool NT = BASE_BF16 != OUT_BF16;
        if (BASE_BF16) { const u32x4 w = NT ? __builtin_nontemporal_load((const u32x4*)((const bf16_t*)bsel + off)) : *(const u32x4*)((const bf16_t*)bsel + off);
            lo = (f32x4){bflo(w.x), bfhi(w.x), bflo(w.y), bfhi(w.y)}; hi = (f32x4){bflo(w.z), bfhi(w.z), bflo(w.w), bfhi(w.w)}; }
        else { lo = NT ? __builtin_nontemporal_load((const f32x4*)((const float*)bsel + off)) : *(const f32x4*)((const float*)bsel + off);
               hi = NT ? __builtin_nontemporal_load((const f32x4*)((const float*)bsel + off + 4)) : *(const f32x4*)((const float*)bsel + off + 4); }
    }
    __device__ __forceinline__ void operator()(const f32x4 (&acc)[2][2][4][2], const Unit& u, int wr, int wc, int fr, int fq) const {
        const int row0 = u.pm * BM + wr * 64 + fr, col0 = u.pn * BM + wc * 32 + 8 * fq;
        const int bb = u.pm < (NLAT / BM) ? u.pm / (SEQ / BM) : 8;
        const float* gp = mod + bb * 9216 + kg * 1024 + col0;
        f32x4 gv[2][2];
#pragma unroll
        for (int bj = 0; bj < 2; ++bj)
#pragma unroll
            for (int n = 0; n < 2; ++n) gv[bj][n] = *(const f32x4*)(gp + bj * HALF + 4 * n) * mul;
        f32x4 cur[2][2], nxt[2][2];
#pragma unroll
        for (int bj = 0; bj < 2; ++bj) ldb(row0, col0 + bj * HALF, cur[bj][0], cur[bj][1]);
#pragma unroll
        for (int gi = 0; gi < 8; ++gi) {
            const int ai = gi >> 2, m = gi & 3;
            if (gi + 1 < 8) { const int r = row0 + ((gi + 1) >> 2) * HALF + ((gi + 1) & 3) * 16;
#pragma unroll
                for (int bj = 0; bj < 2; ++bj) ldb(r, col0 + bj * HALF, nxt[bj][0], nxt[bj][1]); }
            const size_t ooff = (size_t)(row0 + ai * HALF + m * 16) * D + col0;
#pragma unroll
            for (int bj = 0; bj < 2; ++bj) {
                const f32x4 o0 = cur[bj][0] + gv[bj][0] * acc[ai][bj][m][0], o1 = cur[bj][1] + gv[bj][1] * acc[ai][bj][m][1];
                cur[bj][0] = nxt[bj][0]; cur[bj][1] = nxt[bj][1];
                if (OUT_BF16) { u32x4 w; w.x = cvt_pk_bf16(o0[0], o0[1]); w.y = cvt_pk_bf16(o0[2], o0[3]); w.z = cvt_pk_bf16(o1[0], o1[1]); w.w = cvt_pk_bf16(o1[2], o1[3]); *(u32x4*)((bf16_t*)out + ooff + bj * HALF) = w; }
                else { *(f32x4*)((float*)out + ooff + bj * HALF) = o0; *(f32x4*)((float*)out + ooff + bj * HALF + 4) = o1; }
            }
        }
    }
};
struct EpiSplit {
    static constexpr bool PERM = true, AFTER_DRAIN = false;
    bf16_t *zb, *xbcr, *cq, *ckv, *misc;
    __device__ __forceinline__ void operator()(const f32x4 (&acc)[2][2][4][2], const Unit& u, int wr, int wc, int fr, int fq) const {
        const int pn = u.pn; bf16_t* base; int ld;
        if (pn < 2) { base = zb + pn * 256; ld = 512; } else if (pn < 6) { base = xbcr + (pn - 2) * 256; ld = 1024; } else if (pn < 9) { base = cq + (pn - 6) * 256; ld = 768; }
        else if (pn == 9) { base = ckv; ld = 256; } else { base = misc; ld = 256; }
        const int row0 = u.pm * BM + wr * 64 + fr, col0 = wc * 32 + 8 * fq;
#pragma unroll
        for (int ai = 0; ai < 2; ++ai)
#pragma unroll
            for (int m = 0; m < 4; ++m) {
                bf16_t* rowp = base + (size_t)(row0 + ai * HALF + m * 16) * ld + col0;
#pragma unroll
                for (int bj = 0; bj < 2; ++bj) { const f32x4 v0 = acc[ai][bj][m][0], v1 = acc[ai][bj][m][1];
                    u32x4 w; w.x = cvt_pk_bf16(v0[0], v0[1]); w.y = cvt_pk_bf16(v0[2], v0[3]); w.z = cvt_pk_bf16(v1[0], v1[1]); w.w = cvt_pk_bf16(v1[2], v1[3]);
                    *(u32x4*)(rowp + bj * HALF) = w; }
            }
    }
};
struct EpiScale {
    static constexpr bool PERM = true, AFTER_DRAIN = false;
    bf16_t* O; int ldc; const float* rs; const float* cs;
    __device__ __forceinline__ void operator()(const f32x4 (&acc)[2][2][4][2], const Unit& u, int wr, int wc, int fr, int fq) const {
        const int row0 = u.pm * BM + wr * 64 + fr, col0 = u.pn * BM + wc * 32 + 8 * fq;
        f32x4 cv[2][2];
#pragma unroll
        for (int bj = 0; bj < 2; ++bj)
#pragma unroll
            for (int n = 0; n < 2; ++n) cv[bj][n] = cs ? *(const f32x4*)(cs + col0 + bj * HALF + 4 * n) : (f32x4){1.f, 1.f, 1.f, 1.f};
#pragma unroll
        for (int ai = 0; ai < 2; ++ai)
#pragma unroll
            for (int m = 0; m < 4; ++m) {
                const int r = row0 + ai * HALF + m * 16; const float rv = rs ? rs[r] : 1.f;
                bf16_t* rowp = O + (size_t)r * ldc + col0;
#pragma unroll
                for (int bj = 0; bj < 2; ++bj) { const f32x4 v0 = acc[ai][bj][m][0] * cv[bj][0] * rv, v1 = acc[ai][bj][m][1] * cv[bj][1] * rv;
                    u32x4 w; w.x = cvt_pk_bf16(v0[0], v0[1]); w.y = cvt_pk_bf16(v0[2], v0[3]); w.z = cvt_pk_bf16(v1[0], v1[1]); w.w = cvt_pk_bf16(v1[2], v1[3]);
                    *(u32x4*)(rowp + bj * HALF) = w; }
            }
    }
};
struct CtxSplitOrder {
    int G, c;
    __device__ __forceinline__ bool next(int i, Unit& u) const { const int L = i * G + c; if (L >= 128) return false; u.pm = (NLAT / BM) + (L & 7); u.pn = (L >> 3) & 3; u.ks = L >> 5; return true; }
    __device__ __forceinline__ size_t koff(const Unit& u) const { return (size_t)(u.ks < 2 ? u.ks * 768 : 1536 + (u.ks - 2) * 640) * 2; }
    __device__ __forceinline__ int ntiles(const Unit& u, int) const { return u.ks < 2 ? 12 : 10; }
    __device__ __forceinline__ void a_ready(const Unit&) const {}
    __device__ __forceinline__ void done(const Unit&) const {}
};
struct EpiResCtx {
    static constexpr bool PERM = false, AFTER_DRAIN = false;
    const float* base_ctx; bf16_t* out; float* part; const float* mod; int kg; float mul;
    __device__ __forceinline__ void operator()(const f32x4 (&acc)[2][2][4][2], const Unit& u, int wr, int wc, int fr, int fq) const {
        const int row0 = (u.pm - NLAT / BM) * BM + wr * 64 + fr, col0 = u.pn * BM + wc * 32 + 4 * fq;
        const float* gp = mod + 8 * 9216 + kg * 1024 + col0;
        f32x4 gv[2][2];
#pragma unroll
        for (int bj = 0; bj < 2; ++bj)
#pragma unroll
            for (int n = 0; n < 2; ++n) gv[bj][n] = *(const f32x4*)(gp + bj * HALF + n * 16) * mul;
#pragma unroll
        for (int ai = 0; ai < 2; ++ai)
#pragma unroll
            for (int m = 0; m < 4; ++m) {
                const int r = row0 + ai * HALF + m * 16;
                const float* bp = base_ctx + (size_t)r * D + col0;
#pragma unroll
                for (int bj = 0; bj < 2; ++bj)
#pragma unroll
                    for (int n = 0; n < 2; ++n) { f32x4 v = gv[bj][n] * acc[ai][bj][m][n];
                        if (u.ks == 0) { v += *(const f32x4*)(bp + bj * HALF + n * 16); u32x2 w; w.x = cvt_pk_bf16(v[0], v[1]); w.y = cvt_pk_bf16(v[2], v[3]);
                            *(u32x2*)(out + (size_t)(NLAT + r) * D + col0 + bj * HALF + n * 16) = w; }
                        else *(f32x4*)(part + (size_t)(u.ks - 1) * NCTX * D + (size_t)r * D + col0 + bj * HALF + n * 16) = v; }
            }
    }
};
struct EpiQ {
    static constexpr bool PERM = true, AFTER_DRAIN = false;
    bf16_t* O; const float* rs; const f32x2* rope;
    __device__ __forceinline__ void operator()(const f32x4 (&acc)[2][2][4][2], const Unit& u, int wr, int wc, int fr, int fq) const {
        const int row0 = u.pm * BM + wr * 64 + fr, col0 = u.pn * BM + wc * 32 + 8 * fq;
#pragma unroll
        for (int ai = 0; ai < 2; ++ai)
#pragma unroll
            for (int m = 0; m < 4; ++m) {
                const int r = row0 + ai * HALF + m * 16; const float rv = rs[r] * QSCALE; const int t = r & (SEQ - 1);
                bf16_t* rowp = O + (size_t)r * 768 + col0;
#pragma unroll
                for (int bj = 0; bj < 2; ++bj) {
                    f32x4 v0 = acc[ai][bj][m][0] * rv, v1 = acc[ai][bj][m][1] * rv;
                    const int cc = (col0 + bj * HALF) % 96;
                    if (cc >= 64) {
                        const int q = cc - 64, half = q >> 4, jj = (q & 15) >> 1, pos = half ? (t & 63) : (t >> 6);
                        const f32x2* rp = rope + pos * 8 + jj;
                        const f32x2 c0 = rp[0], c1 = rp[1], c2 = rp[2], c3 = rp[3];
                        f32x4 o0, o1;
                        o0[0] = v0[0] * c0.x - v0[1] * c0.y; o0[1] = v0[0] * c0.y + v0[1] * c0.x; o0[2] = v0[2] * c1.x - v0[3] * c1.y; o0[3] = v0[2] * c1.y + v0[3] * c1.x;
                        o1[0] = v1[0] * c2.x - v1[1] * c2.y; o1[1] = v1[0] * c2.y + v1[1] * c2.x; o1[2] = v1[2] * c3.x - v1[3] * c3.y; o1[3] = v1[2] * c3.y + v1[3] * c3.x;
                        v0 = o0; v1 = o1;
                    }
                    u32x4 w; w.x = cvt_pk_bf16(v0[0], v0[1]); w.y = cvt_pk_bf16(v0[2], v0[3]); w.z = cvt_pk_bf16(v1[0], v1[1]); w.w = cvt_pk_bf16(v1[2], v1[3]);
                    *(u32x4*)(rowp + bj * HALF) = w;
                }
            }
    }
};
}

__device__ __forceinline__ int cmap(int id, int n) {
    switch (id) {
    case 0: return ((n >> 7) & 1) * DFF + (n >> 8) * 128 + (n & 127);
    case 1: return n;
    case 2: {
        if (n < 1536) return n;
        if (n < 2304) return 1552 + (n - 1536);
        if (n < 2560) return 2320 + (n - 2304);
        if (n < 2592) { const int q = n - 2560, half = q >> 4, jj = (q & 15) >> 1, which = q & 1; return 2576 + half * 16 + which * 8 + jj; }
        if (n < 2608) return 1536 + (n - 2592);
        return -1; }
    case 3: { const int hh = n / 96, cc = n % 96; if (cc < 64) return hh * 96 + cc;
        const int q = cc - 64, half = q >> 4, jj = (q & 15) >> 1, which = q & 1; return hh * 96 + 64 + half * 16 + which * 8 + jj; }
    case 4: return (n >> 6) * 128 + (n & 63);
    default: return (n >> 6) * 128 + 64 + (n & 63);
    }
}
__device__ __forceinline__ void titem(const float* W, int K, int N, bf16* WT, const float* gk, LAS float* scr, int item, int nblk, int lane, int id, float mulc = 1.f) {
    const int kb = item / nblk, nb = item % nblk, k0 = 64 * kb, n0 = 32 * nb;
    const int src = cmap(id, n0 + (lane & 31));
    float tv[32];
#pragma unroll
    for (int i = 0; i < 32; ++i) { const int kk = 2 * i + (lane >> 5); tv[i] = src >= 0 ? W[(size_t)(k0 + kk) * N + src] : 0.f; }
#pragma unroll
    for (int i = 0; i < 32; ++i) { const int kk = 2 * i + (lane >> 5); float v = tv[i]; if (gk) v *= gk[k0 + kk] * mulc; scr[kk * 33 + (lane & 31)] = v; }
    LDS_FENCE();
    const int c = lane & 7;
#pragma unroll
    for (int j = 0; j < 4; ++j) { const int n = (lane >> 3) + 8 * j; const LAS float* s = scr + (8 * c) * 33 + n;
        u32x4 o; o.x = pk2(s[0 * 33], s[1 * 33]); o.y = pk2(s[2 * 33], s[3 * 33]); o.z = pk2(s[4 * 33], s[5 * 33]); o.w = pk2(s[6 * 33], s[7 * 33]);
        *(u32x4*)(WT + (size_t)(n0 + n) * K + k0 + 8 * c) = o; }
    LDS_FENCE();
}
__device__ __forceinline__ void phase0(const Args& a, LAS unsigned char* lds, int gw, int NGW, int tid, int lane, int wave) {
    unsigned char* ws = a.ws;
    LAS float* scr = (LAS float*)(lds + wave * 16384);
    if (blockIdx.x < 144) {
        float* MOD = (float*)(ws + WS_MOD);
        const float* cin = a.in[1]; const float* cctx = a.in[3]; const float* wada = a.in[4]; const float* bada = a.in[5];
        LAS float* SV = (LAS float*)lds;
        LAS float* red = (LAS float*)(lds + 36864);
        for (int o = tid; o < 9 * 1024; o += 512) SV[o] = silu_f(o < 8192 ? cin[o] : cctx[o - 8192]);
        __syncthreads();
        const int kq = lane >> 4, c4 = (lane & 15) * 4;
        const float* wp = wada + (size_t)(wave * 128 + kq) * 9216 + blockIdx.x * 64 + c4;
        f32x4 acc[9];
#pragma unroll
        for (int bb = 0; bb < 9; ++bb) acc[bb] = (f32x4){0.f, 0.f, 0.f, 0.f};
#pragma unroll 8
        for (int i = 0; i < 32; ++i) {
            const f32x4 w = *(const f32x4*)(wp + (size_t)(4 * i) * 9216);
            const int k = wave * 128 + 4 * i + kq;
#pragma unroll
            for (int bb = 0; bb < 9; ++bb) acc[bb] += w * SV[bb * 1024 + k];
        }
#pragma unroll
        for (int bb = 0; bb < 9; ++bb)
#pragma unroll
            for (int e = 0; e < 4; ++e) { float v = acc[bb][e]; v += __shfl_xor(v, 16); v += __shfl_xor(v, 32); acc[bb][e] = v; }
        if (lane < 16) {
#pragma unroll
            for (int bb = 0; bb < 9; ++bb) *(LAS f32x4*)(red + (wave * 9 + bb) * 64 + c4) = acc[bb];
        }
        __syncthreads();
        for (int o = tid; o < 576; o += 512) { float t = bada[blockIdx.x * 64 + (o & 63)];
#pragma unroll
            for (int w = 0; w < 8; ++w) t += red[w * 576 + o];
            MOD[(o >> 6) * 9216 + blockIdx.x * 64 + (o & 63)] = t; }
        __syncthreads();
    }
    constexpr int I_W1A = 16 * 176, I_W1B = 44 * 32, I_WIN = 16 * 88, I_WUQ = 12 * 24, I_WK = 4 * 16, I_WOUT = 16 * 32;
    constexpr int NITEMS = 2 * I_W1A + 2 * I_W1B + I_WIN + I_WUQ + 2 * I_WK + I_WOUT;
    for (int rep0 = 0; rep0 < (PROBE_PHASE == 201 ? 2 : 1); ++rep0)
    for (int it = gw; it < NITEMS; it += NGW) {
        int r = it;
        if (r < I_W1A) { titem(a.in[7], 1024, 5632, (bf16*)(ws + WS_W1A), nullptr, scr, r, 176, lane, 0); continue; } r -= I_W1A;
        if (r < I_W1A) { titem(a.in[23], 1024, 5632, (bf16*)(ws + WS_W2A), nullptr, scr, r, 176, lane, 0); continue; } r -= I_W1A;
        if (r < I_W1B) { titem(a.in[8], 2816, 1024, (bf16*)(ws + WS_W1B), nullptr, scr, r, 32, lane, 1); continue; } r -= I_W1B;
        if (r < I_W1B) { titem(a.in[24], 2816, 1024, (bf16*)(ws + WS_W2B), nullptr, scr, r, 32, lane, 1); continue; } r -= I_W1B;
        if (r < I_WIN) { titem(a.in[10], 1024, 2608, (bf16*)(ws + WS_WIN), nullptr, scr, r, 88, lane, 2); continue; } r -= I_WIN;
        if (r < I_WUQ) { titem(a.in[18], 768, 768, (bf16*)(ws + WS_WUQ), a.in[17], scr, r, 24, lane, 3, QSCALE); continue; } r -= I_WUQ;
        if (r < I_WK) { titem(a.in[20], 256, 1024, (bf16*)(ws + WS_WK), a.in[19], scr, r, 16, lane, 4); continue; } r -= I_WK;
        if (r < I_WK) { titem(a.in[20], 256, 1024, (bf16*)(ws + WS_WV), a.in[19], scr, r, 16, lane, 5); continue; } r -= I_WK;
        titem(a.in[21], 1024, 1024, (bf16*)(ws + WS_WOUT), nullptr, scr, r, 32, lane, 1);
    }
    if (blockIdx.x == 0) {
        const int pos = tid >> 3, jj = tid & 7; const float inv = __builtin_amdgcn_exp2f(-(float)jj * 1.6609640474436813f);
        const float ang = (float)pos * inv;
        ((f32x2*)(ws + WS_ROPE))[tid] = (f32x2){__cosf(ang), __sinf(ang)};
    }
}

template <bool SRC_BF16> __device__ __forceinline__ void norm_rows(const void* src_lat, const void* src_ctx, int nrows, const float* gvec, const float* mod, int kshift, bf16* out, int gw, int NGW, int lane, const float* part = nullptr) {
    const int nlat = nrows < NLAT ? nrows : NLAT, per = (nlat + NGW - 1) / NGW, r_end = min(nlat, (gw + 1) * per), nctx = nrows - nlat;
    const int n_it = (r_end > gw * per ? (r_end - gw * per + 1) / 2 : 0), n_ctx_it = nctx > gw ? (nctx - gw + NGW - 1) / NGW : 0;
    int cur_bb = -1; f32x4 fa[4], fb[4];
    const int c0 = 8 * lane;
    for (int it = 0; it < n_it + n_ctx_it; ++it) {
        const bool isl = it < n_it;
        const int row0 = isl ? gw * per + 2 * it : NLAT + gw + (it - n_it) * NGW;
        const bool two = isl && (row0 + 1 < r_end);
        f32x4 v[2][4]; float s[2];
#pragma unroll
        for (int q = 0; q < 2; ++q) if (q == 0 || two) {
            const int row = row0 + q;
            const size_t xo = (row < NLAT ? (size_t)row : (size_t)(row - NLAT)) * D + c0; const void* xs = row < NLAT ? src_lat : src_ctx;
#pragma unroll
            for (int j = 0; j < 2; ++j) {
                if (SRC_BF16) { const u32x4 w = *(const u32x4*)((const bf16*)xs + xo + 512 * j);
                    v[q][2 * j] = (f32x4){bflo(w.x), bfhi(w.x), bflo(w.y), bfhi(w.y)}; v[q][2 * j + 1] = (f32x4){bflo(w.z), bfhi(w.z), bflo(w.w), bfhi(w.w)}; }
                else { v[q][2 * j] = __builtin_nontemporal_load((const f32x4*)((const float*)xs + xo + 512 * j)); v[q][2 * j + 1] = __builtin_nontemporal_load((const f32x4*)((const float*)xs + xo + 512 * j + 4)); } }
        }
#pragma unroll
        for (int q = 0; q < 2; ++q) if (q == 0 || two) {
            const int row = row0 + q; s[q] = 0.f;
#pragma unroll
            for (int j = 0; j < 4; ++j) {
                if (part && row >= NLAT) { const float* pp = part + (size_t)(row - NLAT) * D + c0 + 512 * (j >> 1) + 4 * (j & 1);
                    v[q][j] += *(const f32x4*)pp + *(const f32x4*)(pp + (size_t)NCTX * D) + *(const f32x4*)(pp + (size_t)2 * NCTX * D); }
                s[q] += (v[q][j][0] * v[q][j][0] + v[q][j][1] * v[q][j][1]) + (v[q][j][2] * v[q][j][2] + v[q][j][3] * v[q][j][3]); }
        }
#pragma unroll
        for (int q = 0; q < 2; ++q) if (q == 0 || two) {
            const int row = row0 + q;
            const int bb = row < NLAT ? row / SEQ : 8;
            if (bb != cur_bb) { cur_bb = bb; const float* sh = mod + bb * 9216 + kshift * 1024 + c0;
#pragma unroll
                for (int j = 0; j < 4; ++j) { const int co = 512 * (j >> 1) + 4 * (j & 1);
                    fa[j] = *(const f32x4*)(gvec + c0 + co) * (*(const f32x4*)(sh + 1024 + co) + 1.f); fb[j] = *(const f32x4*)(sh + co); } }
            const float rstd = 1.0f / sqrtf(wave_sum(s[q]) * (1.f / D) + EPS);
            bf16* orow = out + (size_t)row * D + c0;
#pragma unroll
            for (int j = 0; j < 2; ++j) { const f32x4 y0 = (v[q][2 * j] * rstd) * fa[2 * j] + fb[2 * j], y1 = (v[q][2 * j + 1] * rstd) * fa[2 * j + 1] + fb[2 * j + 1];
                u32x4 w; w.x = pk2(y0[0], y0[1]); w.y = pk2(y0[2], y0[3]); w.z = pk2(y1[0], y1[1]); w.w = pk2(y1[2], y1[3]); *(u32x4*)(orow + 512 * j) = w; }
        }
    }
}
__device__ __forceinline__ void final_norm_rows(float* io, const float* gvec, int gw, int NGW, int lane) {
    const int per = NLAT / NGW;
    f32x4 g[4];
#pragma unroll
    for (int j = 0; j < 4; ++j) g[j] = *(const f32x4*)(gvec + 4 * lane + 256 * j);
    for (int row0 = gw * per; row0 < (gw + 1) * per; row0 += 2) {
        f32x4 v[2][4]; float s[2];
#pragma unroll
        for (int q = 0; q < 2; ++q)
#pragma unroll
            for (int j = 0; j < 4; ++j) v[q][j] = *(const f32x4*)(io + (size_t)(row0 + q) * D + 4 * lane + 256 * j);
#pragma unroll
        for (int q = 0; q < 2; ++q) { s[q] = 0.f;
#pragma unroll
            for (int j = 0; j < 4; ++j) s[q] += (v[q][j][0] * v[q][j][0] + v[q][j][1] * v[q][j][1]) + (v[q][j][2] * v[q][j][2] + v[q][j][3] * v[q][j][3]); }
#pragma unroll
        for (int q = 0; q < 2; ++q) {
            const float rstd = 1.0f / sqrtf(wave_sum(s[q]) * (1.f / D) + EPS);
#pragma unroll
            for (int j = 0; j < 4; ++j) __builtin_nontemporal_store((v[q][j] * rstd) * g[j], (f32x4*)(io + (size_t)(row0 + q) * D + 4 * lane + 256 * j));
        }
    }
}

__device__ __forceinline__ float softplus_f(float x) { return fmaxf(x, 0.f) + log1pf(__expf(-fabsf(x))); }
__device__ __forceinline__ void phase6(const Args& a, LAS unsigned char* lds, int G, int bx, int tid, int lane, int wave) {
    unsigned char* ws = a.ws;
    const bf16* XBCR = (const bf16*)(ws + WS_XBCR); const bf16* MISC = (const bf16*)(ws + WS_MISC); const bf16* CQ = (const bf16*)(ws + WS_CQ); const bf16* CKV = (const bf16*)(ws + WS_CKV);
    bf16* XT = (bf16*)(ws + WS_XT); bf16* BT = (bf16*)(ws + WS_BT); bf16* BROW = (bf16*)(ws + WS_BROW); bf16* CROW = (bf16*)(ws + WS_CROW); bf16* KPE = (bf16*)(ws + WS_KPE);
    float* DT = (float*)(ws + WS_DT); float* RSTDQ = (float*)(ws + WS_RSTDQ); float* RSTDKV = (float*)(ws + WS_RSTDKV); const f32x2* ROPE = (const f32x2*)(ws + WS_ROPE);
    const float* conv_w = a.in[11]; const float* conv_b = a.in[12]; const float* dt_bias = a.in[13];
    LAS bf16* T = (LAS bf16*)lds;
    const int ch = 4 * (tid & 255), tsw = 2 * ((ch >> 3) & 15);
    float cw[5][4], cb[4];
#pragma unroll
    for (int k = 0; k < 5; ++k) { const f32x4 w = *(const f32x4*)(conv_w + k * 1024 + ch); cw[k][0] = w[0]; cw[k][1] = w[1]; cw[k][2] = w[2]; cw[k][3] = w[3]; }
    { const f32x4 w = *(const f32x4*)(conv_b + ch); cb[0] = w[0]; cb[1] = w[1]; cb[2] = w[2]; cb[3] = w[3]; }
    for (int unit = bx; unit < NB * 64 + NB * 16; unit += G) {
        const bool isctx = unit >= NB * 64;
        const int b = isctx ? (unit - NB * 64) >> 4 : unit >> 6, len = isctx ? 16 : 64, u0 = isctx ? ((unit - NB * 64) & 15) * 16 : CTXL + (unit & 63) * 64;
        const int seg_lo = isctx ? 0 : CTXL, seg_hi = isctx ? CTXL : UL;
        const int rb = isctx ? NLAT + b * CTXL : b * SEQ - CTXL;
        const int spt = len >> 1, tseg = (tid >> 8) * spt;
#define P6_LD(u) (((u) >= seg_lo && (u) < seg_hi) ? *(const u32x2*)(XBCR + (size_t)(rb + (u)) * 1024 + ch) : (u32x2){0u, 0u})
        const int ub = u0 + tseg;
        u32x2 xin[36];
#pragma unroll
        for (int i = 0; i < 36; ++i) if (i < spt + 4) xin[i] = P6_LD(ub - 2 + i);
#pragma unroll
        for (int t = 0; t < 32; ++t) if (t < spt) {
            const u32x2 xm2 = xin[t], xm1 = xin[t + 1], x0 = xin[t + 2], xp1 = xin[t + 3], xp2 = xin[t + 4];
            const float y0 = cb[0] + cw[0][0] * bflo(xm2.x) + cw[1][0] * bflo(xm1.x) + cw[2][0] * bflo(x0.x) + cw[3][0] * bflo(xp1.x) + cw[4][0] * bflo(xp2.x);
            const float y1 = cb[1] + cw[0][1] * bfhi(xm2.x) + cw[1][1] * bfhi(xm1.x) + cw[2][1] * bfhi(x0.x) + cw[3][1] * bfhi(xp1.x) + cw[4][1] * bfhi(xp2.x);
            const float y2 = cb[2] + cw[0][2] * bflo(xm2.y) + cw[1][2] * bflo(xm1.y) + cw[2][2] * bflo(x0.y) + cw[3][2] * bflo(xp1.y) + cw[4][2] * bflo(xp2.y);
            const float y3 = cb[3] + cw[0][3] * bfhi(xm2.y) + cw[1][3] * bfhi(xm1.y) + cw[2][3] * bfhi(x0.y) + cw[3][3] * bfhi(xp1.y) + cw[4][3] * bfhi(xp2.y);
            u32x2 pk; pk.x = pk2(silu_f(y0), silu_f(y1)); pk.y = pk2(silu_f(y2), silu_f(y3));
            const int tt = tseg + t;
            if (ch < 768) { const int ts = tt ^ tsw;
                T[ch * 72 + ts] = (bf16)(pk.x & 0xffffu); T[(ch + 1) * 72 + ts] = (bf16)(pk.x >> 16); T[(ch + 2) * 72 + ts] = (bf16)(pk.y & 0xffffu); T[(ch + 3) * 72 + ts] = (bf16)(pk.y >> 16); }
            if (ch >= 512) { bf16* dst = ch < 768 ? BROW + (ch - 512) : CROW + (ch - 768); *(u32x2*)(dst + (size_t)(b * UL + u0 + tt) * 256) = pk; }
        }
#undef P6_LD
        __syncthreads();
        { const int cpr = len >> 3, sh = isctx ? 1 : 3;
          for (int q = tid; q < 768 * cpr; q += 512) { const int c = q >> sh, part = q & (cpr - 1), g = (c >> 3) & 15, x = g & 3;
            const u32x4 vr = *(const LAS u32x4*)(T + c * 72 + (part ^ (g >> 2)) * 8);
            const u32x4 v = x == 0 ? vr : (x == 1 ? (u32x4){vr.y, vr.x, vr.w, vr.z} : (x == 2 ? (u32x4){vr.z, vr.w, vr.x, vr.y} : (u32x4){vr.w, vr.z, vr.y, vr.x}));
            bf16* dst = c < 512 ? XT + (size_t)(b * 512 + c) * UL : BT + (size_t)(b * 256 + c - 512) * UL;
            *(u32x4*)(dst + u0 + part * 8) = v; } }
        if ((tid >> 3) < len) {
            const int uu = tid >> 3, k = (tid & 7) * 2; const size_t row = (size_t)(rb + u0 + uu);
            const unsigned raw = *(const unsigned*)(MISC + row * 256 + 32 + k);
            f32x2 o; o.x = softplus_f(bflo(raw) + dt_bias[k]); o.y = softplus_f(bfhi(raw) + dt_bias[k + 1]);
            *(f32x2*)(DT + (size_t)(b * UL + u0 + uu) * 16 + k) = o;
        }
        if ((tid >> 3) < len) {
            const int uu = tid >> 3, pp = (tid & 7) * 2; const size_t row = (size_t)(rb + u0 + uu);
            u32x2 raw = *(const u32x2*)(MISC + row * 256 + 2 * pp);
            if (!isctx) {
                const int t = u0 + uu - CTXL, half = pp >> 3, jj = pp & 7, pos = half ? (t & 63) : (t >> 6);
                const f32x2 c0 = ROPE[pos * 8 + jj], c1 = ROPE[pos * 8 + jj + 1];
                const float a0 = bflo(raw.x), a1 = bfhi(raw.x), a2 = bflo(raw.y), a3 = bfhi(raw.y);
                raw.x = pk2(a0 * c0.x - a1 * c0.y, a0 * c0.y + a1 * c0.x); raw.y = pk2(a2 * c1.x - a3 * c1.y, a2 * c1.y + a3 * c1.x);
            }
            *(u32x2*)(KPE + row * 32 + 2 * pp) = raw;
        }
        {
            u32x2 wkv[8], wq[8][3];
#pragma unroll
            for (int i = 0; i < 8; ++i) if (wave + 8 * i < len) { const size_t row = (size_t)(rb + u0 + wave + 8 * i);
                wkv[i] = *(const u32x2*)(CKV + row * 256 + 4 * lane);
                if (!isctx) {
#pragma unroll
                    for (int j = 0; j < 3; ++j) wq[i][j] = *(const u32x2*)(CQ + row * 768 + 4 * lane + 256 * j); } }
#pragma unroll
            for (int i = 0; i < 8; ++i) if (wave + 8 * i < len) { const size_t row = (size_t)(rb + u0 + wave + 8 * i);
                { const float c0 = bflo(wkv[i].x), c1 = bfhi(wkv[i].x), c2 = bflo(wkv[i].y), c3 = bfhi(wkv[i].y);
                  const float sk = wave_sum((c0 * c0 + c1 * c1) + (c2 * c2 + c3 * c3)); if (lane == 0) RSTDKV[row] = 1.0f / sqrtf(sk * (1.f / 256.f) + EPS); }
                if (!isctx) { float sq = 0.f;
#pragma unroll
                    for (int j = 0; j < 3; ++j) { const float c0 = bflo(wq[i][j].x), c1 = bfhi(wq[i][j].x), c2 = bflo(wq[i][j].y), c3 = bfhi(wq[i][j].y); sq += (c0 * c0 + c1 * c1) + (c2 * c2 + c3 * c3); }
                    sq = wave_sum(sq); if (lane == 0) RSTDQ[row] = 1.0f / sqrtf(sq * (1.f / 768.f) + EPS); } }
        }
        __syncthreads();
    }
}

__device__ __forceinline__ void acum_wave(const float* DT, size_t dtrow0, int h, float anf, float anb, LAS float* sc, int lane) {
    const float df0 = DT[(dtrow0 + lane) * 16 + h], df1 = DT[(dtrow0 + 64 + lane) * 16 + h];
    const float db0 = DT[(dtrow0 + lane) * 16 + 8 + h], db1 = DT[(dtrow0 + 64 + lane) * 16 + 8 + h];
    const float f0 = incl_scan(df0 * anf, lane); float f1 = incl_scan(df1 * anf, lane); f1 += __shfl(f0, 63);
    const float a0 = db0 * anb, a1 = db1 * anb; const float g0 = incl_scan(a0, lane), g1 = incl_scan(a1, lane);
    const float t0 = __shfl(g0, 63), t1 = __shfl(g1, 63), tot = t0 + t1;
    sc[lane] = f0; sc[64 + lane] = f1; sc[128 + lane] = tot - g0 + a0; sc[192 + lane] = t1 - g1 + a1;
    sc[256 + lane] = df0; sc[320 + lane] = df1; sc[384 + lane] = db0; sc[448 + lane] = db1;
    LDS_FENCE();
}
#define MFMA32(a, b, c) __builtin_amdgcn_mfma_f32_32x32x16_bf16((a), (b), (c), 0, 0, 0)
__device__ __forceinline__ f32x16 zero16() { f32x16 z;
#pragma unroll
    for (int r = 0; r < 16; ++r) z[r] = 0.f; return z; }

constexpr int S3_STR = 136, S3_TILE = 128 * S3_STR * 2;
constexpr int S3_CL = 0, S3_BL = 2 * S3_TILE, S3_SC = 4 * S3_TILE, S3_SS = S3_SC + 16384;
__device__ __forceinline__ void phase8(const Args& a, LAS unsigned char* lds, int G, int bx, int tid, int lane, int wave) {
    unsigned char* ws = a.ws;
    const bf16* XT = (const bf16*)(ws + WS_XT); const bf16* BT = (const bf16*)(ws + WS_BT); const float* DT = (const float*)(ws + WS_DT);
    bf16* ST = (bf16*)(ws + WS_ST); float* CD = (float*)(ws + WS_CD);
    LAS float* sc = (LAS float*)(lds + S3_SC) + wave * 512;
    const int h = wave, g = h >> 2, r32 = lane & 31, hi = lane >> 5;
    const float anf = -__expf(a.in[14][h]), anb = -__expf(a.in[14][8 + h]);
    const int rbx = G - 1 - bx, ufull = (NB * NCH / G) * G, nhalf = 2 * (NB * NCH - ufull);
    for (int wi = rbx; wi < ufull + nhalf; wi += G) {
        const int unit = wi < ufull ? wi : ufull + ((wi - ufull) >> 1), half_lo = wi < ufull ? 0 : ((wi - ufull) & 1), half_hi = wi < ufull ? 2 : half_lo + 1;
        const int b = unit / NCH, c = unit % NCH;
#pragma unroll
        for (int it = 0; it < 8; ++it) { const int q = tid + 512 * it, n = q >> 4, k16 = q & 15;
            const u32x4 v = *(const u32x4*)(BT + (size_t)(b * 256 + n) * UL + c * 128 + 8 * k16);
            *(LAS u32x4*)(lds + (n * S3_STR + 8 * k16) * 2) = v; }
        acum_wave(DT, (size_t)b * UL + c * 128, h, anf, anb, sc, lane);
        const float af_last = sc[127], ab_first = sc[128];
#pragma unroll
        for (int hf = 0; hf < 2; ++hf) { const int j = lane + 64 * hf;
            const float wf = __expf(af_last - sc[j]) * sc[256 + j], wb = __expf(ab_first - sc[128 + j]) * sc[384 + j];
            sc[256 + j] = wf; sc[384 + j] = wb; }
        if (lane == 0) { CD[((b * 2 + 0) * 8 + h) * NCH + c] = __expf(af_last); CD[((b * 2 + 1) * 8 + h) * NCH + c] = __expf(ab_first); }
        __syncthreads();
        const bf16* xbase = XT + (size_t)(b * 512 + h * 64 + r32) * UL + c * 128 + 8 * hi;
        const LAS unsigned char* btl = lds + ((g * 128 + r32) * S3_STR + 8 * hi) * 2;
        const LAS float* wfp = sc + 256 + 8 * hi; const LAS float* wbp = sc + 384 + 8 * hi;
#pragma unroll 1
        for (int half = half_lo; half < half_hi; ++half) {
            f32x16 accf[2][2], accb[2][2];
#pragma unroll
            for (int nn = 0; nn < 2; ++nn) { accf[nn][0] = zero16(); accf[nn][1] = zero16(); accb[nn][0] = zero16(); accb[nn][1] = zero16(); }
#pragma unroll 1
            for (int sq = 0; sq < 2; ++sq) {
            u32x4 xraw[2][4];
#pragma unroll
            for (int pb = 0; pb < 2; ++pb)
#pragma unroll
                for (int s4 = 0; s4 < 4; ++s4) xraw[pb][s4] = *(const u32x4*)(xbase + (size_t)pb * 32 * UL + 16 * (4 * sq + s4));
#pragma unroll
            for (int s4 = 0; s4 < 4; ++s4) { const int s = 4 * sq + s4;
                const f32x4 fa = *(const LAS f32x4*)(wfp + 16 * s), fb = *(const LAS f32x4*)(wfp + 16 * s + 4), ba = *(const LAS f32x4*)(wbp + 16 * s), bb = *(const LAS f32x4*)(wbp + 16 * s + 4);
                bf16x8 xwf[2], xwb[2];
#pragma unroll
                for (int pb = 0; pb < 2; ++pb) { const u32x4 raw = xraw[pb][s4];
                    const float x0 = bflo(raw.x), x1 = bfhi(raw.x), x2 = bflo(raw.y), x3 = bfhi(raw.y), x4 = bflo(raw.z), x5 = bfhi(raw.z), x6 = bflo(raw.w), x7 = bfhi(raw.w);
                    xwf[pb] = pack8(x0 * fa[0], x1 * fa[1], x2 * fa[2], x3 * fa[3], x4 * fb[0], x5 * fb[1], x6 * fb[2], x7 * fb[3]);
                    xwb[pb] = pack8(x0 * ba[0], x1 * ba[1], x2 * ba[2], x3 * ba[3], x4 * bb[0], x5 * bb[1], x6 * bb[2], x7 * bb[3]); }
#pragma unroll
                for (int nn = 0; nn < 2; ++nn) { const bf16x8 bt = *(const LAS bf16x8*)(btl + ((2 * half + nn) * 32 * S3_STR + 16 * s) * 2);
                    accf[nn][0] = MFMA32(bt, xwf[0], accf[nn][0]); accf[nn][1] = MFMA32(bt, xwf[1], accf[nn][1]);
                    accb[nn][0] = MFMA32(bt, xwb[0], accb[nn][0]); accb[nn][1] = MFMA32(bt, xwb[1], accb[nn][1]); }
            }
            }
            bf16* sof = ST + ((size_t)(((b * 2 + 0) * 8 + h) * NCH + c) * 64) * 128; bf16* sob = ST + ((size_t)(((b * 2 + 1) * 8 + h) * NCH + c) * 64) * 128;
#pragma unroll
            for (int nn = 0; nn < 2; ++nn)
#pragma unroll
                for (int pb = 0; pb < 2; ++pb)
#pragma unroll
                    for (int g4 = 0; g4 < 4; ++g4) { const size_t off = (size_t)(32 * pb + r32) * 128 + 32 * (2 * half + nn) + 8 * g4 + 4 * hi;
                        u32x2 o; o.x = pk2(accf[nn][pb][4 * g4], accf[nn][pb][4 * g4 + 1]); o.y = pk2(accf[nn][pb][4 * g4 + 2], accf[nn][pb][4 * g4 + 3]); *(u32x2*)(sof + off) = o;
                        o.x = pk2(accb[nn][pb][4 * g4], accb[nn][pb][4 * g4 + 1]); o.y = pk2(accb[nn][pb][4 * g4 + 2], accb[nn][pb][4 * g4 + 3]); *(u32x2*)(sob + off) = o; }
        }
        __syncthreads();
    }
}
__device__ __forceinline__ void phase9(const Args& a, int G, int bx, int tid) {
    unsigned char* ws = a.ws;
    const bf16* ST = (const bf16*)(ws + WS_ST); bf16* HE = (bf16*)(ws + WS_HE); const float* CD = (const float*)(ws + WS_CD);
    for (int idx = bx * 512 + tid; idx < NB * 2 * 8 * 1024; idx += G * 512) {
        const int e = (idx & 1023) * 8, bdh = idx >> 10, dir = (bdh >> 3) & 1;
        const bf16* st = ST + (size_t)bdh * NCH * 8192 + e; bf16* he = HE + (size_t)bdh * 32 * 8192 + e; const float* cd = CD + bdh * NCH;
        float hh[8];
#pragma unroll
        for (int k = 0; k < 8; ++k) hh[k] = 0.f;
#define P9_STEP(c) do { const u32x4 w_ = __builtin_nontemporal_load((const u32x4*)(st + (size_t)(c) * 8192)); const float d_ = cd[c]; \
        hh[0] = d_ * hh[0] + bflo(w_.x); hh[1] = d_ * hh[1] + bfhi(w_.x); hh[2] = d_ * hh[2] + bflo(w_.y); hh[3] = d_ * hh[3] + bfhi(w_.y); \
        hh[4] = d_ * hh[4] + bflo(w_.z); hh[5] = d_ * hh[5] + bfhi(w_.z); hh[6] = d_ * hh[6] + bflo(w_.w); hh[7] = d_ * hh[7] + bfhi(w_.w); } while (0)
#define P9_OUT(c) do { u32x4 o_; o_.x = pk2(hh[0], hh[1]); o_.y = pk2(hh[2], hh[3]); o_.z = pk2(hh[4], hh[5]); o_.w = pk2(hh[6], hh[7]); *(u32x4*)(he + (size_t)((c) - 2) * 8192) = o_; } while (0)
        if (dir == 0) {
            P9_STEP(0); P9_STEP(1);
#pragma unroll 8
            for (int c = 2; c < NCH; ++c) { P9_OUT(c); P9_STEP(c); }
        } else {
            P9_STEP(1); P9_STEP(0);
#pragma unroll 8
            for (int c = NCH - 1; c >= 2; --c) { P9_OUT(c); P9_STEP(c); }
        }
#undef P9_STEP
#undef P9_OUT
    }
}
#if defined(PROBE_TA)
#define SSTAMP(i) do { if (bx == 0 && tid == 0) ((unsigned long long*)(ws + 480 * KiB))[i] = __builtin_amdgcn_s_memrealtime(); } while (0)
#else
#define SSTAMP(i) do { } while (0)
#endif
__device__ __forceinline__ void phase10_ssd(const Args& a, LAS unsigned char* lds, int G, int bx, int tid, int lane, int wave) {
    unsigned char* ws = a.ws;
    const bf16* XT = (const bf16*)(ws + WS_XT); const bf16* BROW = (const bf16*)(ws + WS_BROW); const bf16* CROW = (const bf16*)(ws + WS_CROW); const float* DT = (const float*)(ws + WS_DT);
    const bf16* HE = (const bf16*)(ws + WS_HE); const bf16* Z = (const bf16*)(ws + WS_Z); bf16* MIX = (bf16*)(ws + WS_MIX);
    LAS float* sc = (LAS float*)(lds + S3_SC) + wave * 512;
    LAS float* SS = (LAS float*)(lds + S3_SS);
    const int h = wave, g = h >> 2, r32 = lane & 31, hi = lane >> 5;
    const float anf = -__expf(a.in[14][h]), anb = -__expf(a.in[14][8 + h]);
    const float dskip = a.in[15][h]; const float* snorm = a.in[16] + h * 64;
    for (int unit = bx; unit < NB * 32; unit += G) {
        const int b = unit >> 5, lc = unit & 31, c = lc + 2; const size_t u0 = (size_t)b * UL + c * 128;
#pragma unroll
        for (int it = 0; it < 8; ++it) { const int q = tid + 512 * it, i = q >> 5, ch16 = q & 31, off = ((ch16 >> 4) * S3_TILE) + (i * S3_STR + (ch16 & 15) * 8) * 2;
            const u32x4 vc = *(const u32x4*)(CROW + (u0 + i) * 256 + 8 * ch16), vb = *(const u32x4*)(BROW + (u0 + i) * 256 + 8 * ch16);
            *(LAS u32x4*)(lds + S3_CL + off) = vc; *(LAS u32x4*)(lds + S3_BL + off) = vb; }
        acum_wave(DT, u0, h, anf, anb, sc, lane);
        {
            float wfv[2], wbv[2];
#pragma unroll
            for (int hf = 0; hf < 2; ++hf) { const int j = lane + 64 * hf, jb = j >> 5;
                const float afb = jb ? sc[32 * jb - 1] : 0.f, abb = jb < 3 ? sc[128 + 32 * jb + 32] : 0.f;
                wfv[hf] = __expf(afb - sc[j]) * sc[256 + j]; wbv[hf] = __expf(abb - sc[128 + j]) * sc[384 + j]; }
            LDS_FENCE();
#pragma unroll
            for (int hf = 0; hf < 2; ++hf) { const int j = lane + 64 * hf; sc[256 + j] = wfv[hf]; sc[384 + j] = wbv[hf]; }
        }
        __syncthreads();
        SSTAMP(18);
        const LAS unsigned char* CLg = lds + S3_CL + g * S3_TILE + (r32 * S3_STR + 8 * hi) * 2;
        const LAS unsigned char* BLg = lds + S3_BL + g * S3_TILE + (r32 * S3_STR + 8 * hi) * 2;
#pragma unroll 1
        for (int ibp = 0; ibp < 2; ++ibp) {
        f32x16 acc[2][2];
#pragma unroll
        for (int k = 0; k < 2; ++k) { acc[k][0] = zero16(); acc[k][1] = zero16(); }
#ifndef NO_DIAG
        u32x2 xn[2][4];
#pragma unroll
        for (int pb = 0; pb < 2; ++pb) { const bf16* xp = XT + (size_t)(b * 512 + h * 64 + 32 * pb + r32) * UL + c * 128 + 4 * hi;
#pragma unroll
            for (int e = 0; e < 4; ++e) xn[pb][e] = *(const u32x2*)(xp + 8 * e); }
#pragma unroll 1
        for (int jb = 0; jb < 4; ++jb) {
            bf16x8 xa[2][2];
#pragma unroll
            for (int pb = 0; pb < 2; ++pb) {
                xa[pb][0] = __builtin_bit_cast(bf16x8, (u32x4){xn[pb][0].x, xn[pb][0].y, xn[pb][1].x, xn[pb][1].y}); xa[pb][1] = __builtin_bit_cast(bf16x8, (u32x4){xn[pb][2].x, xn[pb][2].y, xn[pb][3].x, xn[pb][3].y});
                if (jb < 3) { const bf16* xp = XT + (size_t)(b * 512 + h * 64 + 32 * pb + r32) * UL + c * 128 + 32 * (jb + 1) + 4 * hi;
#pragma unroll
                    for (int e = 0; e < 4; ++e) xn[pb][e] = *(const u32x2*)(xp + 8 * e); }
            }
#pragma unroll
            for (int k = 0; k < 2; ++k) {
                const int ib = 2 * ibp + k;
                f32x16 ga = zero16();
#pragma unroll
                for (int s = 0; s < 8; ++s) { const bf16x8 bfr = *(const LAS bf16x8*)(BLg + (32 * jb * S3_STR + 16 * s) * 2), cf = *(const LAS bf16x8*)(CLg + (32 * ib * S3_STR + 16 * s) * 2);
                    ga = MFMA32(bfr, cf, ga); }
                float mm[16];
                if (jb < ib) {
                    const float efi = __expf(sc[32 * ib + r32] - sc[32 * jb + 31]);
#pragma unroll
                    for (int r = 0; r < 16; ++r) mm[r] = ga[r] * sc[256 + 32 * jb + crow(r, hi)];
                    const float efb = __expf(sc[32 * ib + r32] - (jb ? sc[32 * jb - 1] : 0.f));
#pragma unroll
                    for (int r = 0; r < 16; ++r) mm[r] *= efb;
                    (void)efi;
                } else if (jb > ib) {
                    const float ebb = __expf(sc[128 + 32 * ib + r32] - (jb < 3 ? sc[128 + 32 * jb + 32] : 0.f));
#pragma unroll
                    for (int r = 0; r < 16; ++r) mm[r] = ga[r] * sc[384 + 32 * jb + crow(r, hi)] * ebb;
                } else {
                    const float efb = __expf(sc[32 * ib + r32] - (jb ? sc[32 * jb - 1] : 0.f)), ebb = __expf(sc[128 + 32 * ib + r32] - (jb < 3 ? sc[128 + 32 * jb + 32] : 0.f));
#pragma unroll
                    for (int r = 0; r < 16; ++r) { const int jl = crow(r, hi);
                        const float mf = jl <= r32 ? efb * sc[256 + 32 * jb + jl] : 0.f, mb = jl >= r32 ? ebb * sc[384 + 32 * jb + jl] : 0.f;
                        mm[r] = ga[r] * (mf + mb) + (jl == r32 ? dskip : 0.f); }
                }
                const bf16x8 pf0 = pack8(mm[0], mm[1], mm[2], mm[3], mm[4], mm[5], mm[6], mm[7]), pf1 = pack8(mm[8], mm[9], mm[10], mm[11], mm[12], mm[13], mm[14], mm[15]);
                acc[k][0] = MFMA32(xa[0][0], pf0, acc[k][0]); acc[k][0] = MFMA32(xa[0][1], pf1, acc[k][0]);
                acc[k][1] = MFMA32(xa[1][0], pf0, acc[k][1]); acc[k][1] = MFMA32(xa[1][1], pf1, acc[k][1]);
                asm volatile("" ::: "memory");
            }
        }
#endif
#ifndef NO_OFF
        if (ibp == 0) SSTAMP(19);
#pragma unroll 1
        for (int dir = 0; dir < 2; ++dir) {
#pragma unroll
            for (int pb = 0; pb < 2; ++pb) {
                const bf16* hp = HE + ((size_t)(((b * 2 + dir) * 8 + h) * 32 + lc) * 64 + 32 * pb + r32) * 128 + 8 * hi;
                f32x16 ta0 = zero16(), ta1 = zero16();
                bf16x8 hf[8];
#pragma unroll
                for (int s = 0; s < 8; ++s) hf[s] = *(const bf16x8*)(hp + 16 * s);
#pragma unroll
                for (int s = 0; s < 8; ++s) {
                    const bf16x8 cf0 = *(const LAS bf16x8*)(CLg + (32 * (2 * ibp) * S3_STR + 16 * s) * 2), cf1 = *(const LAS bf16x8*)(CLg + (32 * (2 * ibp + 1) * S3_STR + 16 * s) * 2);
                    ta0 = MFMA32(hf[s], cf0, ta0); ta1 = MFMA32(hf[s], cf1, ta1); }
                const float e0 = __expf(sc[128 * dir + 32 * (2 * ibp) + r32]), e1 = __expf(sc[128 * dir + 32 * (2 * ibp + 1) + r32]);
#pragma unroll
                for (int r = 0; r < 16; ++r) { acc[0][pb][r] += e0 * ta0[r]; acc[1][pb][r] += e1 * ta1[r]; }
                asm volatile("" ::: "memory");
            }
        }
#endif
        if (ibp == 0) SSTAMP(20);
#pragma unroll
        for (int k = 0; k < 2; ++k) {
            const int ib = 2 * ibp + k;
            const size_t row = (size_t)b * SEQ + lc * 128 + 32 * ib + r32;
            float ss = 0.f;
#pragma unroll
            for (int pb = 0; pb < 2; ++pb)
#pragma unroll
                for (int g4 = 0; g4 < 4; ++g4) { const u32x2 zw = *(const u32x2*)(Z + row * 512 + h * 64 + 32 * pb + 8 * g4 + 4 * hi);
                    const float v0 = acc[k][pb][4 * g4] * silu_f(bflo(zw.x)), v1 = acc[k][pb][4 * g4 + 1] * silu_f(bfhi(zw.x)), v2 = acc[k][pb][4 * g4 + 2] * silu_f(bflo(zw.y)), v3 = acc[k][pb][4 * g4 + 3] * silu_f(bfhi(zw.y));
                    ss += (v0 * v0 + v1 * v1) + (v2 * v2 + v3 * v3);
                    acc[k][pb][4 * g4] = v0; acc[k][pb][4 * g4 + 1] = v1; acc[k][pb][4 * g4 + 2] = v2; acc[k][pb][4 * g4 + 3] = v3; }
            ss += __shfl_xor(ss, 32);
            if (hi == 0) SS[(ib * 8 + wave) * 32 + r32] = ss;
        }
        __syncthreads();
#pragma unroll
        for (int k = 0; k < 2; ++k) {
            const int ib = 2 * ibp + k;
            const size_t row = (size_t)b * SEQ + lc * 128 + 32 * ib + r32;
            float tot = 0.f;
#pragma unroll
            for (int w = 0; w < 8; ++w) tot += SS[(ib * 8 + w) * 32 + r32];
            const float rstd = 1.0f / sqrtf(tot * (1.f / 512.f) + EPS);
#pragma unroll
            for (int pb = 0; pb < 2; ++pb)
#pragma unroll
                for (int g4 = 0; g4 < 4; ++g4) { const int p0 = 32 * pb + 8 * g4 + 4 * hi; const f32x4 gn = *(const f32x4*)(snorm + p0);
                    u32x2 o; o.x = pk2(acc[k][pb][4 * g4] * rstd * gn[0], acc[k][pb][4 * g4 + 1] * rstd * gn[1]); o.y = pk2(acc[k][pb][4 * g4 + 2] * rstd * gn[2], acc[k][pb][4 * g4 + 3] * rstd * gn[3]);
                    *(u32x2*)(MIX + row * 1024 + h * 64 + p0) = o; }
        }
        }
        __syncthreads();
    }
}

__device__ __forceinline__ float at_max3(float a, float b, float c) { float r; asm("v_max3_f32 %0, %1, %2, %3" : "=v"(r) : "v"(a), "v"(b), "v"(c)); return r; }
constexpr int AT_KS = 104, AT_VS = 68, AT_KB = 64 * AT_KS * 2, AT_BUF = AT_KB + 64 * AT_VS * 2;
__device__ __forceinline__ void phase10_attn(const Args& a, LAS unsigned char* lds, int G, int vcu, int tid, int lane, int wave) {
    unsigned char* ws = a.ws; unsigned char* ob = (unsigned char*)a.out;
    const bf16* Q = (const bf16*)(ob + OUT_Q); const bf16* KN = (const bf16*)(ob + OUT_KN); const bf16* VT = (const bf16*)(ob + OUT_VT); const bf16* KPE = (const bf16*)(ws + WS_KPE);
    bf16* MIX = (bf16*)(ws + WS_MIX); const f32x2* ROPE = (const f32x2*)(ws + WS_ROPE);
    const int r32 = lane & 31, hi = lane >> 5;
    if (wave >= 4) __builtin_amdgcn_s_setprio(1);
    for (int unit = vcu; unit < NB * 8 * 8; unit += G) {
        const int bh = unit >> 3, qb = unit & 7, b = bh >> 3, h = bh & 7;
        bf16x8 qr[2][6];
#pragma unroll
        for (int qq = 0; qq < 2; ++qq) {
            const int tq = qb * 512 + qq * 256 + wave * 32 + r32;
            const bf16* qp = Q + ((size_t)b * SEQ + tq) * 768 + h * 96 + 8 * hi;
#pragma unroll
            for (int s = 0; s < 6; ++s) qr[qq][s] = *(const bf16x8*)(qp + 16 * s);
#pragma unroll
            for (int s = 4; s < 6; ++s) { const int pos = (s == 4) ? (tq >> 6) : (tq & 63); const f32x2* rp = ROPE + pos * 8 + 4 * hi;
                const u32x4 w = __builtin_bit_cast(u32x4, qr[qq][s]); const f32x2 c0 = rp[0], c1 = rp[1], c2 = rp[2], c3 = rp[3]; u32x4 o;
                o.x = pk2(bflo(w.x) * c0.x - bfhi(w.x) * c0.y, bflo(w.x) * c0.y + bfhi(w.x) * c0.x); o.y = pk2(bflo(w.y) * c1.x - bfhi(w.y) * c1.y, bflo(w.y) * c1.y + bfhi(w.y) * c1.x);
                o.z = pk2(bflo(w.z) * c2.x - bfhi(w.z) * c2.y, bflo(w.z) * c2.y + bfhi(w.z) * c2.x); o.w = pk2(bflo(w.w) * c3.x - bfhi(w.w) * c3.y, bflo(w.w) * c3.y + bfhi(w.w) * c3.x);
                qr[qq][s] = __builtin_bit_cast(bf16x8, o); }
        }
        const int kr = tid >> 3, kpart = tid & 7;
        const int pr = tid >> 2, ppart = tid & 3;
#define AT_ROW0(t) ((t) < 4 ? (size_t)NLAT + b * CTXL + (t) * 64 : (size_t)b * SEQ + ((t) - 4) * 64)
#define AT_LOAD(t) do { const size_t r0_ = AT_ROW0(t); \
        gk = *(const u32x4*)(KN + (r0_ + kr) * 512 + h * 64 + kpart * 8); \
        gv = *(const u32x4*)(VT + (size_t)(h * 64 + kr) * MTOT + r0_ + kpart * 8); \
        if (tid < 256) gp = *(const u32x4*)(KPE + (r0_ + pr) * 32 + ppart * 8); } while (0)
#define AT_STORE(bufi) do { LAS unsigned char* B_ = lds + (bufi) * AT_BUF; \
        *(LAS u32x4*)(B_ + (kr * AT_KS + kpart * 8) * 2) = gk; \
        *(LAS u32x2*)(B_ + AT_KB + (kr * AT_VS + kpart * 8) * 2) = (u32x2){gv.x, gv.y}; *(LAS u32x2*)(B_ + AT_KB + (kr * AT_VS + kpart * 8 + 4) * 2) = (u32x2){gv.z, gv.w}; \
        if (tid < 256) *(LAS u32x4*)(B_ + (pr * AT_KS + 64 + ppart * 8) * 2) = gp; } while (0)
        u32x4 gk, gv, gp = (u32x4){0u, 0u, 0u, 0u};
        AT_LOAD(0); AT_STORE(0);
        __syncthreads();
        float mrun[2] = {-INFINITY, -INFINITY}, lrun[2] = {0.f, 0.f};
        f32x16 o[2][2]; o[0][0] = zero16(); o[0][1] = zero16(); o[1][0] = zero16(); o[1][1] = zero16();
#pragma unroll 1
        for (int t = 0; t < 68; ++t) {
            if (t + 1 < 68) AT_LOAD(t + 1);
            const LAS unsigned char* Bc = lds + (t & 1) * AT_BUF;
#pragma unroll
            for (int qq = 0; qq < 2; ++qq) {
                f32x16 p0 = zero16(), p1 = zero16();
#pragma unroll
                for (int s = 0; s < 6; ++s) {
                    const bf16x8 k0 = *(const LAS bf16x8*)(Bc + (r32 * AT_KS + 16 * s + 8 * hi) * 2), k1 = *(const LAS bf16x8*)(Bc + ((32 + r32) * AT_KS + 16 * s + 8 * hi) * 2);
                    p0 = MFMA32(k0, qr[qq][s], p0); p1 = MFMA32(k1, qr[qq][s], p1); }
                float mx = fmaxf(p0[0], p1[0]);
#pragma unroll
                for (int r = 1; r < 16; ++r) mx = fmaxf(mx, fmaxf(p0[r], p1[r]));
                mx = fmaxf(mx, __shfl_xor(mx, 32));
                if (__any(mx > mrun[qq])) {
                    const float mnew = fmaxf(mrun[qq], mx), alpha = __builtin_amdgcn_exp2f(mrun[qq] - mnew);
                    mrun[qq] = mnew; lrun[qq] *= alpha;
#pragma unroll
                    for (int r = 0; r < 16; ++r) { o[qq][0][r] *= alpha; o[qq][1][r] *= alpha; }
                }
                float rs = 0.f;
#pragma unroll
                for (int r = 0; r < 16; ++r) { p0[r] = __builtin_amdgcn_exp2f(p0[r] - mrun[qq]); p1[r] = __builtin_amdgcn_exp2f(p1[r] - mrun[qq]); rs += p0[r] + p1[r]; }
                lrun[qq] += rs;
                bf16x8 pf[4];
                pf[0] = pack8(p0[0], p0[1], p0[2], p0[3], p0[4], p0[5], p0[6], p0[7]); pf[1] = pack8(p0[8], p0[9], p0[10], p0[11], p0[12], p0[13], p0[14], p0[15]);
                pf[2] = pack8(p1[0], p1[1], p1[2], p1[3], p1[4], p1[5], p1[6], p1[7]); pf[3] = pack8(p1[8], p1[9], p1[10], p1[11], p1[12], p1[13], p1[14], p1[15]);
#pragma unroll
                for (int db = 0; db < 2; ++db)
#pragma unroll
                    for (int s = 0; s < 4; ++s) { const LAS unsigned char* vp = Bc + AT_KB + ((32 * db + r32) * AT_VS + 16 * s + 4 * hi) * 2;
                        const u32x2 v0 = *(const LAS u32x2*)vp, v1 = *(const LAS u32x2*)(vp + 16);
                        o[qq][db] = MFMA32(__builtin_bit_cast(bf16x8, (u32x4){v0.x, v0.y, v1.x, v1.y}), pf[s], o[qq][db]); }
                asm volatile("" ::: "memory"); __builtin_amdgcn_sched_barrier(0);
            }
            if (t + 1 < 68) AT_STORE((t + 1) & 1);
            __syncthreads();
        }
#undef AT_ROW0
#undef AT_LOAD
#undef AT_STORE
#pragma unroll
        for (int qq = 0; qq < 2; ++qq) {
            const float ltot = lrun[qq] + __shfl_xor(lrun[qq], 32), rl = 1.0f / ltot;
            const size_t qrow = (size_t)b * SEQ + qb * 512 + qq * 256 + wave * 32 + r32;
            bf16* op = MIX + qrow * 1024 + 512 + h * 64 + 4 * hi;
#pragma unroll
            for (int db = 0; db < 2; ++db)
#pragma unroll
                for (int g4 = 0; g4 < 4; ++g4) { u32x2 w; w.x = pk2(o[qq][db][4 * g4] * rl, o[qq][db][4 * g4 + 1] * rl); w.y = pk2(o[qq][db][4 * g4 + 2] * rl, o[qq][db][4 * g4 + 3] * rl);
                    *(u32x2*)(op + 32 * db + 8 * g4) = w; }
        }
    }
    __builtin_amdgcn_s_setprio(0);
}

#define XB_TMO      128
#define XB_XCNT(j)  (256  + 64 * (j))
#define XB_XSUB(j)  (1280 + 64 * (j))
#define XB_XGEN(j)  (2304 + 64 * (j))
#define XB_TOP      3328
#define XB_TOPGEN   3392
#define XCD_BAR_WORDS 3456
#define XB_SPIN_CAP (1u << 18)

__device__ __forceinline__ unsigned xb_ld(unsigned* p)              { return __hip_atomic_load(p, __ATOMIC_RELAXED, __HIP_MEMORY_SCOPE_AGENT); }
__device__ __forceinline__ unsigned xb_add(unsigned* p, unsigned v) { return __hip_atomic_fetch_add(p, v, __ATOMIC_RELAXED, __HIP_MEMORY_SCOPE_AGENT); }
__device__ __forceinline__ unsigned xb_xcc_id() { return (unsigned)__builtin_amdgcn_s_getreg((3 << 11) | 20) & 0xFu; }
#define XB_SPIN(cond, bar) do { unsigned _sp = 0; while (cond) { __builtin_amdgcn_s_sleep(1); \
    if ((++_sp & 255u) == 0u) { if (xb_ld(&(bar)[XB_TMO])) break; if (_sp > XB_SPIN_CAP) { atomicAdd(&(bar)[XB_TMO], 1u); break; } } } } while (0)

struct XcdBarrier {
    unsigned* bar; unsigned x;
    volatile LAS unsigned* st;
};

__device__ __forceinline__ XcdBarrier xcd_barrier_post(unsigned* bar, volatile LAS unsigned* st) {
    XcdBarrier b; b.bar = bar; b.x = xb_xcc_id(); b.st = st;
    if (threadIdx.x == 0) (void)xb_add(&bar[XB_XCNT(b.x)], 1u);
    return b;
}
__device__ __forceinline__ void xcd_barrier_complete(unsigned* bar, unsigned x, unsigned& nloc, unsigned& nx) {
    const unsigned G = gridDim.x * gridDim.y * gridDim.z;
    unsigned sum, cnt, mine, sp = 0u;
    for (;;) {
        sum = 0u; cnt = 0u; mine = 0u;
#pragma unroll
        for (unsigned j = 0; j < 16; ++j) { const unsigned c = xb_ld(&bar[XB_XCNT(j)]); sum += c; cnt += (c > 0u) ? 1u : 0u; mine = (j == x) ? c : mine; }
        if (sum == G) break;
        __builtin_amdgcn_s_sleep(1);
        if ((++sp & 255u) == 0u) { if (xb_ld(&bar[XB_TMO])) break; if (sp > XB_SPIN_CAP) { atomicAdd(&bar[XB_TMO], 1u); break; } }
    }
    nloc = mine > 0u ? mine : 1u; nx = cnt > 0u ? cnt : 1u;
}

__device__ __forceinline__ void xcd_barrier(const XcdBarrier& b) {
    asm volatile("s_waitcnt vmcnt(0)" ::: "memory");
    __syncthreads();
    if (threadIdx.x == 0) {
        unsigned* bar = b.bar;
        __builtin_amdgcn_s_waitcnt(0);
        unsigned nloc = b.st[0], nx = b.st[1];
        if (nloc == 0u) { xcd_barrier_complete(bar, b.x, nloc, nx); b.st[0] = nloc; b.st[1] = nx; }
        const unsigned old = xb_add(&bar[XB_XSUB(b.x)], 1u);
        const unsigned gen = old / nloc;
        if (old + 1u == (gen + 1u) * nloc) {
            __builtin_amdgcn_fence(__ATOMIC_RELEASE, "agent");
            asm volatile("s_waitcnt vmcnt(0)" ::: "memory");
            const unsigned og = xb_add(&bar[XB_TOP], 1u);
            const unsigned tg = og / nx;
            if (og + 1u == (tg + 1u) * nx) xb_add(&bar[XB_TOPGEN], 1u);
            else XB_SPIN(xb_ld(&bar[XB_TOPGEN]) == tg, bar);
            __builtin_amdgcn_fence(__ATOMIC_ACQUIRE, "agent");
            xb_add(&bar[XB_XGEN(b.x)], 1u);
            asm volatile("s_waitcnt vmcnt(0)" ::: "memory");
        } else {
            XB_SPIN(xb_ld(&bar[XB_XGEN(b.x)]) == gen, bar);
            __builtin_amdgcn_fence(__ATOMIC_ACQUIRE, "agent");
            asm volatile("s_waitcnt vmcnt(0)" ::: "memory");
        }
    }
    __syncthreads();
}

#ifndef RES_ALIGN
#define RES_ALIGN true
#endif
#ifndef GEMM_SP2
#define GEMM_SP2 false
#endif
__global__ void __launch_bounds__(512, 2) hymba_fwd(Args args) {
    extern __shared__ __attribute__((aligned(16))) unsigned char lds_raw[];
    LAS unsigned char* lds = (LAS unsigned char*)lds_raw;
    cg::grid_group grid = cg::this_grid();
    const int tid = threadIdx.x, lane = tid & 63, wave = __builtin_amdgcn_readfirstlane(tid >> 6);
    const int G = gridDim.x, bx = blockIdx.x, vcu = (G % 8 == 0) ? (bx % 8) * (G / 8) + bx / 8 : bx;
    const int gw = bx * 8 + wave, NGW = G * 8;
    unsigned char* ws = args.ws;
    const int lo = args.ph_lo, hi = args.ph_hi;
    const float* MOD = (const float*)(ws + WS_MOD);
    volatile LAS unsigned* bst = (volatile LAS unsigned*)(lds + LDS_BST);
    if (tid < 2) bst[tid] = 0u;
    __syncthreads();
    const XcdBarrier xbar = xcd_barrier_post((unsigned*)(ws + WS_BAR), bst);
    bf16* XN = (bf16*)(ws + WS_A); bf16* HB = (bf16*)(ws + WS_B); bf16* X1 = (bf16*)(ws + WS_C);
#ifndef PHMASK
#define PHMASK 0xFFFF
#endif
#define IN(k) (((PHMASK >> (k)) & 1) && lo <= (k) && (k) < hi)
#define GSYNC(k) do { xcd_barrier(xbar); } while (0)
#if defined(PROBE_TA)
#define STAMP(i) do { if (bx == 0 && tid == 0) ((unsigned long long*)(ws + 480 * KiB))[i] = __builtin_amdgcn_s_memrealtime(); } while (0)
#else
#define STAMP(i) do { } while (0)
#endif
#define SEAM(k) do { if (IN(k) && IN((k) + 1)) GSYNC(k); STAMP((k) + 1); } while (0)
#define PH_BEGIN(k) if (IN(k)) for (int rep_ = 0; rep_ < ((k) == PROBE_PHASE ? 2 : 1); ++rep_) { if (rep_) xcd_barrier(xbar);
#define PH_END(k) } SEAM(k)
    STAMP(0);
    if (args.ph_lo < 0) grid.sync();
    if (PROBE_PHASE == 200) { for (int r3 = 0; r3 < 16; ++r3) xcd_barrier(xbar); }
    PH_BEGIN(0) { phase0(args, lds, gw, NGW, tid, lane, wave); } PH_END(0);
    PH_BEGIN(1) { norm_rows<false>(args.in[0], args.in[2], MTOT, args.in[6], MOD, 0, XN, gw, NGW, lane); } PH_END(1);
    PH_BEGIN(2) { pg8::Gemm g{XN, (const bf16*)(ws + WS_W1A), MTOT, 2 * DFF, D}; pg8::StaticOrder S; S.init(MTOT, 2 * DFF, G, bx);
        pg8::EpiSwiglu E{HB, DFF}; pg8::gemm_phase<pg8::EpiSwiglu, pg8::StaticOrder, true, GEMM_SP2>(lds, g, S, E); } PH_END(2);
    PH_BEGIN(3) {
        { pg8::Gemm g{HB, (const bf16*)(ws + WS_W1B), NLAT, D, DFF}; pg8::StaticOrder S; S.init(NLAT, D, G, bx);
          pg8::EpiRes<false, true> E{args.in[0], args.in[2], X1, MOD, 2, 0.5f}; pg8::gemm_phase<pg8::EpiRes<false, true>, pg8::StaticOrder, RES_ALIGN, GEMM_SP2>(lds, g, S, E); }
        { pg8::Gemm g{HB, (const bf16*)(ws + WS_W1B), MTOT, D, DFF, DFF}; pg8::CtxSplitOrder S{G, (bx + G / 2) % G};
          pg8::EpiResCtx E{args.in[2], X1, (float*)args.out, MOD, 2, 0.5f}; pg8::gemm_phase<pg8::EpiResCtx, pg8::CtxSplitOrder, true, GEMM_SP2>(lds, g, S, E); }
    } PH_END(3);
    PH_BEGIN(4) { norm_rows<true>(X1, X1 + (size_t)NLAT * D, MTOT, args.in[9], MOD, 3, XN, gw, NGW, lane, (const float*)args.out); } PH_END(4);
    PH_BEGIN(5) { pg8::Gemm g{XN, (const bf16*)(ws + WS_WIN), MTOT, 2816, D}; pg8::StaticOrder S; S.init(MTOT, 2816, G, bx);
        pg8::EpiSplit E{(bf16*)(ws + WS_Z), (bf16*)(ws + WS_XBCR), (bf16*)(ws + WS_CQ), (bf16*)(ws + WS_CKV), (bf16*)(ws + WS_MISC)};
        pg8::gemm_phase<pg8::EpiSplit, pg8::StaticOrder, true, GEMM_SP2>(lds, g, S, E); } PH_END(5);
    PH_BEGIN(6) { phase6(args, lds, G, bx, tid, lane, wave); } PH_END(6);
    PH_BEGIN(7) {
        unsigned char* ob = (unsigned char*)args.out;
        { pg8::Gemm g{(const bf16*)(ws + WS_CQ), (const bf16*)(ws + WS_WUQ), NLAT, 768, 768}; pg8::StaticOrder S; S.init(NLAT, 768, G, bx);
          pg8::EpiScale E{(bf16*)(ob + OUT_Q), 768, (const float*)(ws + WS_RSTDQ), nullptr}; pg8::gemm_phase<pg8::EpiScale, pg8::StaticOrder, true, GEMM_SP2>(lds, g, S, E); }
        { pg8::Gemm g{(const bf16*)(ws + WS_CKV), (const bf16*)(ws + WS_WK), MTOT, 512, 256}; pg8::StaticOrder S; S.init(MTOT, 512, G, (bx + 128) % G);
          pg8::EpiScale E{(bf16*)(ob + OUT_KN), 512, (const float*)(ws + WS_RSTDKV), nullptr}; pg8::gemm_phase<pg8::EpiScale, pg8::StaticOrder, true, GEMM_SP2>(lds, g, S, E); }
        { pg8::Gemm g{(const bf16*)(ws + WS_WV), (const bf16*)(ws + WS_CKV), 512, MTOT, 256}; pg8::StaticOrder S; S.init(512, MTOT, G, (bx + 112) % G);
          pg8::EpiScale E{(bf16*)(ob + OUT_VT), MTOT, nullptr, (const float*)(ws + WS_RSTDKV)}; pg8::gemm_phase<pg8::EpiScale, pg8::StaticOrder, true, GEMM_SP2>(lds, g, S, E); }
        phase8(args, lds, G, bx, tid, lane, wave);
    } PH_END(7);
    PH_BEGIN(9) { phase9(args, G, bx, tid); } PH_END(9);
    PH_BEGIN(10) {
#ifndef NO_SSD
        for (int r2 = 0; r2 < (PROBE_PHASE == 100 ? 2 : 1); ++r2) phase10_ssd(args, lds, G, bx, tid, lane, wave);
#endif

        STAMP(17);
#ifndef NO_ATTN
        for (int r2 = 0; r2 < (PROBE_PHASE == 101 ? 2 : 1); ++r2) phase10_attn(args, lds, G, vcu, tid, lane, wave);
#endif
    } PH_END(10);
    PH_BEGIN(11) { pg8::Gemm g{(const bf16*)(ws + WS_MIX), (const bf16*)(ws + WS_WOUT), NLAT, D, D}; pg8::StaticOrder S; S.init(NLAT, D, G, bx);
        pg8::EpiRes<true, true> E{X1, X1, X1, MOD, 5, 1.0f}; pg8::gemm_phase<pg8::EpiRes<true, true>, pg8::StaticOrder, RES_ALIGN, GEMM_SP2>(lds, g, S, E); } PH_END(11);
    PH_BEGIN(12) { norm_rows<true>(X1, X1, NLAT, args.in[22], MOD, 6, XN, gw, NGW, lane); } PH_END(12);
    PH_BEGIN(13) { pg8::Gemm g{XN, (const bf16*)(ws + WS_W2A), NLAT, 2 * DFF, D}; pg8::StaticOrder S; S.init(NLAT, 2 * DFF, G, bx);
        pg8::EpiSwiglu E{HB, DFF}; pg8::gemm_phase<pg8::EpiSwiglu, pg8::StaticOrder, true, GEMM_SP2>(lds, g, S, E); } PH_END(13);
    PH_BEGIN(14) { pg8::Gemm g{HB, (const bf16*)(ws + WS_W2B), NLAT, D, DFF}; pg8::StaticOrder S; S.init(NLAT, D, G, bx);
        pg8::EpiRes<true, false> E{X1, X1, args.out, MOD, 8, 0.5f}; pg8::gemm_phase<pg8::EpiRes<true, false>, pg8::StaticOrder, RES_ALIGN, GEMM_SP2>(lds, g, S, E); } PH_END(14);
    PH_BEGIN(15) { final_norm_rows(args.out, args.in[25], gw, NGW, lane); } PH_END(15);
#if defined(PROBE_TA)
    xcd_barrier(xbar);
    if (bx == 0) {
        const unsigned long long* TS = (const unsigned long long*)(ws + 480 * KiB);
#ifdef PROBE_A1
        const int a0 = PROBE_TA, b0 = PROBE_TB;
#undef PROBE_TA
#undef PROBE_TB
#define PROBE_TA (PROBE_A1 - 1)
#define PROBE_TB (PROBE_B1 - 1)
#else
        const int a0 = (PROBE_TA == 9) ? 8 : (PROBE_TA == 16 ? 10 : PROBE_TA), b0 = (PROBE_TB == 9) ? 8 : PROBE_TB;
#endif
        const float ta = (float)(__hip_atomic_load(TS + PROBE_TA + 1, __ATOMIC_RELAXED, __HIP_MEMORY_SCOPE_AGENT) - __hip_atomic_load(TS + a0, __ATOMIC_RELAXED, __HIP_MEMORY_SCOPE_AGENT)) * 0.01f;
        const float tb = (float)(__hip_atomic_load(TS + PROBE_TB + 1, __ATOMIC_RELAXED, __HIP_MEMORY_SCOPE_AGENT) - __hip_atomic_load(TS + b0, __ATOMIC_RELAXED, __HIP_MEMORY_SCOPE_AGENT)) * 0.01f;
        for (int i = tid; i < 1024 * 1024; i += 512) args.out[i] += ta * (1.f / 2000.f);
        if (tid == 0) args.out[2000 * 1024] += tb * (1.f / 500.f);
    }
#endif
#undef IN
#undef SEAM
}

#ifndef N_LAUNCHES
#define N_LAUNCHES 1
#endif
extern "C" void kernel_launch(void* const* d_in, const int* in_sizes, int n_in, void* d_out, int out_size, void* d_ws, size_t ws_size, hipStream_t stream) {
    static int grid = 0;
    if (grid == 0) {
        if (n_in != 26 || out_size != NLAT * D || ws_size < WS_END) { fprintf(stderr, "kernel_launch: unexpected shapes (n_in %d out %d ws %zu)\n", n_in, out_size, ws_size); grid = -1; return; }
        int dev = 0, cus = 0, per_cu = 0;
        (void)hipGetDevice(&dev); (void)hipDeviceGetAttribute(&cus, hipDeviceAttributeMultiprocessorCount, dev);
        if (hipFuncSetAttribute((const void*)hymba_fwd, hipFuncAttributeMaxDynamicSharedMemorySize, LDS_BYTES) != hipSuccess) { fprintf(stderr, "kernel_launch: hipFuncSetAttribute failed\n"); grid = -1; return; }
        if (hipOccupancyMaxActiveBlocksPerMultiprocessor(&per_cu, (const void*)hymba_fwd, 512, LDS_BYTES) != hipSuccess || per_cu < 1) { fprintf(stderr, "kernel_launch: occupancy query failed (%d)\n", per_cu); grid = -1; (void)hipGetLastError(); return; }
        grid = cus;
    }
    if (grid < 0) return;
    (void)hipMemsetAsync((char*)d_ws + WS_BAR, 0, 16 * KiB, stream);
    Args a{};
    for (int i = 0; i < 26; ++i) a.in[i] = (const float*)d_in[i];
    a.out = (float*)d_out; a.ws = (unsigned char*)d_ws;
    for (int li = 0; li < N_LAUNCHES; ++li) {
        a.ph_lo = (N_LAUNCHES == 1) ? 0 : li; a.ph_hi = (N_LAUNCHES == 1) ? NPHASE : li + 1;
        void* kargs[] = {&a};
        hipError_t e = hipLaunchCooperativeKernel((const void*)hymba_fwd, dim3(grid), dim3(512), kargs, LDS_BYTES, stream);
        if (e != hipSuccess) { fprintf(stderr, "kernel_launch: cooperative launch %d failed: %s (grid %d)\n", li, hipGetErrorString(e), grid); break; }
    }
}
```

```cpp
#include <hip/hip_runtime.h>
#include <hip/hip_cooperative_groups.h>
#include <cstdio>
#include <cstdint>
namespace cg = cooperative_groups;
namespace pg8 {
#define PG8_LAS __attribute__((address_space(3)))
typedef unsigned short bf16_t;
typedef short bf16x8 __attribute__((ext_vector_type(8)));
typedef float f32x4 __attribute__((ext_vector_type(4)));
typedef unsigned u32x4 __attribute__((ext_vector_type(4)));
constexpr int BM = 256, BK = 64, HALF = 128, HTB = HALF * BK * 2  , STAGE_BYTES = 8 * HTB, NXCD = 8, WGM = 8;

__host__ __device__ __forceinline__ int lds_byte(int r, int c) { const int st = (r >> 4) * 2 + (c >> 5), rr = r & 15, cc = c & 31, ob = rr * 64 + cc * 2; return st * 1024 + (ob ^ (((ob >> 9) & 1) << 5)); }
__host__ __device__ __forceinline__ void stage_rc(int b, int& R, int& C) { const int st = b / 1024, sb = b % 1024, swz = sb ^ (((sb >> 9) & 1) << 5); R = (st >> 1) * 16 + swz / 64; C = (st & 1) * 32 + (swz % 64) / 2; }
__host__ __device__ __forceinline__ int perm32(int rho) { const int n = rho >> 4, i = rho & 15; return 8 * (i >> 2) + 4 * n + (i & 3); }

struct Unit { int pm, pn, ks; };
struct Gemm { const bf16_t* A; const bf16_t* Bt; int M, N, K; int ld; };

struct StaticOrder {
    int nM, nN, nwg, G, c;
    __host__ __device__ void init(int M, int N, int G_, int c_) { nM = M / BM; nN = N / BM; nwg = nM * nN; G = G_; c = c_; }
    __host__ __device__ bool next(int i, Unit& u) const {
        const long L = (long)i * G + c; if (L >= nwg) return false;
        int wgid = (int)L; { const int q = nwg / NXCD, r = nwg % NXCD, xcd = wgid % NXCD, off = wgid / NXCD; wgid = (xcd < r ? xcd * (q + 1) : r * (q + 1) + (xcd - r) * q) + off; }
        const int nig = WGM * nN, gid = wgid / nig, fm = gid * WGM, gsz = (nM - fm) < WGM ? (nM - fm) : WGM;
        u.pm = fm + ((wgid % nig) % gsz); u.pn = (wgid % nig) / gsz; u.ks = 0; return true;
    }
    __device__ __forceinline__ size_t koff(const Unit&) const { return 0; }
    __device__ __forceinline__ int ntiles(const Unit&, int nt) const { return nt; }
    __device__ __forceinline__ void a_ready(const Unit&) const {}
    __device__ __forceinline__ void done(const Unit&) const {}
};

__device__ __forceinline__ unsigned cvt_pk_bf16(float lo, float hi) { unsigned r; asm volatile("v_cvt_pk_bf16_f32 %0, %1, %2" : "=v"(r) : "v"(lo), "v"(hi)); return r; }
typedef float f32x2 __attribute__((ext_vector_type(2)));
__device__ __forceinline__ f32x2 gelu_pk(f32x2 v) {
    const f32x2 av = __builtin_elementwise_abs(v), d = av * 0.2316418882f + 1.0f;
    f32x2 t; t.x = __builtin_amdgcn_rcpf(d.x); t.y = __builtin_amdgcn_rcpf(d.y);
    f32x2 q = t * 0.5307027145f + (-0.7265760135f); q = q * t + 0.7107068705f; q = q * t + (-0.142248368f); q = q * t + 0.127414796f; q = q * t;
    const f32x2 s = (v * v) * (-0.72134752044f);
    f32x2 e; e.x = __builtin_amdgcn_exp2f(s.x); e.y = __builtin_amdgcn_exp2f(s.y);
    const f32x2 m = v * (q * e), r = v - m;
    f32x2 o; o.x = v.x < 0.f ? m.x : r.x; o.y = v.y < 0.f ? m.y : r.y; return o;
}

template <int ACT  > struct EpiBf16 {
    static constexpr bool PERM = true, AFTER_DRAIN = false; static_assert(ACT == 0 || ACT == 1, "EpiBf16: ACT is 0 (none) or 1 (gelu_pk)");
    bf16_t* O; int ldc; const float* bias; int split_cols; size_t split_stride; float scale0;
    __device__ __forceinline__ void operator()(const f32x4 (&acc)[2][2][4][2], const Unit& u, int wr, int wc, int fr, int fq) const {
        const int row0 = u.pm * BM + wr * 64 + fr; int colt = u.pn * BM; bf16_t* base = O;
        float sc = 1.f; if (split_cols) { const int t = colt / split_cols; base += (size_t)t * split_stride; colt -= t * split_cols; if (t == 0) sc = scale0; }
        const int col0 = colt + wc * 32 + 8 * fq, bcol0 = u.pn * BM + wc * 32 + 8 * fq;
        f32x4 bv[2][2];
#pragma unroll
        for (int bj = 0; bj < 2; ++bj)
#pragma unroll
            for (int n = 0; n < 2; ++n) bv[bj][n] = bias ? *(const f32x4*)(bias + bcol0 + bj * HALF + 4 * n) : (f32x4){0.f, 0.f, 0.f, 0.f};
#pragma unroll
        for (int ai = 0; ai < 2; ++ai)
#pragma unroll
            for (int m = 0; m < 4; ++m) { bf16_t* rowp = base + (size_t)(row0 + ai * HALF + m * 16) * ldc + col0;
#pragma unroll
                for (int bj = 0; bj < 2; ++bj) { f32x4 v0 = acc[ai][bj][m][0] + bv[bj][0], v1 = acc[ai][bj][m][1] + bv[bj][1];
                    if (ACT == 1) { f32x2 a = gelu_pk((f32x2){v0[0], v0[1]}), b = gelu_pk((f32x2){v0[2], v0[3]}), c = gelu_pk((f32x2){v1[0], v1[1]}), d = gelu_pk((f32x2){v1[2], v1[3]});
                        v0 = (f32x4){a.x, a.y, b.x, b.y}; v1 = (f32x4){c.x, c.y, d.x, d.y}; }
                    v0 = v0 * sc; v1 = v1 * sc; u32x4 w; w.x = cvt_pk_bf16(v0[0], v0[1]); w.y = cvt_pk_bf16(v0[2], v0[3]); w.z = cvt_pk_bf16(v1[0], v1[1]); w.w = cvt_pk_bf16(v1[2], v1[3]);
                    *(u32x4*)(rowp + bj * HALF) = w; } }
    }
};
template <class Epi, class Sched, bool ALIGN_EPI = false, bool SP2 = false>
__device__ __forceinline__ void gemm_phase(PG8_LAS unsigned char* lds, const Gemm g, const Sched& S, const Epi& E) {
    const int tid = threadIdx.x, wid = __builtin_amdgcn_readfirstlane(tid >> 6), lane = tid & 63, wr = wid >> 2, wc = wid & 3, fr = lane & 15, fq = lane >> 4;
    const int K = g.K, LD = g.ld ? g.ld : g.K; int nt = K / BK;
    unsigned voffA[2], voffB[2];
#pragma unroll
    for (int i = 0; i < 2; ++i) { int R, C; stage_rc(tid * 16 + i * 8192, R, C); const int Rb = Epi::PERM ? ((R & ~31) + perm32(R & 31)) : R;
        voffA[i] = (unsigned)(R * LD + C) * 2u; voffB[i] = (unsigned)(Rb * LD + C) * 2u; }
    const size_t kstep = (size_t)(BK * 2);
    const size_t hstep = (size_t)HALF * LD * 2;
    const size_t tstep = 2 * hstep;
    const unsigned ldsw = (unsigned)wid * 1024u;
    const int aoff = lds_byte(wr * 64 + fr, fq * 8), boff = lds_byte(wc * 32 + fr, fq * 8);
#define PG8_SA(b, h) (((b) * 2 + (h)) * HTB)
#define PG8_SB(b, h) ((4 + (b) * 2 + (h)) * HTB)
#define PG8_STAGE(bufoff, gbase, voff) do { _Pragma("unroll") for (int _i = 0; _i < 2; ++_i) \
        __builtin_amdgcn_global_load_lds((const unsigned*)((const char*)(gbase) + (voff)[_i]), (PG8_LAS unsigned*)(lds + (bufoff) + ldsw + _i * 8192), 16, 0, 0); } while (0)
#define PG8_LDA(dst, b, h) do { _Pragma("unroll") for (int m = 0; m < 4; ++m) _Pragma("unroll") for (int k = 0; k < 2; ++k) dst[m][k] = *(const PG8_LAS bf16x8*)(lds + PG8_SA(b, h) + aoff + m * 2048 + k * 1024); } while (0)
#define PG8_LDB(dst, b, h) do { _Pragma("unroll") for (int n = 0; n < 2; ++n) _Pragma("unroll") for (int k = 0; k < 2; ++k) dst[n][k] = *(const PG8_LAS bf16x8*)(lds + PG8_SB(b, h) + boff + n * 2048 + k * 1024); } while (0)
#define PG8_MMA(ai, bj, At, Bt) do { __builtin_amdgcn_s_setprio(1); _Pragma("unroll") for (int m = 0; m < 4; ++m) _Pragma("unroll") for (int n = 0; n < 2; ++n) _Pragma("unroll") for (int k = 0; k < 2; ++k) \
        acc[ai][bj][m][n] = __builtin_amdgcn_mfma_f32_16x16x32_bf16(Bt[n][k], At[m][k], acc[ai][bj][m][n], 0, 0, 0); __builtin_amdgcn_s_setprio(0); } while (0)
#define PG8_WAIT_V(n) asm volatile("s_waitcnt vmcnt(" #n ")" ::: "memory")
#define PG8_WAIT_L(n) asm volatile("s_waitcnt lgkmcnt(" #n ")" ::: "memory")
#define PG8_BAR __builtin_amdgcn_s_barrier()
#define PG8_SCHED __builtin_amdgcn_sched_barrier(0)
    Unit cur, nxt; int ui = 0;
    if (!S.next(0, cur)) return;
    f32x4 acc[2][2][4][2];
#pragma unroll
    for (int a = 0; a < 2; ++a)
#pragma unroll
        for (int b = 0; b < 2; ++b)
#pragma unroll
            for (int m = 0; m < 4; ++m)
#pragma unroll
                for (int n = 0; n < 2; ++n) acc[a][b][m][n] = (f32x4){0.f, 0.f, 0.f, 0.f};
    bf16x8 At[4][2], B0[2][2], B1[2][2];
    const char* cA = (const char*)g.A + (size_t)cur.pm * tstep + S.koff(cur); const char* cB = (const char*)g.Bt + (size_t)cur.pn * tstep + S.koff(cur);
    S.a_ready(cur);
    if constexpr (SP2) {
        PG8_STAGE(PG8_SB(0, 0), cB, voffB); PG8_STAGE(PG8_SB(0, 1), cB + hstep, voffB); PG8_STAGE(PG8_SA(0, 0), cA, voffA); PG8_STAGE(PG8_SA(0, 1), cA + hstep, voffA);
        if (wr == 1) PG8_BAR;
        PG8_WAIT_V(2); PG8_BAR;
        PG8_STAGE(PG8_SB(1, 0), cB + kstep, voffB); PG8_STAGE(PG8_SA(1, 0), cA + kstep, voffA); PG8_STAGE(PG8_SB(1, 1), cB + hstep + kstep, voffB);
        PG8_WAIT_V(6); PG8_BAR;
    } else {
        PG8_STAGE(PG8_SB(0, 0), cB, voffB); PG8_STAGE(PG8_SA(0, 0), cA, voffA); PG8_STAGE(PG8_SB(0, 1), cB + hstep, voffB); PG8_STAGE(PG8_SA(0, 1), cA + hstep, voffA);
        if (wr == 1) PG8_BAR;
        PG8_WAIT_V(4); PG8_BAR;
        PG8_STAGE(PG8_SB(1, 0), cB + kstep, voffB); PG8_STAGE(PG8_SA(1, 0), cA + kstep, voffA); PG8_STAGE(PG8_SB(1, 1), cB + hstep + kstep, voffB);
        PG8_WAIT_V(6); PG8_BAR;
    }
    for (;;) {
        const bool has_next = S.next(ui + 1, nxt);
        const char* nA = has_next ? (const char*)g.A + (size_t)nxt.pm * tstep + S.koff(nxt) : cA; const char* nB = has_next ? (const char*)g.Bt + (size_t)nxt.pn * tstep + S.koff(nxt) : cB;
        nt = S.ntiles(cur, K / BK);
        for (int t = 0; t < nt; t += 2) {
            const bool last = (t == nt - 2);
            const char* a1 = cA + (size_t)(t + 1) * kstep;
            const char* a2 = last ? nA : cA + (size_t)(t + 2) * kstep; const char* b2 = last ? nB : cB + (size_t)(t + 2) * kstep;
            const char* a3 = a2 + kstep; const char* b3 = b2 + kstep;
            if (last && has_next) S.a_ready(nxt);
            if constexpr (SP2) {
            PG8_LDB(B0, 0, 0); PG8_LDB(B1, 0, 1); PG8_SCHED; PG8_LDA(At, 0, 0); PG8_STAGE(PG8_SA(1, 1), a1 + hstep, voffA);
            PG8_WAIT_V(8); PG8_WAIT_L(0); PG8_BAR; PG8_MMA(0, 0, At, B0); PG8_MMA(0, 1, At, B1); PG8_BAR; PG8_SCHED;
            PG8_LDA(At, 0, 1); PG8_STAGE(PG8_SB(0, 0), b2, voffB); PG8_STAGE(PG8_SB(0, 1), b2 + hstep, voffB); PG8_STAGE(PG8_SA(0, 0), a2, voffA);
            PG8_WAIT_V(8); PG8_WAIT_L(0); PG8_BAR; PG8_MMA(1, 0, At, B0); PG8_MMA(1, 1, At, B1); PG8_BAR; PG8_SCHED;
            PG8_LDB(B0, 1, 0); PG8_LDB(B1, 1, 1); PG8_SCHED; PG8_LDA(At, 1, 0); PG8_STAGE(PG8_SA(0, 1), a2 + hstep, voffA);
            PG8_WAIT_V(8); PG8_WAIT_L(0); PG8_BAR; PG8_MMA(0, 0, At, B0); PG8_MMA(0, 1, At, B1); PG8_BAR; PG8_SCHED;
            PG8_LDA(At, 1, 1); PG8_STAGE(PG8_SB(1, 0), b3, voffB); PG8_STAGE(PG8_SB(1, 1), b3 + hstep, voffB); PG8_STAGE(PG8_SA(1, 0), a3, voffA);
            PG8_WAIT_V(8); PG8_WAIT_L(0); PG8_BAR; PG8_MMA(1, 0, At, B0); PG8_MMA(1, 1, At, B1); PG8_BAR; PG8_SCHED;
            } else {
            PG8_LDB(B0, 0, 0); PG8_SCHED; PG8_LDA(At, 0, 0); PG8_STAGE(PG8_SA(1, 1), a1 + hstep, voffA);
            PG8_WAIT_L(8); PG8_BAR; PG8_WAIT_L(0); PG8_MMA(0, 0, At, B0); PG8_BAR; PG8_SCHED;
            PG8_LDB(B1, 0, 1); PG8_STAGE(PG8_SB(0, 0), b2, voffB);
            PG8_BAR; PG8_WAIT_L(0); PG8_MMA(0, 1, At, B1); PG8_BAR;
            PG8_LDA(At, 0, 1); PG8_STAGE(PG8_SA(0, 0), a2, voffA);
            PG8_BAR; PG8_WAIT_L(0); PG8_MMA(1, 0, At, B0); PG8_BAR; PG8_SCHED;
            PG8_STAGE(PG8_SB(0, 1), b2 + hstep, voffB);
            PG8_WAIT_V(6); PG8_BAR; PG8_MMA(1, 1, At, B1); PG8_BAR;
            PG8_LDB(B0, 1, 0); PG8_SCHED; PG8_LDA(At, 1, 0); PG8_STAGE(PG8_SA(0, 1), a2 + hstep, voffA);
            PG8_WAIT_L(8); PG8_BAR; PG8_WAIT_L(0); PG8_MMA(0, 0, At, B0); PG8_BAR; PG8_SCHED;
            PG8_LDB(B1, 1, 1); PG8_STAGE(PG8_SB(1, 0), b3, voffB);
            PG8_BAR; PG8_WAIT_L(0); PG8_MMA(0, 1, At, B1); PG8_BAR;
            PG8_LDA(At, 1, 1); PG8_STAGE(PG8_SA(1, 0), a3, voffA);
            PG8_BAR; PG8_WAIT_L(0); PG8_MMA(1, 0, At, B0); PG8_BAR; PG8_SCHED;
            PG8_STAGE(PG8_SB(1, 1), b3 + hstep, voffB);
            PG8_WAIT_V(6); PG8_BAR; PG8_MMA(1, 1, At, B1); PG8_BAR;
            }
        }
        if constexpr (ALIGN_EPI) { if (wr == 0) PG8_BAR; }
        if constexpr (!Epi::AFTER_DRAIN) { E(acc, cur, wr, wc, fr, fq); S.done(cur); }
        if (!has_next) break;
#pragma unroll
        for (int a = 0; a < 2; ++a)
#pragma unroll
            for (int b = 0; b < 2; ++b)
#pragma unroll
                for (int m = 0; m < 4; ++m)
#pragma unroll
                    for (int n = 0; n < 2; ++n) acc[a][b][m][n] = (f32x4){0.f, 0.f, 0.f, 0.f};
        cur = nxt; cA = nA; cB = nB; ++ui;
        if constexpr (ALIGN_EPI) { if (wr == 1) PG8_BAR; }
    }
    PG8_WAIT_V(0);
    if constexpr (!ALIGN_EPI) { if (wr == 0) PG8_BAR; }
    PG8_BAR;
    if constexpr (Epi::AFTER_DRAIN) { E.fused(acc, cur, wr, wc, fr, fq, lds, wid, lane); S.done(cur); }
#undef PG8_SA
#undef PG8_SB
#undef PG8_STAGE
#undef PG8_LDA
#undef PG8_LDB
#undef PG8_MMA
#undef PG8_WAIT_V
#undef PG8_WAIT_L
#undef PG8_BAR
#undef PG8_SCHED
}
}
#ifndef PROBE_PHASE
#define PROBE_PHASE -1
#endif

#define LAS __attribute__((address_space(3)))
typedef unsigned short bf16;
typedef short bf16x8 __attribute__((ext_vector_type(8)));
typedef float f32x2 __attribute__((ext_vector_type(2)));
typedef float f32x4 __attribute__((ext_vector_type(4)));
typedef float f32x16 __attribute__((ext_vector_type(16)));
typedef unsigned u32x2 __attribute__((ext_vector_type(2)));
typedef unsigned u32x4 __attribute__((ext_vector_type(4)));
typedef __bf16 bf16x2_t __attribute__((ext_vector_type(2)));

constexpr int D = 1024, NB = 8, SEQ = 4096, CTXL = 256, NLAT = NB * SEQ, NCTX = NB * CTXL, MTOT = NLAT + NCTX;
constexpr int DFF = 2816, UL = SEQ + CTXL, NCH = UL / 128;
constexpr float EPS = 1e-6f;
constexpr float QSCALE = 0.10206207261596575f * 1.4426950408889634f;
constexpr int NPHASE = 16;

constexpr size_t MiB = (size_t)1 << 20, KiB = 1024;
constexpr size_t WS_BAR = 1 * MiB, WS_ZERO_BYTES = 1 * MiB + 16 * KiB;
constexpr size_t WS_MOD = 0, WS_ROPE = 384 * KiB, WS_CD = 448 * KiB, WS_RSTDQ = 512 * KiB, WS_RSTDKV = 768 * KiB;
constexpr size_t WS_W1A = 2 * MiB, WS_W1B = 13 * MiB, WS_WIN = 18 * MiB + 512 * KiB, WS_WUQ = 24 * MiB, WS_WK = 25 * MiB + 512 * KiB, WS_WV = 25 * MiB + 768 * KiB,
                 WS_WOUT = 26 * MiB, WS_W2A = 28 * MiB, WS_W2B = 39 * MiB;
constexpr size_t WS_A = 45 * MiB;
constexpr size_t WS_B = 113 * MiB;
constexpr size_t WS_Z = WS_B, WS_XBCR = WS_B + 34 * MiB, WS_CQ = WS_B + 102 * MiB, WS_CKV = WS_B + 153 * MiB, WS_MISC = WS_B + 170 * MiB;
constexpr size_t WS_ST = WS_XBCR, WS_MIX = WS_XBCR, WS_HE = WS_CQ;
constexpr size_t WS_C = 300 * MiB;
constexpr size_t WS_XT = 436 * MiB, WS_BT = 470 * MiB, WS_CROW = 487 * MiB, WS_DT = 504 * MiB, WS_KPE = 506 * MiB + 256 * KiB, WS_END = 512 * MiB;
constexpr size_t WS_BROW = WS_A;
constexpr size_t OUT_Q = 0, OUT_KN = 48 * MiB, OUT_VT = 82 * MiB;
constexpr int LDS_BYTES = 163840, LDS_BST = LDS_BYTES - 64;

__device__ __forceinline__ unsigned pk2(float lo, float hi) { f32x2 v = {lo, hi}; bf16x2_t b = __builtin_convertvector(v, bf16x2_t); return __builtin_bit_cast(unsigned, b); }
__device__ __forceinline__ float bflo(unsigned w) { return __uint_as_float(w << 16); }
__device__ __forceinline__ float bfhi(unsigned w) { return __uint_as_float(w & 0xffff0000u); }
__device__ __forceinline__ float bf2f(bf16 u) { return __uint_as_float((unsigned)u << 16); }
__device__ __forceinline__ float silu_f(float x) { return x * __builtin_amdgcn_rcpf(1.f + __builtin_amdgcn_exp2f(-1.4426950408889634f * x)); }
__device__ __forceinline__ float wave_sum(float v) {
#pragma unroll
    for (int o = 1; o < 64; o <<= 1) v += __shfl_xor(v, o);
    return v;
}
__device__ __forceinline__ float incl_scan(float v, int lane) {
#pragma unroll
    for (int o = 1; o < 64; o <<= 1) { float t = __shfl_up(v, o); if (lane >= o) v += t; }
    return v;
}
#define LDS_FENCE() asm volatile("s_waitcnt lgkmcnt(0)" ::: "memory")
__device__ __forceinline__ int crow(int r, int hi) { return (r & 3) + 8 * (r >> 2) + 4 * hi; }
__device__ __forceinline__ bf16x8 pack8(float a0, float a1, float a2, float a3, float a4, float a5, float a6, float a7) {
    u32x4 w; w.x = pk2(a0, a1); w.y = pk2(a2, a3); w.z = pk2(a4, a5); w.w = pk2(a6, a7); return __builtin_bit_cast(bf16x8, w);
}

struct Args { const float* in[26]; float* out; unsigned char* ws; int ph_lo, ph_hi; };

namespace pg8 {
typedef unsigned u32x2 __attribute__((ext_vector_type(2)));
struct EpiSwiglu {
    static constexpr bool PERM = true, AFTER_DRAIN = false;
    bf16_t* O; int ldc;
    __device__ __forceinline__ void operator()(const f32x4 (&acc)[2][2][4][2], const Unit& u, int wr, int wc, int fr, int fq) const {
        const int row0 = u.pm * BM + wr * 64 + fr, col0 = u.pn * HALF + wc * 32 + 8 * fq;
#pragma unroll
        for (int ai = 0; ai < 2; ++ai)
#pragma unroll
            for (int m = 0; m < 4; ++m) {
                bf16_t* rowp = O + (size_t)(row0 + ai * HALF + m * 16) * ldc + col0;
                const f32x4 g0 = acc[ai][0][m][0], g1 = acc[ai][0][m][1], u0 = acc[ai][1][m][0], u1 = acc[ai][1][m][1];
                u32x4 w;
                w.x = cvt_pk_bf16(silu_f(g0[0]) * u0[0], silu_f(g0[1]) * u0[1]); w.y = cvt_pk_bf16(silu_f(g0[2]) * u0[2], silu_f(g0[3]) * u0[3]);
                w.z = cvt_pk_bf16(silu_f(g1[0]) * u1[0], silu_f(g1[1]) * u1[1]); w.w = cvt_pk_bf16(silu_f(g1[2]) * u1[2], silu_f(g1[3]) * u1[3]);
                *(u32x4*)rowp = w;
            }
    }
};
template <bool BASE_BF16, bool OUT_BF16> struct EpiRes {
    static constexpr bool PERM = true, AFTER_DRAIN = false;
    const void* base_lat; const void* base_ctx; void* out; const float* mod; int kg; float mul;
    __device__ __forceinline__ void ldb(int r, int coff, f32x4& lo, f32x4& hi) const {
        const size_t off = (r < NLAT ? (size_t)r : (size_t)(r - NLAT)) * D + coff; const void* bsel = r < NLAT ? base_lat : base_ctx;
        constexpr bool NT = BASE_BF16 != OUT_BF16;
        if (BASE_BF16) { const u32x4 w = NT ? __builtin_nontemporal_load((const u32x4*)((const bf16_t*)bsel + off)) : *(const u32x4*)((const bf16_t*)bsel + off);
            lo = (f32x4){bflo(w.x), bfhi(w.x), bflo(w.y), bfhi(w.y)}; hi = (f32x4){bflo(w.z), bfhi(w.z), bflo(w.w), bfhi(w.w)}; }
        else { lo = NT ? __builtin_nontemporal_load((const f32x4*)((const float*)bsel + off)) : *(const f32x4*)((const float*)bsel + off);
               hi = NT ? __builtin_nontemporal_load((const f32x4*)((const float*)bsel + off + 4)) : *(const f32x4*)((const float*)bsel + off + 4); }
    }
    __device__ __forceinline__ void operator()(const f32x4 (&acc)[2][2][4][2], const Unit& u, int wr, int wc, int fr, int fq) const {
        const int row0 = u.pm * BM + wr * 64 + fr, col0 = u.pn * BM + wc * 32 + 8 * fq;
        const int bb = u.pm < (NLAT / BM) ? u.pm / (SEQ / BM) : 8;
        const float* gp = mod + bb * 9216 + kg * 1024 + col0;
        f32x4 gv[2][2];
#pragma unroll
        for (int bj = 0; bj < 2; ++bj)
#pragma unroll
            for (int n = 0; n < 2; ++n) gv[bj][n] = *(const f32x4*)(gp + bj * HALF + 4 * n) * mul;
        f32x4 cur[2][2], nxt[2][2];
#pragma unroll
        for (int bj = 0; bj < 2; ++bj) ldb(row0, col0 + bj * HALF, cur[bj][0], cur[bj][1]);
#pragma unroll
        for (int gi = 0; gi < 8; ++gi) {
            const int ai = gi >> 2, m = gi & 3;
            if (gi + 1 < 8) { const int r = row0 + ((gi + 1) >> 2) * HALF + ((gi + 1) & 3) * 16;
#pragma unroll
                for (int bj = 0; bj < 2; ++bj) ldb(r, col0 + bj * HALF, nxt[bj][0], nxt[bj][1]); }
            const size_t ooff = (size_t)(row0 + ai * HALF + m * 16) * D + col0;
#pragma unroll
            for (int bj = 0; bj < 2; ++bj) {
                const f32x4 o0 = cur[bj][0] + gv[bj][0] * acc[ai][bj][m][0], o1 = cur[bj][1] + gv[bj][1] * acc[ai][bj][m][1];
                cur[bj][0] = nxt[bj][0]; cur[bj][1] = nxt[bj][1];
                if (OUT_BF16) { u32x4 w; w.x = cvt_pk_bf16(o0[0], o0[1]); w.y = cvt_pk_bf16(o0[2], o0[3]); w.z = cvt_pk_bf16(o1[0], o1[1]); w.w = cvt_pk_bf16(o1[2], o1[3]); *(u32x4*)((bf16_t*)out + ooff + bj * HALF) = w; }
                else { *(f32x4*)((float*)out + ooff + bj * HALF) = o0; *(f32x4*)((float*)out + ooff + bj * HALF + 4) = o1; }
            }
        }
    }
};
struct EpiSplit {
    static constexpr bool PERM = true, AFTER_DRAIN = false;
    bf16_t *zb, *xbcr, *cq, *ckv, *misc;
    __device__ __forceinline__ void operator()(const f32x4 (&acc)[2][2][4][2], const Unit& u, int wr, int wc, int fr, int fq) const {
        const int pn = u.pn; bf16_t* base; int ld;
        if (pn < 2) { base = zb + pn * 256; ld = 512; } else if (pn < 6) { base = xbcr + (pn - 2) * 256; ld = 1024; } else if (pn < 9) { base = cq + (pn - 6) * 256; ld = 768; }
        else if (pn == 9) { base = ckv; ld = 256; } else { base = misc; ld = 256; }
        const int row0 = u.pm * BM + wr * 64 + fr, col0 = wc * 32 + 8 * fq;
#pragma unroll
        for (int ai = 0; ai < 2; ++ai)
#pragma unroll
            for (int m = 0; m < 4; ++m) {
                bf16_t* rowp = base + (size_t)(row0 + ai * HALF + m * 16) * ld + col0;
#pragma unroll
                for (int bj = 0; bj < 2; ++bj) { const f32x4 v0 = acc[ai][bj][m][0], v1 = acc[ai][bj][m][1];
                    u32x4 w; w.x = cvt_pk_bf16(v0[0], v0[1]); w.y = cvt_pk_bf16(v0[2], v0[3]); w.z = cvt_pk_bf16(v1[0], v1[1]); w.w = cvt_pk_bf16(v1[2], v1[3]);
                    *(u32x4*)(rowp + bj * HALF) = w; }
            }
    }
};
struct EpiScale {
    static constexpr bool PERM = true, AFTER_DRAIN = false;
    bf16_t* O; int ldc; const float* rs; const float* cs;
    __device__ __forceinline__ void operator()(const f32x4 (&acc)[2][2][4][2], const Unit& u, int wr, int wc, int fr, int fq) const {
        const int row0 = u.pm * BM + wr * 64 + fr, col0 = u.pn * BM + wc * 32 + 8 * fq;
        f32x4 cv[2][2];
#pragma unroll
        for (int bj = 0; bj < 2; ++bj)
#pragma unroll
            for (int n = 0; n < 2; ++n) cv[bj][n] = cs ? *(const f32x4*)(cs + col0 + bj * HALF + 4 * n) : (f32x4){1.f, 1.f, 1.f, 1.f};
#pragma unroll
        for (int ai = 0; ai < 2; ++ai)
#pragma unroll
            for (int m = 0; m < 4; ++m) {
                const int r = row0 + ai * HALF + m * 16; const float rv = rs ? rs[r] : 1.f;
                bf16_t* rowp = O + (size_t)r * ldc + col0;
#pragma unroll
                for (int bj = 0; bj < 2; ++bj) { const f32x4 v0 = acc[ai][bj][m][0] * cv[bj][0] * rv, v1 = acc[ai][bj][m][1] * cv[bj][1] * rv;
                    u32x4 w; w.x = cvt_pk_bf16(v0[0], v0[1]); w.y = cvt_pk_bf16(v0[2], v0[3]); w.z = cvt_pk_bf16(v1[0], v1[1]); w.w = cvt_pk_bf16(v1[2], v1[3]);
                    *(u32x4*)(rowp + bj * HALF) = w; }
            }
    }
};
struct CtxSplitOrder {
    int G, c;
    __device__ __forceinline__ bool next(int i, Unit& u) const { const int L = i * G + c; if (L >= 128) return false; u.pm = (NLAT / BM) + (L & 7); u.pn = (L >> 3) & 3; u.ks = L >> 5; return true; }
    __device__ __forceinline__ size_t koff(const Unit& u) const { return (size_t)(u.ks < 2 ? u.ks * 768 : 1536 + (u.ks - 2) * 640) * 2; }
    __device__ __forceinline__ int ntiles(const Unit& u, int) const { return u.ks < 2 ? 12 : 10; }
    __device__ __forceinline__ void a_ready(const Unit&) const {}
    __device__ __forceinline__ void done(const Unit&) const {}
};
struct EpiResCtx {
    static constexpr bool PERM = false, AFTER_DRAIN = false;
    const float* base_ctx; bf16_t* out; float* part; const float* mod; int kg; float mul;
    __device__ __forceinline__ void operator()(const f32x4 (&acc)[2][2][4][2], const Unit& u, int wr, int wc, int fr, int fq) const {
        const int row0 = (u.pm - NLAT / BM) * BM + wr * 64 + fr, col0 = u.pn * BM + wc * 32 + 4 * fq;
        const float* gp = mod + 8 * 9216 + kg * 1024 + col0;
        f32x4 gv[2][2];
#pragma unroll
        for (int bj = 0; bj < 2; ++bj)
#pragma unroll
            for (int n = 0; n < 2; ++n) gv[bj][n] = *(const f32x4*)(gp + bj * HALF + n * 16) * mul;
#pragma unroll
        for (int ai = 0; ai < 2; ++ai)
#pragma unroll
            for (int m = 0; m < 4; ++m) {
                const int r = row0 + ai * HALF + m * 16;
                const float* bp = base_ctx + (size_t)r * D + col0;
#pragma unroll
                for (int bj = 0; bj < 2; ++bj)
#pragma unroll
                    for (int n = 0; n < 2; ++n) { f32x4 v = gv[bj][n] * acc[ai][bj][m][n];
                        if (u.ks == 0) { v += *(const f32x4*)(bp + bj * HALF + n * 16); u32x2 w; w.x = cvt_pk_bf16(v[0], v[1]); w.y = cvt_pk_bf16(v[2], v[3]);
                            *(u32x2*)(out + (size_t)(NLAT + r) * D + col0 + bj * HALF + n * 16) = w; }
                        else *(f32x4*)(part + (size_t)(u.ks - 1) * NCTX * D + (size_t)r * D + col0 + bj * HALF + n * 16) = v; }
            }
    }
};
struct EpiQ {
    static constexpr bool PERM = true, AFTER_DRAIN = false;
    bf16_t* O; const float* rs; const f32x2* rope;
    __device__ __forceinline__ void operator()(const f32x4 (&acc)[2][2][4][2], const Unit& u, int wr, int wc, int fr, int fq) const {
        const int row0 = u.pm * BM + wr * 64 + fr, col0 = u.pn * BM + wc * 32 + 8 * fq;
#pragma unroll
        for (int ai = 0; ai < 2; ++ai)
#pragma unroll
            for (int m = 0; m < 4; ++m) {
                const int r = row0 + ai * HALF + m * 16; const float rv = rs[r] * QSCALE; const int t = r & (SEQ - 1);
                bf16_t* rowp = O + (size_t)r * 768 + col0;
#pragma unroll
                for (int bj = 0; bj < 2; ++bj) {
                    f32x4 v0 = acc[ai][bj][m][0] * rv, v1 = acc[ai][bj][m][1] * rv;
                    const int cc = (col0 + bj * HALF) % 96;
                    if (cc >= 64) {
                        const int q = cc - 64, half = q >> 4, jj = (q & 15) >> 1, pos = half ? (t & 63) : (t >> 6);
                        const f32x2* rp = rope + pos * 8 + jj;
                        const f32x2 c0 = rp[0], c1 = rp[1], c2 = rp[2], c3 = rp[3];
                        f32x4 o0, o1;
                        o0[0] = v0[0] * c0.x - v0[1] * c0.y; o0[1] = v0[0] * c0.y + v0[1] * c0.x; o0[2] = v0[2] * c1.x - v0[3] * c1.y; o0[3] = v0[2] * c1.y + v0[3] * c1.x;
                        o1[0] = v1[0] * c2.x - v1[1] * c2.y; o1[1] = v1[0] * c2.y + v1[1] * c2.x; o1[2] = v1[2] * c3.x - v1[3] * c3.y; o1[3] = v1[2] * c3.y + v1[3] * c3.x;
                        v0 = o0; v1 = o1;
                    }
                    u32x4 w; w.x = cvt_pk_bf16(v0[0], v0[1]); w.y = cvt_pk_bf16(v0[2], v0[3]); w.z = cvt_pk_bf16(v1[0], v1[1]); w.w = cvt_pk_bf16(v1[2], v1[3]);
                    *(u32x4*)(rowp + bj * HALF) = w;
                }
            }
    }
};
}

__device__ __forceinline__ int cmap(int id, int n) {
    switch (id) {
    case 0: return ((n >> 7) & 1) * DFF + (n >> 8) * 128 + (n & 127);
    case 1: return n;
    case 2: {
        if (n < 1536) return n;
        if (n < 2304) return 1552 + (n - 1536);
        if (n < 2560) return 2320 + (n - 2304);
        if (n < 2592) { const int q = n - 2560, half = q >> 4, jj = (q & 15) >> 1, which = q & 1; return 2576 + half * 16 + which * 8 + jj; }
        if (n < 2608) return 1536 + (n - 2592);
        return -1; }
    case 3: { const int hh = n / 96, cc = n % 96; if (cc < 64) return hh * 96 + cc;
        const int q = cc - 64, half = q >> 4, jj = (q & 15) >> 1, which = q & 1; return hh * 96 + 64 + half * 16 + which * 8 + jj; }
    case 4: return (n >> 6) * 128 + (n & 63);
    default: return (n >> 6) * 128 + 64 + (n & 63);
    }
}
__device__ __forceinline__ void titem(const float* W, int K, int N, bf16* WT, const float* gk, LAS float* scr, int item, int nblk, int lane, int id, float mulc = 1.f) {
    const int kb = item / nblk, nb = item % nblk, k0 = 64 * kb, n0 = 32 * nb;
    const int src = cmap(id, n0 + (lane & 31));
    float tv[32];
#pragma unroll
    for (int i = 0; i < 32; ++i) { const int kk = 2 * i + (lane >> 5); tv[i] = src >= 0 ? W[(size_t)(k0 + kk) * N + src] : 0.f; }
#pragma unroll
    for (int i = 0; i < 32; ++i) { const int kk = 2 * i + (lane >> 5); float v = tv[i]; if (gk) v *= gk[k0 + kk] * mulc; scr[kk * 33 + (lane & 31)] = v; }
    LDS_FENCE();
    const int c = lane & 7;
#pragma unroll
    for (int j = 0; j < 4; ++j) { const int n = (lane >> 3) + 8 * j; const LAS float* s = scr + (8 * c) * 33 + n;
        u32x4 o; o.x = pk2(s[0 * 33], s[1 * 33]); o.y = pk2(s[2 * 33], s[3 * 33]); o.z = pk2(s[4 * 33], s[5 * 33]); o.w = pk2(s[6 * 33], s[7 * 33]);
        *(u32x4*)(WT + (size_t)(n0 + n) * K + k0 + 8 * c) = o; }
    LDS_FENCE();
}
__device__ __forceinline__ void phase0(const Args& a, LAS unsigned char* lds, int gw, int NGW, int tid, int lane, int wave) {
    unsigned char* ws = a.ws;
    LAS float* scr = (LAS float*)(lds + wave * 16384);
    if (blockIdx.x < 144) {
        float* MOD = (float*)(ws + WS_MOD);
        const float* cin = a.in[1]; const float* cctx = a.in[3]; const float* wada = a.in[4]; const float* bada = a.in[5];
        LAS float* SV = (LAS float*)lds;
        LAS float* red = (LAS float*)(lds + 36864);
        for (int o = tid; o < 9 * 1024; o += 512) SV[o] = silu_f(o < 8192 ? cin[o] : cctx[o - 8192]);
        __syncthreads();
        const int kq = lane >> 4, c4 = (lane & 15) * 4;
        const float* wp = wada + (size_t)(wave * 128 + kq) * 9216 + blockIdx.x * 64 + c4;
        f32x4 acc[9];
#pragma unroll
        for (int bb = 0; bb < 9; ++bb) acc[bb] = (f32x4){0.f, 0.f, 0.f, 0.f};
#pragma unroll 8
        for (int i = 0; i < 32; ++i) {
            const f32x4 w = *(const f32x4*)(wp + (size_t)(4 * i) * 9216);
            const int k = wave * 128 + 4 * i + kq;
#pragma unroll
            for (int bb = 0; bb < 9; ++bb) acc[bb] += w * SV[bb * 1024 + k];
        }
#pragma unroll
        for (int bb = 0; bb < 9; ++bb)
#pragma unroll
            for (int e = 0; e < 4; ++e) { float v = acc[bb][e]; v += __shfl_xor(v, 16); v += __shfl_xor(v, 32); acc[bb][e] = v; }
        if (lane < 16) {
#pragma unroll
            for (int bb = 0; bb < 9; ++bb) *(LAS f32x4*)(red + (wave * 9 + bb) * 64 + c4) = acc[bb];
        }
        __syncthreads();
        for (int o = tid; o < 576; o += 512) { float t = bada[blockIdx.x * 64 + (o & 63)];
#pragma unroll
            for (int w = 0; w < 8; ++w) t += red[w * 576 + o];
            MOD[(o >> 6) * 9216 + blockIdx.x * 64 + (o & 63)] = t; }
        __syncthreads();
    }
    constexpr int I_W1A = 16 * 176, I_W1B = 44 * 32, I_WIN = 16 * 88, I_WUQ = 12 * 24, I_WK = 4 * 16, I_WOUT = 16 * 32;
    constexpr int NITEMS = 2 * I_W1A + 2 * I_W1B + I_WIN + I_WUQ + 2 * I_WK + I_WOUT;
    for (int rep0 = 0; rep0 < (PROBE_PHASE == 201 ? 2 : 1); ++rep0)
    for (int it = gw; it < NITEMS; it += NGW) {
        int r = it;
        if (r < I_W1A) { titem(a.in[7], 1024, 5632, (bf16*)(ws + WS_W1A), nullptr, scr, r, 176, lane, 0); continue; } r -= I_W1A;
        if (r < I_W1A) { titem(a.in[23], 1024, 5632, (bf16*)(ws + WS_W2A), nullptr, scr, r, 176, lane, 0); continue; } r -= I_W1A;
        if (r < I_W1B) { titem(a.in[8], 2816, 1024, (bf16*)(ws + WS_W1B), nullptr, scr, r, 32, lane, 1); continue; } r -= I_W1B;
        if (r < I_W1B) { titem(a.in[24], 2816, 1024, (bf16*)(ws + WS_W2B), nullptr, scr, r, 32, lane, 1); continue; } r -= I_W1B;
        if (r < I_WIN) { titem(a.in[10], 1024, 2608, (bf16*)(ws + WS_WIN), nullptr, scr, r, 88, lane, 2); continue; } r -= I_WIN;
        if (r < I_WUQ) { titem(a.in[18], 768, 768, (bf16*)(ws + WS_WUQ), a.in[17], scr, r, 24, lane, 3, QSCALE); continue; } r -= I_WUQ;
        if (r < I_WK) { titem(a.in[20], 256, 1024, (bf16*)(ws + WS_WK), a.in[19], scr, r, 16, lane, 4); continue; } r -= I_WK;
        if (r < I_WK) { titem(a.in[20], 256, 1024, (bf16*)(ws + WS_WV), a.in[19], scr, r, 16, lane, 5); continue; } r -= I_WK;
        titem(a.in[21], 1024, 1024, (bf16*)(ws + WS_WOUT), nullptr, scr, r, 32, lane, 1);
    }
    if (blockIdx.x == 0) {
        const int pos = tid >> 3, jj = tid & 7; const float inv = __builtin_amdgcn_exp2f(-(float)jj * 1.6609640474436813f);
        const float ang = (float)pos * inv;
        ((f32x2*)(ws + WS_ROPE))[tid] = (f32x2){__cosf(ang), __sinf(ang)};
    }
}

template <bool SRC_BF16> __device__ __forceinline__ void norm_rows(const void* src_lat, const void* src_ctx, int nrows, const float* gvec, const float* mod, int kshift, bf16* out, int gw, int NGW, int lane, const float* part = nullptr) {
    const int nlat = nrows < NLAT ? nrows : NLAT, per = (nlat + NGW - 1) / NGW, r_end = min(nlat, (gw + 1) * per), nctx = nrows - nlat;
    const int n_it = (r_end > gw * per ? (r_end - gw * per + 1) / 2 : 0), n_ctx_it = nctx > gw ? (nctx - gw + NGW - 1) / NGW : 0;
    int cur_bb = -1; f32x4 fa[4], fb[4];
    const int c0 = 8 * lane;
    for (int it = 0; it < n_it + n_ctx_it; ++it) {
        const bool isl = it < n_it;
        const int row0 = isl ? gw * per + 2 * it : NLAT + gw + (it - n_it) * NGW;
        const bool two = isl && (row0 + 1 < r_end);
        f32x4 v[2][4]; float s[2];
#pragma unroll
        for (int q = 0; q < 2; ++q) if (q == 0 || two) {
            const int row = row0 + q;
            const size_t xo = (row < NLAT ? (size_t)row : (size_t)(row - NLAT)) * D + c0; const void* xs = row < NLAT ? src_lat : src_ctx;
#pragma unroll
            for (int j = 0; j < 2; ++j) {
                if (SRC_BF16) { const u32x4 w = *(const u32x4*)((const bf16*)xs + xo + 512 * j);
                    v[q][2 * j] = (f32x4){bflo(w.x), bfhi(w.x), bflo(w.y), bfhi(w.y)}; v[q][2 * j + 1] = (f32x4){bflo(w.z), bfhi(w.z), bflo(w.w), bfhi(w.w)}; }
                else { v[q][2 * j] = __builtin_nontemporal_load((const f32x4*)((const float*)xs + xo + 512 * j)); v[q][2 * j + 1] = __builtin_nontemporal_load((const f32x4*)((const float*)xs + xo + 512 * j + 4)); } }
        }
#pragma unroll
        for (int q = 0; q < 2; ++q) if (q == 0 || two) {
            const int row = row0 + q; s[q] = 0.f;
#pragma unroll
            for (int j = 0; j < 4; ++j) {
                if (part && row >= NLAT) { const float* pp = part + (size_t)(row - NLAT) * D + c0 + 512 * (j >> 1) + 4 * (j & 1);
                    v[q][j] += *(const f32x4*)pp + *(const f32x4*)(pp + (size_t)NCTX * D) + *(const f32x4*)(pp + (size_t)2 * NCTX * D); }
                s[q] += (v[q][j][0] * v[q][j][0] + v[q][j][1] * v[q][j][1]) + (v[q][j][2] * v[q][j][2] + v[q][j][3] * v[q][j][3]); }
        }
#pragma unroll
        for (int q = 0; q < 2; ++q) if (q == 0 || two) {
            const int row = row0 + q;
            const int bb = row < NLAT ? row / SEQ : 8;
            if (bb != cur_bb) { cur_bb = bb; const float* sh = mod + bb * 9216 + kshift * 1024 + c0;
#pragma unroll
                for (int j = 0; j < 4; ++j) { const int co = 512 * (j >> 1) + 4 * (j & 1);
                    fa[j] = *(const f32x4*)(gvec + c0 + co) * (*(const f32x4*)(sh + 1024 + co) + 1.f); fb[j] = *(const f32x4*)(sh + co); } }
            const float rstd = 1.0f / sqrtf(wave_sum(s[q]) * (1.f / D) + EPS);
            bf16* orow = out + (size_t)row * D + c0;
#pragma unroll
            for (int j = 0; j < 2; ++j) { const f32x4 y0 = (v[q][2 * j] * rstd) * fa[2 * j] + fb[2 * j], y1 = (v[q][2 * j + 1] * rstd) * fa[2 * j + 1] + fb[2 * j + 1];
                u32x4 w; w.x = pk2(y0[0], y0[1]); w.y = pk2(y0[2], y0[3]); w.z = pk2(y1[0], y1[1]); w.w = pk2(y1[2], y1[3]); *(u32x4*)(orow + 512 * j) = w; }
        }
    }
}
__device__ __forceinline__ void final_norm_rows(float* io, const float* gvec, int gw, int NGW, int lane) {
    const int per = NLAT / NGW;
    f32x4 g[4];
#pragma unroll
    for (int j = 0; j < 4; ++j) g[j] = *(const f32x4*)(gvec + 4 * lane + 256 * j);
    for (int row0 = gw * per; row0 < (gw + 1) * per; row0 += 2) {
        f32x4 v[2][4]; float s[2];
#pragma unroll
        for (int q = 0; q < 2; ++q)
#pragma unroll
            for (int j = 0; j < 4; ++j) v[q][j] = *(const f32x4*)(io + (size_t)(row0 + q) * D + 4 * lane + 256 * j);
#pragma unroll
        for (int q = 0; q < 2; ++q) { s[q] = 0.f;
#pragma unroll
            for (int j = 0; j < 4; ++j) s[q] += (v[q][j][0] * v[q][j][0] + v[q][j][1] * v[q][j][1]) + (v[q][j][2] * v[q][j][2] + v[q][j][3] * v[q][j][3]); }
#pragma unroll
        for (int q = 0; q < 2; ++q) {
            const float rstd = 1.0f / sqrtf(wave_sum(s[q]) * (1.f / D) + EPS);
#pragma unroll
            for (int j = 0; j < 4; ++j) __builtin_nontemporal_store((v[q][j] * rstd) * g[j], (f32x4*)(io + (size_t)(row0 + q) * D + 4 * lane + 256 * j));
        }
    }
}

__device__ __forceinline__ float softplus_f(float x) { return fmaxf(x, 0.f) + log1pf(__expf(-fabsf(x))); }
__device__ __forceinline__ void phase6(const Args& a, LAS unsigned char* lds, int G, int bx, int tid, int lane, int wave) {
    unsigned char* ws = a.ws;
    const bf16* XBCR = (const bf16*)(ws + WS_XBCR); const bf16* MISC = (const bf16*)(ws + WS_MISC); const bf16* CQ = (const bf16*)(ws + WS_CQ); const bf16* CKV = (const bf16*)(ws + WS_CKV);
    bf16* XT = (bf16*)(ws + WS_XT); bf16* BT = (bf16*)(ws + WS_BT); bf16* BROW = (bf16*)(ws + WS_BROW); bf16* CROW = (bf16*)(ws + WS_CROW); bf16* KPE = (bf16*)(ws + WS_KPE);
    float* DT = (float*)(ws + WS_DT); float* RSTDQ = (float*)(ws + WS_RSTDQ); float* RSTDKV = (float*)(ws + WS_RSTDKV); const f32x2* ROPE = (const f32x2*)(ws + WS_ROPE);
    const float* conv_w = a.in[11]; const float* conv_b = a.in[12]; const float* dt_bias = a.in[13];
    LAS bf16* T = (LAS bf16*)lds;
    const int ch = 4 * (tid & 255), tsw = 2 * ((ch >> 3) & 15);
    float cw[5][4], cb[4];
#pragma unroll
    for (int k = 0; k < 5; ++k) { const f32x4 w = *(const f32x4*)(conv_w + k * 1024 + ch); cw[k][0] = w[0]; cw[k][1] = w[1]; cw[k][2] = w[2]; cw[k][3] = w[3]; }
    { const f32x4 w = *(const f32x4*)(conv_b + ch); cb[0] = w[0]; cb[1] = w[1]; cb[2] = w[2]; cb[3] = w[3]; }
    for (int unit = bx; unit < NB * 64 + NB * 16; unit += G) {
        const bool isctx = unit >= NB * 64;
        const int b = isctx ? (unit - NB * 64) >> 4 : unit >> 6, len = isctx ? 16 : 64, u0 = isctx ? ((unit - NB * 64) & 15) * 16 : CTXL + (unit & 63) * 64;
        const int seg_lo = isctx ? 0 : CTXL, seg_hi = isctx ? CTXL : UL;
        const int rb = isctx ? NLAT + b * CTXL : b * SEQ - CTXL;
        const int spt = len >> 1, tseg = (tid >> 8) * spt;
#define P6_LD(u) (((u) >= seg_lo && (u) < seg_hi) ? *(const u32x2*)(XBCR + (size_t)(rb + (u)) * 1024 + ch) : (u32x2){0u, 0u})
        const int ub = u0 + tseg;
        u32x2 xin[36];
#pragma unroll
        for (int i = 0; i < 36; ++i) if (i < spt + 4) xin[i] = P6_LD(ub - 2 + i);
#pragma unroll
        for (int t = 0; t < 32; ++t) if (t < spt) {
            const u32x2 xm2 = xin[t], xm1 = xin[t + 1], x0 = xin[t + 2], xp1 = xin[t + 3], xp2 = xin[t + 4];
            const float y0 = cb[0] + cw[0][0] * bflo(xm2.x) + cw[1][0] * bflo(xm1.x) + cw[2][0] * bflo(x0.x) + cw[3][0] * bflo(xp1.x) + cw[4][0] * bflo(xp2.x);
            const float y1 = cb[1] + cw[0][1] * bfhi(xm2.x) + cw[1][1] * bfhi(xm1.x) + cw[2][1] * bfhi(x0.x) + cw[3][1] * bfhi(xp1.x) + cw[4][1] * bfhi(xp2.x);
            const float y2 = cb[2] + cw[0][2] * bflo(xm2.y) + cw[1][2] * bflo(xm1.y) + cw[2][2] * bflo(x0.y) + cw[3][2] * bflo(xp1.y) + cw[4][2] * bflo(xp2.y);
            const float y3 = cb[3] + cw[0][3] * bfhi(xm2.y) + cw[1][3] * bfhi(xm1.y) + cw[2][3] * bfhi(x0.y) + cw[3][3] * bfhi(xp1.y) + cw[4][3] * bfhi(xp2.y);
            u32x2 pk; pk.x = pk2(silu_f(y0), silu_f(y1)); pk.y = pk2(silu_f(y2), silu_f(y3));
            const int tt = tseg + t;
            if (ch < 768) { const int ts = tt ^ tsw;
                T[ch * 72 + ts] = (bf16)(pk.x & 0xffffu); T[(ch + 1) * 72 + ts] = (bf16)(pk.x >> 16); T[(ch + 2) * 72 + ts] = (bf16)(pk.y & 0xffffu); T[(ch + 3) * 72 + ts] = (bf16)(pk.y >> 16); }
            if (ch >= 512) { bf16* dst = ch < 768 ? BROW + (ch - 512) : CROW + (ch - 768); *(u32x2*)(dst + (size_t)(b * UL + u0 + tt) * 256) = pk; }
        }
#undef P6_LD
        __syncthreads();
        { const int cpr = len >> 3, sh = isctx ? 1 : 3;
          for (int q = tid; q < 768 * cpr; q += 512) { const int c = q >> sh, part = q & (cpr - 1), g = (c >> 3) & 15, x = g & 3;
            const u32x4 vr = *(const LAS u32x4*)(T + c * 72 + (part ^ (g >> 2)) * 8);
            const u32x4 v = x == 0 ? vr : (x == 1 ? (u32x4){vr.y, vr.x, vr.w, vr.z} : (x == 2 ? (u32x4){vr.z, vr.w, vr.x, vr.y} : (u32x4){vr.w, vr.z, vr.y, vr.x}));
            bf16* dst = c < 512 ? XT + (size_t)(b * 512 + c) * UL : BT + (size_t)(b * 256 + c - 512) * UL;
            *(u32x4*)(dst + u0 + part * 8) = v; } }
        if ((tid >> 3) < len) {
            const int uu = tid >> 3, k = (tid & 7) * 2; const size_t row = (size_t)(rb + u0 + uu);
            const unsigned raw = *(const unsigned*)(MISC + row * 256 + 32 + k);
            f32x2 o; o.x = softplus_f(bflo(raw) + dt_bias[k]); o.y = softplus_f(bfhi(raw) + dt_bias[k + 1]);
            *(f32x2*)(DT + (size_t)(b * UL + u0 + uu) * 16 + k) = o;
        }
        if ((tid >> 3) < len) {
            const int uu = tid >> 3, pp = (tid & 7) * 2; const size_t row = (size_t)(rb + u0 + uu);
            u32x2 raw = *(const u32x2*)(MISC + row * 256 + 2 * pp);
            if (!isctx) {
                const int t = u0 + uu - CTXL, half = pp >> 3, jj = pp & 7, pos = half ? (t & 63) : (t >> 6);
                const f32x2 c0 = ROPE[pos * 8 + jj], c1 = ROPE[pos * 8 + jj + 1];
                const float a0 = bflo(raw.x), a1 = bfhi(raw.x), a2 = bflo(raw.y), a3 = bfhi(raw.y);
                raw.x = pk2(a0 * c0.x - a1 * c0.y, a0 * c0.y + a1 * c0.x); raw.y = pk2(a2 * c1.x - a3 * c1.y, a2 * c1.y + a3 * c1.x);
            }
            *(u32x2*)(KPE + row * 32 + 2 * pp) = raw;
        }
        {
            u32x2 wkv[8], wq[8][3];
#pragma unroll
            for (int i = 0; i < 8; ++i) if (wave + 8 * i < len) { const size_t row = (size_t)(rb + u0 + wave + 8 * i);
                wkv[i] = *(const u32x2*)(CKV + row * 256 + 4 * lane);
                if (!isctx) {
#pragma unroll
                    for (int j = 0; j < 3; ++j) wq[i][j] = *(const u32x2*)(CQ + row * 768 + 4 * lane + 256 * j); } }
#pragma unroll
            for (int i = 0; i < 8; ++i) if (wave + 8 * i < len) { const size_t row = (size_t)(rb + u0 + wave + 8 * i);
                { const float c0 = bflo(wkv[i].x), c1 = bfhi(wkv[i].x), c2 = bflo(wkv[i].y), c3 = bfhi(wkv[i].y);
                  const float sk = wave_sum((c0 * c0 + c1 * c1) + (c2 * c2 + c3 * c3)); if (lane == 0) RSTDKV[row] = 1.0f / sqrtf(sk * (1.f / 256.f) + EPS); }
                if (!isctx) { float sq = 0.f;
#pragma unroll
                    for (int j = 0; j < 3; ++j) { const float c0 = bflo(wq[i][j].x), c1 = bfhi(wq[i][j].x), c2 = bflo(wq[i][j].y), c3 = bfhi(wq[i][j].y); sq += (c0 * c0 + c1 * c1) + (c2 * c2 + c3 * c3); }
                    sq = wave_sum(sq); if (lane == 0) RSTDQ[row] = 1.0f / sqrtf(sq * (1.f / 768.f) + EPS); } }
        }
        __syncthreads();
    }
}

__device__ __forceinline__ void acum_wave(const float* DT, size_t dtrow0, int h, float anf, float anb, LAS float* sc, int lane) {
    const float df0 = DT[(dtrow0 + lane) * 16 + h], df1 = DT[(dtrow0 + 64 + lane) * 16 + h];
    const float db0 = DT[(dtrow0 + lane) * 16 + 8 + h], db1 = DT[(dtrow0 + 64 + lane) * 16 + 8 + h];
    const float f0 = incl_scan(df0 * anf, lane); float f1 = incl_scan(df1 * anf, lane); f1 += __shfl(f0, 63);
    const float a0 = db0 * anb, a1 = db1 * anb; const float g0 = incl_scan(a0, lane), g1 = incl_scan(a1, lane);
    const float t0 = __shfl(g0, 63), t1 = __shfl(g1, 63), tot = t0 + t1;
    sc[lane] = f0; sc[64 + lane] = f1; sc[128 + lane] = tot - g0 + a0; sc[192 + lane] = t1 - g1 + a1;
    sc[256 + lane] = df0; sc[320 + lane] = df1; sc[384 + lane] = db0; sc[448 + lane] = db1;
    LDS_FENCE();
}
#define MFMA32(a, b, c) __builtin_amdgcn_mfma_f32_32x32x16_bf16((a), (b), (c), 0, 0, 0)
__device__ __forceinline__ f32x16 zero16() { f32x16 z;
#pragma unroll
    for (int r = 0; r < 16; ++r) z[r] = 0.f; return z; }

constexpr int S3_STR = 136, S3_TILE = 128 * S3_STR * 2;
constexpr int S3_CL = 0, S3_BL = 2 * S3_TILE, S3_SC = 4 * S3_TILE, S3_SS = S3_SC + 16384;
__device__ __forceinline__ void phase8(const Args& a, LAS unsigned char* lds, int G, int bx, int tid, int lane, int wave) {
    unsigned char* ws = a.ws;
    const bf16* XT = (const bf16*)(ws + WS_XT); const bf16* BT = (const bf16*)(ws + WS_BT); const float* DT = (const float*)(ws + WS_DT);
    bf16* ST = (bf16*)(ws + WS_ST); float* CD = (float*)(ws + WS_CD);
    LAS float* sc = (LAS float*)(lds + S3_SC) + wave * 512;
    const int h = wave, g = h >> 2, r32 = lane & 31, hi = lane >> 5;
    const float anf = -__expf(a.in[14][h]), anb = -__expf(a.in[14][8 + h]);
    const int rbx = G - 1 - bx, ufull = (NB * NCH / G) * G, nhalf = 2 * (NB * NCH - ufull);
    for (int wi = rbx; wi < ufull + nhalf; wi += G) {
        const int unit = wi < ufull ? wi : ufull + ((wi - ufull) >> 1), half_lo = wi < ufull ? 0 : ((wi - ufull) & 1), half_hi = wi < ufull ? 2 : half_lo + 1;
        const int b = unit / NCH, c = unit % NCH;
#pragma unroll
        for (int it = 0; it < 8; ++it) { const int q = tid + 512 * it, n = q >> 4, k16 = q & 15;
            const u32x4 v = *(const u32x4*)(BT + (size_t)(b * 256 + n) * UL + c * 128 + 8 * k16);
            *(LAS u32x4*)(lds + (n * S3_STR + 8 * k16) * 2) = v; }
        acum_wave(DT, (size_t)b * UL + c * 128, h, anf, anb, sc, lane);
        const float af_last = sc[127], ab_first = sc[128];
#pragma unroll
        for (int hf = 0; hf < 2; ++hf) { const int j = lane + 64 * hf;
            const float wf = __expf(af_last - sc[j]) * sc[256 + j], wb = __expf(ab_first - sc[128 + j]) * sc[384 + j];
            sc[256 + j] = wf; sc[384 + j] = wb; }
        if (lane == 0) { CD[((b * 2 + 0) * 8 + h) * NCH + c] = __expf(af_last); CD[((b * 2 + 1) * 8 + h) * NCH + c] = __expf(ab_first); }
        __syncthreads();
        const bf16* xbase = XT + (size_t)(b * 512 + h * 64 + r32) * UL + c * 128 + 8 * hi;
        const LAS unsigned char* btl = lds + ((g * 128 + r32) * S3_STR + 8 * hi) * 2;
        const LAS float* wfp = sc + 256 + 8 * hi; const LAS float* wbp = sc + 384 + 8 * hi;
#pragma unroll 1
        for (int half = half_lo; half < half_hi; ++half) {
            f32x16 accf[2][2], accb[2][2];
#pragma unroll
            for (int nn = 0; nn < 2; ++nn) { accf[nn][0] = zero16(); accf[nn][1] = zero16(); accb[nn][0] = zero16(); accb[nn][1] = zero16(); }
#pragma unroll 1
            for (int sq = 0; sq < 2; ++sq) {
            u32x4 xraw[2][4];
#pragma unroll
            for (int pb = 0; pb < 2; ++pb)
#pragma unroll
                for (int s4 = 0; s4 < 4; ++s4) xraw[pb][s4] = *(const u32x4*)(xbase + (size_t)pb * 32 * UL + 16 * (4 * sq + s4));
#pragma unroll
            for (int s4 = 0; s4 < 4; ++s4) { const int s = 4 * sq + s4;
                const f32x4 fa = *(const LAS f32x4*)(wfp + 16 * s), fb = *(const LAS f32x4*)(wfp + 16 * s + 4), ba = *(const LAS f32x4*)(wbp + 16 * s), bb = *(const LAS f32x4*)(wbp + 16 * s + 4);
                bf16x8 xwf[2], xwb[2];
#pragma unroll
                for (int pb = 0; pb < 2; ++pb) { const u32x4 raw = xraw[pb][s4];
                    const float x0 = bflo(raw.x), x1 = bfhi(raw.x), x2 = bflo(raw.y), x3 = bfhi(raw.y), x4 = bflo(raw.z), x5 = bfhi(raw.z), x6 = bflo(raw.w), x7 = bfhi(raw.w);
                    xwf[pb] = pack8(x0 * fa[0], x1 * fa[1], x2 * fa[2], x3 * fa[3], x4 * fb[0], x5 * fb[1], x6 * fb[2], x7 * fb[3]);
                    xwb[pb] = pack8(x0 * ba[0], x1 * ba[1], x2 * ba[2], x3 * ba[3], x4 * bb[0], x5 * bb[1], x6 * bb[2], x7 * bb[3]); }
#pragma unroll
                for (int nn = 0; nn < 2; ++nn) { const bf16x8 bt = *(const LAS bf16x8*)(btl + ((2 * half + nn) * 32 * S3_STR + 16 * s) * 2);
                    accf[nn][0] = MFMA32(bt, xwf[0], accf[nn][0]); accf[nn][1] = MFMA32(bt, xwf[1], accf[nn][1]);
                    accb[nn][0] = MFMA32(bt, xwb[0], accb[nn][0]); accb[nn][1] = MFMA32(bt, xwb[1], accb[nn][1]); }
            }
            }
            bf16* sof = ST + ((size_t)(((b * 2 + 0) * 8 + h) * NCH + c) * 64) * 128; bf16* sob = ST + ((size_t)(((b * 2 + 1) * 8 + h) * NCH + c) * 64) * 128;
#pragma unroll
            for (int nn = 0; nn < 2; ++nn)
#pragma unroll
                for (int pb = 0; pb < 2; ++pb)
#pragma unroll
                    for (int g4 = 0; g4 < 4; ++g4) { const size_t off = (size_t)(32 * pb + r32) * 128 + 32 * (2 * half + nn) + 8 * g4 + 4 * hi;
                        u32x2 o; o.x = pk2(accf[nn][pb][4 * g4], accf[nn][pb][4 * g4 + 1]); o.y = pk2(accf[nn][pb][4 * g4 + 2], accf[nn][pb][4 * g4 + 3]); *(u32x2*)(sof + off) = o;
                        o.x = pk2(accb[nn][pb][4 * g4], accb[nn][pb][4 * g4 + 1]); o.y = pk2(accb[nn][pb][4 * g4 + 2], accb[nn][pb][4 * g4 + 3]); *(u32x2*)(sob + off) = o; }
        }
        __syncthreads();
    }
}
__device__ __forceinline__ void phase9(const Args& a, int G, int bx, int tid) {
    unsigned char* ws = a.ws;
    const bf16* ST = (const bf16*)(ws + WS_ST); bf16* HE = (bf16*)(ws + WS_HE); const float* CD = (const float*)(ws + WS_CD);
    for (int idx = bx * 512 + tid; idx < NB * 2 * 8 * 1024; idx += G * 512) {
        const int e = (idx & 1023) * 8, bdh = idx >> 10, dir = (bdh >> 3) & 1;
        const bf16* st = ST + (size_t)bdh * NCH * 8192 + e; bf16* he = HE + (size_t)bdh * 32 * 8192 + e; const float* cd = CD + bdh * NCH;
        float hh[8];
#pragma unroll
        for (int k = 0; k < 8; ++k) hh[k] = 0.f;
#define P9_STEP(c) do { const u32x4 w_ = __builtin_nontemporal_load((const u32x4*)(st + (size_t)(c) * 8192)); const float d_ = cd[c]; \
        hh[0] = d_ * hh[0] + bflo(w_.x); hh[1] = d_ * hh[1] + bfhi(w_.x); hh[2] = d_ * hh[2] + bflo(w_.y); hh[3] = d_ * hh[3] + bfhi(w_.y); \
        hh[4] = d_ * hh[4] + bflo(w_.z); hh[5] = d_ * hh[5] + bfhi(w_.z); hh[6] = d_ * hh[6] + bflo(w_.w); hh[7] = d_ * hh[7] + bfhi(w_.w); } while (0)
#define P9_OUT(c) do { u32x4 o_; o_.x = pk2(hh[0], hh[1]); o_.y = pk2(hh[2], hh[3]); o_.z = pk2(hh[4], hh[5]); o_.w = pk2(hh[6], hh[7]); *(u32x4*)(he + (size_t)((c) - 2) * 8192) = o_; } while (0)
        if (dir == 0) {
            P9_STEP(0); P9_STEP(1);
#pragma unroll 8
            for (int c = 2; c < NCH; ++c) { P9_OUT(c); P9_STEP(c); }
        } else {
            P9_STEP(1); P9_STEP(0);
#pragma unroll 8
            for (int c = NCH - 1; c >= 2; --c) { P9_OUT(c); P9_STEP(c); }
        }
#undef P9_STEP
#undef P9_OUT
    }
}
#if defined(PROBE_TA)
#define SSTAMP(i) do { if (bx == 0 && tid == 0) ((unsigned long long*)(ws + 480 * KiB))[i] = __builtin_amdgcn_s_memrealtime(); } while (0)
#else
#define SSTAMP(i) do { } while (0)
#endif
__device__ __forceinline__ void phase10_ssd(const Args& a, LAS unsigned char* lds, int G, int bx, int tid, int lane, int wave) {
    unsigned char* ws = a.ws;
    const bf16* XT = (const bf16*)(ws + WS_XT); const bf16* BROW = (const bf16*)(ws + WS_BROW); const bf16* CROW = (const bf16*)(ws + WS_CROW); const float* DT = (const float*)(ws + WS_DT);
    const bf16* HE = (const bf16*)(ws + WS_HE); const bf16* Z = (const bf16*)(ws + WS_Z); bf16* MIX = (bf16*)(ws + WS_MIX);
    LAS float* sc = (LAS float*)(lds + S3_SC) + wave * 512;
    LAS float* SS = (LAS float*)(lds + S3_SS);
    const int h = wave, g = h >> 2, r32 = lane & 31, hi = lane >> 5;
    const float anf = -__expf(a.in[14][h]), anb = -__expf(a.in[14][8 + h]);
    const float dskip = a.in[15][h]; const float* snorm = a.in[16] + h * 64;
    for (int unit = bx; unit < NB * 32; unit += G) {
        const int b = unit >> 5, lc = unit & 31, c = lc + 2; const size_t u0 = (size_t)b * UL + c * 128;
#pragma unroll
        for (int it = 0; it < 8; ++it) { const int q = tid + 512 * it, i = q >> 5, ch16 = q & 31, off = ((ch16 >> 4) * S3_TILE) + (i * S3_STR + (ch16 & 15) * 8) * 2;
            const u32x4 vc = *(const u32x4*)(CROW + (u0 + i) * 256 + 8 * ch16), vb = *(const u32x4*)(BROW + (u0 + i) * 256 + 8 * ch16);
            *(LAS u32x4*)(lds + S3_CL + off) = vc; *(LAS u32x4*)(lds + S3_BL + off) = vb; }
        acum_wave(DT, u0, h, anf, anb, sc, lane);
        {
            float wfv[2], wbv[2];
#pragma unroll
            for (int hf = 0; hf < 2; ++hf) { const int j = lane + 64 * hf, jb = j >> 5;
                const float afb = jb ? sc[32 * jb - 1] : 0.f, abb = jb < 3 ? sc[128 + 32 * jb + 32] : 0.f;
                wfv[hf] = __expf(afb - sc[j]) * sc[256 + j]; wbv[hf] = __expf(abb - sc[128 + j]) * sc[384 + j]; }
            LDS_FENCE();
#pragma unroll
            for (int hf = 0; hf < 2; ++hf) { const int j = lane + 64 * hf; sc[256 + j] = wfv[hf]; sc[384 + j] = wbv[hf]; }
        }
        __syncthreads();
        SSTAMP(18);
        const LAS unsigned char* CLg = lds + S3_CL + g * S3_TILE + (r32 * S3_STR + 8 * hi) * 2;
        const LAS unsigned char* BLg = lds + S3_BL + g * S3_TILE + (r32 * S3_STR + 8 * hi) * 2;
#pragma unroll 1
        for (int ibp = 0; ibp < 2; ++ibp) {
        f32x16 acc[2][2];
#pragma unroll
        for (int k = 0; k < 2; ++k) { acc[k][0] = zero16(); acc[k][1] = zero16(); }
#ifndef NO_DIAG
        u32x2 xn[2][4];
#pragma unroll
        for (int pb = 0; pb < 2; ++pb) { const bf16* xp = XT + (size_t)(b * 512 + h * 64 + 32 * pb + r32) * UL + c * 128 + 4 * hi;
#pragma unroll
            for (int e = 0; e < 4; ++e) xn[pb][e] = *(const u32x2*)(xp + 8 * e); }
#pragma unroll 1
        for (int jb = 0; jb < 4; ++jb) {
            bf16x8 xa[2][2];
#pragma unroll
            for (int pb = 0; pb < 2; ++pb) {
                xa[pb][0] = __builtin_bit_cast(bf16x8, (u32x4){xn[pb][0].x, xn[pb][0].y, xn[pb][1].x, xn[pb][1].y}); xa[pb][1] = __builtin_bit_cast(bf16x8, (u32x4){xn[pb][2].x, xn[pb][2].y, xn[pb][3].x, xn[pb][3].y});
                if (jb < 3) { const bf16* xp = XT + (size_t)(b * 512 + h * 64 + 32 * pb + r32) * UL + c * 128 + 32 * (jb + 1) + 4 * hi;
#pragma unroll
                    for (int e = 0; e < 4; ++e) xn[pb][e] = *(const u32x2*)(xp + 8 * e); }
            }
#pragma unroll
            for (int k = 0; k < 2; ++k) {
                const int ib = 2 * ibp + k;
                f32x16 ga = zero16();
#pragma unroll
                for (int s = 0; s < 8; ++s) { const bf16x8 bfr = *(const LAS bf16x8*)(BLg + (32 * jb * S3_STR + 16 * s) * 2), cf = *(const LAS bf16x8*)(CLg + (32 * ib * S3_STR + 16 * s) * 2);
                    ga = MFMA32(bfr, cf, ga); }
                float mm[16];
                if (jb < ib) {
                    const float efi = __expf(sc[32 * ib + r32] - sc[32 * jb + 31]);
#pragma unroll
                    for (int r = 0; r < 16; ++r) mm[r] = ga[r] * sc[256 + 32 * jb + crow(r, hi)];
                    const float efb = __expf(sc[32 * ib + r32] - (jb ? sc[32 * jb - 1] : 0.f));
#pragma unroll
                    for (int r = 0; r < 16; ++r) mm[r] *= efb;
                    (void)efi;
                } else if (jb > ib) {
                    const float ebb = __expf(sc[128 + 32 * ib + r32] - (jb < 3 ? sc[128 + 32 * jb + 32] : 0.f));
#pragma unroll
                    for (int r = 0; r < 16; ++r) mm[r] = ga[r] * sc[384 + 32 * jb + crow(r, hi)] * ebb;
                } else {
                    const float efb = __expf(sc[32 * ib + r32] - (jb ? sc[32 * jb - 1] : 0.f)), ebb = __expf(sc[128 + 32 * ib + r32] - (jb < 3 ? sc[128 + 32 * jb + 32] : 0.f));
#pragma unroll
                    for (int r = 0; r < 16; ++r) { const int jl = crow(r, hi);
                        const float mf = jl <= r32 ? efb * sc[256 + 32 * jb + jl] : 0.f, mb = jl >= r32 ? ebb * sc[384 + 32 * jb + jl] : 0.f;
                        mm[r] = ga[r] * (mf + mb) + (jl == r32 ? dskip : 0.f); }
                }
                const bf16x8 pf0 = pack8(mm[0], mm[1], mm[2], mm[3], mm[4], mm[5], mm[6], mm[7]), pf1 = pack8(mm[8], mm[9], mm[10], mm[11], mm[12], mm[13], mm[14], mm[15]);
                acc[k][0] = MFMA32(xa[0][0], pf0, acc[k][0]); acc[k][0] = MFMA32(xa[0][1], pf1, acc[k][0]);
                acc[k][1] = MFMA32(xa[1][0], pf0, acc[k][1]); acc[k][1] = MFMA32(xa[1][1], pf1, acc[k][1]);
                asm volatile("" ::: "memory");
            }
        }
#endif
#ifndef NO_OFF
        if (ibp == 0) SSTAMP(19);
#pragma unroll 1
        for (int dir = 0; dir < 2; ++dir) {
#pragma unroll
            for (int pb = 0; pb < 2; ++pb) {
                const bf16* hp = HE + ((size_t)(((b * 2 + dir) * 8 + h) * 32 + lc) * 64 + 32 * pb + r32) * 128 + 8 * hi;
                f32x16 ta0 = zero16(), ta1 = zero16();
                bf16x8 hf[8];
#pragma unroll
                for (int s = 0; s < 8; ++s) hf[s] = *(const bf16x8*)(hp + 16 * s);
#pragma unroll
                for (int s = 0; s < 8; ++s) {
                    const bf16x8 cf0 = *(const LAS bf16x8*)(CLg + (32 * (2 * ibp) * S3_STR + 16 * s) * 2), cf1 = *(const LAS bf16x8*)(CLg + (32 * (2 * ibp + 1) * S3_STR + 16 * s) * 2);
                    ta0 = MFMA32(hf[s], cf0, ta0); ta1 = MFMA32(hf[s], cf1, ta1); }
                const float e0 = __expf(sc[128 * dir + 32 * (2 * ibp) + r32]), e1 = __expf(sc[128 * dir + 32 * (2 * ibp + 1) + r32]);
#pragma unroll
                for (int r = 0; r < 16; ++r) { acc[0][pb][r] += e0 * ta0[r]; acc[1][pb][r] += e1 * ta1[r]; }
                asm volatile("" ::: "memory");
            }
        }
#endif
        if (ibp == 0) SSTAMP(20);
#pragma unroll
        for (int k = 0; k < 2; ++k) {
            const int ib = 2 * ibp + k;
            const size_t row = (size_t)b * SEQ + lc * 128 + 32 * ib + r32;
            float ss = 0.f;
#pragma unroll
            for (int pb = 0; pb < 2; ++pb)
#pragma unroll
                for (int g4 = 0; g4 < 4; ++g4) { const u32x2 zw = *(const u32x2*)(Z + row * 512 + h * 64 + 32 * pb + 8 * g4 + 4 * hi);
                    const float v0 = acc[k][pb][4 * g4] * silu_f(bflo(zw.x)), v1 = acc[k][pb][4 * g4 + 1] * silu_f(bfhi(zw.x)), v2 = acc[k][pb][4 * g4 + 2] * silu_f(bflo(zw.y)), v3 = acc[k][pb][4 * g4 + 3] * silu_f(bfhi(zw.y));
                    ss += (v0 * v0 + v1 * v1) + (v2 * v2 + v3 * v3);
                    acc[k][pb][4 * g4] = v0; acc[k][pb][4 * g4 + 1] = v1; acc[k][pb][4 * g4 + 2] = v2; acc[k][pb][4 * g4 + 3] = v3; }
            ss += __shfl_xor(ss, 32);
            if (hi == 0) SS[(ib * 8 + wave) * 32 + r32] = ss;
        }
        __syncthreads();
#pragma unroll
        for (int k = 0; k < 2; ++k) {
            const int ib = 2 * ibp + k;
            const size_t row = (size_t)b * SEQ + lc * 128 + 32 * ib + r32;
            float tot = 0.f;
#pragma unroll
            for (int w = 0; w < 8; ++w) tot += SS[(ib * 8 + w) * 32 + r32];
            const float rstd = 1.0f / sqrtf(tot * (1.f / 512.f) + EPS);
#pragma unroll
            for (int pb = 0; pb < 2; ++pb)
#pragma unroll
                for (int g4 = 0; g4 < 4; ++g4) { const int p0 = 32 * pb + 8 * g4 + 4 * hi; const f32x4 gn = *(const f32x4*)(snorm + p0);
                    u32x2 o; o.x = pk2(acc[k][pb][4 * g4] * rstd * gn[0], acc[k][pb][4 * g4 + 1] * rstd * gn[1]); o.y = pk2(acc[k][pb][4 * g4 + 2] * rstd * gn[2], acc[k][pb][4 * g4 + 3] * rstd * gn[3]);
                    *(u32x2*)(MIX + row * 1024 + h * 64 + p0) = o; }
        }
        }
        __syncthreads();
    }
}

__device__ __forceinline__ float at_max3(float a, float b, float c) { float r; asm("v_max3_f32 %0, %1, %2, %3" : "=v"(r) : "v"(a), "v"(b), "v"(c)); return r; }
constexpr int AT_KS = 104, AT_VS = 68, AT_KB = 64 * AT_KS * 2, AT_BUF = AT_KB + 64 * AT_VS * 2;
__device__ __forceinline__ void phase10_attn(const Args& a, LAS unsigned char* lds, int G, int vcu, int tid, int lane, int wave) {
    unsigned char* ws = a.ws; unsigned char* ob = (unsigned char*)a.out;
    const bf16* Q = (const bf16*)(ob + OUT_Q); const bf16* KN = (const bf16*)(ob + OUT_KN); const bf16* VT = (const bf16*)(ob + OUT_VT); const bf16* KPE = (const bf16*)(ws + WS_KPE);
    bf16* MIX = (bf16*)(ws + WS_MIX); const f32x2* ROPE = (const f32x2*)(ws + WS_ROPE);
    const int r32 = lane & 31, hi = lane >> 5;
    if (wave >= 4) __builtin_amdgcn_s_setprio(1);
    for (int unit = vcu; unit < NB * 8 * 8; unit += G) {
        const int bh = unit >> 3, qb = unit & 7, b = bh >> 3, h = bh & 7;
        bf16x8 qr[2][6];
#pragma unroll
        for (int qq = 0; qq < 2; ++qq) {
            const int tq = qb * 512 + qq * 256 + wave * 32 + r32;
            const bf16* qp = Q + ((size_t)b * SEQ + tq) * 768 + h * 96 + 8 * hi;
#pragma unroll
            for (int s = 0; s < 6; ++s) qr[qq][s] = *(const bf16x8*)(qp + 16 * s);
#pragma unroll
            for (int s = 4; s < 6; ++s) { const int pos = (s == 4) ? (tq >> 6) : (tq & 63); const f32x2* rp = ROPE + pos * 8 + 4 * hi;
                const u32x4 w = __builtin_bit_cast(u32x4, qr[qq][s]); const f32x2 c0 = rp[0], c1 = rp[1], c2 = rp[2], c3 = rp[3]; u32x4 o;
                o.x = pk2(bflo(w.x) * c0.x - bfhi(w.x) * c0.y, bflo(w.x) * c0.y + bfhi(w.x) * c0.x); o.y = pk2(bflo(w.y) * c1.x - bfhi(w.y) * c1.y, bflo(w.y) * c1.y + bfhi(w.y) * c1.x);
                o.z = pk2(bflo(w.z) * c2.x - bfhi(w.z) * c2.y, bflo(w.z) * c2.y + bfhi(w.z) * c2.x); o.w = pk2(bflo(w.w) * c3.x - bfhi(w.w) * c3.y, bflo(w.w) * c3.y + bfhi(w.w) * c3.x);
                qr[qq][s] = __builtin_bit_cast(bf16x8, o); }
        }
        const int kr = tid >> 3, kpart = tid & 7;
        const int pr = tid >> 2, ppart = tid & 3;
#define AT_ROW0(t) ((t) < 4 ? (size_t)NLAT + b * CTXL + (t) * 64 : (size_t)b * SEQ + ((t) - 4) * 64)
#define AT_LOAD(t) do { const size_t r0_ = AT_ROW0(t); \
        gk = *(const u32x4*)(KN + (r0_ + kr) * 512 + h * 64 + kpart * 8); \
        gv = *(const u32x4*)(VT + (size_t)(h * 64 + kr) * MTOT + r0_ + kpart * 8); \
        if (tid < 256) gp = *(const u32x4*)(KPE + (r0_ + pr) * 32 + ppart * 8); } while (0)
#define AT_STORE(bufi) do { LAS unsigned char* B_ = lds + (bufi) * AT_BUF; \
        *(LAS u32x4*)(B_ + (kr * AT_KS + kpart * 8) * 2) = gk; \
        *(LAS u32x2*)(B_ + AT_KB + (kr * AT_VS + kpart * 8) * 2) = (u32x2){gv.x, gv.y}; *(LAS u32x2*)(B_ + AT_KB + (kr * AT_VS + kpart * 8 + 4) * 2) = (u32x2){gv.z, gv.w}; \
        if (tid < 256) *(LAS u32x4*)(B_ + (pr * AT_KS + 64 + ppart * 8) * 2) = gp; } while (0)
        u32x4 gk, gv, gp = (u32x4){0u, 0u, 0u, 0u};
        AT_LOAD(0); AT_STORE(0);
        __syncthreads();
        float mrun[2] = {-INFINITY, -INFINITY}, lrun[2] = {0.f, 0.f};
        f32x16 o[2][2]; o[0][0] = zero16(); o[0][1] = zero16(); o[1][0] = zero16(); o[1][1] = zero16();
#pragma unroll 1
        for (int t = 0; t < 68; ++t) {
            if (t + 1 < 68) AT_LOAD(t + 1);
            const LAS unsigned char* Bc = lds + (t & 1) * AT_BUF;
#pragma unroll
            for (int qq = 0; qq < 2; ++qq) {
                f32x16 p0 = zero16(), p1 = zero16();
#pragma unroll
                for (int s = 0; s < 6; ++s) {
                    const bf16x8 k0 = *(const LAS bf16x8*)(Bc + (r32 * AT_KS + 16 * s + 8 * hi) * 2), k1 = *(const LAS bf16x8*)(Bc + ((32 + r32) * AT_KS + 16 * s + 8 * hi) * 2);
                    p0 = MFMA32(k0, qr[qq][s], p0); p1 = MFMA32(k1, qr[qq][s], p1); }
                float mx = fmaxf(p0[0], p1[0]);
#pragma unroll
                for (int r = 1; r < 16; ++r) mx = fmaxf(mx, fmaxf(p0[r], p1[r]));
                mx = fmaxf(mx, __shfl_xor(mx, 32));
                if (__any(mx > mrun[qq])) {
                    const float mnew = fmaxf(mrun[qq], mx), alpha = __builtin_amdgcn_exp2f(mrun[qq] - mnew);
                    mrun[qq] = mnew; lrun[qq] *= alpha;
#pragma unroll
                    for (int r = 0; r < 16; ++r) { o[qq][0][r] *= alpha; o[qq][1][r] *= alpha; }
                }
                float rs = 0.f;
#pragma unroll
                for (int r = 0; r < 16; ++r) { p0[r] = __builtin_amdgcn_exp2f(p0[r] - mrun[qq]); p1[r] = __builtin_amdgcn_exp2f(p1[r] - mrun[qq]); rs += p0[r] + p1[r]; }
                lrun[qq] += rs;
                bf16x8 pf[4];
                pf[0] = pack8(p0[0], p0[1], p0[2], p0[3], p0[4], p0[5], p0[6], p0[7]); pf[1] = pack8(p0[8], p0[9], p0[10], p0[11], p0[12], p0[13], p0[14], p0[15]);
                pf[2] = pack8(p1[0], p1[1], p1[2], p1[3], p1[4], p1[5], p1[6], p1[7]); pf[3] = pack8(p1[8], p1[9], p1[10], p1[11], p1[12], p1[13], p1[14], p1[15]);
#pragma unroll
                for (int db = 0; db < 2; ++db)
#pragma unroll
                    for (int s = 0; s < 4; ++s) { const LAS unsigned char* vp = Bc + AT_KB + ((32 * db + r32) * AT_VS + 16 * s + 4 * hi) * 2;
                        const u32x2 v0 = *(const LAS u32x2*)vp, v1 = *(const LAS u32x2*)(vp + 16);
                        o[qq][db] = MFMA32(__builtin_bit_cast(bf16x8, (u32x4){v0.x, v0.y, v1.x, v1.y}), pf[s], o[qq][db]); }
                asm volatile("" ::: "memory"); __builtin_amdgcn_sched_barrier(0);
            }
            if (t + 1 < 68) AT_STORE((t + 1) & 1);
            __syncthreads();
        }
#undef AT_ROW0
#undef AT_LOAD
#undef AT_STORE
#pragma unroll
        for (int qq = 0; qq < 2; ++qq) {
            const float ltot = lrun[qq] + __shfl_xor(lrun[qq], 32), rl = 1.0f / ltot;
            const size_t qrow = (size_t)b * SEQ + qb * 512 + qq * 256 + wave * 32 + r32;
            bf16* op = MIX + qrow * 1024 + 512 + h * 64 + 4 * hi;
#pragma unroll
            for (int db = 0; db < 2; ++db)
#pragma unroll
                for (int g4 = 0; g4 < 4; ++g4) { u32x2 w; w.x = pk2(o[qq][db][4 * g4] * rl, o[qq][db][4 * g4 + 1] * rl); w.y = pk2(o[qq][db][4 * g4 + 2] * rl, o[qq][db][4 * g4 + 3] * rl);
                    *(u32x2*)(op + 32 * db + 8 * g4) = w; }
        }
    }
    __builtin_amdgcn_s_setprio(0);
}

#define XB_TMO      128
#define XB_XCNT(j)  (256  + 64 * (j))
#define XB_XSUB(j)  (1280 + 64 * (j))
#define XB_XGEN(j)  (2304 + 64 * (j))
#define XB_TOP      3328
#define XB_TOPGEN   3392
#define XCD_BAR_WORDS 3456
#define XB_SPIN_CAP (1u << 18)

__device__ __forceinline__ unsigned xb_ld(unsigned* p)              { return __hip_atomic_load(p, __ATOMIC_RELAXED, __HIP_MEMORY_SCOPE_AGENT); }
__device__ __forceinline__ unsigned xb_add(unsigned* p, unsigned v) { return __hip_atomic_fetch_add(p, v, __ATOMIC_RELAXED, __HIP_MEMORY_SCOPE_AGENT); }
__device__ __forceinline__ unsigned xb_xcc_id() { return (unsigned)__builtin_amdgcn_s_getreg((3 << 11) | 20) & 0xFu; }
#define XB_SPIN(cond, bar) do { unsigned _sp = 0; while (cond) { __builtin_amdgcn_s_sleep(1); \
    if ((++_sp & 255u) == 0u) { if (xb_ld(&(bar)[XB_TMO])) break; if (_sp > XB_SPIN_CAP) { atomicAdd(&(bar)[XB_TMO], 1u); break; } } } } while (0)

struct XcdBarrier {
    unsigned* bar; unsigned x;
    volatile LAS unsigned* st;
};

__device__ __forceinline__ XcdBarrier xcd_barrier_post(unsigned* bar, volatile LAS unsigned* st) {
    XcdBarrier b; b.bar = bar; b.x = xb_xcc_id(); b.st = st;
    if (threadIdx.x == 0) (void)xb_add(&bar[XB_XCNT(b.x)], 1u);
    return b;
}
__device__ __forceinline__ void xcd_barrier_complete(unsigned* bar, unsigned x, unsigned& nloc, unsigned& nx) {
    const unsigned G = gridDim.x * gridDim.y * gridDim.z;
    unsigned sum, cnt, mine, sp = 0u;
    for (;;) {
        sum = 0u; cnt = 0u; mine = 0u;
#pragma unroll
        for (unsigned j = 0; j < 16; ++j) { const unsigned c = xb_ld(&bar[XB_XCNT(j)]); sum += c; cnt += (c > 0u) ? 1u : 0u; mine = (j == x) ? c : mine; }
        if (sum == G) break;
        __builtin_amdgcn_s_sleep(1);
        if ((++sp & 255u) == 0u) { if (xb_ld(&bar[XB_TMO])) break; if (sp > XB_SPIN_CAP) { atomicAdd(&bar[XB_TMO], 1u); break; } }
    }
    nloc = mine > 0u ? mine : 1u; nx = cnt > 0u ? cnt : 1u;
}

__device__ __forceinline__ void xcd_barrier(const XcdBarrier& b) {
    asm volatile("s_waitcnt vmcnt(0)" ::: "memory");
    __syncthreads();
    if (threadIdx.x == 0) {
        unsigned* bar = b.bar;
        __builtin_amdgcn_s_waitcnt(0);
        unsigned nloc = b.st[0], nx = b.st[1];
        if (nloc == 0u) { xcd_barrier_complete(bar, b.x, nloc, nx); b.st[0] = nloc; b.st[1] = nx; }
        const unsigned old = xb_add(&bar[XB_XSUB(b.x)], 1u);
        const unsigned gen = old / nloc;
        if (old + 1u == (gen + 1u) * nloc) {
            __builtin_amdgcn_fence(__ATOMIC_RELEASE, "agent");
            asm volatile("s_waitcnt vmcnt(0)" ::: "memory");
            const unsigned og = xb_add(&bar[XB_TOP], 1u);
            const unsigned tg = og / nx;
            if (og + 1u == (tg + 1u) * nx) xb_add(&bar[XB_TOPGEN], 1u);
            else XB_SPIN(xb_ld(&bar[XB_TOPGEN]) == tg, bar);
            __builtin_amdgcn_fence(__ATOMIC_ACQUIRE, "agent");
            xb_add(&bar[XB_XGEN(b.x)], 1u);
            asm volatile("s_waitcnt vmcnt(0)" ::: "memory");
        } else {
            XB_SPIN(xb_ld(&bar[XB_XGEN(b.x)]) == gen, bar);
            __builtin_amdgcn_fence(__ATOMIC_ACQUIRE, "agent");
            asm volatile("s_waitcnt vmcnt(0)" ::: "memory");
        }
    }
    __syncthreads();
}

#ifndef RES_ALIGN
#define RES_ALIGN true
#endif
__global__ void __launch_bounds__(512, 2) hymba_fwd(Args args) {
    extern __shared__ __attribute__((aligned(16))) unsigned char lds_raw[];
    LAS unsigned char* lds = (LAS unsigned char*)lds_raw;
    cg::grid_group grid = cg::this_grid();
    const int tid = threadIdx.x, lane = tid & 63, wave = __builtin_amdgcn_readfirstlane(tid >> 6);
    const int G = gridDim.x, bx = blockIdx.x, vcu = (G % 8 == 0) ? (bx % 8) * (G / 8) + bx / 8 : bx;
    const int gw = bx * 8 + wave, NGW = G * 8;
    unsigned char* ws = args.ws;
    const int lo = args.ph_lo, hi = args.ph_hi;
    const float* MOD = (const float*)(ws + WS_MOD);
    volatile LAS unsigned* bst = (volatile LAS unsigned*)(lds + LDS_BST);
    if (tid < 2) bst[tid] = 0u;
    __syncthreads();
    const XcdBarrier xbar = xcd_barrier_post((unsigned*)(ws + WS_BAR), bst);
    bf16* XN = (bf16*)(ws + WS_A); bf16* HB = (bf16*)(ws + WS_B); bf16* X1 = (bf16*)(ws + WS_C);
#ifndef PHMASK
#define PHMASK 0xFFFF
#endif
#define IN(k) (((PHMASK >> (k)) & 1) && lo <= (k) && (k) < hi)
#define GSYNC(k) do { xcd_barrier(xbar); } while (0)
#if defined(PROBE_TA)
#define STAMP(i) do { if (bx == 0 && tid == 0) ((unsigned long long*)(ws + 480 * KiB))[i] = __builtin_amdgcn_s_memrealtime(); } while (0)
#else
#define STAMP(i) do { } while (0)
#endif
#define SEAM(k) do { if (IN(k) && IN((k) + 1)) GSYNC(k); STAMP((k) + 1); } while (0)
#define PH_BEGIN(k) if (IN(k)) for (int rep_ = 0; rep_ < ((k) == PROBE_PHASE ? 2 : 1); ++rep_) { if (rep_) xcd_barrier(xbar);
#define PH_END(k) } SEAM(k)
    STAMP(0);
    if (args.ph_lo < 0) grid.sync();
    if (PROBE_PHASE == 200) { for (int r3 = 0; r3 < 16; ++r3) xcd_barrier(xbar); }
    PH_BEGIN(0) { phase0(args, lds, gw, NGW, tid, lane, wave); } PH_END(0);
    PH_BEGIN(1) { norm_rows<false>(args.in[0], args.in[2], MTOT, args.in[6], MOD, 0, XN, gw, NGW, lane); } PH_END(1);
    PH_BEGIN(2) { pg8::Gemm g{XN, (const bf16*)(ws + WS_W1A), MTOT, 2 * DFF, D}; pg8::StaticOrder S; S.init(MTOT, 2 * DFF, G, bx);
        pg8::EpiSwiglu E{HB, DFF}; pg8::gemm_phase<pg8::EpiSwiglu, pg8::StaticOrder, false, true>(lds, g, S, E); } PH_END(2);
    PH_BEGIN(3) {
        { pg8::Gemm g{HB, (const bf16*)(ws + WS_W1B), NLAT, D, DFF}; pg8::StaticOrder S; S.init(NLAT, D, G, bx);
          pg8::EpiRes<false, true> E{args.in[0], args.in[2], X1, MOD, 2, 0.5f}; pg8::gemm_phase<pg8::EpiRes<false, true>, pg8::StaticOrder, RES_ALIGN, true>(lds, g, S, E); }
        { pg8::Gemm g{HB, (const bf16*)(ws + WS_W1B), MTOT, D, DFF, DFF}; pg8::CtxSplitOrder S{G, (bx + G / 2) % G};
          pg8::EpiResCtx E{args.in[2], X1, (float*)args.out, MOD, 2, 0.5f}; pg8::gemm_phase<pg8::EpiResCtx, pg8::CtxSplitOrder, true, true>(lds, g, S, E); }
    } PH_END(3);
    PH_BEGIN(4) { norm_rows<true>(X1, X1 + (size_t)NLAT * D, MTOT, args.in[9], MOD, 3, XN, gw, NGW, lane, (const float*)args.out); } PH_END(4);
    PH_BEGIN(5) { pg8::Gemm g{XN, (const bf16*)(ws + WS_WIN), MTOT, 2816, D}; pg8::StaticOrder S; S.init(MTOT, 2816, G, bx);
        pg8::EpiSplit E{(bf16*)(ws + WS_Z), (bf16*)(ws + WS_XBCR), (bf16*)(ws + WS_CQ), (bf16*)(ws + WS_CKV), (bf16*)(ws + WS_MISC)};
        pg8::gemm_phase<pg8::EpiSplit, pg8::StaticOrder, true, true>(lds, g, S, E); } PH_END(5);
    PH_BEGIN(6) { phase6(args, lds, G, bx, tid, lane, wave); } PH_END(6);
    PH_BEGIN(7) {
        unsigned char* ob = (unsigned char*)args.out;
        { pg8::Gemm g{(const bf16*)(ws + WS_CQ), (const bf16*)(ws + WS_WUQ), NLAT, 768, 768}; pg8::StaticOrder S; S.init(NLAT, 768, G, bx);
          pg8::EpiScale E{(bf16*)(ob + OUT_Q), 768, (const float*)(ws + WS_RSTDQ), nullptr}; pg8::gemm_phase<pg8::EpiScale, pg8::StaticOrder, true, true>(lds, g, S, E); }
        { pg8::Gemm g{(const bf16*)(ws + WS_CKV), (const bf16*)(ws + WS_WK), MTOT, 512, 256}; pg8::StaticOrder S; S.init(MTOT, 512, G, (bx + 128) % G);
          pg8::EpiScale E{(bf16*)(ob + OUT_KN), 512, (const float*)(ws + WS_RSTDKV), nullptr}; pg8::gemm_phase<pg8::EpiScale, pg8::StaticOrder, true, true>(lds, g, S, E); }
        { pg8::Gemm g{(const bf16*)(ws + WS_WV), (const bf16*)(ws + WS_CKV), 512, MTOT, 256}; pg8::StaticOrder S; S.init(512, MTOT, G, (bx + 112) % G);
          pg8::EpiScale E{(bf16*)(ob + OUT_VT), MTOT, nullptr, (const float*)(ws + WS_RSTDKV)}; pg8::gemm_phase<pg8::EpiScale, pg8::StaticOrder, true, true>(lds, g, S, E); }
        phase8(args, lds, G, bx, tid, lane, wave);
    } PH_END(7);
    PH_BEGIN(9) { phase9(args, G, bx, tid); } PH_END(9);
    PH_BEGIN(10) {
#ifndef NO_SSD
        for (int r2 = 0; r2 < (PROBE_PHASE == 100 ? 2 : 1); ++r2) phase10_ssd(args, lds, G, bx, tid, lane, wave);
#endif

        STAMP(17);
#ifndef NO_ATTN
        for (int r2 = 0; r2 < (PROBE_PHASE == 101 ? 2 : 1); ++r2) phase10_attn(args, lds, G, vcu, tid, lane, wave);
#endif
    } PH_END(10);
    PH_BEGIN(11) { pg8::Gemm g{(const bf16*)(ws + WS_MIX), (const bf16*)(ws + WS_WOUT), NLAT, D, D}; pg8::StaticOrder S; S.init(NLAT, D, G, bx);
        pg8::EpiRes<true, true> E{X1, X1, X1, MOD, 5, 1.0f}; pg8::gemm_phase<pg8::EpiRes<true, true>, pg8::StaticOrder, RES_ALIGN, true>(lds, g, S, E); } PH_END(11);
    PH_BEGIN(12) { norm_rows<true>(X1, X1, NLAT, args.in[22], MOD, 6, XN, gw, NGW, lane); } PH_END(12);
    PH_BEGIN(13) { pg8::Gemm g{XN, (const bf16*)(ws + WS_W2A), NLAT, 2 * DFF, D}; pg8::StaticOrder S; S.init(NLAT, 2 * DFF, G, bx);
        pg8::EpiSwiglu E{HB, DFF}; pg8::gemm_phase<pg8::EpiSwiglu, pg8::StaticOrder, false, true>(lds, g, S, E); } PH_END(13);
    PH_BEGIN(14) { pg8::Gemm g{HB, (const bf16*)(ws + WS_W2B), NLAT, D, DFF}; pg8::StaticOrder S; S.init(NLAT, D, G, bx);
        pg8::EpiRes<true, false> E{X1, X1, args.out, MOD, 8, 0.5f}; pg8::gemm_phase<pg8::EpiRes<true, false>, pg8::StaticOrder, RES_ALIGN, true>(lds, g, S, E); } PH_END(14);
    PH_BEGIN(15) { final_norm_rows(args.out, args.in[25], gw, NGW, lane); } PH_END(15);
#if defined(PROBE_TA)
    xcd_barrier(xbar);
    if (bx == 0) {
        const unsigned long long* TS = (const unsigned long long*)(ws + 480 * KiB);
#ifdef PROBE_A1
        const int a0 = PROBE_TA, b0 = PROBE_TB;
#undef PROBE_TA
#undef PROBE_TB
#define PROBE_TA (PROBE_A1 - 1)
#define PROBE_TB (PROBE_B1 - 1)
#else
        const int a0 = (PROBE_TA == 9) ? 8 : (PROBE_TA == 16 ? 10 : PROBE_TA), b0 = (PROBE_TB == 9) ? 8 : PROBE_TB;
#endif
        const float ta = (float)(__hip_atomic_load(TS + PROBE_TA + 1, __ATOMIC_RELAXED, __HIP_MEMORY_SCOPE_AGENT) - __hip_atomic_load(TS + a0, __ATOMIC_RELAXED, __HIP_MEMORY_SCOPE_AGENT)) * 0.01f;
        const float tb = (float)(__hip_atomic_load(TS + PROBE_TB + 1, __ATOMIC_RELAXED, __HIP_MEMORY_SCOPE_AGENT) - __hip_atomic_load(TS + b0, __ATOMIC_RELAXED, __HIP_MEMORY_SCOPE_AGENT)) * 0.01f;
        for (int i = tid; i < 1024 * 1024; i += 512) args.out[i] += ta * (1.f / 2000.f);
        if (tid == 0) args.out[2000 * 1024] += tb * (1.f / 500.f);
    }
#endif
#undef IN
#undef SEAM
}

#ifndef N_LAUNCHES
#define N_LAUNCHES 1
#endif
extern "C" void kernel_launch(void* const* d_in, const int* in_sizes, int n_in, void* d_out, int out_size, void* d_ws, size_t ws_size, hipStream_t stream) {
    static int grid = 0;
    if (grid == 0) {
        if (n_in != 26 || out_size != NLAT * D || ws_size < WS_END) { fprintf(stderr, "kernel_launch: unexpected shapes (n_in %d out %d ws %zu)\n", n_in, out_size, ws_size); grid = -1; return; }
        int dev = 0, cus = 0, per_cu = 0;
        (void)hipGetDevice(&dev); (void)hipDeviceGetAttribute(&cus, hipDeviceAttributeMultiprocessorCount, dev);
        if (hipFuncSetAttribute((const void*)hymba_fwd, hipFuncAttributeMaxDynamicSharedMemorySize, LDS_BYTES) != hipSuccess) { fprintf(stderr, "kernel_launch: hipFuncSetAttribute failed\n"); grid = -1; return; }
        if (hipOccupancyMaxActiveBlocksPerMultiprocessor(&per_cu, (const void*)hymba_fwd, 512, LDS_BYTES) != hipSuccess || per_cu < 1) { fprintf(stderr, "kernel_launch: occupancy query failed (%d)\n", per_cu); grid = -1; (void)hipGetLastError(); return; }
        grid = cus;
    }
    if (grid < 0) return;
    (void)hipMemsetAsync((char*)d_ws + WS_BAR, 0, 16 * KiB, stream);
    Args a{};
    for (int i = 0; i < 26; ++i) a.in[i] = (const float*)d_in[i];
    a.out = (float*)d_out; a.ws = (unsigned char*)d_ws;
    for (int li = 0; li < N_LAUNCHES; ++li) {
        a.ph_lo = (N_LAUNCHES == 1) ? 0 : li; a.ph_hi = (N_LAUNCHES == 1) ? NPHASE : li + 1;
        void* kargs[] = {&a};
        hipError_t e = hipLaunchCooperativeKernel((const void*)hymba_fwd, dim3(grid), dim3(512), kargs, LDS_BYTES, stream);
        if (e != hipSuccess) { fprintf(stderr, "kernel_launch: cooperative launch %d failed: %s (grid %d)\n", li, hipGetErrorString(e), grid); break; }
    }
}
```

```cpp
#include <hip/hip_runtime.h>
#include <hip/hip_cooperative_groups.h>
#include <cstdio>
#include <cstdint>
namespace cg = cooperative_groups;
namespace pg8 {
#define PG8_LAS __attribute__((address_space(3)))
typedef unsigned short bf16_t;
typedef short bf16x8 __attribute__((ext_vector_type(8)));
typedef float f32x4 __attribute__((ext_vector_type(4)));
typedef unsigned u32x4 __attribute__((ext_vector_type(4)));
constexpr int BM = 256, BK = 64, HALF = 128, HTB = HALF * BK * 2  , STAGE_BYTES = 8 * HTB, NXCD = 8, WGM = 8;

__host__ __device__ __forceinline__ int lds_byte(int r, int c) { const int st = (r >> 4) * 2 + (c >> 5), rr = r & 15, cc = c & 31, ob = rr * 64 + cc * 2; return st * 1024 + (ob ^ (((ob >> 9) & 1) << 5)); }
__host__ __device__ __forceinline__ void stage_rc(int b, int& R, int& C) { const int st = b / 1024, sb = b % 1024, swz = sb ^ (((sb >> 9) & 1) << 5); R = (st >> 1) * 16 + swz / 64; C = (st & 1) * 32 + (swz % 64) / 2; }
__host__ __device__ __forceinline__ int perm32(int rho) { const int n = rho >> 4, i = rho & 15; return 8 * (i >> 2) + 4 * n + (i & 3); }

struct Unit { int pm, pn, ks; };
struct Gemm { const bf16_t* A; const bf16_t* Bt; int M, N, K; int ld; };

struct StaticOrder {
    int nM, nN, nwg, G, c;
    __host__ __device__ void init(int M, int N, int G_, int c_) { nM = M / BM; nN = N / BM; nwg = nM * nN; G = G_; c = c_; }
    __host__ __device__ bool next(int i, Unit& u) const {
        const long L = (long)i * G + c; if (L >= nwg) return false;
        int wgid = (int)L; { const int q = nwg / NXCD, r = nwg % NXCD, xcd = wgid % NXCD, off = wgid / NXCD; wgid = (xcd < r ? xcd * (q + 1) : r * (q + 1) + (xcd - r) * q) + off; }
        const int nig = WGM * nN, gid = wgid / nig, fm = gid * WGM, gsz = (nM - fm) < WGM ? (nM - fm) : WGM;
        u.pm = fm + ((wgid % nig) % gsz); u.pn = (wgid % nig) / gsz; u.ks = 0; return true;
    }
    __device__ __forceinline__ size_t koff(const Unit&) const { return 0; }
    __device__ __forceinline__ int ntiles(const Unit&, int nt) const { return nt; }
    __device__ __forceinline__ void a_ready(const Unit&) const {}
    __device__ __forceinline__ void done(const Unit&) const {}
};

__device__ __forceinline__ unsigned cvt_pk_bf16(float lo, float hi) { unsigned r; asm volatile("v_cvt_pk_bf16_f32 %0, %1, %2" : "=v"(r) : "v"(lo), "v"(hi)); return r; }
typedef float f32x2 __attribute__((ext_vector_type(2)));
__device__ __forceinline__ f32x2 gelu_pk(f32x2 v) {
    const f32x2 av = __builtin_elementwise_abs(v), d = av * 0.2316418882f + 1.0f;
    f32x2 t; t.x = __builtin_amdgcn_rcpf(d.x); t.y = __builtin_amdgcn_rcpf(d.y);
    f32x2 q = t * 0.5307027145f + (-0.7265760135f); q = q * t + 0.7107068705f; q = q * t + (-0.142248368f); q = q * t + 0.127414796f; q = q * t;
    const f32x2 s = (v * v) * (-0.72134752044f);
    f32x2 e; e.x = __builtin_amdgcn_exp2f(s.x); e.y = __builtin_amdgcn_exp2f(s.y);
    const f32x2 m = v * (q * e), r = v - m;
    f32x2 o; o.x = v.x < 0.f ? m.x : r.x; o.y = v.y < 0.f ? m.y : r.y; return o;
}

template <int ACT  > struct EpiBf16 {
    static constexpr bool PERM = true, AFTER_DRAIN = false; static_assert(ACT == 0 || ACT == 1, "EpiBf16: ACT is 0 (none) or 1 (gelu_pk)");
    bf16_t* O; int ldc; const float* bias; int split_cols; size_t split_stride; float scale0;
    __device__ __forceinline__ void operator()(const f32x4 (&acc)[2][2][4][2], const Unit& u, int wr, int wc, int fr, int fq) const {
        const int row0 = u.pm * BM + wr * 64 + fr; int colt = u.pn * BM; bf16_t* base = O;
        float sc = 1.f; if (split_cols) { const int t = colt / split_cols; base += (size_t)t * split_stride; colt -= t * split_cols; if (t == 0) sc = scale0; }
        const int col0 = colt + wc * 32 + 8 * fq, bcol0 = u.pn * BM + wc * 32 + 8 * fq;
        f32x4 bv[2][2];
#pragma unroll
        for (int bj = 0; bj < 2; ++bj)
#pragma unroll
            for (int n = 0; n < 2; ++n) bv[bj][n] = bias ? *(const f32x4*)(bias + bcol0 + bj * HALF + 4 * n) : (f32x4){0.f, 0.f, 0.f, 0.f};
#pragma unroll
        for (int ai = 0; ai < 2; ++ai)
#pragma unroll
            for (int m = 0; m < 4; ++m) { bf16_t* rowp = base + (size_t)(row0 + ai * HALF + m * 16) * ldc + col0;
#pragma unroll
                for (int bj = 0; bj < 2; ++bj) { f32x4 v0 = acc[ai][bj][m][0] + bv[bj][0], v1 = acc[ai][bj][m][1] + bv[bj][1];
                    if (ACT == 1) { f32x2 a = gelu_pk((f32x2){v0[0], v0[1]}), b = gelu_pk((f32x2){v0[2], v0[3]}), c = gelu_pk((f32x2){v1[0], v1[1]}), d = gelu_pk((f32x2){v1[2], v1[3]});
                        v0 = (f32x4){a.x, a.y, b.x, b.y}; v1 = (f32x4){c.x, c.y, d.x, d.y}; }
                    v0 = v0 * sc; v1 = v1 * sc; u32x4 w; w.x = cvt_pk_bf16(v0[0], v0[1]); w.y = cvt_pk_bf16(v0[2], v0[3]); w.z = cvt_pk_bf16(v1[0], v1[1]); w.w = cvt_pk_bf16(v1[2], v1[3]);
                    *(u32x4*)(rowp + bj * HALF) = w; } }
    }
};
template <class Epi, class Sched, bool ALIGN_EPI = false, bool SP2 = false>
__device__ __forceinline__ void gemm_phase(PG8_LAS unsigned char* lds, const Gemm g, const Sched& S, const Epi& E) {
    const int tid = threadIdx.x, wid = __builtin_amdgcn_readfirstlane(tid >> 6), lane = tid & 63, wr = wid >> 2, wc = wid & 3, fr = lane & 15, fq = lane >> 4;
    const int K = g.K, LD = g.ld ? g.ld : g.K; int nt = K / BK;
    unsigned voffA[2], voffB[2];
#pragma unroll
    for (int i = 0; i < 2; ++i) { int R, C; stage_rc(tid * 16 + i * 8192, R, C); const int Rb = Epi::PERM ? ((R & ~31) + perm32(R & 31)) : R;
        voffA[i] = (unsigned)(R * LD + C) * 2u; voffB[i] = (unsigned)(Rb * LD + C) * 2u; }
    const size_t kstep = (size_t)(BK * 2);
    const size_t hstep = (size_t)HALF * LD * 2;
    const size_t tstep = 2 * hstep;
    const unsigned ldsw = (unsigned)wid * 1024u;
    const int aoff = lds_byte(wr * 64 + fr, fq * 8), boff = lds_byte(wc * 32 + fr, fq * 8);
#define PG8_SA(b, h) (((b) * 2 + (h)) * HTB)
#define PG8_SB(b, h) ((4 + (b) * 2 + (h)) * HTB)
#define PG8_STAGE(bufoff, gbase, voff) do { _Pragma("unroll") for (int _i = 0; _i < 2; ++_i) \
        __builtin_amdgcn_global_load_lds((const unsigned*)((const char*)(gbase) + (voff)[_i]), (PG8_LAS unsigned*)(lds + (bufoff) + ldsw + _i * 8192), 16, 0, 0); } while (0)
#define PG8_LDA(dst, b, h) do { _Pragma("unroll") for (int m = 0; m < 4; ++m) _Pragma("unroll") for (int k = 0; k < 2; ++k) dst[m][k] = *(const PG8_LAS bf16x8*)(lds + PG8_SA(b, h) + aoff + m * 2048 + k * 1024); } while (0)
#define PG8_LDB(dst, b, h) do { _Pragma("unroll") for (int n = 0; n < 2; ++n) _Pragma("unroll") for (int k = 0; k < 2; ++k) dst[n][k] = *(const PG8_LAS bf16x8*)(lds + PG8_SB(b, h) + boff + n * 2048 + k * 1024); } while (0)
#define PG8_MMA(ai, bj, At, Bt) do { __builtin_amdgcn_s_setprio(1); _Pragma("unroll") for (int m = 0; m < 4; ++m) _Pragma("unroll") for (int n = 0; n < 2; ++n) _Pragma("unroll") for (int k = 0; k < 2; ++k) \
        acc[ai][bj][m][n] = __builtin_amdgcn_mfma_f32_16x16x32_bf16(Bt[n][k], At[m][k], acc[ai][bj][m][n], 0, 0, 0); __builtin_amdgcn_s_setprio(0); } while (0)
#define PG8_WAIT_V(n) asm volatile("s_waitcnt vmcnt(" #n ")" ::: "memory")
#define PG8_WAIT_L(n) asm volatile("s_waitcnt lgkmcnt(" #n ")" ::: "memory")
#define PG8_BAR __builtin_amdgcn_s_barrier()
#define PG8_SCHED __builtin_amdgcn_sched_barrier(0)
    Unit cur, nxt; int ui = 0;
    if (!S.next(0, cur)) return;
    f32x4 acc[2][2][4][2];
#pragma unroll
    for (int a = 0; a < 2; ++a)
#pragma unroll
        for (int b = 0; b < 2; ++b)
#pragma unroll
            for (int m = 0; m < 4; ++m)
#pragma unroll
                for (int n = 0; n < 2; ++n) acc[a][b][m][n] = (f32x4){0.f, 0.f, 0.f, 0.f};
    bf16x8 At[4][2], B0[2][2], B1[2][2];
    const char* cA = (const char*)g.A + (size_t)cur.pm * tstep + S.koff(cur); const char* cB = (const char*)g.Bt + (size_t)cur.pn * tstep + S.koff(cur);
    S.a_ready(cur);
    if constexpr (SP2) {
        PG8_STAGE(PG8_SB(0, 0), cB, voffB); PG8_STAGE(PG8_SB(0, 1), cB + hstep, voffB); PG8_STAGE(PG8_SA(0, 0), cA, voffA); PG8_STAGE(PG8_SA(0, 1), cA + hstep, voffA);
        if (wr == 1) PG8_BAR;
        PG8_WAIT_V(2); PG8_BAR;
        PG8_STAGE(PG8_SB(1, 0), cB + kstep, voffB); PG8_STAGE(PG8_SA(1, 0), cA + kstep, voffA); PG8_STAGE(PG8_SB(1, 1), cB + hstep + kstep, voffB);
        PG8_WAIT_V(6); PG8_BAR;
    } else {
        PG8_STAGE(PG8_SB(0, 0), cB, voffB); PG8_STAGE(PG8_SA(0, 0), cA, voffA); PG8_STAGE(PG8_SB(0, 1), cB + hstep, voffB); PG8_STAGE(PG8_SA(0, 1), cA + hstep, voffA);
        if (wr == 1) PG8_BAR;
        PG8_WAIT_V(4); PG8_BAR;
        PG8_STAGE(PG8_SB(1, 0), cB + kstep, voffB); PG8_STAGE(PG8_SA(1, 0), cA + kstep, voffA); PG8_STAGE(PG8_SB(1, 1), cB + hstep + kstep, voffB);
        PG8_WAIT_V(6); PG8_BAR;
    }
    for (;;) {
        const bool has_next = S.next(ui + 1, nxt);
        const char* nA = has_next ? (const char*)g.A + (size_t)nxt.pm * tstep + S.koff(nxt) : cA; const char* nB = has_next ? (const char*)g.Bt + (size_t)nxt.pn * tstep + S.koff(nxt) : cB;
        nt = S.ntiles(cur, K / BK);
        for (int t = 0; t < nt; t += 2) {
            const bool last = (t == nt - 2);
            const char* a1 = cA + (size_t)(t + 1) * kstep;
            const char* a2 = last ? nA : cA + (size_t)(t + 2) * kstep; const char* b2 = last ? nB : cB + (size_t)(t + 2) * kstep;
            const char* a3 = a2 + kstep; const char* b3 = b2 + kstep;
            if (last && has_next) S.a_ready(nxt);
            if constexpr (SP2) {
            PG8_LDB(B0, 0, 0); PG8_LDB(B1, 0, 1); PG8_SCHED; PG8_LDA(At, 0, 0); PG8_STAGE(PG8_SA(1, 1), a1 + hstep, voffA);
            PG8_WAIT_V(8); PG8_WAIT_L(0); PG8_BAR; PG8_MMA(0, 0, At, B0); PG8_MMA(0, 1, At, B1); PG8_BAR; PG8_SCHED;
            PG8_LDA(At, 0, 1); PG8_STAGE(PG8_SB(0, 0), b2, voffB); PG8_STAGE(PG8_SB(0, 1), b2 + hstep, voffB); PG8_STAGE(PG8_SA(0, 0), a2, voffA);
            PG8_WAIT_V(8); PG8_WAIT_L(0); PG8_BAR; PG8_MMA(1, 0, At, B0); PG8_MMA(1, 1, At, B1); PG8_BAR; PG8_SCHED;
            PG8_LDB(B0, 1, 0); PG8_LDB(B1, 1, 1); PG8_SCHED; PG8_LDA(At, 1, 0); PG8_STAGE(PG8_SA(0, 1), a2 + hstep, voffA);
            PG8_WAIT_V(8); PG8_WAIT_L(0); PG8_BAR; PG8_MMA(0, 0, At, B0); PG8_MMA(0, 1, At, B1); PG8_BAR; PG8_SCHED;
            PG8_LDA(At, 1, 1); PG8_STAGE(PG8_SB(1, 0), b3, voffB); PG8_STAGE(PG8_SB(1, 1), b3 + hstep, voffB); PG8_STAGE(PG8_SA(1, 0), a3, voffA);
            PG8_WAIT_V(8); PG8_WAIT_L(0); PG8_BAR; PG8_MMA(1, 0, At, B0); PG8_MMA(1, 1, At, B1); PG8_BAR; PG8_SCHED;
            } else {
            PG8_LDB(B0, 0, 0); PG8_SCHED; PG8_LDA(At, 0, 0); PG8_STAGE(PG8_SA(1, 1), a1 + hstep, voffA);
            PG8_WAIT_L(8); PG8_BAR; PG8_WAIT_L(0); PG8_MMA(0, 0, At, B0); PG8_BAR; PG8_SCHED;
            PG8_LDB(B1, 0, 1); PG8_STAGE(PG8_SB(0, 0), b2, voffB);
            PG8_BAR; PG8_WAIT_L(0); PG8_MMA(0, 1, At, B1); PG8_BAR;
            PG8_LDA(At, 0, 1); PG8_STAGE(PG8_SA(0, 0), a2, voffA);
            PG8_BAR; PG8_WAIT_L(0); PG8_MMA(1, 0, At, B0); PG8_BAR; PG8_SCHED;
            PG8_STAGE(PG8_SB(0, 1), b2 + hstep, voffB);
            PG8_WAIT_V(6); PG8_BAR; PG8_MMA(1, 1, At, B1); PG8_BAR;
            PG8_LDB(B0, 1, 0); PG8_SCHED; PG8_LDA(At, 1, 0); PG8_STAGE(PG8_SA(0, 1), a2 + hstep, voffA);
            PG8_WAIT_L(8); PG8_BAR; PG8_WAIT_L(0); PG8_MMA(0, 0, At, B0); PG8_BAR; PG8_SCHED;
            PG8_LDB(B1, 1, 1); PG8_STAGE(PG8_SB(1, 0), b3, voffB);
            PG8_BAR; PG8_WAIT_L(0); PG8_MMA(0, 1, At, B1); PG8_BAR;
            PG8_LDA(At, 1, 1); PG8_STAGE(PG8_SA(1, 0), a3, voffA);
            PG8_BAR; PG8_WAIT_L(0); PG8_MMA(1, 0, At, B0); PG8_BAR; PG8_SCHED;
            PG8_STAGE(PG8_SB(1, 1), b3 + hstep, voffB);
            PG8_WAIT_V(6); PG8_BAR; PG8_MMA(1, 1, At, B1); PG8_BAR;
            }
        }
        if constexpr (ALIGN_EPI) { if (wr == 0) PG8_BAR; }
        if constexpr (!Epi::AFTER_DRAIN) { E(acc, cur, wr, wc, fr, fq); S.done(cur); }
        if (!has_next) break;
#pragma unroll
        for (int a = 0; a < 2; ++a)
#pragma unroll
            for (int b = 0; b < 2; ++b)
#pragma unroll
                for (int m = 0; m < 4; ++m)
#pragma unroll
                    for (int n = 0; n < 2; ++n) acc[a][b][m][n] = (f32x4){0.f, 0.f, 0.f, 0.f};
        cur = nxt; cA = nA; cB = nB; ++ui;
        if constexpr (ALIGN_EPI) { if (wr == 1) PG8_BAR; }
    }
    PG8_WAIT_V(0);
    if constexpr (!ALIGN_EPI) { if (wr == 0) PG8_BAR; }
    PG8_BAR;
    if constexpr (Epi::AFTER_DRAIN) { E.fused(acc, cur, wr, wc, fr, fq, lds, wid, lane); S.done(cur); }
#undef PG8_SA
#undef PG8_SB
#undef PG8_STAGE
#undef PG8_LDA
#undef PG8_LDB
#undef PG8_MMA
#undef PG8_WAIT_V
#undef PG8_WAIT_L
#undef PG8_BAR
#undef PG8_SCHED
}
}
#ifndef PROBE_PHASE
#define PROBE_PHASE -1
#endif

#define LAS __attribute__((address_space(3)))
typedef unsigned short bf16;
typedef short bf16x8 __attribute__((ext_vector_type(8)));
typedef float f32x2 __attribute__((ext_vector_type(2)));
typedef float f32x4 __attribute__((ext_vector_type(4)));
typedef float f32x16 __attribute__((ext_vector_type(16)));
typedef unsigned u32x2 __attribute__((ext_vector_type(2)));
typedef unsigned u32x4 __attribute__((ext_vector_type(4)));
typedef __bf16 bf16x2_t __attribute__((ext_vector_type(2)));

constexpr int D = 1024, NB = 8, SEQ = 4096, CTXL = 256, NLAT = NB * SEQ, NCTX = NB * CTXL, MTOT = NLAT + NCTX;
constexpr int DFF = 2816, UL = SEQ + CTXL, NCH = UL / 128;
constexpr float EPS = 1e-6f;
constexpr float QSCALE = 0.10206207261596575f * 1.4426950408889634f;
constexpr int NPHASE = 16;

constexpr size_t MiB = (size_t)1 << 20, KiB = 1024;
constexpr size_t WS_BAR = 1 * MiB, WS_ZERO_BYTES = 1 * MiB + 16 * KiB;
constexpr size_t WS_MOD = 0, WS_ROPE = 384 * KiB, WS_CD = 448 * KiB, WS_RSTDQ = 512 * KiB, WS_RSTDKV = 768 * KiB;
constexpr size_t WS_W1A = 2 * MiB, WS_W1B = 13 * MiB, WS_WIN = 18 * MiB + 512 * KiB, WS_WUQ = 24 * MiB, WS_WK = 25 * MiB + 512 * KiB, WS_WV = 25 * MiB + 768 * KiB,
                 WS_WOUT = 26 * MiB, WS_W2A = 28 * MiB, WS_W2B = 39 * MiB;
constexpr size_t WS_A = 45 * MiB;
constexpr size_t WS_B = 113 * MiB;
constexpr size_t WS_Z = WS_B, WS_XBCR = WS_B + 34 * MiB, WS_CQ = WS_B + 102 * MiB, WS_CKV = WS_B + 153 * MiB, WS_MISC = WS_B + 170 * MiB;
constexpr size_t WS_ST = WS_XBCR, WS_MIX = WS_XBCR, WS_HE = WS_CQ;
constexpr size_t WS_C = 300 * MiB;
constexpr size_t WS_XT = 436 * MiB, WS_BT = 470 * MiB, WS_CROW = 487 * MiB, WS_DT = 504 * MiB, WS_KPE = 506 * MiB + 256 * KiB, WS_END = 512 * MiB;
constexpr size_t WS_BROW = WS_A;
constexpr size_t OUT_Q = 0, OUT_KN = 48 * MiB, OUT_VT = 82 * MiB;
constexpr int LDS_BYTES = 163840, LDS_BST = LDS_BYTES - 64;

__device__ __forceinline__ unsigned pk2(float lo, float hi) { f32x2 v = {lo, hi}; bf16x2_t b = __builtin_convertvector(v, bf16x2_t); return __builtin_bit_cast(unsigned, b); }
__device__ __forceinline__ float bflo(unsigned w) { return __uint_as_float(w << 16); }
__device__ __forceinline__ float bfhi(unsigned w) { return __uint_as_float(w & 0xffff0000u); }
__device__ __forceinline__ float bf2f(bf16 u) { return __uint_as_float((unsigned)u << 16); }
__device__ __forceinline__ float silu_f(float x) { return x * __builtin_amdgcn_rcpf(1.f + __builtin_amdgcn_exp2f(-1.4426950408889634f * x)); }
__device__ __forceinline__ float wave_sum(float v) {
#pragma unroll
    for (int o = 1; o < 64; o <<= 1) v += __shfl_xor(v, o);
    return v;
}
__device__ __forceinline__ float incl_scan(float v, int lane) {
#pragma unroll
    for (int o = 1; o < 64; o <<= 1) { float t = __shfl_up(v, o); if (lane >= o) v += t; }
    return v;
}
#define LDS_FENCE() asm volatile("s_waitcnt lgkmcnt(0)" ::: "memory")
__device__ __forceinline__ int crow(int r, int hi) { return (r & 3) + 8 * (r >> 2) + 4 * hi; }
__device__ __forceinline__ bf16x8 pack8(float a0, float a1, float a2, float a3, float a4, float a5, float a6, float a7) {
    u32x4 w; w.x = pk2(a0, a1); w.y = pk2(a2, a3); w.z = pk2(a4, a5); w.w = pk2(a6, a7); return __builtin_bit_cast(bf16x8, w);
}

struct Args { const float* in[26]; float* out; unsigned char* ws; int ph_lo, ph_hi; };

namespace pg8 {
typedef unsigned u32x2 __attribute__((ext_vector_type(2)));
struct EpiSwiglu {
    static constexpr bool PERM = true, AFTER_DRAIN = false;
    bf16_t* O; int ldc;
    __device__ __forceinline__ void operator()(const f32x4 (&acc)[2][2][4][2], const Unit& u, int wr, int wc, int fr, int fq) const {
        const int row0 = u.pm * BM + wr * 64 + fr, col0 = u.pn * HALF + wc * 32 + 8 * fq;
#pragma unroll
        for (int ai = 0; ai < 2; ++ai)
#pragma unroll
            for (int m = 0; m < 4; ++m) {
                bf16_t* rowp = O + (size_t)(row0 + ai * HALF + m * 16) * ldc + col0;
                const f32x4 g0 = acc[ai][0][m][0], g1 = acc[ai][0][m][1], u0 = acc[ai][1][m][0], u1 = acc[ai][1][m][1];
                u32x4 w;
                w.x = cvt_pk_bf16(silu_f(g0[0]) * u0[0], silu_f(g0[1]) * u0[1]); w.y = cvt_pk_bf16(silu_f(g0[2]) * u0[2], silu_f(g0[3]) * u0[3]);
                w.z = cvt_pk_bf16(silu_f(g1[0]) * u1[0], silu_f(g1[1]) * u1[1]); w.w = cvt_pk_bf16(silu_f(g1[2]) * u1[2], silu_f(g1[3]) * u1[3]);
                *(u32x4*)rowp = w;
            }
    }
};
template <bool BASE_BF16, bool OUT_BF16> struct EpiRes {
    static constexpr bool PERM = true, AFTER_DRAIN = false;
    const void* base_lat; const void* base_ctx; void* out; const float* mod; int kg; float mul;
    __device__ __forceinline__ void ldb(int r, int coff, f32x4& lo, f32x4& hi) const {
        const size_t off = (r < NLAT ? (size_t)r : (size_t)(r - NLAT)) * D + coff; const void* bsel = r < NLAT ? base_lat : base_ctx;
        constexpr bool NT = BASE_BF16 != OUT_BF16;
        if (BASE_BF16) { const u32x4 w = NT ? __builtin_nontemporal_load((const u32x4*)((const bf16_t*)bsel + off)) : *(const u32x4*)((const bf16_t*)bsel + off);
            lo = (f32x4){bflo(w.x), bfhi(w.x), bflo(w.y), bfhi(w.y)}; hi = (f32x4){bflo(w.z), bfhi(w.z), bflo(w.w), bfhi(w.w)}; }
        else { lo = NT ? __builtin_nontemporal_load((const f32x4*)((const float*)bsel + off)) : *(const f32x4*)((const float*)bsel + off);
               hi = NT ? __builtin_nontemporal_load((const f32x4*)((const float*)bsel + off + 4)) : *(const f32x4*)((const float*)bsel + off + 4); }
    }
    __device__ __forceinline__ void operator()(const f32x4 (&acc)[2][2][4][2], const Unit& u, int wr, int wc, int fr, int fq) const {
        const int row0 = u.pm * BM + wr * 64 + fr, col0 = u.pn * BM + wc * 32 + 8 * fq;
        const int bb = u.pm < (NLAT / BM) ? u.pm / (SEQ / BM) : 8;
        const float* gp = mod + bb * 9216 + kg * 1024 + col0;
        f32x4 gv[2][2];
#pragma unroll
        for (int bj = 0; bj < 2; ++bj)
#pragma unroll
            for (int n = 0; n < 2; ++n) gv[bj][n] = *(const f32x4*)(gp + bj * HALF + 4 * n) * mul;
        f32x4 cur[2][2], nxt[2][2];
#pragma unroll
        for (int bj = 0; bj < 2; ++bj) ldb(row0, col0 + bj * HALF, cur[bj][0], cur[bj][1]);
#pragma unroll
        for (int gi = 0; gi < 8; ++gi) {
            const int ai = gi >> 2, m = gi & 3;
            if (gi + 1 < 8) { const int r = row0 + ((gi + 1) >> 2) * HALF + ((gi + 1) & 3) * 16;
#pragma unroll
                for (int bj = 0; bj < 2; ++bj) ldb(r, col0 + bj * HALF, nxt[bj][0], nxt[bj][1]); }
            const size_t ooff = (size_t)(row0 + ai * HALF + m * 16) * D + col0;
#pragma unroll
            for (int bj = 0; bj < 2; ++bj) {
                const f32x4 o0 = cur[bj][0] + gv[bj][0] * acc[ai][bj][m][0], o1 = cur[bj][1] + gv[bj][1] * acc[ai][bj][m][1];
                cur[bj][0] = nxt[bj][0]; cur[bj][1] = nxt[bj][1];
                if (OUT_BF16) { u32x4 w; w.x = cvt_pk_bf16(o0[0], o0[1]); w.y = cvt_pk_bf16(o0[2], o0[3]); w.z = cvt_pk_bf16(o1[0], o1[1]); w.w = cvt_pk_bf16(o1[2], o1[3]); *(u32x4*)((bf16_t*)out + ooff + bj * HALF) = w; }
                else { *(f32x4*)((float*)out + ooff + bj * HALF) = o0; *(f32x4*)((float*)out + ooff + bj * HALF + 4) = o1; }
            }
        }
    }
};
struct EpiSplit {
    static constexpr bool PERM = true, AFTER_DRAIN = false;
    bf16_t *zb, *xbcr, *cq, *ckv, *misc;
    __device__ __forceinline__ void operator()(const f32x4 (&acc)[2][2][4][2], const Unit& u, int wr, int wc, int fr, int fq) const {
        const int pn = u.pn; bf16_t* base; int ld;
        if (pn < 2) { base = zb + pn * 256; ld = 512; } else if (pn < 6) { base = xbcr + (pn - 2) * 256; ld = 1024; } else if (pn < 9) { base = cq + (pn - 6) * 256; ld = 768; }
        else if (pn == 9) { base = ckv; ld = 256; } else { base = misc; ld = 256; }
        const int row0 = u.pm * BM + wr * 64 + fr, col0 = wc * 32 + 8 * fq;
#pragma unroll
        for (int ai = 0; ai < 2; ++ai)
#pragma unroll
            for (int m = 0; m < 4; ++m) {
                bf16_t* rowp = base + (size_t)(row0 + ai * HALF + m * 16) * ld + col0;
#pragma unroll
                for (int bj = 0; bj < 2; ++bj) { const f32x4 v0 = acc[ai][bj][m][0], v1 = acc[ai][bj][m][1];
                    u32x4 w; w.x = cvt_pk_bf16(v0[0], v0[1]); w.y = cvt_pk_bf16(v0[2], v0[3]); w.z = cvt_pk_bf16(v1[0], v1[1]); w.w = cvt_pk_bf16(v1[2], v1[3]);
                    *(u32x4*)(rowp + bj * HALF) = w; }
            }
    }
};
struct EpiScale {
    static constexpr bool PERM = true, AFTER_DRAIN = false;
    bf16_t* O; int ldc; const float* rs; const float* cs;
    __device__ __forceinline__ void operator()(const f32x4 (&acc)[2][2][4][2], const Unit& u, int wr, int wc, int fr, int fq) const {
        const int row0 = u.pm * BM + wr * 64 + fr, col0 = u.pn * BM + wc * 32 + 8 * fq;
        f32x4 cv[2][2];
#pragma unroll
        for (int bj = 0; bj < 2; ++bj)
#pragma unroll
            for (int n = 0; n < 2; ++n) cv[bj][n] = cs ? *(const f32x4*)(cs + col0 + bj * HALF + 4 * n) : (f32x4){1.f, 1.f, 1.f, 1.f};
#pragma unroll
        for (int ai = 0; ai < 2; ++ai)
#pragma unroll
            for (int m = 0; m < 4; ++m) {
                const int r = row0 + ai * HALF + m * 16; const float rv = rs ? rs[r] : 1.f;
                bf16_t* rowp = O + (size_t)r * ldc + col0;
#pragma unroll
                for (int bj = 0; bj < 2; ++bj) { const f32x4 v0 = acc[ai][bj][m][0] * cv[bj][0] * rv, v1 = acc[ai][bj][m][1] * cv[bj][1] * rv;
                    u32x4 w; w.x = cvt_pk_bf16(v0[0], v0[1]); w.y = cvt_pk_bf16(v0[2], v0[3]); w.z = cvt_pk_bf16(v1[0], v1[1]); w.w = cvt_pk_bf16(v1[2], v1[3]);
                    *(u32x4*)(rowp + bj * HALF) = w; }
            }
    }
};
struct CtxSplitOrder {
    int G, c;
    __device__ __forceinline__ bool next(int i, Unit& u) const { const int L = i * G + c; if (L >= 128) return false; u.pm = (NLAT / BM) + (L & 7); u.pn = (L >> 3) & 3; u.ks = L >> 5; return true; }
    __device__ __forceinline__ size_t koff(const Unit& u) const { return (size_t)(u.ks < 2 ? u.ks * 768 : 1536 + (u.ks - 2) * 640) * 2; }
    __device__ __forceinline__ int ntiles(const Unit& u, int) const { return u.ks < 2 ? 12 : 10; }
    __device__ __forceinline__ void a_ready(const Unit&) const {}
    __device__ __forceinline__ void done(const Unit&) const {}
};
struct EpiResCtx {
    static constexpr bool PERM = false, AFTER_DRAIN = false;
    const float* base_ctx; bf16_t* out; float* part; const float* mod; int kg; float mul;
    __device__ __forceinline__ void operator()(const f32x4 (&acc)[2][2][4][2], const Unit& u, int wr, int wc, int fr, int fq) const {
        const int row0 = (u.pm - NLAT / BM) * BM + wr * 64 + fr, col0 = u.pn * BM + wc * 32 + 4 * fq;
        const float* gp = mod + 8 * 9216 + kg * 1024 + col0;
        f32x4 gv[2][2];
#pragma unroll
        for (int bj = 0; bj < 2; ++bj)
#pragma unroll
            for (int n = 0; n < 2; ++n) gv[bj][n] = *(const f32x4*)(gp + bj * HALF + n * 16) * mul;
#pragma unroll
        for (int ai = 0; ai < 2; ++ai)
#pragma unroll
            for (int m = 0; m < 4; ++m) {
                const int r = row0 + ai * HALF + m * 16;
                const float* bp = base_ctx + (size_t)r * D + col0;
#pragma unroll
                for (int bj = 0; bj < 2; ++bj)
#pragma unroll
                    for (int n = 0; n < 2; ++n) { f32x4 v = gv[bj][n] * acc[ai][bj][m][n];
                        if (u.ks == 0) { v += *(const f32x4*)(bp + bj * HALF + n * 16); u32x2 w; w.x = cvt_pk_bf16(v[0], v[1]); w.y = cvt_pk_bf16(v[2], v[3]);
                            *(u32x2*)(out + (size_t)(NLAT + r) * D + col0 + bj * HALF + n * 16) = w; }
                        else *(f32x4*)(part + (size_t)(u.ks - 1) * NCTX * D + (size_t)r * D + col0 + bj * HALF + n * 16) = v; }
            }
    }
};
struct EpiQ {
    static constexpr bool PERM = true, AFTER_DRAIN = false;
    bf16_t* O; const float* rs; const f32x2* rope;
    __device__ __forceinline__ void operator()(const f32x4 (&acc)[2][2][4][2], const Unit& u, int wr, int wc, int fr, int fq) const {
        const int row0 = u.pm * BM + wr * 64 + fr, col0 = u.pn * BM + wc * 32 + 8 * fq;
#pragma unroll
        for (int ai = 0; ai < 2; ++ai)
#pragma unroll
            for (int m = 0; m < 4; ++m) {
                const int r = row0 + ai * HALF + m * 16; const float rv = rs[r] * QSCALE; const int t = r & (SEQ - 1);
                bf16_t* rowp = O + (size_t)r * 768 + col0;
#pragma unroll
                for (int bj = 0; bj < 2; ++bj) {
                    f32x4 v0 = acc[ai][bj][m][0] * rv, v1 = acc[ai][bj][m][1] * rv;
                    const int cc = (col0 + bj * HALF) % 96;
                    if (cc >= 64) {
                        const int q = cc - 64, half = q >> 4, jj = (q & 15) >> 1, pos = half ? (t & 63) : (t >> 6);
                        const f32x2* rp = rope + pos * 8 + jj;
                        const f32x2 c0 = rp[0], c1 = rp[1], c2 = rp[2], c3 = rp[3];
                        f32x4 o0, o1;
                        o0[0] = v0[0] * c0.x - v0[1] * c0.y; o0[1] = v0[0] * c0.y + v0[1] * c0.x; o0[2] = v0[2] * c1.x - v0[3] * c1.y; o0[3] = v0[2] * c1.y + v0[3] * c1.x;
                        o1[0] = v1[0] * c2.x - v1[1] * c2.y; o1[1] = v1[0] * c2.y + v1[1] * c2.x; o1[2] = v1[2] * c3.x - v1[3] * c3.y; o1[3] = v1[2] * c3.y + v1[3] * c3.x;
                        v0 = o0; v1 = o1;
                    }
                    u32x4 w; w.x = cvt_pk_bf16(v0[0], v0[1]); w.y = cvt_pk_bf16(v0[2], v0[3]); w.z = cvt_pk_bf16(v1[0], v1[1]); w.w = cvt_pk_bf16(v1[2], v1[3]);
                    *(u32x4*)(rowp + bj * HALF) = w;
                }
            }
    }
};
}

__device__ __forceinline__ int cmap(int id, int n) {
    switch (id) {
    case 0: return ((n >> 7) & 1) * DFF + (n >> 8) * 128 + (n & 127);
    case 1: return n;
    case 2: {
        if (n < 1536) return n;
        if (n < 2304) return 1552 + (n - 1536);
        if (n < 2560) return 2320 + (n - 2304);
        if (n < 2592) { const int q = n - 2560, half = q >> 4, jj = (q & 15) >> 1, which = q & 1; return 2576 + half * 16 + which * 8 + jj; }
        if (n < 2608) return 1536 + (n - 2592);
        return -1; }
    case 3: { const int hh = n / 96, cc = n % 96; if (cc < 64) return hh * 96 + cc;
        const int q = cc - 64, half = q >> 4, jj = (q & 15) >> 1, which = q & 1; return hh * 96 + 64 + half * 16 + which * 8 + jj; }
    case 4: return (n >> 6) * 128 + (n & 63);
    default: return (n >> 6) * 128 + 64 + (n & 63);
    }
}
__device__ __forceinline__ void titem(const float* W, int K, int N, bf16* WT, const float* gk, LAS float* scr, int item, int nblk, int lane, int id, float mulc = 1.f) {
    const int kb = item / nblk, nb = item % nblk, k0 = 64 * kb, n0 = 32 * nb;
    const int src = cmap(id, n0 + (lane & 31));
    float tv[32];
#pragma unroll
    for (int i = 0; i < 32; ++i) { const int kk = 2 * i + (lane >> 5); tv[i] = src >= 0 ? W[(size_t)(k0 + kk) * N + src] : 0.f; }
#pragma unroll
    for (int i = 0; i < 32; ++i) { const int kk = 2 * i + (lane >> 5); float v = tv[i]; if (gk) v *= gk[k0 + kk] * mulc; scr[kk * 33 + (lane & 31)] = v; }
    LDS_FENCE();
    const int c = lane & 7;
#pragma unroll
    for (int j = 0; j < 4; ++j) { const int n = (lane >> 3) + 8 * j; const LAS float* s = scr + (8 * c) * 33 + n;
        u32x4 o; o.x = pk2(s[0 * 33], s[1 * 33]); o.y = pk2(s[2 * 33], s[3 * 33]); o.z = pk2(s[4 * 33], s[5 * 33]); o.w = pk2(s[6 * 33], s[7 * 33]);
        *(u32x4*)(WT + (size_t)(n0 + n) * K + k0 + 8 * c) = o; }
    LDS_FENCE();
}
__device__ __forceinline__ void phase0(const Args& a, LAS unsigned char* lds, int gw, int NGW, int tid, int lane, int wave) {
    unsigned char* ws = a.ws;
    LAS float* scr = (LAS float*)(lds + wave * 16384);
    if (blockIdx.x < 144) {
        float* MOD = (float*)(ws + WS_MOD);
        const float* cin = a.in[1]; const float* cctx = a.in[3]; const float* wada = a.in[4]; const float* bada = a.in[5];
        LAS float* SV = (LAS float*)lds;
        LAS float* red = (LAS float*)(lds + 36864);
        for (int o = tid; o < 9 * 1024; o += 512) SV[o] = silu_f(o < 8192 ? cin[o] : cctx[o - 8192]);
        __syncthreads();
        const int kq = lane >> 4, c4 = (lane & 15) * 4;
        const float* wp = wada + (size_t)(wave * 128 + kq) * 9216 + blockIdx.x * 64 + c4;
        f32x4 acc[9];
#pragma unroll
        for (int bb = 0; bb < 9; ++bb) acc[bb] = (f32x4){0.f, 0.f, 0.f, 0.f};
#pragma unroll 8
        for (int i = 0; i < 32; ++i) {
            const f32x4 w = *(const f32x4*)(wp + (size_t)(4 * i) * 9216);
            const int k = wave * 128 + 4 * i + kq;
#pragma unroll
            for (int bb = 0; bb < 9; ++bb) acc[bb] += w * SV[bb * 1024 + k];
        }
#pragma unroll
        for (int bb = 0; bb < 9; ++bb)
#pragma unroll
            for (int e = 0; e < 4; ++e) { float v = acc[bb][e]; v += __shfl_xor(v, 16); v += __shfl_xor(v, 32); acc[bb][e] = v; }
        if (lane < 16) {
#pragma unroll
            for (int bb = 0; bb < 9; ++bb) *(LAS f32x4*)(red + (wave * 9 + bb) * 64 + c4) = acc[bb];
        }
        __syncthreads();
        for (int o = tid; o < 576; o += 512) { float t = bada[blockIdx.x * 64 + (o & 63)];
#pragma unroll
            for (int w = 0; w < 8; ++w) t += red[w * 576 + o];
            MOD[(o >> 6) * 9216 + blockIdx.x * 64 + (o & 63)] = t; }
        __syncthreads();
    }
    constexpr int I_W1A = 16 * 176, I_W1B = 44 * 32, I_WIN = 16 * 88, I_WUQ = 12 * 24, I_WK = 4 * 16, I_WOUT = 16 * 32;
    constexpr int NITEMS = 2 * I_W1A + 2 * I_W1B + I_WIN + I_WUQ + 2 * I_WK + I_WOUT;
    for (int rep0 = 0; rep0 < (PROBE_PHASE == 201 ? 2 : 1); ++rep0)
    for (int it = gw; it < NITEMS; it += NGW) {
        int r = it;
        if (r < I_W1A) { titem(a.in[7], 1024, 5632, (bf16*)(ws + WS_W1A), nullptr, scr, r, 176, lane, 0); continue; } r -= I_W1A;
        if (r < I_W1A) { titem(a.in[23], 1024, 5632, (bf16*)(ws + WS_W2A), nullptr, scr, r, 176, lane, 0); continue; } r -= I_W1A;
        if (r < I_W1B) { titem(a.in[8], 2816, 1024, (bf16*)(ws + WS_W1B), nullptr, scr, r, 32, lane, 1); continue; } r -= I_W1B;
        if (r < I_W1B) { titem(a.in[24], 2816, 1024, (bf16*)(ws + WS_W2B), nullptr, scr, r, 32, lane, 1); continue; } r -= I_W1B;
        if (r < I_WIN) { titem(a.in[10], 1024, 2608, (bf16*)(ws + WS_WIN), nullptr, scr, r, 88, lane, 2); continue; } r -= I_WIN;
        if (r < I_WUQ) { titem(a.in[18], 768, 768, (bf16*)(ws + WS_WUQ), a.in[17], scr, r, 24, lane, 3, QSCALE); continue; } r -= I_WUQ;
        if (r < I_WK) { titem(a.in[20], 256, 1024, (bf16*)(ws + WS_WK), a.in[19], scr, r, 16, lane, 4); continue; } r -= I_WK;
        if (r < I_WK) { titem(a.in[20], 256, 1024, (bf16*)(ws + WS_WV), a.in[19], scr, r, 16, lane, 5); continue; } r -= I_WK;
        titem(a.in[21], 1024, 1024, (bf16*)(ws + WS_WOUT), nullptr, scr, r, 32, lane, 1);
    }
    if (blockIdx.x == 0) {
        const int pos = tid >> 3, jj = tid & 7; const float inv = __builtin_amdgcn_exp2f(-(float)jj * 1.6609640474436813f);
        const float ang = (float)pos * inv;
        ((f32x2*)(ws + WS_ROPE))[tid] = (f32x2){__cosf(ang), __sinf(ang)};
    }
}

template <bool SRC_BF16> __device__ __forceinline__ void norm_rows(const void* src_lat, const void* src_ctx, int nrows, const float* gvec, const float* mod, int kshift, bf16* out, int gw, int NGW, int lane, const float* part = nullptr) {
    const int nlat = nrows < NLAT ? nrows : NLAT, per = (nlat + NGW - 1) / NGW, r_end = min(nlat, (gw + 1) * per), nctx = nrows - nlat;
    constexpr int RW = 4;
    const int n_it = (r_end > gw * per ? (r_end - gw * per + RW - 1) / RW : 0), n_ctx_it = nctx > gw ? (nctx - gw + NGW - 1) / NGW : 0;
    int cur_bb = -1; f32x4 fa[4], fb[4];
    const int c0 = 8 * lane;
    for (int it = 0; it < n_it + n_ctx_it; ++it) {
        const bool isl = it < n_it;
        const int row0 = isl ? gw * per + RW * it : NLAT + gw + (it - n_it) * NGW;
        const int nr = isl ? min(RW, r_end - row0) : 1;
        f32x4 v[RW][4]; float s[RW];
#pragma unroll
        for (int q = 0; q < RW; ++q) if (q < nr) {
            const int row = row0 + q;
            const size_t xo = (row < NLAT ? (size_t)row : (size_t)(row - NLAT)) * D + c0; const void* xs = row < NLAT ? src_lat : src_ctx;
#pragma unroll
            for (int j = 0; j < 2; ++j) {
                if (SRC_BF16) { const u32x4 w = *(const u32x4*)((const bf16*)xs + xo + 512 * j);
                    v[q][2 * j] = (f32x4){bflo(w.x), bfhi(w.x), bflo(w.y), bfhi(w.y)}; v[q][2 * j + 1] = (f32x4){bflo(w.z), bfhi(w.z), bflo(w.w), bfhi(w.w)}; }
                else { v[q][2 * j] = __builtin_nontemporal_load((const f32x4*)((const float*)xs + xo + 512 * j)); v[q][2 * j + 1] = __builtin_nontemporal_load((const f32x4*)((const float*)xs + xo + 512 * j + 4)); } }
        }
#pragma unroll
        for (int q = 0; q < RW; ++q) if (q < nr) {
            const int row = row0 + q; s[q] = 0.f;
#pragma unroll
            for (int j = 0; j < 4; ++j) {
                if (part && row >= NLAT) { const float* pp = part + (size_t)(row - NLAT) * D + c0 + 512 * (j >> 1) + 4 * (j & 1);
                    v[q][j] += *(const f32x4*)pp + *(const f32x4*)(pp + (size_t)NCTX * D) + *(const f32x4*)(pp + (size_t)2 * NCTX * D); }
                s[q] += (v[q][j][0] * v[q][j][0] + v[q][j][1] * v[q][j][1]) + (v[q][j][2] * v[q][j][2] + v[q][j][3] * v[q][j][3]); }
        }
#pragma unroll
        for (int q = 0; q < RW; ++q) if (q < nr) {
            const int row = row0 + q;
            const int bb = row < NLAT ? row / SEQ : 8;
            if (bb != cur_bb) { cur_bb = bb; const float* sh = mod + bb * 9216 + kshift * 1024 + c0;
#pragma unroll
                for (int j = 0; j < 4; ++j) { const int co = 512 * (j >> 1) + 4 * (j & 1);
                    fa[j] = *(const f32x4*)(gvec + c0 + co) * (*(const f32x4*)(sh + 1024 + co) + 1.f); fb[j] = *(const f32x4*)(sh + co); } }
            const float rstd = 1.0f / sqrtf(wave_sum(s[q]) * (1.f / D) + EPS);
            bf16* orow = out + (size_t)row * D + c0;
#pragma unroll
            for (int j = 0; j < 2; ++j) { const f32x4 y0 = (v[q][2 * j] * rstd) * fa[2 * j] + fb[2 * j], y1 = (v[q][2 * j + 1] * rstd) * fa[2 * j + 1] + fb[2 * j + 1];
                u32x4 w; w.x = pk2(y0[0], y0[1]); w.y = pk2(y0[2], y0[3]); w.z = pk2(y1[0], y1[1]); w.w = pk2(y1[2], y1[3]); *(u32x4*)(orow + 512 * j) = w; }
        }
    }
}
__device__ __forceinline__ void final_norm_rows(float* io, const float* gvec, int gw, int NGW, int lane) {
    const int per = NLAT / NGW;
    f32x4 g[4];
#pragma unroll
    for (int j = 0; j < 4; ++j) g[j] = *(const f32x4*)(gvec + 4 * lane + 256 * j);
    for (int row0 = gw * per; row0 < (gw + 1) * per; row0 += 2) {
        f32x4 v[2][4]; float s[2];
#pragma unroll
        for (int q = 0; q < 2; ++q)
#pragma unroll
            for (int j = 0; j < 4; ++j) v[q][j] = *(const f32x4*)(io + (size_t)(row0 + q) * D + 4 * lane + 256 * j);
#pragma unroll
        for (int q = 0; q < 2; ++q) { s[q] = 0.f;
#pragma unroll
            for (int j = 0; j < 4; ++j) s[q] += (v[q][j][0] * v[q][j][0] + v[q][j][1] * v[q][j][1]) + (v[q][j][2] * v[q][j][2] + v[q][j][3] * v[q][j][3]); }
#pragma unroll
        for (int q = 0; q < 2; ++q) {
            const float rstd = 1.0f / sqrtf(wave_sum(s[q]) * (1.f / D) + EPS);
#pragma unroll
            for (int j = 0; j < 4; ++j) __builtin_nontemporal_store((v[q][j] * rstd) * g[j], (f32x4*)(io + (size_t)(row0 + q) * D + 4 * lane + 256 * j));
        }
    }
}

__device__ __forceinline__ float softplus_f(float x) { return fmaxf(x, 0.f) + log1pf(__expf(-fabsf(x))); }
__device__ __forceinline__ void phase6(const Args& a, LAS unsigned char* lds, int G, int bx, int tid, int lane, int wave) {
    unsigned char* ws = a.ws;
    const bf16* XBCR = (const bf16*)(ws + WS_XBCR); const bf16* MISC = (const bf16*)(ws + WS_MISC); const bf16* CQ = (const bf16*)(ws + WS_CQ); const bf16* CKV = (const bf16*)(ws + WS_CKV);
    bf16* XT = (bf16*)(ws + WS_XT); bf16* BT = (bf16*)(ws + WS_BT); bf16* BROW = (bf16*)(ws + WS_BROW); bf16* CROW = (bf16*)(ws + WS_CROW); bf16* KPE = (bf16*)(ws + WS_KPE);
    float* DT = (float*)(ws + WS_DT); float* RSTDQ = (float*)(ws + WS_RSTDQ); float* RSTDKV = (float*)(ws + WS_RSTDKV); const f32x2* ROPE = (const f32x2*)(ws + WS_ROPE);
    const float* conv_w = a.in[11]; const float* conv_b = a.in[12]; const float* dt_bias = a.in[13];
    LAS bf16* T = (LAS bf16*)lds;
    const int ch = 4 * (tid & 255), tsw = 2 * ((ch >> 3) & 15);
    float cw[5][4], cb[4];
#pragma unroll
    for (int k = 0; k < 5; ++k) { const f32x4 w = *(const f32x4*)(conv_w + k * 1024 + ch); cw[k][0] = w[0]; cw[k][1] = w[1]; cw[k][2] = w[2]; cw[k][3] = w[3]; }
    { const f32x4 w = *(const f32x4*)(conv_b + ch); cb[0] = w[0]; cb[1] = w[1]; cb[2] = w[2]; cb[3] = w[3]; }
    for (int unit = bx; unit < NB * 64 + NB * 16; unit += G) {
        const bool isctx = unit >= NB * 64;
        const int b = isctx ? (unit - NB * 64) >> 4 : unit >> 6, len = isctx ? 16 : 64, u0 = isctx ? ((unit - NB * 64) & 15) * 16 : CTXL + (unit & 63) * 64;
        const int seg_lo = isctx ? 0 : CTXL, seg_hi = isctx ? CTXL : UL;
        const int rb = isctx ? NLAT + b * CTXL : b * SEQ - CTXL;
        const int spt = len >> 1, tseg = (tid >> 8) * spt;
#define P6_LD(u) (((u) >= seg_lo && (u) < seg_hi) ? *(const u32x2*)(XBCR + (size_t)(rb + (u)) * 1024 + ch) : (u32x2){0u, 0u})
        const int ub = u0 + tseg;
        u32x2 xin[36];
#pragma unroll
        for (int i = 0; i < 36; ++i) if (i < spt + 4) xin[i] = P6_LD(ub - 2 + i);
#pragma unroll
        for (int t = 0; t < 32; ++t) if (t < spt) {
            const u32x2 xm2 = xin[t], xm1 = xin[t + 1], x0 = xin[t + 2], xp1 = xin[t + 3], xp2 = xin[t + 4];
            const float y0 = cb[0] + cw[0][0] * bflo(xm2.x) + cw[1][0] * bflo(xm1.x) + cw[2][0] * bflo(x0.x) + cw[3][0] * bflo(xp1.x) + cw[4][0] * bflo(xp2.x);
            const float y1 = cb[1] + cw[0][1] * bfhi(xm2.x) + cw[1][1] * bfhi(xm1.x) + cw[2][1] * bfhi(x0.x) + cw[3][1] * bfhi(xp1.x) + cw[4][1] * bfhi(xp2.x);
            const float y2 = cb[2] + cw[0][2] * bflo(xm2.y) + cw[1][2] * bflo(xm1.y) + cw[2][2] * bflo(x0.y) + cw[3][2] * bflo(xp1.y) + cw[4][2] * bflo(xp2.y);
            const float y3 = cb[3] + cw[0][3] * bfhi(xm2.y) + cw[1][3] * bfhi(xm1.y) + cw[2][3] * bfhi(x0.y) + cw[3][3] * bfhi(xp1.y) + cw[4][3] * bfhi(xp2.y);
            u32x2 pk; pk.x = pk2(silu_f(y0), silu_f(y1)); pk.y = pk2(silu_f(y2), silu_f(y3));
            const int tt = tseg + t;
            if (ch < 768) { const int ts = tt ^ tsw;
                T[ch * 72 + ts] = (bf16)(pk.x & 0xffffu); T[(ch + 1) * 72 + ts] = (bf16)(pk.x >> 16); T[(ch + 2) * 72 + ts] = (bf16)(pk.y & 0xffffu); T[(ch + 3) * 72 + ts] = (bf16)(pk.y >> 16); }
            if (ch >= 512) { bf16* dst = ch < 768 ? BROW + (ch - 512) : CROW + (ch - 768); *(u32x2*)(dst + (size_t)(b * UL + u0 + tt) * 256) = pk; }
        }
#undef P6_LD
        __syncthreads();
        { const int cpr = len >> 3, sh = isctx ? 1 : 3;
          for (int q = tid; q < 768 * cpr; q += 512) { const int c = q >> sh, part = q & (cpr - 1), g = (c >> 3) & 15, x = g & 3;
            const u32x4 vr = *(const LAS u32x4*)(T + c * 72 + (part ^ (g >> 2)) * 8);
            const u32x4 v = x == 0 ? vr : (x == 1 ? (u32x4){vr.y, vr.x, vr.w, vr.z} : (x == 2 ? (u32x4){vr.z, vr.w, vr.x, vr.y} : (u32x4){vr.w, vr.z, vr.y, vr.x}));
            bf16* dst = c < 512 ? XT + (size_t)(b * 512 + c) * UL : BT + (size_t)(b * 256 + c - 512) * UL;
            *(u32x4*)(dst + u0 + part * 8) = v; } }
        if ((tid >> 3) < len) {
            const int uu = tid >> 3, k = (tid & 7) * 2; const size_t row = (size_t)(rb + u0 + uu);
            const unsigned raw = *(const unsigned*)(MISC + row * 256 + 32 + k);
            f32x2 o; o.x = softplus_f(bflo(raw) + dt_bias[k]); o.y = softplus_f(bfhi(raw) + dt_bias[k + 1]);
            *(f32x2*)(DT + (size_t)(b * UL + u0 + uu) * 16 + k) = o;
        }
        if ((tid >> 3) < len) {
            const int uu = tid >> 3, pp = (tid & 7) * 2; const size_t row = (size_t)(rb + u0 + uu);
            u32x2 raw = *(const u32x2*)(MISC + row * 256 + 2 * pp);
            if (!isctx) {
                const int t = u0 + uu - CTXL, half = pp >> 3, jj = pp & 7, pos = half ? (t & 63) : (t >> 6);
                const f32x2 c0 = ROPE[pos * 8 + jj], c1 = ROPE[pos * 8 + jj + 1];
                const float a0 = bflo(raw.x), a1 = bfhi(raw.x), a2 = bflo(raw.y), a3 = bfhi(raw.y);
                raw.x = pk2(a0 * c0.x - a1 * c0.y, a0 * c0.y + a1 * c0.x); raw.y = pk2(a2 * c1.x - a3 * c1.y, a2 * c1.y + a3 * c1.x);
            }
            *(u32x2*)(KPE + row * 32 + 2 * pp) = raw;
        }
        {
            u32x2 wkv[8], wq[8][3];
#pragma unroll
            for (int i = 0; i < 8; ++i) if (wave + 8 * i < len) { const size_t row = (size_t)(rb + u0 + wave + 8 * i);
                wkv[i] = *(const u32x2*)(CKV + row * 256 + 4 * lane);
                if (!isctx) {
#pragma unroll
                    for (int j = 0; j < 3; ++j) wq[i][j] = *(const u32x2*)(CQ + row * 768 + 4 * lane + 256 * j); } }
#pragma unroll
            for (int i = 0; i < 8; ++i) if (wave + 8 * i < len) { const size_t row = (size_t)(rb + u0 + wave + 8 * i);
                { const float c0 = bflo(wkv[i].x), c1 = bfhi(wkv[i].x), c2 = bflo(wkv[i].y), c3 = bfhi(wkv[i].y);
                  const float sk = wave_sum((c0 * c0 + c1 * c1) + (c2 * c2 + c3 * c3)); if (lane == 0) RSTDKV[row] = 1.0f / sqrtf(sk * (1.f / 256.f) + EPS); }
                if (!isctx) { float sq = 0.f;
#pragma unroll
                    for (int j = 0; j < 3; ++j) { const float c0 = bflo(wq[i][j].x), c1 = bfhi(wq[i][j].x), c2 = bflo(wq[i][j].y), c3 = bfhi(wq[i][j].y); sq += (c0 * c0 + c1 * c1) + (c2 * c2 + c3 * c3); }
                    sq = wave_sum(sq); if (lane == 0) RSTDQ[row] = 1.0f / sqrtf(sq * (1.f / 768.f) + EPS); } }
        }
        __syncthreads();
    }
}

__device__ __forceinline__ void acum_wave(const float* DT, size_t dtrow0, int h, float anf, float anb, LAS float* sc, int lane) {
    const float df0 = DT[(dtrow0 + lane) * 16 + h], df1 = DT[(dtrow0 + 64 + lane) * 16 + h];
    const float db0 = DT[(dtrow0 + lane) * 16 + 8 + h], db1 = DT[(dtrow0 + 64 + lane) * 16 + 8 + h];
    const float f0 = incl_scan(df0 * anf, lane); float f1 = incl_scan(df1 * anf, lane); f1 += __shfl(f0, 63);
    const float a0 = db0 * anb, a1 = db1 * anb; const float g0 = incl_scan(a0, lane), g1 = incl_scan(a1, lane);
    const float t0 = __shfl(g0, 63), t1 = __shfl(g1, 63), tot = t0 + t1;
    sc[lane] = f0; sc[64 + lane] = f1; sc[128 + lane] = tot - g0 + a0; sc[192 + lane] = t1 - g1 + a1;
    sc[256 + lane] = df0; sc[320 + lane] = df1; sc[384 + lane] = db0; sc[448 + lane] = db1;
    LDS_FENCE();
}
#define MFMA32(a, b, c) __builtin_amdgcn_mfma_f32_32x32x16_bf16((a), (b), (c), 0, 0, 0)
__device__ __forceinline__ f32x16 zero16() { f32x16 z;
#pragma unroll
    for (int r = 0; r < 16; ++r) z[r] = 0.f; return z; }

constexpr int S3_STR = 136, S3_TILE = 128 * S3_STR * 2;
constexpr int S3_CL = 0, S3_BL = 2 * S3_TILE, S3_SC = 4 * S3_TILE, S3_SS = S3_SC + 16384;
__device__ __forceinline__ void phase8(const Args& a, LAS unsigned char* lds, int G, int bx, int tid, int lane, int wave) {
    unsigned char* ws = a.ws;
    const bf16* XT = (const bf16*)(ws + WS_XT); const bf16* BT = (const bf16*)(ws + WS_BT); const float* DT = (const float*)(ws + WS_DT);
    bf16* ST = (bf16*)(ws + WS_ST); float* CD = (float*)(ws + WS_CD);
    LAS float* sc = (LAS float*)(lds + S3_SC) + wave * 512;
    const int h = wave, g = h >> 2, r32 = lane & 31, hi = lane >> 5;
    const float anf = -__expf(a.in[14][h]), anb = -__expf(a.in[14][8 + h]);
    const int rbx = G - 1 - bx, ufull = (NB * NCH / G) * G, nhalf = 2 * (NB * NCH - ufull);
    for (int wi = rbx; wi < ufull + nhalf; wi += G) {
        const int unit = wi < ufull ? wi : ufull + ((wi - ufull) >> 1), half_lo = wi < ufull ? 0 : ((wi - ufull) & 1), half_hi = wi < ufull ? 2 : half_lo + 1;
        const int b = unit / NCH, c = unit % NCH;
#pragma unroll
        for (int it = 0; it < 8; ++it) { const int q = tid + 512 * it, n = q >> 4, k16 = q & 15;
            const u32x4 v = *(const u32x4*)(BT + (size_t)(b * 256 + n) * UL + c * 128 + 8 * k16);
            *(LAS u32x4*)(lds + (n * S3_STR + 8 * k16) * 2) = v; }
        acum_wave(DT, (size_t)b * UL + c * 128, h, anf, anb, sc, lane);
        const float af_last = sc[127], ab_first = sc[128];
#pragma unroll
        for (int hf = 0; hf < 2; ++hf) { const int j = lane + 64 * hf;
            const float wf = __expf(af_last - sc[j]) * sc[256 + j], wb = __expf(ab_first - sc[128 + j]) * sc[384 + j];
            sc[256 + j] = wf; sc[384 + j] = wb; }
        if (lane == 0) { CD[((b * 2 + 0) * 8 + h) * NCH + c] = __expf(af_last); CD[((b * 2 + 1) * 8 + h) * NCH + c] = __expf(ab_first); }
        __syncthreads();
        const bf16* xbase = XT + (size_t)(b * 512 + h * 64 + r32) * UL + c * 128 + 8 * hi;
        const LAS unsigned char* btl = lds + ((g * 128 + r32) * S3_STR + 8 * hi) * 2;
        const LAS float* wfp = sc + 256 + 8 * hi; const LAS float* wbp = sc + 384 + 8 * hi;
#pragma unroll 1
        for (int half = half_lo; half < half_hi; ++half) {
            f32x16 accf[2][2], accb[2][2];
#pragma unroll
            for (int nn = 0; nn < 2; ++nn) { accf[nn][0] = zero16(); accf[nn][1] = zero16(); accb[nn][0] = zero16(); accb[nn][1] = zero16(); }
#pragma unroll 1
            for (int sq = 0; sq < 2; ++sq) {
            u32x4 xraw[2][4];
#pragma unroll
            for (int pb = 0; pb < 2; ++pb)
#pragma unroll
                for (int s4 = 0; s4 < 4; ++s4) xraw[pb][s4] = *(const u32x4*)(xbase + (size_t)pb * 32 * UL + 16 * (4 * sq + s4));
#pragma unroll
            for (int s4 = 0; s4 < 4; ++s4) { const int s = 4 * sq + s4;
                const f32x4 fa = *(const LAS f32x4*)(wfp + 16 * s), fb = *(const LAS f32x4*)(wfp + 16 * s + 4), ba = *(const LAS f32x4*)(wbp + 16 * s), bb = *(const LAS f32x4*)(wbp + 16 * s + 4);
                bf16x8 xwf[2], xwb[2];
#pragma unroll
                for (int pb = 0; pb < 2; ++pb) { const u32x4 raw = xraw[pb][s4];
                    const float x0 = bflo(raw.x), x1 = bfhi(raw.x), x2 = bflo(raw.y), x3 = bfhi(raw.y), x4 = bflo(raw.z), x5 = bfhi(raw.z), x6 = bflo(raw.w), x7 = bfhi(raw.w);
                    xwf[pb] = pack8(x0 * fa[0], x1 * fa[1], x2 * fa[2], x3 * fa[3], x4 * fb[0], x5 * fb[1], x6 * fb[2], x7 * fb[3]);
                    xwb[pb] = pack8(x0 * ba[0], x1 * ba[1], x2 * ba[2], x3 * ba[3], x4 * bb[0], x5 * bb[1], x6 * bb[2], x7 * bb[3]); }
#pragma unroll
                for (int nn = 0; nn < 2; ++nn) { const bf16x8 bt = *(const LAS bf16x8*)(btl + ((2 * half + nn) * 32 * S3_STR + 16 * s) * 2);
                    accf[nn][0] = MFMA32(bt, xwf[0], accf[nn][0]); accf[nn][1] = MFMA32(bt, xwf[1], accf[nn][1]);
                    accb[nn][0] = MFMA32(bt, xwb[0], accb[nn][0]); accb[nn][1] = MFMA32(bt, xwb[1], accb[nn][1]); }
            }
            }
            bf16* sof = ST + ((size_t)(((b * 2 + 0) * 8 + h) * NCH + c) * 64) * 128; bf16* sob = ST + ((size_t)(((b * 2 + 1) * 8 + h) * NCH + c) * 64) * 128;
#pragma unroll
            for (int nn = 0; nn < 2; ++nn)
#pragma unroll
                for (int pb = 0; pb < 2; ++pb)
#pragma unroll
                    for (int g4 = 0; g4 < 4; ++g4) { const size_t off = (size_t)(32 * pb + r32) * 128 + 32 * (2 * half + nn) + 8 * g4 + 4 * hi;
                        u32x2 o; o.x = pk2(accf[nn][pb][4 * g4], accf[nn][pb][4 * g4 + 1]); o.y = pk2(accf[nn][pb][4 * g4 + 2], accf[nn][pb][4 * g4 + 3]); *(u32x2*)(sof + off) = o;
                        o.x = pk2(accb[nn][pb][4 * g4], accb[nn][pb][4 * g4 + 1]); o.y = pk2(accb[nn][pb][4 * g4 + 2], accb[nn][pb][4 * g4 + 3]); *(u32x2*)(sob + off) = o; }
        }
        __syncthreads();
    }
}
__device__ __forceinline__ void phase9(const Args& a, int G, int bx, int tid) {
    unsigned char* ws = a.ws;
    const bf16* ST = (const bf16*)(ws + WS_ST); bf16* HE = (bf16*)(ws + WS_HE); const float* CD = (const float*)(ws + WS_CD);
    for (int idx = bx * 512 + tid; idx < NB * 2 * 8 * 1024; idx += G * 512) {
        const int e = (idx & 1023) * 8, bdh = idx >> 10, dir = (bdh >> 3) & 1;
        const bf16* st = ST + (size_t)bdh * NCH * 8192 + e; bf16* he = HE + (size_t)bdh * 32 * 8192 + e; const float* cd = CD + bdh * NCH;
        float hh[8];
#pragma unroll
        for (int k = 0; k < 8; ++k) hh[k] = 0.f;
#define P9_STEP(c) do { const u32x4 w_ = __builtin_nontemporal_load((const u32x4*)(st + (size_t)(c) * 8192)); const float d_ = cd[c]; \
        hh[0] = d_ * hh[0] + bflo(w_.x); hh[1] = d_ * hh[1] + bfhi(w_.x); hh[2] = d_ * hh[2] + bflo(w_.y); hh[3] = d_ * hh[3] + bfhi(w_.y); \
        hh[4] = d_ * hh[4] + bflo(w_.z); hh[5] = d_ * hh[5] + bfhi(w_.z); hh[6] = d_ * hh[6] + bflo(w_.w); hh[7] = d_ * hh[7] + bfhi(w_.w); } while (0)
#define P9_OUT(c) do { u32x4 o_; o_.x = pk2(hh[0], hh[1]); o_.y = pk2(hh[2], hh[3]); o_.z = pk2(hh[4], hh[5]); o_.w = pk2(hh[6], hh[7]); *(u32x4*)(he + (size_t)((c) - 2) * 8192) = o_; } while (0)
        if (dir == 0) {
            P9_STEP(0); P9_STEP(1);
#pragma unroll 8
            for (int c = 2; c < NCH; ++c) { P9_OUT(c); P9_STEP(c); }
        } else {
            P9_STEP(1); P9_STEP(0);
#pragma unroll 8
            for (int c = NCH - 1; c >= 2; --c) { P9_OUT(c); P9_STEP(c); }
        }
#undef P9_STEP
#undef P9_OUT
    }
}
#if defined(PROBE_TA)
#define SSTAMP(i) do { if (bx == 0 && tid == 0) ((unsigned long long*)(ws + 480 * KiB))[i] = __builtin_amdgcn_s_memrealtime(); } while (0)
#else
#define SSTAMP(i) do { } while (0)
#endif
__device__ __forceinline__ void phase10_ssd(const Args& a, LAS unsigned char* lds, int G, int bx, int tid, int lane, int wave) {
    unsigned char* ws = a.ws;
    const bf16* XT = (const bf16*)(ws + WS_XT); const bf16* BROW = (const bf16*)(ws + WS_BROW); const bf16* CROW = (const bf16*)(ws + WS_CROW); const float* DT = (const float*)(ws + WS_DT);
    const bf16* HE = (const bf16*)(ws + WS_HE); const bf16* Z = (const bf16*)(ws + WS_Z); bf16* MIX = (bf16*)(ws + WS_MIX);
    LAS float* sc = (LAS float*)(lds + S3_SC) + wave * 512;
    LAS float* SS = (LAS float*)(lds + S3_SS);
    const int h = wave, g = h >> 2, r32 = lane & 31, hi = lane >> 5;
    const float anf = -__expf(a.in[14][h]), anb = -__expf(a.in[14][8 + h]);
    const float dskip = a.in[15][h]; const float* snorm = a.in[16] + h * 64;
    for (int unit = bx; unit < NB * 32; unit += G) {
        const int b = unit >> 5, lc = unit & 31, c = lc + 2; const size_t u0 = (size_t)b * UL + c * 128;
#pragma unroll
        for (int it = 0; it < 8; ++it) { const int q = tid + 512 * it, i = q >> 5, ch16 = q & 31, off = ((ch16 >> 4) * S3_TILE) + (i * S3_STR + (ch16 & 15) * 8) * 2;
            const u32x4 vc = *(const u32x4*)(CROW + (u0 + i) * 256 + 8 * ch16), vb = *(const u32x4*)(BROW + (u0 + i) * 256 + 8 * ch16);
            *(LAS u32x4*)(lds + S3_CL + off) = vc; *(LAS u32x4*)(lds + S3_BL + off) = vb; }
        acum_wave(DT, u0, h, anf, anb, sc, lane);
        {
            float wfv[2], wbv[2];
#pragma unroll
            for (int hf = 0; hf < 2; ++hf) { const int j = lane + 64 * hf, jb = j >> 5;
                const float afb = jb ? sc[32 * jb - 1] : 0.f, abb = jb < 3 ? sc[128 + 32 * jb + 32] : 0.f;
                wfv[hf] = __expf(afb - sc[j]) * sc[256 + j]; wbv[hf] = __expf(abb - sc[128 + j]) * sc[384 + j]; }
            LDS_FENCE();
#pragma unroll
            for (int hf = 0; hf < 2; ++hf) { const int j = lane + 64 * hf; sc[256 + j] = wfv[hf]; sc[384 + j] = wbv[hf]; }
        }
        __syncthreads();
        SSTAMP(18);
        const LAS unsigned char* CLg = lds + S3_CL + g * S3_TILE + (r32 * S3_STR + 8 * hi) * 2;
        const LAS unsigned char* BLg = lds + S3_BL + g * S3_TILE + (r32 * S3_STR + 8 * hi) * 2;
#pragma unroll 1
        for (int ibp = 0; ibp < 2; ++ibp) {
        f32x16 acc[2][2];
#pragma unroll
        for (int k = 0; k < 2; ++k) { acc[k][0] = zero16(); acc[k][1] = zero16(); }
#ifndef NO_DIAG
        u32x2 xn[2][4];
#pragma unroll
        for (int pb = 0; pb < 2; ++pb) { const bf16* xp = XT + (size_t)(b * 512 + h * 64 + 32 * pb + r32) * UL + c * 128 + 4 * hi;
#pragma unroll
            for (int e = 0; e < 4; ++e) xn[pb][e] = *(const u32x2*)(xp + 8 * e); }
#pragma unroll 1
        for (int jb = 0; jb < 4; ++jb) {
            bf16x8 xa[2][2];
#pragma unroll
            for (int pb = 0; pb < 2; ++pb) {
                xa[pb][0] = __builtin_bit_cast(bf16x8, (u32x4){xn[pb][0].x, xn[pb][0].y, xn[pb][1].x, xn[pb][1].y}); xa[pb][1] = __builtin_bit_cast(bf16x8, (u32x4){xn[pb][2].x, xn[pb][2].y, xn[pb][3].x, xn[pb][3].y});
                if (jb < 3) { const bf16* xp = XT + (size_t)(b * 512 + h * 64 + 32 * pb + r32) * UL + c * 128 + 32 * (jb + 1) + 4 * hi;
#pragma unroll
                    for (int e = 0; e < 4; ++e) xn[pb][e] = *(const u32x2*)(xp + 8 * e); }
            }
#pragma unroll
            for (int k = 0; k < 2; ++k) {
                const int ib = 2 * ibp + k;
                f32x16 ga = zero16();
#pragma unroll
                for (int s = 0; s < 8; ++s) { const bf16x8 bfr = *(const LAS bf16x8*)(BLg + (32 * jb * S3_STR + 16 * s) * 2), cf = *(const LAS bf16x8*)(CLg + (32 * ib * S3_STR + 16 * s) * 2);
                    ga = MFMA32(bfr, cf, ga); }
                float mm[16];
                if (jb < ib) {
                    const float efi = __expf(sc[32 * ib + r32] - sc[32 * jb + 31]);
#pragma unroll
                    for (int r = 0; r < 16; ++r) mm[r] = ga[r] * sc[256 + 32 * jb + crow(r, hi)];
                    const float efb = __expf(sc[32 * ib + r32] - (jb ? sc[32 * jb - 1] : 0.f));
#pragma unroll
                    for (int r = 0; r < 16; ++r) mm[r] *= efb;
                    (void)efi;
                } else if (jb > ib) {
                    const float ebb = __expf(sc[128 + 32 * ib + r32] - (jb < 3 ? sc[128 + 32 * jb + 32] : 0.f));
#pragma unroll
                    for (int r = 0; r < 16; ++r) mm[r] = ga[r] * sc[384 + 32 * jb + crow(r, hi)] * ebb;
                } else {
                    const float efb = __expf(sc[32 * ib + r32] - (jb ? sc[32 * jb - 1] : 0.f)), ebb = __expf(sc[128 + 32 * ib + r32] - (jb < 3 ? sc[128 + 32 * jb + 32] : 0.f));
#pragma unroll
                    for (int r = 0; r < 16; ++r) { const int jl = crow(r, hi);
                        const float mf = jl <= r32 ? efb * sc[256 + 32 * jb + jl] : 0.f, mb = jl >= r32 ? ebb * sc[384 + 32 * jb + jl] : 0.f;
                        mm[r] = ga[r] * (mf + mb) + (jl == r32 ? dskip : 0.f); }
                }
                const bf16x8 pf0 = pack8(mm[0], mm[1], mm[2], mm[3], mm[4], mm[5], mm[6], mm[7]), pf1 = pack8(mm[8], mm[9], mm[10], mm[11], mm[12], mm[13], mm[14], mm[15]);
                acc[k][0] = MFMA32(xa[0][0], pf0, acc[k][0]); acc[k][0] = MFMA32(xa[0][1], pf1, acc[k][0]);
                acc[k][1] = MFMA32(xa[1][0], pf0, acc[k][1]); acc[k][1] = MFMA32(xa[1][1], pf1, acc[k][1]);
                asm volatile("" ::: "memory");
            }
        }
#endif
#ifndef NO_OFF
        if (ibp == 0) SSTAMP(19);
#pragma unroll 1
        for (int dir = 0; dir < 2; ++dir) {
#pragma unroll
            for (int pb = 0; pb < 2; ++pb) {
                const bf16* hp = HE + ((size_t)(((b * 2 + dir) * 8 + h) * 32 + lc) * 64 + 32 * pb + r32) * 128 + 8 * hi;
                f32x16 ta0 = zero16(), ta1 = zero16();
                bf16x8 hf[8];
#pragma unroll
                for (int s = 0; s < 8; ++s) hf[s] = *(const bf16x8*)(hp + 16 * s);
#pragma unroll
                for (int s = 0; s < 8; ++s) {
                    const bf16x8 cf0 = *(const LAS bf16x8*)(CLg + (32 * (2 * ibp) * S3_STR + 16 * s) * 2), cf1 = *(const LAS bf16x8*)(CLg + (32 * (2 * ibp + 1) * S3_STR + 16 * s) * 2);
                    ta0 = MFMA32(hf[s], cf0, ta0); ta1 = MFMA32(hf[s], cf1, ta1); }
                const float e0 = __expf(sc[128 * dir + 32 * (2 * ibp) + r32]), e1 = __expf(sc[128 * dir + 32 * (2 * ibp + 1) + r32]);
#pragma unroll
                for (int r = 0; r < 16; ++r) { acc[0][pb][r] += e0 * ta0[r]; acc[1][pb][r] += e1 * ta1[r]; }
                asm volatile("" ::: "memory");
            }
        }
#endif
        if (ibp == 0) SSTAMP(20);
#pragma unroll
        for (int k = 0; k < 2; ++k) {
            const int ib = 2 * ibp + k;
            const size_t row = (size_t)b * SEQ + lc * 128 + 32 * ib + r32;
            float ss = 0.f;
#pragma unroll
            for (int pb = 0; pb < 2; ++pb)
#pragma unroll
                for (int g4 = 0; g4 < 4; ++g4) { const u32x2 zw = *(const u32x2*)(Z + row * 512 + h * 64 + 32 * pb + 8 * g4 + 4 * hi);
                    const float v0 = acc[k][pb][4 * g4] * silu_f(bflo(zw.x)), v1 = acc[k][pb][4 * g4 + 1] * silu_f(bfhi(zw.x)), v2 = acc[k][pb][4 * g4 + 2] * silu_f(bflo(zw.y)), v3 = acc[k][pb][4 * g4 + 3] * silu_f(bfhi(zw.y));
                    ss += (v0 * v0 + v1 * v1) + (v2 * v2 + v3 * v3);
                    acc[k][pb][4 * g4] = v0; acc[k][pb][4 * g4 + 1] = v1; acc[k][pb][4 * g4 + 2] = v2; acc[k][pb][4 * g4 + 3] = v3; }
            ss += __shfl_xor(ss, 32);
            if (hi == 0) SS[(ib * 8 + wave) * 32 + r32] = ss;
        }
        __syncthreads();
#pragma unroll
        for (int k = 0; k < 2; ++k) {
            const int ib = 2 * ibp + k;
            const size_t row = (size_t)b * SEQ + lc * 128 + 32 * ib + r32;
            float tot = 0.f;
#pragma unroll
            for (int w = 0; w < 8; ++w) tot += SS[(ib * 8 + w) * 32 + r32];
            const float rstd = 1.0f / sqrtf(tot * (1.f / 512.f) + EPS);
#pragma unroll
            for (int pb = 0; pb < 2; ++pb)
#pragma unroll
                for (int g4 = 0; g4 < 4; ++g4) { const int p0 = 32 * pb + 8 * g4 + 4 * hi; const f32x4 gn = *(const f32x4*)(snorm + p0);
                    u32x2 o; o.x = pk2(acc[k][pb][4 * g4] * rstd * gn[0], acc[k][pb][4 * g4 + 1] * rstd * gn[1]); o.y = pk2(acc[k][pb][4 * g4 + 2] * rstd * gn[2], acc[k][pb][4 * g4 + 3] * rstd * gn[3]);
                    *(u32x2*)(MIX + row * 1024 + h * 64 + p0) = o; }
        }
        }
        __syncthreads();
    }
}

__device__ __forceinline__ float at_max3(float a, float b, float c) { float r; asm("v_max3_f32 %0, %1, %2, %3" : "=v"(r) : "v"(a), "v"(b), "v"(c)); return r; }
constexpr int AT_KS = 104, AT_VS = 68, AT_KB = 64 * AT_KS * 2, AT_BUF = AT_KB + 64 * AT_VS * 2;
__device__ __forceinline__ void phase10_attn(const Args& a, LAS unsigned char* lds, int G, int vcu, int tid, int lane, int wave) {
    unsigned char* ws = a.ws; unsigned char* ob = (unsigned char*)a.out;
    const bf16* Q = (const bf16*)(ob + OUT_Q); const bf16* KN = (const bf16*)(ob + OUT_KN); const bf16* VT = (const bf16*)(ob + OUT_VT); const bf16* KPE = (const bf16*)(ws + WS_KPE);
    bf16* MIX = (bf16*)(ws + WS_MIX); const f32x2* ROPE = (const f32x2*)(ws + WS_ROPE);
    const int r32 = lane & 31, hi = lane >> 5;
    if (wave >= 4) __builtin_amdgcn_s_setprio(1);
    for (int unit = vcu; unit < NB * 8 * 8; unit += G) {
        const int bh = unit >> 3, qb = unit & 7, b = bh >> 3, h = bh & 7;
        bf16x8 qr[2][6];
#pragma unroll
        for (int qq = 0; qq < 2; ++qq) {
            const int tq = qb * 512 + qq * 256 + wave * 32 + r32;
            const bf16* qp = Q + ((size_t)b * SEQ + tq) * 768 + h * 96 + 8 * hi;
#pragma unroll
            for (int s = 0; s < 6; ++s) qr[qq][s] = *(const bf16x8*)(qp + 16 * s);
#pragma unroll
            for (int s = 4; s < 6; ++s) { const int pos = (s == 4) ? (tq >> 6) : (tq & 63); const f32x2* rp = ROPE + pos * 8 + 4 * hi;
                const u32x4 w = __builtin_bit_cast(u32x4, qr[qq][s]); const f32x2 c0 = rp[0], c1 = rp[1], c2 = rp[2], c3 = rp[3]; u32x4 o;
                o.x = pk2(bflo(w.x) * c0.x - bfhi(w.x) * c0.y, bflo(w.x) * c0.y + bfhi(w.x) * c0.x); o.y = pk2(bflo(w.y) * c1.x - bfhi(w.y) * c1.y, bflo(w.y) * c1.y + bfhi(w.y) * c1.x);
                o.z = pk2(bflo(w.z) * c2.x - bfhi(w.z) * c2.y, bflo(w.z) * c2.y + bfhi(w.z) * c2.x); o.w = pk2(bflo(w.w) * c3.x - bfhi(w.w) * c3.y, bflo(w.w) * c3.y + bfhi(w.w) * c3.x);
                qr[qq][s] = __builtin_bit_cast(bf16x8, o); }
        }
        const int kr = tid >> 3, kpart = tid & 7;
        const int pr = tid >> 2, ppart = tid & 3;
#define AT_ROW0(t) ((t) < 4 ? (size_t)NLAT + b * CTXL + (t) * 64 : (size_t)b * SEQ + ((t) - 4) * 64)
#define AT_LOAD(t) do { const size_t r0_ = AT_ROW0(t); \
        gk = *(const u32x4*)(KN + (r0_ + kr) * 512 + h * 64 + kpart * 8); \
        gv = *(const u32x4*)(VT + (size_t)(h * 64 + kr) * MTOT + r0_ + kpart * 8); \
        if (tid < 256) gp = *(const u32x4*)(KPE + (r0_ + pr) * 32 + ppart * 8); } while (0)
#define AT_STORE(bufi) do { LAS unsigned char* B_ = lds + (bufi) * AT_BUF; \
        *(LAS u32x4*)(B_ + (kr * AT_KS + kpart * 8) * 2) = gk; \
        *(LAS u32x2*)(B_ + AT_KB + (kr * AT_VS + kpart * 8) * 2) = (u32x2){gv.x, gv.y}; *(LAS u32x2*)(B_ + AT_KB + (kr * AT_VS + kpart * 8 + 4) * 2) = (u32x2){gv.z, gv.w}; \
        if (tid < 256) *(LAS u32x4*)(B_ + (pr * AT_KS + 64 + ppart * 8) * 2) = gp; } while (0)
        u32x4 gk, gv, gp = (u32x4){0u, 0u, 0u, 0u};
        AT_LOAD(0); AT_STORE(0);
        __syncthreads();
        float mrun[2] = {-INFINITY, -INFINITY}, lrun[2] = {0.f, 0.f};
        f32x16 o[2][2]; o[0][0] = zero16(); o[0][1] = zero16(); o[1][0] = zero16(); o[1][1] = zero16();
#pragma unroll 1
        for (int t = 0; t < 68; ++t) {
            if (t + 1 < 68) AT_LOAD(t + 1);
            const LAS unsigned char* Bc = lds + (t & 1) * AT_BUF;
#pragma unroll
            for (int qq = 0; qq < 2; ++qq) {
                f32x16 p0 = zero16(), p1 = zero16();
#pragma unroll
                for (int s = 0; s < 6; ++s) {
                    const bf16x8 k0 = *(const LAS bf16x8*)(Bc + (r32 * AT_KS + 16 * s + 8 * hi) * 2), k1 = *(const LAS bf16x8*)(Bc + ((32 + r32) * AT_KS + 16 * s + 8 * hi) * 2);
                    p0 = MFMA32(k0, qr[qq][s], p0); p1 = MFMA32(k1, qr[qq][s], p1); }
                float mx = fmaxf(p0[0], p1[0]);
#pragma unroll
                for (int r = 1; r < 16; ++r) mx = fmaxf(mx, fmaxf(p0[r], p1[r]));
                mx = fmaxf(mx, __shfl_xor(mx, 32));
                if (__any(mx > mrun[qq])) {
                    const float mnew = fmaxf(mrun[qq], mx), alpha = __builtin_amdgcn_exp2f(mrun[qq] - mnew);
                    mrun[qq] = mnew; lrun[qq] *= alpha;
#pragma unroll
                    for (int r = 0; r < 16; ++r) { o[qq][0][r] *= alpha; o[qq][1][r] *= alpha; }
                }
                float rs = 0.f;
#pragma unroll
                for (int r = 0; r < 16; ++r) { p0[r] = __builtin_amdgcn_exp2f(p0[r] - mrun[qq]); p1[r] = __builtin_amdgcn_exp2f(p1[r] - mrun[qq]); rs += p0[r] + p1[r]; }
                lrun[qq] += rs;
                bf16x8 pf[4];
                pf[0] = pack8(p0[0], p0[1], p0[2], p0[3], p0[4], p0[5], p0[6], p0[7]); pf[1] = pack8(p0[8], p0[9], p0[10], p0[11], p0[12], p0[13], p0[14], p0[15]);
                pf[2] = pack8(p1[0], p1[1], p1[2], p1[3], p1[4], p1[5], p1[6], p1[7]); pf[3] = pack8(p1[8], p1[9], p1[10], p1[11], p1[12], p1[13], p1[14], p1[15]);
#pragma unroll
                for (int db = 0; db < 2; ++db)
#pragma unroll
                    for (int s = 0; s < 4; ++s) { const LAS unsigned char* vp = Bc + AT_KB + ((32 * db + r32) * AT_VS + 16 * s + 4 * hi) * 2;
                        const u32x2 v0 = *(const LAS u32x2*)vp, v1 = *(const LAS u32x2*)(vp + 16);
                        o[qq][db] = MFMA32(__builtin_bit_cast(bf16x8, (u32x4){v0.x, v0.y, v1.x, v1.y}), pf[s], o[qq][db]); }
                asm volatile("" ::: "memory"); __builtin_amdgcn_sched_barrier(0);
            }
            if (t + 1 < 68) AT_STORE((t + 1) & 1);
            __syncthreads();
        }
#undef AT_ROW0
#undef AT_LOAD
#undef AT_STORE
#pragma unroll
        for (int qq = 0; qq < 2; ++qq) {
            const float ltot = lrun[qq] + __shfl_xor(lrun[qq], 32), rl = 1.0f / ltot;
            const size_t qrow = (size_t)b * SEQ + qb * 512 + qq * 256 + wave * 32 + r32;
            bf16* op = MIX + qrow * 1024 + 512 + h * 64 + 4 * hi;
#pragma unroll
            for (int db = 0; db < 2; ++db)
#pragma unroll
                for (int g4 = 0; g4 < 4; ++g4) { u32x2 w; w.x = pk2(o[qq][db][4 * g4] * rl, o[qq][db][4 * g4 + 1] * rl); w.y = pk2(o[qq][db][4 * g4 + 2] * rl, o[qq][db][4 * g4 + 3] * rl);
                    *(u32x2*)(op + 32 * db + 8 * g4) = w; }
        }
    }
    __builtin_amdgcn_s_setprio(0);
}

#define XB_TMO      128
#define XB_XCNT(j)  (256  + 64 * (j))
#define XB_XSUB(j)  (1280 + 64 * (j))
#define XB_XGEN(j)  (2304 + 64 * (j))
#define XB_TOP      3328
#define XB_TOPGEN   3392
#define XCD_BAR_WORDS 3456
#define XB_SPIN_CAP (1u << 18)

__device__ __forceinline__ unsigned xb_ld(unsigned* p)              { return __hip_atomic_load(p, __ATOMIC_RELAXED, __HIP_MEMORY_SCOPE_AGENT); }
__device__ __forceinline__ unsigned xb_add(unsigned* p, unsigned v) { return __hip_atomic_fetch_add(p, v, __ATOMIC_RELAXED, __HIP_MEMORY_SCOPE_AGENT); }
__device__ __forceinline__ unsigned xb_xcc_id() { return (unsigned)__builtin_amdgcn_s_getreg((3 << 11) | 20) & 0xFu; }
#define XB_SPIN(cond, bar) do { unsigned _sp = 0; while (cond) { __builtin_amdgcn_s_sleep(1); \
    if ((++_sp & 255u) == 0u) { if (xb_ld(&(bar)[XB_TMO])) break; if (_sp > XB_SPIN_CAP) { atomicAdd(&(bar)[XB_TMO], 1u); break; } } } } while (0)

struct XcdBarrier {
    unsigned* bar; unsigned x;
    volatile LAS unsigned* st;
};

__device__ __forceinline__ XcdBarrier xcd_barrier_post(unsigned* bar, volatile LAS unsigned* st) {
    XcdBarrier b; b.bar = bar; b.x = xb_xcc_id(); b.st = st;
    if (threadIdx.x == 0) (void)xb_add(&bar[XB_XCNT(b.x)], 1u);
    return b;
}
__device__ __forceinline__ void xcd_barrier_complete(unsigned* bar, unsigned x, unsigned& nloc, unsigned& nx) {
    const unsigned G = gridDim.x * gridDim.y * gridDim.z;
    unsigned sum, cnt, mine, sp = 0u;
    for (;;) {
        sum = 0u; cnt = 0u; mine = 0u;
#pragma unroll
        for (unsigned j = 0; j < 16; ++j) { const unsigned c = xb_ld(&bar[XB_XCNT(j)]); sum += c; cnt += (c > 0u) ? 1u : 0u; mine = (j == x) ? c : mine; }
        if (sum == G) break;
        __builtin_amdgcn_s_sleep(1);
        if ((++sp & 255u) == 0u) { if (xb_ld(&bar[XB_TMO])) break; if (sp > XB_SPIN_CAP) { atomicAdd(&bar[XB_TMO], 1u); break; } }
    }
    nloc = mine > 0u ? mine : 1u; nx = cnt > 0u ? cnt : 1u;
}

__device__ __forceinline__ void xcd_barrier(const XcdBarrier& b) {
    asm volatile("s_waitcnt vmcnt(0)" ::: "memory");
    __syncthreads();
    if (threadIdx.x == 0) {
        unsigned* bar = b.bar;
        __builtin_amdgcn_s_waitcnt(0);
        unsigned nloc = b.st[0], nx = b.st[1];
        if (nloc == 0u) { xcd_barrier_complete(bar, b.x, nloc, nx); b.st[0] = nloc; b.st[1] = nx; }
        const unsigned old = xb_add(&bar[XB_XSUB(b.x)], 1u);
        const unsigned gen = old / nloc;
        if (old + 1u == (gen + 1u) * nloc) {
            __builtin_amdgcn_fence(__ATOMIC_RELEASE, "agent");
            asm volatile("s_waitcnt vmcnt(0)" ::: "memory");
            const unsigned og = xb_add(&bar[XB_TOP], 1u);
            const unsigned tg = og / nx;
            if (og + 1u == (tg + 1u) * nx) xb_add(&bar[XB_TOPGEN], 1u);
            else XB_SPIN(xb_ld(&bar[XB_TOPGEN]) == tg, bar);
            __builtin_amdgcn_fence(__ATOMIC_ACQUIRE, "agent");
            xb_add(&bar[XB_XGEN(b.x)], 1u);
            asm volatile("s_waitcnt vmcnt(0)" ::: "memory");
        } else {
            XB_SPIN(xb_ld(&bar[XB_XGEN(b.x)]) == gen, bar);
            __builtin_amdgcn_fence(__ATOMIC_ACQUIRE, "agent");
            asm volatile("s_waitcnt vmcnt(0)" ::: "memory");
        }
    }
    __syncthreads();
}

#ifndef RES_ALIGN
#define RES_ALIGN true
#endif
__global__ void __launch_bounds__(512, 2) hymba_fwd(Args args) {
    extern __shared__ __attribute__((aligned(16))) unsigned char lds_raw[];
    LAS unsigned char* lds = (LAS unsigned char*)lds_raw;
    cg::grid_group grid = cg::this_grid();
    const int tid = threadIdx.x, lane = tid & 63, wave = __builtin_amdgcn_readfirstlane(tid >> 6);
    const int G = gridDim.x, bx = blockIdx.x, vcu = (G % 8 == 0) ? (bx % 8) * (G / 8) + bx / 8 : bx;
    const int gw = bx * 8 + wave, NGW = G * 8;
    unsigned char* ws = args.ws;
    const int lo = args.ph_lo, hi = args.ph_hi;
    const float* MOD = (const float*)(ws + WS_MOD);
    volatile LAS unsigned* bst = (volatile LAS unsigned*)(lds + LDS_BST);
    if (tid < 2) bst[tid] = 0u;
    __syncthreads();
    const XcdBarrier xbar = xcd_barrier_post((unsigned*)(ws + WS_BAR), bst);
    bf16* XN = (bf16*)(ws + WS_A); bf16* HB = (bf16*)(ws + WS_B); bf16* X1 = (bf16*)(ws + WS_C);
#ifndef PHMASK
#define PHMASK 0xFFFF
#endif
#define IN(k) (((PHMASK >> (k)) & 1) && lo <= (k) && (k) < hi)
#define GSYNC(k) do { xcd_barrier(xbar); } while (0)
#if defined(PROBE_TA)
#define STAMP(i) do { if (bx == 0 && tid == 0) ((unsigned long long*)(ws + 480 * KiB))[i] = __builtin_amdgcn_s_memrealtime(); } while (0)
#else
#define STAMP(i) do { } while (0)
#endif
#define SEAM(k) do { if (IN(k) && IN((k) + 1)) GSYNC(k); STAMP((k) + 1); } while (0)
#define PH_BEGIN(k) if (IN(k)) for (int rep_ = 0; rep_ < ((k) == PROBE_PHASE ? 2 : 1); ++rep_) { if (rep_) xcd_barrier(xbar);
#define PH_END(k) } SEAM(k)
    STAMP(0);
    if (args.ph_lo < 0) grid.sync();
    if (PROBE_PHASE == 200) { for (int r3 = 0; r3 < 16; ++r3) xcd_barrier(xbar); }
    PH_BEGIN(0) { phase0(args, lds, gw, NGW, tid, lane, wave); } PH_END(0);
    PH_BEGIN(1) { norm_rows<false>(args.in[0], args.in[2], MTOT, args.in[6], MOD, 0, XN, gw, NGW, lane); } PH_END(1);
    PH_BEGIN(2) { pg8::Gemm g{XN, (const bf16*)(ws + WS_W1A), MTOT, 2 * DFF, D}; pg8::StaticOrder S; S.init(MTOT, 2 * DFF, G, bx);
        pg8::EpiSwiglu E{HB, DFF}; pg8::gemm_phase<pg8::EpiSwiglu, pg8::StaticOrder, true, true>(lds, g, S, E); } PH_END(2);
    PH_BEGIN(3) {
        { pg8::Gemm g{HB, (const bf16*)(ws + WS_W1B), NLAT, D, DFF}; pg8::StaticOrder S; S.init(NLAT, D, G, bx);
          pg8::EpiRes<false, true> E{args.in[0], args.in[2], X1, MOD, 2, 0.5f}; pg8::gemm_phase<pg8::EpiRes<false, true>, pg8::StaticOrder, RES_ALIGN, true>(lds, g, S, E); }
        { pg8::Gemm g{HB, (const bf16*)(ws + WS_W1B), MTOT, D, DFF, DFF}; pg8::CtxSplitOrder S{G, (bx + G / 2) % G};
          pg8::EpiResCtx E{args.in[2], X1, (float*)args.out, MOD, 2, 0.5f}; pg8::gemm_phase<pg8::EpiResCtx, pg8::CtxSplitOrder, true, true>(lds, g, S, E); }
    } PH_END(3);
    PH_BEGIN(4) { norm_rows<true>(X1, X1 + (size_t)NLAT * D, MTOT, args.in[9], MOD, 3, XN, gw, NGW, lane, (const float*)args.out); } PH_END(4);
    PH_BEGIN(5) { pg8::Gemm g{XN, (const bf16*)(ws + WS_WIN), MTOT, 2816, D}; pg8::StaticOrder S; S.init(MTOT, 2816, G, bx);
        pg8::EpiSplit E{(bf16*)(ws + WS_Z), (bf16*)(ws + WS_XBCR), (bf16*)(ws + WS_CQ), (bf16*)(ws + WS_CKV), (bf16*)(ws + WS_MISC)};
        pg8::gemm_phase<pg8::EpiSplit, pg8::StaticOrder, true, true>(lds, g, S, E); } PH_END(5);
    PH_BEGIN(6) { phase6(args, lds, G, bx, tid, lane, wave); } PH_END(6);
    PH_BEGIN(7) {
        unsigned char* ob = (unsigned char*)args.out;
        { pg8::Gemm g{(const bf16*)(ws + WS_CQ), (const bf16*)(ws + WS_WUQ), NLAT, 768, 768}; pg8::StaticOrder S; S.init(NLAT, 768, G, bx);
          pg8::EpiScale E{(bf16*)(ob + OUT_Q), 768, (const float*)(ws + WS_RSTDQ), nullptr}; pg8::gemm_phase<pg8::EpiScale, pg8::StaticOrder, true, true>(lds, g, S, E); }
        { pg8::Gemm g{(const bf16*)(ws + WS_CKV), (const bf16*)(ws + WS_WK), MTOT, 512, 256}; pg8::StaticOrder S; S.init(MTOT, 512, G, (bx + 128) % G);
          pg8::EpiScale E{(bf16*)(ob + OUT_KN), 512, (const float*)(ws + WS_RSTDKV), nullptr}; pg8::gemm_phase<pg8::EpiScale, pg8::StaticOrder, true, true>(lds, g, S, E); }
        { pg8::Gemm g{(const bf16*)(ws + WS_WV), (const bf16*)(ws + WS_CKV), 512, MTOT, 256}; pg8::StaticOrder S; S.init(512, MTOT, G, (bx + 112) % G);
          pg8::EpiScale E{(bf16*)(ob + OUT_VT), MTOT, nullptr, (const float*)(ws + WS_RSTDKV)}; pg8::gemm_phase<pg8::EpiScale, pg8::StaticOrder, true, true>(lds, g, S, E); }
        phase8(args, lds, G, bx, tid, lane, wave);
    } PH_END(7);
    PH_BEGIN(9) { phase9(args, G, bx, tid); } PH_END(9);
    PH_BEGIN(10) {
#ifndef NO_SSD
        for (int r2 = 0; r2 < (PROBE_PHASE == 100 ? 2 : 1); ++r2) phase10_ssd(args, lds, G, bx, tid, lane, wave);
#endif

        STAMP(17);
#ifndef NO_ATTN
        for (int r2 = 0; r2 < (PROBE_PHASE == 101 ? 2 : 1); ++r2) phase10_attn(args, lds, G, vcu, tid, lane, wave);
#endif
    } PH_END(10);
    PH_BEGIN(11) { pg8::Gemm g{(const bf16*)(ws + WS_MIX), (const bf16*)(ws + WS_WOUT), NLAT, D, D}; pg8::StaticOrder S; S.init(NLAT, D, G, bx);
        pg8::EpiRes<true, true> E{X1, X1, X1, MOD, 5, 1.0f}; pg8::gemm_phase<pg8::EpiRes<true, true>, pg8::StaticOrder, RES_ALIGN, true>(lds, g, S, E); } PH_END(11);
    PH_BEGIN(12) { norm_rows<true>(X1, X1, NLAT, args.in[22], MOD, 6, XN, gw, NGW, lane); } PH_END(12);
    PH_BEGIN(13) { pg8::Gemm g{XN, (const bf16*)(ws + WS_W2A), NLAT, 2 * DFF, D}; pg8::StaticOrder S; S.init(NLAT, 2 * DFF, G, bx);
        pg8::EpiSwiglu E{HB, DFF}; pg8::gemm_phase<pg8::EpiSwiglu, pg8::StaticOrder, true, true>(lds, g, S, E); } PH_END(13);
    PH_BEGIN(14) { pg8::Gemm g{HB, (const bf16*)(ws + WS_W2B), NLAT, D, DFF}; pg8::StaticOrder S; S.init(NLAT, D, G, bx);
        pg8::EpiRes<true, false> E{X1, X1, args.out, MOD, 8, 0.5f}; pg8::gemm_phase<pg8::EpiRes<true, false>, pg8::StaticOrder, RES_ALIGN, true>(lds, g, S, E); } PH_END(14);
    PH_BEGIN(15) { final_norm_rows(args.out, args.in[25], gw, NGW, lane); } PH_END(15);
#if defined(PROBE_TA)
    xcd_barrier(xbar);
    if (bx == 0) {
        const unsigned long long* TS = (const unsigned long long*)(ws + 480 * KiB);
#ifdef PROBE_A1
        const int a0 = PROBE_TA, b0 = PROBE_TB;
#undef PROBE_TA
#undef PROBE_TB
#define PROBE_TA (PROBE_A1 - 1)
#define PROBE_TB (PROBE_B1 - 1)
#else
        const int a0 = (PROBE_TA == 9) ? 8 : (PROBE_TA == 16 ? 10 : PROBE_TA), b0 = (PROBE_TB == 9) ? 8 : PROBE_TB;
#endif
        const float ta = (float)(__hip_atomic_load(TS + PROBE_TA + 1, __ATOMIC_RELAXED, __HIP_MEMORY_SCOPE_AGENT) - __hip_atomic_load(TS + a0, __ATOMIC_RELAXED, __HIP_MEMORY_SCOPE_AGENT)) * 0.01f;
        const float tb = (float)(__hip_atomic_load(TS + PROBE_TB + 1, __ATOMIC_RELAXED, __HIP_MEMORY_SCOPE_AGENT) - __hip_atomic_load(TS + b0, __ATOMIC_RELAXED, __HIP_MEMORY_SCOPE_AGENT)) * 0.01f;
        for (int i = tid; i < 1024 * 1024; i += 512) args.out[i] += ta * (1.f / 2000.f);
        if (tid == 0) args.out[2000 * 1024] += tb * (1.f / 500.f);
    }
#endif
#undef IN
#undef SEAM
}

#ifndef N_LAUNCHES
#define N_LAUNCHES 1
#endif
extern "C" void kernel_launch(void* const* d_in, const int* in_sizes, int n_in, void* d_out, int out_size, void* d_ws, size_t ws_size, hipStream_t stream) {
    static int grid = 0;
    if (grid == 0) {
        if (n_in != 26 || out_size != NLAT * D || ws_size < WS_END) { fprintf(stderr, "kernel_launch: unexpected shapes (n_in %d out %d ws %zu)\n", n_in, out_size, ws_size); grid = -1; return; }
        int dev = 0, cus = 0, per_cu = 0;
        (void)hipGetDevice(&dev); (void)hipDeviceGetAttribute(&cus, hipDeviceAttributeMultiprocessorCount, dev);
        if (hipFuncSetAttribute((const void*)hymba_fwd, hipFuncAttributeMaxDynamicSharedMemorySize, LDS_BYTES) != hipSuccess) { fprintf(stderr, "kernel_launch: hipFuncSetAttribute failed\n"); grid = -1; return; }
        if (hipOccupancyMaxActiveBlocksPerMultiprocessor(&per_cu, (const void*)hymba_fwd, 512, LDS_BYTES) != hipSuccess || per_cu < 1) { fprintf(stderr, "kernel_launch: occupancy query failed (%d)\n", per_cu); grid = -1; (void)hipGetLastError(); return; }
        grid = cus;
    }
    if (grid < 0) return;
    (void)hipMemsetAsync((char*)d_ws + WS_BAR, 0, 16 * KiB, stream);
    Args a{};
    for (int i = 0; i < 26; ++i) a.in[i] = (const float*)d_in[i];
    a.out = (float*)d_out; a.ws = (unsigned char*)d_ws;
    for (int li = 0; li < N_LAUNCHES; ++li) {
        a.ph_lo = (N_LAUNCHES == 1) ? 0 : li; a.ph_hi = (N_LAUNCHES == 1) ? NPHASE : li + 1;
        void* kargs[] = {&a};
        hipError_t e = hipLaunchCooperativeKernel((const void*)hymba_fwd, dim3(grid), dim3(512), kargs, LDS_BYTES, stream);
        if (e != hipSuccess) { fprintf(stderr, "kernel_launch: cooperative launch %d failed: %s (grid %d)\n", li, hipGetErrorString(e), grid); break; }
    }
}
```
